# Optimizing an MI355X kernel written in HIP

```python
import math
import jax, jax.numpy as jnp
from jax import lax
import numpy as np

D_MODEL = 1024
BATCH = 8
SEQ = 2048
DEPTH = 2

MOBA_HEADS = 8
HEAD_DIM = 64
MOBA_BLOCK = 256
MOBA_TOPK = 3
MOBA_Q_CHUNK = 16
MLA_HEADS = 8
MLA_Q_LORA = 384
MLA_KV_LORA = 256
MLA_NOPE = 64
MLA_ROPE = 32
MLA_V = 64
ROPE_THETA = 10000.0
DIFF_HEADS = 4
DIFF_QK = 64
DIFF_V = 2 * DIFF_QK
PLE_DIM = 256
Q_BLOCK = 128
NORM_EPS = 1e-5
NEG = -1e30

MOBA_W = MOBA_HEADS * HEAD_DIM
MLA_W = MLA_HEADS * MLA_V
DIFF_W = DIFF_HEADS * DIFF_V
DIFF_QK_W = DIFF_HEADS * 2 * DIFF_QK
IN_SIZES = (MOBA_W, MOBA_W, MOBA_W, MOBA_W,
            MLA_Q_LORA, MLA_KV_LORA, MLA_ROPE, MLA_W,
            DIFF_QK_W, DIFF_QK_W, DIFF_W, DIFF_W)
IN_WIDTH = sum(IN_SIZES)
N_BRANCH = 3
ALPHA = (2 * DEPTH) ** 0.25
BETA = (8 * DEPTH) ** -0.25

kernel_name = 'hybrid_moba_mla_diff_gated_deepnorm'


def _split_points():
    return [int(v) for v in np.cumsum(np.array(IN_SIZES))[:-1]]


def _alibi_slopes():
    n = MOBA_HEADS + DIFF_HEADS
    s = 2.0 ** (-8.0 * (np.arange(n) + 1) / n)
    diff_idx = np.arange(DIFF_HEADS) * (n // DIFF_HEADS)
    moba_idx = np.setdiff1d(np.arange(n), diff_idx)
    return (jnp.asarray(s[moba_idx], dtype=jnp.float32),
            jnp.asarray(s[diff_idx], dtype=jnp.float32))


def _rmsnorm(x, g, eps=1e-6):
    xf = x.astype(jnp.float32)
    y = xf * lax.rsqrt(jnp.mean(xf * xf, axis=-1, keepdims=True) + eps)
    return (y * g.astype(jnp.float32)).astype(x.dtype)


def _layernorm(x, g, b):
    xf = x.astype(jnp.float32)
    mu = jnp.mean(xf, axis=-1, keepdims=True)
    var = jnp.mean(jnp.square(xf - mu), axis=-1, keepdims=True)
    y = (xf - mu) * lax.rsqrt(var + NORM_EPS)
    return (y * g.astype(jnp.float32) + b.astype(jnp.float32)).astype(x.dtype)


def _rope(t, pos):
    d = t.shape[-1]
    freqs = ROPE_THETA ** (-jnp.arange(0, d, 2, dtype=jnp.float32) / d)
    ang = pos.astype(jnp.float32)[:, None] * freqs[None, :]
    cos, sin = jnp.cos(ang), jnp.sin(ang)
    tf = t.astype(jnp.float32)
    t1, t2 = tf[..., : d // 2], tf[..., d // 2:]
    return jnp.concatenate([t1 * cos - t2 * sin, t1 * sin + t2 * cos], axis=-1).astype(t.dtype)


def _split_heads(t, n):
    B, S, _ = t.shape
    return t.reshape(B, S, n, -1).transpose(0, 2, 1, 3)


def _merge_heads(t):
    B, H, S, d = t.shape
    return t.transpose(0, 2, 1, 3).reshape(B, S, H * d)


def moba_attention(q, k, v, slopes):
    B, H, S, dh = q.shape
    blk = MOBA_BLOCK
    nb = -(-S // blk)
    s_pad = nb * blk
    padw = ((0, 0), (0, 0), (0, s_pad - S), (0, 0))
    kp = jnp.pad(k, padw)
    vp = jnp.pad(v, padw)
    kb = kp.reshape(B, H, nb, blk, dh)
    vb = vp.reshape(B, H, nb, blk, dh)
    kmean = jnp.mean(kb.astype(jnp.float32), axis=3)
    pos = jnp.arange(S)
    gate = jnp.einsum('bhsd,bhnd->bhsn', q.astype(jnp.float32), kmean)
    past = jnp.arange(nb)[None, :] < (pos // blk)[:, None]
    gate = jnp.where(past, gate, -jnp.inf)
    kk = min(MOBA_TOPK, nb)
    _, sel = lax.top_k(gate, kk)

    C = MOBA_Q_CHUNK
    nc = S // C
    qc = q.reshape(B, H, nc, C, dh).transpose(2, 0, 1, 3, 4)
    selc = sel.reshape(B, H, nc, C, kk).transpose(2, 0, 1, 3, 4)
    bi = jnp.arange(B)[:, None, None, None]
    hi = jnp.arange(H)[None, :, None, None]
    scale = dh ** -0.5
    offs = jnp.arange(blk)

    def one(args):
        qi, si, c = args
        qpos = c * C + jnp.arange(C)
        ob = (c * C) // blk
        kg = kb[bi, hi, si]
        vg = vb[bi, hi, si]
        s_sel = jnp.einsum('bhqd,bhqjkd->bhqjk', qi, kg).astype(jnp.float32) * scale
        kpos_sel = si[..., None] * blk + offs
        dist_sel = (qpos[None, None, :, None, None] - kpos_sel).astype(jnp.float32)
        s_sel = s_sel - slopes[None, :, None, None, None] * dist_sel
        valid = jnp.arange(kk)[None, :] < (qpos // blk)[:, None]
        s_sel = jnp.where(valid[None, None, :, :, None], s_sel, NEG)
        ko = lax.dynamic_slice_in_dim(kp, ob * blk, blk, axis=2)
        vo = lax.dynamic_slice_in_dim(vp, ob * blk, blk, axis=2)
        dist_own = (qpos[:, None] - (ob * blk + offs)[None, :]).astype(jnp.float32)
        s_own = jnp.einsum('bhqd,bhkd->bhqk', qi, ko).astype(jnp.float32) * scale
        s_own = s_own - slopes[None, :, None, None] * dist_own
        s_own = jnp.where(dist_own >= 0, s_own, NEG)
        s_all = jnp.concatenate([s_sel.reshape(B, H, C, kk * blk), s_own], axis=-1)
        pr = jax.nn.softmax(s_all, axis=-1).astype(v.dtype)
        p_sel = pr[..., : kk * blk].reshape(B, H, C, kk, blk)
        p_own = pr[..., kk * blk:]
        return (jnp.einsum('bhqjk,bhqjkd->bhqd', p_sel, vg)
                + jnp.einsum('bhqk,bhkd->bhqd', p_own, vo))

    out = lax.map(one, (qc, selc, jnp.arange(nc)))
    return out.transpose(1, 2, 0, 3, 4).reshape(B, H, S, dh)


def mla_attention(q, k, v):
    B, H, S, dq = q.shape
    nq = S // Q_BLOCK
    scale = dq ** -0.5
    qb = q.reshape(B, H, nq, Q_BLOCK, dq).transpose(2, 0, 1, 3, 4)
    kpos = jnp.arange(S)

    def one(args):
        qi, i = args
        qpos = i * Q_BLOCK + jnp.arange(Q_BLOCK)
        s = jnp.einsum('bhqd,bhkd->bhqk', qi, k).astype(jnp.float32) * scale
        s = jnp.where(kpos[None, :] <= qpos[:, None], s, NEG)
        pr = jax.nn.softmax(s, axis=-1).astype(v.dtype)
        return jnp.einsum('bhqk,bhkd->bhqd', pr, v)

    out = lax.map(one, (qb, jnp.arange(nq)))
    return out.transpose(1, 2, 0, 3, 4).reshape(B, H, S, -1)


def diff_attention(q, k, v, slopes, lam):
    B, H, S = q.shape[:3]
    nq = S // Q_BLOCK
    scale = DIFF_QK ** -0.5
    qb = q.reshape(B, H, nq, Q_BLOCK, 2, DIFF_QK).transpose(2, 0, 1, 3, 4, 5)
    kpos = jnp.arange(S)

    def one(args):
        qi, i = args
        qpos = i * Q_BLOCK + jnp.arange(Q_BLOCK)
        dist = (qpos[:, None] - kpos[None, :]).astype(jnp.float32)
        s = jnp.einsum('bhqcd,bhkcd->bhcqk', qi, k).astype(jnp.float32) * scale
        s = s - slopes[None, :, None, None, None] * dist
        s = jnp.where(dist >= 0, s, NEG)
        pr = jax.nn.softmax(s, axis=-1)
        a = (pr[:, :, 0] - lam * pr[:, :, 1]).astype(v.dtype)
        return jnp.einsum('bhqk,bhkd->bhqd', a, v)

    out = lax.map(one, (qb, jnp.arange(nq)))
    return out.transpose(1, 2, 0, 3, 4).reshape(B, H, S, -1)


def _layer(x, p_i, li, w_in, gq, gkv, w_uq, w_ukv, lam_p, subln_g, w_a, w_b, w_c,
           w_m, b_m, w_o, ln_g, ln_b, w_pg, w_p, slopes_a, slopes_c):
    B, S, D = x.shape
    pos = jnp.arange(S)
    h = x @ w_in
    (a_q, a_k, a_v, a_z, b_cq, b_ckv, b_kr, b_z,
     c_q, c_k, c_v, c_z) = jnp.split(h, _split_points(), axis=-1)

    ya = moba_attention(_split_heads(a_q, MOBA_HEADS), _split_heads(a_k, MOBA_HEADS),
                        _split_heads(a_v, MOBA_HEADS), slopes_a)
    ya = _merge_heads(ya) * jax.nn.silu(a_z)

    cq = _rmsnorm(b_cq, gq)
    ckv = _rmsnorm(b_ckv, gkv)
    qh = _split_heads(cq @ w_uq, MLA_HEADS)
    q_b = jnp.concatenate([qh[..., :MLA_NOPE], _rope(qh[..., MLA_NOPE:], pos)], axis=-1)
    kvh = _split_heads(ckv @ w_ukv, MLA_HEADS)
    k_rope = _rope(b_kr[:, None], pos)
    k_b = jnp.concatenate([kvh[..., :MLA_NOPE],
                           jnp.broadcast_to(k_rope, (B, MLA_HEADS, S, MLA_ROPE))], axis=-1)
    yb = mla_attention(q_b, k_b, kvh[..., MLA_NOPE:])
    yb = _merge_heads(yb) * jax.nn.silu(b_z)

    lam_init = 0.8 - 0.6 * math.exp(-0.3 * li)
    lf = lam_p.astype(jnp.float32)
    lam = (jnp.exp(jnp.sum(lf[0] * lf[1])) - jnp.exp(jnp.sum(lf[2] * lf[3])) + lam_init)
    qc = c_q.reshape(B, S, DIFF_HEADS, 2, DIFF_QK).transpose(0, 2, 1, 3, 4)
    kc = c_k.reshape(B, S, DIFF_HEADS, 2, DIFF_QK).transpose(0, 2, 1, 3, 4)
    yc = diff_attention(qc, kc, _split_heads(c_v, DIFF_HEADS), slopes_c, lam)
    yc = _rmsnorm(yc, subln_g, eps=1e-5) * (1.0 - lam_init)
    yc = _merge_heads(yc) * jax.nn.silu(c_z)

    g = jax.nn.sigmoid(x @ w_m + b_m)
    ga, gb, gc = jnp.split(g, N_BRANCH, axis=-1)
    merged = ga * (ya @ w_a) + gb * (yb @ w_b) + gc * (yc @ w_c)
    out = merged @ w_o

    r = ALPHA * x + out
    r = r + jax.nn.sigmoid(r @ w_pg) * (p_i @ w_p)
    return _layernorm(r, ln_g, ln_b)


def setup_inputs(seed: int = 0) -> dict:
    key = jax.random.key(seed)
    ks = jax.random.split(key, 20)
    f32 = jnp.float32

    def nrm(k, shape, scale):
        return jax.random.normal(k, shape, f32) * scale

    L, D = DEPTH, D_MODEL
    return {
        'x': nrm(ks[0], (BATCH, SEQ, D), 1.0),
        'p': nrm(ks[1], (L, BATCH, SEQ, PLE_DIM), 1.0),
        'w_in': nrm(ks[2], (L, D, IN_WIDTH), D ** -0.5),
        'mla_q_norm_g': 1.0 + nrm(ks[3], (L, MLA_Q_LORA), 0.01),
        'mla_kv_norm_g': 1.0 + nrm(ks[4], (L, MLA_KV_LORA), 0.01),
        'mla_w_uq': nrm(ks[5], (L, MLA_Q_LORA, MLA_HEADS * (MLA_NOPE + MLA_ROPE)), MLA_Q_LORA ** -0.5),
        'mla_w_ukv': nrm(ks[6], (L, MLA_KV_LORA, MLA_HEADS * (MLA_NOPE + MLA_V)), MLA_KV_LORA ** -0.5),
        'diff_lambda': nrm(ks[7], (L, 4, DIFF_QK), 0.1),
        'diff_subln_g': 1.0 + nrm(ks[8], (L, DIFF_V), 0.01),
        'w_branch_a': nrm(ks[9], (L, MOBA_W, D), BETA * MOBA_W ** -0.5),
        'w_branch_b': nrm(ks[10], (L, MLA_W, D), BETA * MLA_W ** -0.5),
        'w_branch_c': nrm(ks[11], (L, DIFF_W, D), BETA * DIFF_W ** -0.5),
        'w_merge': nrm(ks[12], (L, D, N_BRANCH * D), D ** -0.5),
        'b_merge': nrm(ks[13], (L, N_BRANCH * D), 0.01),
        'w_out': nrm(ks[14], (L, D, D), BETA * D ** -0.5),
        'ln_g': 1.0 + nrm(ks[15], (L, D), 0.01),
        'ln_b': nrm(ks[16], (L, D), 0.01),
        'w_ple_gate': nrm(ks[17], (L, D, D), D ** -0.5),
        'w_ple': nrm(ks[18], (L, PLE_DIM, D), BETA * PLE_DIM ** -0.5),
    }


def reference(x, p, w_in, mla_q_norm_g, mla_kv_norm_g, mla_w_uq, mla_w_ukv, diff_lambda,
              diff_subln_g, w_branch_a, w_branch_b, w_branch_c, w_merge, b_merge, w_out,
              ln_g, ln_b, w_ple_gate, w_ple):
    slopes_a, slopes_c = _alibi_slopes()
    h = x
    for i in range(DEPTH):
        h = _layer(h, p[i], i, w_in[i], mla_q_norm_g[i], mla_kv_norm_g[i], mla_w_uq[i],
                   mla_w_ukv[i], diff_lambda[i], diff_subln_g[i], w_branch_a[i], w_branch_b[i],
                   w_branch_c[i], w_merge[i], b_merge[i], w_out[i], ln_g[i], ln_b[i],
                   w_ple_gate[i], w_ple[i], slopes_a, slopes_c)
    return h
```

```cpp
#include <hip/hip_runtime.h>
#include <hip/hip_cooperative_groups.h>
#include <cstdio>
#include <cstdint>
namespace cg = cooperative_groups;
#ifndef REP_ATT
#define REP_ATT 1
#endif
#ifndef REP_P1
#define REP_P1 1
#endif
#ifndef REP_P0
#define REP_P0 1
#endif

#define LAS __attribute__((address_space(3)))
#define DI __device__ __forceinline__
typedef unsigned short bf16_t;
typedef short bf16x8 __attribute__((ext_vector_type(8)));
typedef short s16x4 __attribute__((ext_vector_type(4)));
typedef float f32x2 __attribute__((ext_vector_type(2)));
typedef float f32x4 __attribute__((ext_vector_type(4)));
typedef float f32x16 __attribute__((ext_vector_type(16)));
typedef unsigned u32x4 __attribute__((ext_vector_type(4)));
typedef unsigned u32x2 __attribute__((ext_vector_type(2)));
typedef __bf16 bf16x2_t __attribute__((ext_vector_type(2)));

constexpr int M = 16384, D = 1024, SEQ = 2048, HM = 8192;
constexpr int HP = 2304;
constexpr int NH1 = 5376;
constexpr int NWIN = 8448;
constexpr float LOG2E = 1.4426950408889634f;
constexpr float QS64 = 0.125f * LOG2E;
constexpr float QS96 = 0.10206207261596575f * LOG2E;
constexpr float ALPHA = 1.4142135623730951f;
constexpr int C_AZ = 0, C_BZ = 512, C_CZ = 1024, C_CKV = 1536, C_CQL = 1792;
constexpr size_t HM_AQ = (size_t)18 * 1048576, HM_AK = (size_t)22 * 1048576, HM_AV = (size_t)26 * 1048576, HM_CQ = (size_t)30 * 1048576, HM_CK = (size_t)34 * 1048576, HM_CV = (size_t)38 * 1048576;

constexpr size_t MiB = 1048576;
constexpr size_t WS_CTL = 0, WS_XB = 2 * MiB, WS_WT = 34 * MiB, WS_PB = 60 * MiB, WS_Y = 68 * MiB, WS_H = 116 * MiB, WS_MLA = 200 * MiB, WS_END = 232 * MiB;
constexpr size_t CTL_BAR = 16384, CTL_LAM = 4096, CTL_ROPE = 65536, CTL_KMP = 384 * 1024, CTL_STQ = 640 * 1024, CTL_STKV = 1152 * 1024;
constexpr size_t OFF_WIN = 0, OFF_WUQ = 8650752, OFF_WUKV = 8945664, OFF_WABC = 9207808, OFF_WO = 10780672, OFF_WPG = 11829248, OFF_WP = 12877824;
constexpr int LDS_BYTES = 132 * 1024, LDS_IDX = 131072;

DI int opaque_s(int v) { asm volatile("" : "+s"(v)); return v; }
DI int opaque_tid() { int t = threadIdx.x; asm volatile("" : "+v"(t)); return t; }
DI unsigned pk2(float lo, float hi) { f32x2 v = {lo, hi}; bf16x2_t b = __builtin_convertvector(v, bf16x2_t); return __builtin_bit_cast(unsigned, b); }
DI float bflo(unsigned w) { return __uint_as_float(w << 16); }
DI float bfhi(unsigned w) { return __uint_as_float(w & 0xffff0000u); }
DI float bf2f(bf16_t b) { return __uint_as_float((unsigned)b << 16); }
DI bf16_t f2bf(float f) { return (bf16_t)(pk2(f, 0.f) & 0xffffu); }
DI float sigm(float x) { return __builtin_amdgcn_rcpf(1.f + __builtin_amdgcn_exp2f(-x * LOG2E)); }
DI float silu(float x) { return x * sigm(x); }
DI u32x4 pack8(const f32x4 a, const f32x4 b) { u32x4 w; w.x = pk2(a[0], a[1]); w.y = pk2(a[2], a[3]); w.z = pk2(b[0], b[1]); w.w = pk2(b[2], b[3]); return w; }
DI void unpack8(const u32x4 w, f32x4& a, f32x4& b) { a = (f32x4){bflo(w.x), bfhi(w.x), bflo(w.y), bfhi(w.y)}; b = (f32x4){bflo(w.z), bfhi(w.z), bflo(w.w), bfhi(w.w)}; }

namespace pg8 {
constexpr int BM = 256, BK = 64, HALF = 128, HTB = HALF * BK * 2, NXCD = 8, WGM = 8;
__host__ __device__ __forceinline__ int lds_byte(int r, int c) { const int st = (r >> 4) * 2 + (c >> 5), rr = r & 15, cc = c & 31, ob = rr * 64 + cc * 2; return st * 1024 + (ob ^ (((ob >> 9) & 1) << 5)); }
__host__ __device__ __forceinline__ void stage_rc(int b, int& R, int& C) { const int st = b / 1024, sb = b % 1024, swz = sb ^ (((sb >> 9) & 1) << 5); R = (st >> 1) * 16 + swz / 64; C = (st & 1) * 32 + (swz % 64) / 2; }
__host__ __device__ __forceinline__ int perm32(int rho) { const int n = rho >> 4, i = rho & 15; return 8 * (i >> 2) + 4 * n + (i & 3); }

struct Unit { int pm, pn; };
struct Gemm { const bf16_t* A; const bf16_t* Bt; int lda, K; };

struct StaticOrder {
    int nM, nN, nwg, G, c;
    DI void init(int M_, int N_, int G_, int c_) { nM = M_ / BM; nN = N_ / BM; nwg = nM * nN; G = G_; c = c_; }
    DI bool next(int i, Unit& u) const {
        const long L = (long)i * G + c; if (L >= nwg) return false;
        int wgid = (int)L; { const int q = nwg / NXCD, r = nwg % NXCD, xcd = wgid % NXCD, off = wgid / NXCD; wgid = (xcd < r ? xcd * (q + 1) : r * (q + 1) + (xcd - r) * q) + off; }
        const int nig = WGM * nN, gid = wgid / nig, fm = gid * WGM, gsz = (nM - fm) < WGM ? (nM - fm) : WGM;
        u.pm = fm + ((wgid % nig) % gsz); u.pn = (wgid % nig) / gsz; return true;
    }
};
struct ListOrder {
    int lo, hi, nN, c, G;
    DI bool next(int i, Unit& u) const {
        int k0 = 0; if (c < lo) k0 = (lo - c + G - 1) / G;
        const int idx = c + (k0 + i) * G; if (idx >= hi) return false;
        const int loc = idx - lo; u.pm = loc / nN; u.pn = loc % nN; return true;
    }
};
struct MergeOrder {
    int c, G;
    DI bool next(int i, Unit& u) const {
        const int tile = c + (i / 3) * G, br = i % 3; if (tile >= 256) return false;
        u.pm = br * 64 + (tile >> 2); u.pn = br * 4 + (tile & 3); return true;
    }
};

template <class Epi, class Sched>
DI void gemm_phase(LAS unsigned char* lds, const Gemm g, const Sched& S, const Epi& E) {
    const int tid = opaque_tid(), wid = __builtin_amdgcn_readfirstlane(tid >> 6), lane = tid & 63, wr = wid >> 2, wc = wid & 3, fr = lane & 15, fq = lane >> 4;
    const int K = g.K, nt = K / BK, lda = g.lda;
    unsigned voffA[2], voffB[2];
#pragma unroll
    for (int i = 0; i < 2; ++i) { int R, C; stage_rc(tid * 16 + i * 8192, R, C); const int Rb = (R & ~31) + perm32(R & 31);
        voffA[i] = (unsigned)(R * lda + C) * 2u; voffB[i] = (unsigned)(Rb * K + C) * 2u; }
    const size_t kstep = (size_t)(BK * 2);
    const size_t hstepA = (size_t)HALF * lda * 2, hstepB = (size_t)HALF * K * 2;
    const size_t tstepA = 2 * hstepA, tstepB = 2 * hstepB;
    const unsigned ldsw = (unsigned)wid * 1024u;
    const int aoff = lds_byte(wr * 64 + fr, fq * 8), boff = lds_byte(wc * 32 + fr, fq * 8);
#define PG8_SA(b, h) (((b) * 2 + (h)) * HTB)
#define PG8_SB(b, h) ((4 + (b) * 2 + (h)) * HTB)
#define PG8_STAGE(bufoff, gbase, voff) do { _Pragma("unroll") for (int _i = 0; _i < 2; ++_i) \
        __builtin_amdgcn_global_load_lds((const unsigned*)((const char*)(gbase) + (voff)[_i]), (LAS unsigned*)(lds + (bufoff) + ldsw + _i * 8192), 16, 0, 0); } while (0)
#define PG8_LDA(dst, b, h) do { _Pragma("unroll") for (int m = 0; m < 4; ++m) _Pragma("unroll") for (int k = 0; k < 2; ++k) dst[m][k] = *(const LAS bf16x8*)(lds + PG8_SA(b, h) + aoff + m * 2048 + k * 1024); } while (0)
#define PG8_LDB(dst, b, h) do { _Pragma("unroll") for (int n = 0; n < 2; ++n) _Pragma("unroll") for (int k = 0; k < 2; ++k) dst[n][k] = *(const LAS bf16x8*)(lds + PG8_SB(b, h) + boff + n * 2048 + k * 1024); } while (0)
#define PG8_MMA(ai, bj, At, Bt) do { __builtin_amdgcn_s_setprio(1); _Pragma("unroll") for (int m = 0; m < 4; ++m) _Pragma("unroll") for (int n = 0; n < 2; ++n) _Pragma("unroll") for (int k = 0; k < 2; ++k) \
        acc[ai][bj][m][n] = __builtin_amdgcn_mfma_f32_16x16x32_bf16(Bt[n][k], At[m][k], acc[ai][bj][m][n], 0, 0, 0); __builtin_amdgcn_s_setprio(0); } while (0)
#define PG8_WAIT_V(n) asm volatile("s_waitcnt vmcnt(" #n ")" ::: "memory")
#define PG8_WAIT_L(n) asm volatile("s_waitcnt lgkmcnt(" #n ")" ::: "memory")
#define PG8_BAR __builtin_amdgcn_s_barrier()
#define PG8_SCHED __builtin_amdgcn_sched_barrier(0)
    Unit cur, nxt; int ui = 0;
    if (!S.next(0, cur)) return;
    f32x4 acc[2][2][4][2];
#pragma unroll
    for (int a = 0; a < 2; ++a)
#pragma unroll
        for (int b = 0; b < 2; ++b)
#pragma unroll
            for (int m = 0; m < 4; ++m)
#pragma unroll
                for (int n = 0; n < 2; ++n) acc[a][b][m][n] = (f32x4){0.f, 0.f, 0.f, 0.f};
    bf16x8 At[4][2], B0[2][2], B1[2][2];
    const char* cA = (const char*)g.A + (size_t)cur.pm * tstepA; const char* cB = (const char*)g.Bt + (size_t)cur.pn * tstepB;
    PG8_STAGE(PG8_SB(0, 0), cB, voffB); PG8_STAGE(PG8_SB(0, 1), cB + hstepB, voffB); PG8_STAGE(PG8_SA(0, 0), cA, voffA); PG8_STAGE(PG8_SA(0, 1), cA + hstepA, voffA);
    if (wr == 1) PG8_BAR;
    PG8_WAIT_V(2); PG8_BAR;
    PG8_STAGE(PG8_SB(1, 0), cB + kstep, voffB); PG8_STAGE(PG8_SA(1, 0), cA + kstep, voffA); PG8_STAGE(PG8_SB(1, 1), cB + hstepB + kstep, voffB);
    PG8_WAIT_V(6); PG8_BAR;
    for (;;) {
        const bool has_next = S.next(ui + 1, nxt);
        const char* nA = has_next ? (const char*)g.A + (size_t)nxt.pm * tstepA : cA; const char* nB = has_next ? (const char*)g.Bt + (size_t)nxt.pn * tstepB : cB;
#pragma nounroll
        for (int t = 0; t < nt; t += 2) {
            const bool last = (t == nt - 2);
            const char* a1 = cA + (size_t)(t + 1) * kstep;
            const char* a2 = last ? nA : cA + (size_t)(t + 2) * kstep; const char* b2 = last ? nB : cB + (size_t)(t + 2) * kstep;
            const char* a3 = a2 + kstep; const char* b3 = b2 + kstep;
            PG8_LDB(B0, 0, 0); PG8_LDB(B1, 0, 1); PG8_SCHED; PG8_LDA(At, 0, 0); PG8_STAGE(PG8_SA(1, 1), a1 + hstepA, voffA);
            PG8_WAIT_V(8); PG8_WAIT_L(0); PG8_BAR; PG8_MMA(0, 0, At, B0); PG8_MMA(0, 1, At, B1); PG8_BAR; PG8_SCHED;
            PG8_LDA(At, 0, 1); PG8_STAGE(PG8_SB(0, 0), b2, voffB); PG8_STAGE(PG8_SB(0, 1), b2 + hstepB, voffB); PG8_STAGE(PG8_SA(0, 0), a2, voffA);
            PG8_WAIT_V(8); PG8_WAIT_L(0); PG8_BAR; PG8_MMA(1, 0, At, B0); PG8_MMA(1, 1, At, B1); PG8_BAR; PG8_SCHED;
            PG8_LDB(B0, 1, 0); PG8_LDB(B1, 1, 1); PG8_SCHED; PG8_LDA(At, 1, 0); PG8_STAGE(PG8_SA(0, 1), a2 + hstepA, voffA);
            PG8_WAIT_V(8); PG8_WAIT_L(0); PG8_BAR; PG8_MMA(0, 0, At, B0); PG8_MMA(0, 1, At, B1); PG8_BAR; PG8_SCHED;
            PG8_LDA(At, 1, 1); PG8_STAGE(PG8_SB(1, 0), b3, voffB); PG8_STAGE(PG8_SB(1, 1), b3 + hstepB, voffB); PG8_STAGE(PG8_SA(1, 0), a3, voffA);
            PG8_WAIT_V(8); PG8_WAIT_L(0); PG8_BAR; PG8_MMA(1, 0, At, B0); PG8_MMA(1, 1, At, B1); PG8_BAR; PG8_SCHED;
        }
        if (wr == 0) PG8_BAR;
        E(acc, cur, wr, wc, fr, fq);
        if (!has_next) break;
#pragma unroll
        for (int a = 0; a < 2; ++a)
#pragma unroll
            for (int b = 0; b < 2; ++b)
#pragma unroll
                for (int m = 0; m < 4; ++m)
#pragma unroll
                    for (int n = 0; n < 2; ++n) acc[a][b][m][n] = (f32x4){0.f, 0.f, 0.f, 0.f};
        cur = nxt; cA = nA; cB = nB; ++ui;
        if (wr == 1) PG8_BAR;
    }
    PG8_WAIT_V(0);
    PG8_BAR;
#undef PG8_SA
#undef PG8_SB
#undef PG8_STAGE
#undef PG8_LDA
#undef PG8_LDB
#undef PG8_MMA
#undef PG8_WAIT_V
#undef PG8_WAIT_L
#undef PG8_BAR
#undef PG8_SCHED
}
typedef f32x4 Acc[2][2][4][2];

struct EpiH {
    bf16_t* H; bf16_t* KB; float* KMP; float* STQ; float* STKV; const float* rope;
    DI void operator()(const Acc& acc, const Unit& u, int wr, int wc, int fr, int fq) const {
        const int row0 = u.pm * BM + wr * 64 + fr;
        {
            const int pn = u.pn; bf16_t* base; int hw = 0, cseg;
            if (pn < 6) { base = H + (pn < 2 ? HM_AQ : pn < 4 ? HM_AK : HM_AV); hw = 64; cseg = (pn & 1) * 256; }
            else if (pn < 10) { base = H + (pn < 8 ? C_AZ : C_BZ); cseg = (pn & 1) * 256; }
            else if (pn < 16) { base = H + (pn < 12 ? HM_CQ : pn < 14 ? HM_CK : HM_CV); hw = 128; cseg = (pn & 1) * 256; }
            else if (pn < 18) { base = H + C_CZ; cseg = (pn & 1) * 256; }
            else { base = H + C_CKV; cseg = (pn - 18) * 256; }
            const int bl = u.pm >> 3, s0 = (u.pm & 7) * 256 + wr * 64 + fr;
#pragma unroll
            for (int bj = 0; bj < 2; ++bj) { const int cs = cseg + bj * HALF + wc * 32 + 8 * fq;
                bf16_t* colp; size_t pitch;
                if (hw == 64) { colp = base + ((size_t)(bl * 8 + (cs >> 6)) * SEQ) * 64 + (cs & 63); pitch = 64; }
                else if (hw == 128) { colp = base + ((size_t)(bl * 4 + (cs >> 7)) * SEQ) * 128 + (cs & 127); pitch = 128; }
                else { colp = base + (size_t)bl * SEQ * HP + cs; pitch = HP; }
#pragma unroll
                for (int ai = 0; ai < 2; ++ai)
#pragma unroll
                    for (int m = 0; m < 4; ++m) *(u32x4*)(colp + (size_t)(s0 + ai * HALF + m * 16) * pitch) = pack8(acc[ai][bj][m][0], acc[ai][bj][m][1]); }
        }
        if (u.pn == 2 || u.pn == 3) {
            float* dst = KMP + (size_t)(u.pm * 2 + wr) * 512 + (u.pn - 2) * 256 + wc * 32 + 8 * fq;
#pragma unroll
            for (int bj = 0; bj < 2; ++bj)
#pragma unroll
                for (int n = 0; n < 2; ++n) { f32x4 s = (f32x4){0.f, 0.f, 0.f, 0.f};
#pragma unroll
                    for (int ai = 0; ai < 2; ++ai)
#pragma unroll
                        for (int m = 0; m < 4; ++m) s += acc[ai][bj][m][n];
#pragma unroll
                    for (int e = 0; e < 4; ++e) { float v = s[e]; v += __shfl_xor(v, 1); v += __shfl_xor(v, 2); v += __shfl_xor(v, 4); v += __shfl_xor(v, 8); s[e] = v; }
                    if (fr == 0) *(f32x4*)(dst + bj * HALF + 4 * n) = s; }
        }
        if (u.pn >= 18) {
#pragma unroll
            for (int ai = 0; ai < 2; ++ai)
#pragma unroll
                for (int m = 0; m < 4; ++m) { const int row = row0 + ai * HALF + m * 16; float ss = 0.f;
#pragma unroll
                    for (int bj = 0; bj < 2; ++bj) { if (u.pn == 20 && bj == 1) continue;
#pragma unroll
                        for (int n = 0; n < 2; ++n) { const f32x4 x = acc[ai][bj][m][n]; ss += (x[0] * x[0] + x[1] * x[1]) + (x[2] * x[2] + x[3] * x[3]); } }
                    ss += __shfl_xor(ss, 16); ss += __shfl_xor(ss, 32);
                    if (fq == 0) { if (u.pn == 18) STKV[(size_t)row * 4 + wc] = ss; else STQ[(size_t)row * 8 + (u.pn - 19) * 4 + wc] = ss; }
                    if (u.pn == 20 && wc == 0) {
                        const int pos = row & (SEQ - 1); f32x4 o[2];
#pragma unroll
                        for (int n = 0; n < 2; ++n) { const f32x4 cs = *(const f32x4*)(rope + ((size_t)pos * 16 + 4 * fq + 2 * n) * 2); const f32x4 t = acc[ai][1][m][n];
                            o[n] = (f32x4){t[0] * cs[0] - t[1] * cs[1], t[0] * cs[1] + t[1] * cs[0], t[2] * cs[2] - t[3] * cs[3], t[2] * cs[3] + t[3] * cs[2]}; }
                        const u32x4 w = pack8(o[0], o[1]);
#pragma unroll
                        for (int h = 0; h < 8; ++h) *(u32x4*)(KB + ((size_t)((row >> 11) * 8 + h) * SEQ + pos) * 96 + 64 + 8 * fq) = w;
                    }
                }
        }
    }
};
template <int MODE> struct EpiUp {
    bf16_t* QB; bf16_t* KB; bf16_t* VB; const float* ST; const float* rope;
    DI void operator()(const Acc& acc, const Unit& u, int wr, int wc, int fr, int fq) const {
        const int row0 = u.pm * BM + wr * 64 + fr;
#pragma unroll
        for (int ai = 0; ai < 2; ++ai)
#pragma unroll
            for (int m = 0; m < 4; ++m) { const int row = row0 + ai * HALF + m * 16; float sc;
                if (MODE == 0) { const f32x4 a = *(const f32x4*)(ST + (size_t)row * 8), b = *(const f32x4*)(ST + (size_t)row * 8 + 4);
                    sc = __builtin_amdgcn_rsqf(((a[0] + a[1]) + (a[2] + a[3]) + (b[0] + b[1]) + (b[2] + b[3])) * (1.f / 384.f) + 1e-6f) * QS96; }
                else { const f32x4 a = *(const f32x4*)(ST + (size_t)row * 4); sc = __builtin_amdgcn_rsqf(((a[0] + a[1]) + (a[2] + a[3])) * (1.f / 256.f) + 1e-6f); }
                const int pos = row & (SEQ - 1);
#pragma unroll
                for (int bj = 0; bj < 2; ++bj) { const int c0 = u.pn * BM + bj * HALF + wc * 32 + 8 * fq;
                    f32x4 v0 = acc[ai][bj][m][0] * sc, v1 = acc[ai][bj][m][1] * sc;
                    if (MODE == 0) { const int j = c0 % 96;
                        if (j >= 64) { const int i0 = (j - 64) >> 1; const f32x4 ca = *(const f32x4*)(rope + ((size_t)pos * 16 + i0) * 2), cb = *(const f32x4*)(rope + ((size_t)pos * 16 + i0 + 2) * 2);
                            v0 = (f32x4){v0[0] * ca[0] - v0[1] * ca[1], v0[0] * ca[1] + v0[1] * ca[0], v0[2] * ca[2] - v0[3] * ca[3], v0[2] * ca[3] + v0[3] * ca[2]};
                            v1 = (f32x4){v1[0] * cb[0] - v1[1] * cb[1], v1[0] * cb[1] + v1[1] * cb[0], v1[2] * cb[2] - v1[3] * cb[3], v1[2] * cb[3] + v1[3] * cb[2]}; }
                        *(u32x4*)(QB + ((size_t)((row >> 11) * 8 + c0 / 96) * SEQ + pos) * 96 + j) = pack8(v0, v1); }
                    else { if (c0 < 512) *(u32x4*)(KB + ((size_t)((row >> 11) * 8 + (c0 >> 6)) * SEQ + pos) * 96 + (c0 & 63)) = pack8(v0, v1);
                           else *(u32x4*)(VB + ((size_t)((row >> 11) * 8 + ((c0 - 512) >> 6)) * SEQ + pos) * 64 + (c0 & 63)) = pack8(v0, v1); }
                }
            }
    }
};
struct EpiG {
    bf16_t* G; const float* bias;
    DI void operator()(const Acc& acc, const Unit& u, int wr, int wc, int fr, int fq) const {
        const int row0 = u.pm * BM + wr * 64 + fr, col0 = u.pn * BM + wc * 32 + 8 * fq;
        f32x4 bv[2][2];
#pragma unroll
        for (int bj = 0; bj < 2; ++bj)
#pragma unroll
            for (int n = 0; n < 2; ++n) bv[bj][n] = *(const f32x4*)(bias + col0 + bj * HALF + 4 * n);
#pragma unroll
        for (int ai = 0; ai < 2; ++ai)
#pragma unroll
            for (int m = 0; m < 4; ++m) { bf16_t* rowp = G + (size_t)(row0 + ai * HALF + m * 16) * 3072 + col0;
#pragma unroll
                for (int bj = 0; bj < 2; ++bj) { f32x4 v0 = acc[ai][bj][m][0] + bv[bj][0], v1 = acc[ai][bj][m][1] + bv[bj][1];
#pragma unroll
                    for (int e = 0; e < 4; ++e) { v0[e] = sigm(v0[e]); v1[e] = sigm(v1[e]); }
                    *(u32x4*)(rowp + bj * HALF) = pack8(v0, v1); } }
    }
};
struct EpiMerge {
    const bf16_t* G; bf16_t* MG;
    DI void operator()(const Acc& acc, const Unit& u, int wr, int wc, int fr, int fq) const {
        const int br = u.pn >> 2, pm = u.pm - 64 * br, pn = u.pn & 3;
        const int row0 = pm * BM + wr * 64 + fr, col0 = pn * BM + wc * 32 + 8 * fq;
#pragma unroll
        for (int ai = 0; ai < 2; ++ai)
#pragma unroll
            for (int m = 0; m < 4; ++m) { const size_t row = (size_t)(row0 + ai * HALF + m * 16);
#pragma unroll
                for (int bj = 0; bj < 2; ++bj) { f32x4 g0, g1; unpack8(*(const u32x4*)(G + row * 3072 + br * 1024 + col0 + bj * HALF), g0, g1);
                    f32x4 v0 = acc[ai][bj][m][0] * g0, v1 = acc[ai][bj][m][1] * g1;
                    bf16_t* dst = MG + row * 1024 + col0 + bj * HALF;
                    if (br > 0) { f32x4 p0, p1; unpack8(*(const u32x4*)dst, p0, p1); v0 += p0; v1 += p1; }
                    *(u32x4*)dst = pack8(v0, v1); } }
    }
};
struct EpiR {
    const float* X; float* R; bf16_t* RB;
    DI void operator()(const Acc& acc, const Unit& u, int wr, int wc, int fr, int fq) const {
        const int row0 = u.pm * BM + wr * 64 + fr, col0 = u.pn * BM + wc * 32 + 8 * fq;
#pragma unroll
        for (int ai = 0; ai < 2; ++ai)
#pragma unroll
            for (int m = 0; m < 4; ++m) { const size_t off = (size_t)(row0 + ai * HALF + m * 16) * 1024 + col0;
#pragma unroll
                for (int bj = 0; bj < 2; ++bj) { const f32x4 x0 = *(const f32x4*)(X + off + bj * HALF), x1 = *(const f32x4*)(X + off + bj * HALF + 4);
                    const f32x4 v0 = x0 * ALPHA + acc[ai][bj][m][0], v1 = x1 * ALPHA + acc[ai][bj][m][1];
                    *(f32x4*)(R + off + bj * HALF) = v0; *(f32x4*)(R + off + bj * HALF + 4) = v1;
                    *(u32x4*)(RB + off + bj * HALF) = pack8(v0, v1); } }
    }
};
struct EpiBf {
    bf16_t* O;
    DI void operator()(const Acc& acc, const Unit& u, int wr, int wc, int fr, int fq) const {
        const int row0 = u.pm * BM + wr * 64 + fr, col0 = u.pn * BM + wc * 32 + 8 * fq;
#pragma unroll
        for (int ai = 0; ai < 2; ++ai)
#pragma unroll
            for (int m = 0; m < 4; ++m) { bf16_t* rowp = O + (size_t)(row0 + ai * HALF + m * 16) * 1024 + col0;
#pragma unroll
                for (int bj = 0; bj < 2; ++bj) *(u32x4*)(rowp + bj * HALF) = pack8(acc[ai][bj][m][0], acc[ai][bj][m][1]); }
    }
};
struct EpiR2 {
    float* R; const bf16_t* PP;
    DI void operator()(const Acc& acc, const Unit& u, int wr, int wc, int fr, int fq) const {
        const int row0 = u.pm * BM + wr * 64 + fr, col0 = u.pn * BM + wc * 32 + 8 * fq;
#pragma unroll
        for (int ai = 0; ai < 2; ++ai)
#pragma unroll
            for (int m = 0; m < 4; ++m) { const size_t off = (size_t)(row0 + ai * HALF + m * 16) * 1024 + col0;
#pragma unroll
                for (int bj = 0; bj < 2; ++bj) { f32x4 p0, p1; unpack8(*(const u32x4*)(PP + off + bj * HALF), p0, p1);
                    f32x4 r0 = *(const f32x4*)(R + off + bj * HALF), r1 = *(const f32x4*)(R + off + bj * HALF + 4);
                    const f32x4 a0 = acc[ai][bj][m][0], a1 = acc[ai][bj][m][1];
#pragma unroll
                    for (int e = 0; e < 4; ++e) { r0[e] += sigm(a0[e]) * p0[e]; r1[e] += sigm(a1[e]) * p1[e]; }
                    *(f32x4*)(R + off + bj * HALF) = r0; *(f32x4*)(R + off + bj * HALF + 4) = r1; } }
    }
};
}

DI int crow(int r, int hi) { return (r & 3) + 8 * (r >> 2) + 4 * hi; }
DI s16x4 vtr(LAS const char* p) { typedef short v4i16_t __attribute__((ext_vector_type(4))); return __builtin_bit_cast(s16x4, __builtin_amdgcn_ds_read_tr16_b64_v4i16((LAS v4i16_t*)p)); }
constexpr int AT_SCR = 112 * 1024, AT_KM = 113 * 1024;
constexpr float NEGBIG = -1e30f;
DI float max3f(float a, float b, float c) { return fmaxf(fmaxf(a, b), c); }

template <int DQK, int KW, int DV, int NROWS, bool ALIBI, bool MOBA, bool PIPE, int NSET>
DI void attn_unit(LAS char* lds, const bf16_t* Qp, int ldq, const bf16_t* Kp, int ldk, const bf16_t* Vp, int ldv,
                  const bf16_t* Zp, int ldz, bf16_t* Yp, int ldy, int q0, float sl2, const float* kmp, float lam, const float* subg, float post) {
    constexpr int NTD = NROWS / 64, NS = DQK / 16, ND = DV / 32;
    constexpr int KPITCH = KW * 2 + 16, VPITCH = DV * 2 + 64;
    constexpr int KOFF0 = 0, VOFF0 = 3 * 64 * KPITCH;
    constexpr int KCH = KW / 8, VCH = DV / 8, NKC = 64 * KCH, NVC = 64 * VCH, KPT = (NKC + 511) / 512, VPT = (NVC + 511) / 512;
    static_assert(VOFF0 + 3 * 64 * VPITCH <= AT_SCR, "attention LDS map");
    const int tid = opaque_tid(), lane = tid & 63, r32 = lane & 31, hi = lane >> 5;
    const int wid = __builtin_amdgcn_readfirstlane(tid >> 6);
    const int ro = (NROWS == 256) ? 32 * wid : 32 * (wid & 3);
    const int map = (NROWS == 256) ? 0 : (wid >> 2);
    const int qpos = q0 + ro + r32;
    LAS float* scr = (LAS float*)(lds + AT_SCR) + wid * 32;

    bf16x8 qf[NS];
    { const bf16_t* qrow = Qp + (size_t)qpos * ldq + 64 * map + 8 * hi;
#pragma unroll
      for (int s = 0; s < NS; ++s) qf[s] = *(const bf16x8*)(qrow + 16 * s); }

    unsigned sel = 0xFFu;
    if (MOBA) {
        const int u = q0 >> 8;
        if (u > 3) {
            LAS float* km = (LAS float*)(lds + AT_KM);
            { const int j = tid >> 6, d = tid & 63; if (j < u) km[j * 64 + d] = (kmp[(size_t)(j * 2) * 512 + d] + kmp[(size_t)(j * 2 + 1) * 512 + d]) * (1.f / 256.f); }
            __syncthreads();
            float g[7];
#pragma unroll
            for (int j = 0; j < 7; ++j) { float a = 0.f;
                if (j < u) {
#pragma unroll
                    for (int s = 0; s < 4; ++s) { const f32x4 k0 = *(const LAS f32x4*)(km + j * 64 + 16 * s + 8 * hi), k1 = *(const LAS f32x4*)(km + j * 64 + 16 * s + 8 * hi + 4);
#pragma unroll
                        for (int e = 0; e < 4; ++e) { a += bf2f((bf16_t)qf[s][e]) * k0[e]; a += bf2f((bf16_t)qf[s][4 + e]) * k1[e]; } }
                }
                a += __shfl_xor(a, 32); g[j] = a; }
            sel = 0u;
#pragma unroll
            for (int k = 0; k < 3; ++k) { float best = -INFINITY; int bi = 0;
#pragma unroll
                for (int j = 0; j < 7; ++j) { const bool ok = (j < u) && !((sel >> j) & 1u) && (g[j] > best); best = ok ? g[j] : best; bi = ok ? j : bi; }
                sel |= 1u << bi; }
        }
    }

    f32x16 o[ND];
#pragma unroll
    for (int d0 = 0; d0 < ND; ++d0)
#pragma unroll
        for (int r = 0; r < 16; ++r) o[d0][r] = 0.f;
    f32x16 bias;
#pragma unroll
    for (int r = 0; r < 16; ++r) bias[r] = ALIBI ? sl2 * (float)((r & 3) + 8 * (r >> 2) + 4 * hi) : 0.f;
    const float d32 = ALIBI ? 32.f * sl2 : 0.f;
    float mrun = NEGBIG, lrun = 0.f;
    const int nt = NTD + (q0 >> 6);
    u32x4 kregA[KPT], vregA[VPT], kregB[KPT], vregB[VPT], kregC[KPT], vregC[VPT], kregD[KPT], vregD[VPT];
#define AT_TB(it) ((it) < NTD ? q0 + 64 * (it) : 64 * ((it) - NTD))
#define AT_LOAD(it, kreg, vreg) do { const int _ti = ((it) < nt) ? (it) : nt - 1; const int _kb = AT_TB(_ti); \
        _Pragma("unroll") for (int _i = 0; _i < KPT; ++_i) { const int _c = tid + 512 * _i; if (NKC % 512 == 0 || _i + 1 < KPT || _c < NKC) { const int _r = _c / KCH, _cc = _c % KCH; kreg[_i] = *(const u32x4*)(Kp + (size_t)(_kb + _r) * ldk + 8 * _cc); } } \
        _Pragma("unroll") for (int _i = 0; _i < VPT; ++_i) { const int _c = tid + 512 * _i; if (NVC % 512 == 0 || _i + 1 < VPT || _c < NVC) { const int _r = _c / VCH, _cc = _c % VCH; vreg[_i] = *(const u32x4*)(Vp + (size_t)(_kb + _r) * ldv + 8 * _cc); } } } while (0)
#define AT_STORE(buf, kreg, vreg) do { \
        _Pragma("unroll") for (int _i = 0; _i < KPT; ++_i) { const int _c = tid + 512 * _i; if (NKC % 512 == 0 || _i + 1 < KPT || _c < NKC) { const int _r = _c / KCH, _cc = _c % KCH; *(LAS u32x4*)(lds + KOFF0 + (buf) * 64 * KPITCH + _r * KPITCH + 16 * _cc) = kreg[_i]; } } \
        _Pragma("unroll") for (int _i = 0; _i < VPT; ++_i) { const int _c = tid + 512 * _i; if (NVC % 512 == 0 || _i + 1 < VPT || _c < NVC) { const int _r = _c / VCH, _cc = _c % VCH; *(LAS u32x4*)(lds + VOFF0 + (buf) * 64 * VPITCH + _r * VPITCH + 16 * _cc) = vreg[_i]; } } } while (0)
#define AT_ACTIVE(it) ((it) >= NTD || 64 * (it) <= ro + 31)
#define AT_QK(it, bufi, P0, P1) do { if (AT_ACTIVE(it)) { \
        LAS const char* _Kb = lds + KOFF0 + (bufi) * 64 * KPITCH + r32 * KPITCH + (64 * map + 8 * hi) * 2; \
        _Pragma("unroll") for (int _h = 0; _h < NS; _h += 4) { \
            bf16x8 _kf[8]; \
            _Pragma("unroll") for (int _s = 0; _s < 4; ++_s) if (_h + _s < NS) { _kf[2 * _s] = *(const LAS bf16x8*)(_Kb + 32 * (_h + _s)); _kf[2 * _s + 1] = *(const LAS bf16x8*)(_Kb + 32 * KPITCH + 32 * (_h + _s)); } \
            __builtin_amdgcn_sched_barrier(0); \
            _Pragma("unroll") for (int _s = 0; _s < 4; ++_s) if (_h + _s < NS) { \
                if (_h + _s == 0) { P0 = __builtin_amdgcn_mfma_f32_32x32x16_bf16(_kf[0], qf[0], bias, 0, 0, 0); P1 = __builtin_amdgcn_mfma_f32_32x32x16_bf16(_kf[1], qf[0], bias, 0, 0, 0); } \
                else { P0 = __builtin_amdgcn_mfma_f32_32x32x16_bf16(_kf[2 * _s], qf[_h + _s], P0, 0, 0, 0); P1 = __builtin_amdgcn_mfma_f32_32x32x16_bf16(_kf[2 * _s + 1], qf[_h + _s], P1, 0, 0, 0); } } \
            __builtin_amdgcn_sched_barrier(0); } } } while (0)
    if (NSET == 4) { AT_LOAD(0, kregA, vregA); AT_LOAD(1, kregB, vregB); AT_LOAD(2, kregC, vregC); AT_LOAD(3, kregD, vregD); AT_STORE(0, kregA, vregA); AT_STORE(1, kregB, vregB);
                     AT_LOAD(4, kregA, vregA); AT_LOAD(5, kregB, vregB); }
    else if (NSET == 2) { AT_LOAD(0, kregA, vregA); AT_LOAD(1, kregB, vregB); AT_STORE(0, kregA, vregA); AT_STORE(1, kregB, vregB); AT_LOAD(2, kregA, vregA); AT_LOAD(3, kregB, vregB); }
    else { AT_LOAD(0, kregA, vregA); AT_STORE(0, kregA, vregA); AT_LOAD(1, kregA, vregA); AT_STORE(1, kregA, vregA); AT_LOAD(2, kregA, vregA); }
    __syncthreads();
    const int i16 = lane & 15;
    const int vlane = (4 * hi + (i16 >> 2)) * VPITCH + (16 * ((lane >> 4) & 1) + 4 * (i16 & 3)) * 2;
    f32x16 pa0, pa1, pb0, pb1;
#pragma unroll
    for (int r = 0; r < 16; ++r) { pa0[r] = 0.f; pa1[r] = 0.f; pb0[r] = 0.f; pb1[r] = 0.f; }
    if (PIPE) AT_QK(0, 0, pa0, pa1);
    int bcur = 0;
#define AT_ITER(it, C0, C1, N0, N1, kreg, vreg) do { \
        const int _b1 = (bcur == 2) ? 0 : bcur + 1, _b2 = (_b1 == 2) ? 0 : _b1 + 1; \
        AT_STORE(_b2, kreg, vreg); \
        AT_LOAD((it) + 2 + NSET, kreg, vreg); \
        if (PIPE) { if ((it) + 1 < nt) AT_QK((it) + 1, _b1, N0, N1); } else AT_QK(it, bcur, C0, C1); \
        if (AT_ACTIVE(it)) { \
            const int _kb = AT_TB(it); const bool _diag = (it) < NTD; \
            if (_diag) { const int _kq = _kb + 4 * hi - qpos; \
                _Pragma("unroll") for (int _r = 0; _r < 16; ++_r) { const int _dd = _kq + (_r & 3) + 8 * (_r >> 2); if (_dd > 0) C0[_r] = NEGBIG; if (_dd + 32 > 0) C1[_r] = NEGBIG; } } \
            float _m0 = max3f(C0[0], C0[1], C0[2]), _m1 = max3f(C1[0], C1[1], C1[2]); \
            _Pragma("unroll") for (int _r = 3; _r < 15; _r += 2) { _m0 = max3f(_m0, C0[_r], C0[_r + 1]); _m1 = max3f(_m1, C1[_r], C1[_r + 1]); } \
            _m0 = fmaxf(_m0, C0[15]); _m1 = fmaxf(_m1, C1[15]); \
            const float _c0 = ALIBI ? sl2 * (float)(_kb - qpos) : 0.f; \
            float _mx = fmaxf(_m0, _m1 + d32) + _c0; \
            bool _selok = true; if (MOBA && !_diag) _selok = ((sel >> (_kb >> 8)) & 1u) != 0u; \
            if (!_selok) _mx = NEGBIG; \
            _mx = fmaxf(_mx, __shfl_xor(_mx, 32)); \
            const float _mn = fmaxf(mrun, _mx); \
            if (__any(_mn - mrun > 8.f)) { \
                const float _alpha = __builtin_amdgcn_exp2f(mrun - _mn); lrun *= _alpha; mrun = _mn; \
                scr[r32] = _alpha; \
                asm volatile("s_waitcnt lgkmcnt(0)" ::: "memory"); \
                f32x4 _a4[4]; \
                _Pragma("unroll") for (int _g = 0; _g < 4; ++_g) _a4[_g] = *(const LAS f32x4*)(scr + 8 * _g + 4 * hi); \
                asm volatile("s_waitcnt lgkmcnt(0)" ::: "memory"); \
                _Pragma("unroll") for (int _d0 = 0; _d0 < ND; ++_d0) _Pragma("unroll") for (int _r = 0; _r < 16; ++_r) o[_d0][_r] *= _a4[_r >> 2][_r & 3]; \
            } \
            const float _ms0 = _selok ? (mrun - _c0) : INFINITY, _ms1 = _ms0 - d32; \
            float _ls = 0.f; \
            _Pragma("unroll") for (int _r = 0; _r < 16; ++_r) { C0[_r] = __builtin_amdgcn_exp2f(C0[_r] - _ms0); C1[_r] = __builtin_amdgcn_exp2f(C1[_r] - _ms1); _ls += C0[_r] + C1[_r]; } \
            lrun += _ls; \
            bf16x8 _pa[4]; \
            _Pragma("unroll") for (int _ks = 0; _ks < 2; ++_ks) { u32x4 _w; \
                _w.x = pk2(C0[8 * _ks], C0[8 * _ks + 1]); _w.y = pk2(C0[8 * _ks + 2], C0[8 * _ks + 3]); _w.z = pk2(C0[8 * _ks + 4], C0[8 * _ks + 5]); _w.w = pk2(C0[8 * _ks + 6], C0[8 * _ks + 7]); \
                _pa[_ks] = __builtin_bit_cast(bf16x8, _w); \
                _w.x = pk2(C1[8 * _ks], C1[8 * _ks + 1]); _w.y = pk2(C1[8 * _ks + 2], C1[8 * _ks + 3]); _w.z = pk2(C1[8 * _ks + 4], C1[8 * _ks + 5]); _w.w = pk2(C1[8 * _ks + 6], C1[8 * _ks + 7]); \
                _pa[2 + _ks] = __builtin_bit_cast(bf16x8, _w); } \
            LAS const char* _Vb = lds + VOFF0 + bcur * 64 * VPITCH + vlane; \
            _Pragma("unroll") for (int _d0 = 0; _d0 < ND; ++_d0) { bf16x8 _vf[4]; \
                _Pragma("unroll") for (int _ks = 0; _ks < 4; ++_ks) { \
                    const s16x4 _lo = vtr(_Vb + (16 * _ks) * VPITCH + 64 * _d0), _hh = vtr(_Vb + (16 * _ks + 8) * VPITCH + 64 * _d0); \
                    _vf[_ks] = __builtin_shufflevector(_lo, _hh, 0, 1, 2, 3, 4, 5, 6, 7); } \
                __builtin_amdgcn_sched_barrier(0); \
                _Pragma("unroll") for (int _ks = 0; _ks < 4; ++_ks) o[_d0] = __builtin_amdgcn_mfma_f32_32x32x16_bf16(_pa[_ks], _vf[_ks], o[_d0], 0, 0, 0); \
                __builtin_amdgcn_sched_barrier(0); } \
        } \
        bcur = _b1; \
        asm volatile("s_waitcnt lgkmcnt(0)\n\ts_barrier" ::: "memory"); } while (0)
    if (NSET == 4) {
        for (int it = 0; it < nt; it += 4) {
            AT_ITER(it, pa0, pa1, pb0, pb1, kregC, vregC);
            AT_ITER(it + 1, pb0, pb1, pa0, pa1, kregD, vregD);
            AT_ITER(it + 2, pa0, pa1, pb0, pb1, kregA, vregA);
            AT_ITER(it + 3, pb0, pb1, pa0, pa1, kregB, vregB);
        }
    } else {
        for (int it = 0; it < nt; it += 2) {
            AT_ITER(it, pa0, pa1, pb0, pb1, kregA, vregA);
            if (NSET == 2) AT_ITER(it + 1, pb0, pb1, pa0, pa1, kregB, vregB); else AT_ITER(it + 1, pb0, pb1, pa0, pa1, kregA, vregA);
        }
    }
#undef AT_TB
#undef AT_LOAD
#undef AT_STORE
#undef AT_ACTIVE
#undef AT_QK
#undef AT_ITER
    {
        const float lt = lrun + __shfl_xor(lrun, 32);
        scr[r32] = 1.f / lt;
        asm volatile("s_waitcnt lgkmcnt(0)" ::: "memory");
        f32x4 a4[4];
#pragma unroll
        for (int g = 0; g < 4; ++g) a4[g] = *(const LAS f32x4*)(scr + 8 * g + 4 * hi);
        asm volatile("s_waitcnt lgkmcnt(0)" ::: "memory");
#pragma unroll
        for (int d0 = 0; d0 < ND; ++d0)
#pragma unroll
            for (int r = 0; r < 16; ++r) o[d0][r] *= a4[r >> 2][r & 3];
    }
    if (NROWS == 256) {
#pragma unroll
        for (int d0 = 0; d0 < ND; ++d0)
#pragma unroll
            for (int r = 0; r < 16; ++r) { const size_t row = (size_t)(q0 + ro + crow(r, hi)); const int col = 32 * d0 + r32;
                const float z = bf2f(Zp[row * ldz + col]); Yp[row * ldy + col] = f2bf(o[d0][r] * silu(z)); }
    } else {
        LAS float* xch = (LAS float*)lds;
        if (map == 1) {
#pragma unroll
            for (int d0 = 0; d0 < ND; ++d0)
#pragma unroll
                for (int r = 0; r < 16; ++r) xch[(((wid & 3) * ND + d0) * 16 + r) * 64 + lane] = o[d0][r];
        }
        __syncthreads();
        if (map == 0) {
#pragma unroll
            for (int d0 = 0; d0 < ND; ++d0)
#pragma unroll
                for (int r = 0; r < 16; ++r) o[d0][r] -= lam * xch[(((wid & 3) * ND + d0) * 16 + r) * 64 + lane];
#pragma unroll
            for (int r = 0; r < 16; ++r) { float ss = 0.f;
#pragma unroll
                for (int d0 = 0; d0 < ND; ++d0) ss += o[d0][r] * o[d0][r];
                ss += __shfl_xor(ss, 1); ss += __shfl_xor(ss, 2); ss += __shfl_xor(ss, 4); ss += __shfl_xor(ss, 8); ss += __shfl_xor(ss, 16);
                const float rs = __builtin_amdgcn_rsqf(ss * (1.f / (float)DV) + 1e-5f) * post;
                const size_t row = (size_t)(q0 + ro + crow(r, hi));
#pragma unroll
                for (int d0 = 0; d0 < ND; ++d0) { const int col = 32 * d0 + r32; const float z = bf2f(Zp[row * ldz + col]);
                    Yp[row * ldy + col] = f2bf(o[d0][r] * rs * subg[col] * silu(z)); } }
        }
        __syncthreads();
    }
}

#define XB_TMO      128
#define XB_XCNT(j)  (256  + 64 * (j))
#define XB_XSUB(j)  (1280 + 64 * (j))
#define XB_XGEN(j)  (2304 + 64 * (j))
#define XB_TOP      3328
#define XB_TOPGEN   3392
#define XCD_BAR_WORDS 3456
#define XB_SPIN_CAP (1u << 22)
DI unsigned xb_ld(unsigned* p)              { return __hip_atomic_load(p, __ATOMIC_RELAXED, __HIP_MEMORY_SCOPE_AGENT); }
DI unsigned xb_add(unsigned* p, unsigned v) { return __hip_atomic_fetch_add(p, v, __ATOMIC_RELAXED, __HIP_MEMORY_SCOPE_AGENT); }
DI unsigned xb_xcc_id() { return (unsigned)__builtin_amdgcn_s_getreg((3 << 11) | 20) & 0xFu; }
#define XB_SPIN(cond, bar) do { unsigned _sp = 0; while (cond) { __builtin_amdgcn_s_sleep(1); \
    if ((++_sp & 255u) == 0u) { if (xb_ld(&(bar)[XB_TMO])) break; if (_sp > XB_SPIN_CAP) { atomicAdd(&(bar)[XB_TMO], 1u); break; } } } } while (0)
DI void xcd_barrier_complete(unsigned* bar, unsigned x, unsigned& nloc, unsigned& nx) {
    const unsigned Gn = gridDim.x;
    unsigned sum, cnt, mine, sp = 0u;
    for (;;) {
        sum = 0u; cnt = 0u; mine = 0u;
#pragma unroll
        for (unsigned j = 0; j < 16; ++j) { const unsigned c = xb_ld(&bar[XB_XCNT(j)]); sum += c; cnt += (c > 0u) ? 1u : 0u; mine = (j == x) ? c : mine; }
        if (sum == Gn) break;
        __builtin_amdgcn_s_sleep(1);
        if ((++sp & 255u) == 0u) { if (xb_ld(&bar[XB_TMO])) break; if (sp > XB_SPIN_CAP) { atomicAdd(&bar[XB_TMO], 1u); break; } }
    }
    nloc = mine > 0u ? mine : 1u; nx = cnt > 0u ? cnt : 1u;
}
DI void xcd_barrier(unsigned* bar, volatile LAS unsigned* st) {
    asm volatile("s_waitcnt vmcnt(0)" ::: "memory");
    __syncthreads();
    if (threadIdx.x == 0) {
        __builtin_amdgcn_s_waitcnt(0);
        const unsigned x = xb_xcc_id();
        unsigned nloc = st[0], nx = st[1];
        if (nloc == 0u) { xcd_barrier_complete(bar, x, nloc, nx); st[0] = nloc; st[1] = nx; }
        const unsigned old = xb_add(&bar[XB_XSUB(x)], 1u);
        const unsigned gen = old / nloc;
        if (old + 1u == (gen + 1u) * nloc) {
            __builtin_amdgcn_fence(__ATOMIC_RELEASE, "agent");
            asm volatile("s_waitcnt vmcnt(0)" ::: "memory");
            const unsigned og = xb_add(&bar[XB_TOP], 1u);
            const unsigned tg = og / nx;
            if (og + 1u == (tg + 1u) * nx) xb_add(&bar[XB_TOPGEN], 1u);
            else XB_SPIN(xb_ld(&bar[XB_TOPGEN]) == tg, bar);
            __builtin_amdgcn_fence(__ATOMIC_ACQUIRE, "agent");
            xb_add(&bar[XB_XGEN(x)], 1u);
            asm volatile("s_waitcnt vmcnt(0)" ::: "memory");
        } else {
            XB_SPIN(xb_ld(&bar[XB_XGEN(x)]) == gen, bar);
            __builtin_amdgcn_fence(__ATOMIC_ACQUIRE, "agent");
            asm volatile("s_waitcnt vmcnt(0)" ::: "memory");
        }
    }
    __syncthreads();
}

struct Params { const float* in[19]; float* out; unsigned char* ws; };

DI void colmap(int kind, int n, int& col, float& cs) {
    cs = 1.f;
    if (kind == 0) {
        if (n < 2048) { col = n; if (n < 512) cs = QS64; }
        else if (n < 2560) col = 2720 + (n - 2048);
        else if (n < 3072) { col = 3232 + (n - 2560); cs = QS64; }
        else if (n < 3584) col = 3744 + (n - 3072);
        else if (n < 4096) col = 4256 + (n - 3584);
        else if (n < 4608) col = 4768 + (n - 4096);
        else if (n < 4864) col = 2432 + (n - 4608);
        else if (n < 5248) col = 2048 + (n - 4864);
        else if (n < 5280) { const int j = n - 5248; col = 2688 + (j >> 1) + 16 * (j & 1); }
        else col = -1;
    } else if (kind == 1) col = n;
    else if (kind == 2) { const int h = n / 96, j = n % 96; if (j < 64) col = h * 96 + j; else { const int jj = j - 64; col = h * 96 + 64 + (jj >> 1) + 16 * (jj & 1); } }
    else { if (n < 512) col = (n >> 6) * 128 + (n & 63); else { const int m = n - 512; col = (m >> 6) * 128 + 64 + (m & 63); } }
}
DI void tr_tile(const float* src, int srcN, int K, bf16_t* dst, int kind, int n0, int k0, const float* kscale, LAS float* scr, int tid) {
    { const int nl = tid & 127, kl0 = tid >> 7; int col; float cs; colmap(kind, n0 + nl, col, cs);
      float v[16];
#pragma unroll
      for (int i = 0; i < 16; ++i) { const int kl = kl0 + 4 * i; v[i] = (col >= 0) ? src[(size_t)(k0 + kl) * srcN + col] : 0.f; }
#pragma unroll
      for (int i = 0; i < 16; ++i) { const int kl = kl0 + 4 * i; float w = v[i] * cs; if (kscale) w *= kscale[k0 + kl]; scr[kl * 129 + nl] = w; } }
    __syncthreads();
    { const int kp = tid & 31;
#pragma unroll
      for (int i = 0; i < 8; ++i) { const int nl = (tid >> 5) + 16 * i;
          *(unsigned*)(dst + (size_t)(n0 + nl) * K + k0 + 2 * kp) = pk2(scr[(2 * kp) * 129 + nl], scr[(2 * kp + 1) * 129 + nl]); } }
    __syncthreads();
}
typedef const __attribute__((address_space(4))) Params* KParams0;
DI void convert_weights(KParams0 Pk, int l, bf16_t* WT, LAS float* scr) {
    const int tid = opaque_tid();
    constexpr int T0 = 42 * 16, T1 = T0 + 24 * 16, T2 = T1 + 6 * 6, T3 = T2 + 8 * 4, T4 = T3 + 8 * 8, T5 = T4 + 8 * 8, T6 = T5 + 8 * 8, T7 = T6 + 8 * 16, T8 = T7 + 8 * 16, T9 = T8 + 8 * 4;
    for (int t = blockIdx.x; t < T9; t += gridDim.x) {
        const float* src; int srcN, K, kind, loc; bf16_t* dst; const float* ks = nullptr;
        if (t < T0) { src = Pk->in[2] + (size_t)l * 1024 * 5280; srcN = 5280; K = 1024; kind = 0; loc = t; dst = WT + OFF_WIN; }
        else if (t < T1) { src = Pk->in[12] + (size_t)l * 1024 * 3072; srcN = 3072; K = 1024; kind = 1; loc = t - T0; dst = WT + OFF_WIN + (size_t)5376 * 1024; }
        else if (t < T2) { src = Pk->in[5] + (size_t)l * 384 * 768; srcN = 768; K = 384; kind = 2; loc = t - T1; dst = WT + OFF_WUQ; ks = Pk->in[3] + l * 384; }
        else if (t < T3) { src = Pk->in[6] + (size_t)l * 256 * 1024; srcN = 1024; K = 256; kind = 3; loc = t - T2; dst = WT + OFF_WUKV; ks = Pk->in[4] + l * 256; }
        else if (t < T4) { src = Pk->in[9] + (size_t)l * 512 * 1024; srcN = 1024; K = 512; kind = 1; loc = t - T3; dst = WT + OFF_WABC; }
        else if (t < T5) { src = Pk->in[10] + (size_t)l * 512 * 1024; srcN = 1024; K = 512; kind = 1; loc = t - T4; dst = WT + OFF_WABC + (size_t)1024 * 512; }
        else if (t < T6) { src = Pk->in[11] + (size_t)l * 512 * 1024; srcN = 1024; K = 512; kind = 1; loc = t - T5; dst = WT + OFF_WABC + (size_t)2048 * 512; }
        else if (t < T7) { src = Pk->in[14] + (size_t)l * 1024 * 1024; srcN = 1024; K = 1024; kind = 1; loc = t - T6; dst = WT + OFF_WO; }
        else if (t < T8) { src = Pk->in[17] + (size_t)l * 1024 * 1024; srcN = 1024; K = 1024; kind = 1; loc = t - T7; dst = WT + OFF_WPG; }
        else { src = Pk->in[18] + (size_t)l * 256 * 1024; srcN = 1024; K = 256; kind = 1; loc = t - T8; dst = WT + OFF_WP; }
        const int kt = K / 64; const int n0 = (loc / kt) * 128, k0 = (loc % kt) * 64;
        tr_tile(src, srcN, K, dst, kind, n0, k0, ks, scr, tid);
    }
}
DI void convert_rows(const float* src, bf16_t* dst, size_t n) {
    const size_t stride = (size_t)gridDim.x * blockDim.x, ng = n / 8;
    for (size_t i = (size_t)blockIdx.x * blockDim.x + opaque_tid(); i < ng; i += 4 * stride) {
        f32x4 a[4], b[4];
#pragma unroll
        for (int j = 0; j < 4; ++j) { const size_t q = i + j * stride; if (q < ng) { a[j] = *(const f32x4*)(src + q * 8); b[j] = *(const f32x4*)(src + q * 8 + 4); } }
#pragma unroll
        for (int j = 0; j < 4; ++j) { const size_t q = i + j * stride; if (q < ng) *(u32x4*)(dst + q * 8) = pack8(a[j], b[j]); }
    }
}
typedef const __attribute__((address_space(4))) Params* KParams;
DI KParams kparams() { KParams p = (KParams)__builtin_amdgcn_kernarg_segment_ptr(); asm volatile("" : "+s"(p)); return p; }
DI unsigned char* wsbase() { unsigned char* w = kparams()->ws; asm volatile("" : "+s"(w)); return w; }

__global__ void __launch_bounds__(512, 2) fwd_megakernel(Params Punused) {
    extern __shared__ __attribute__((aligned(16))) unsigned char lds_raw[];
    cg::grid_group grid = cg::this_grid();
    LAS unsigned char* lds = (LAS unsigned char*)lds_raw;
#define G opaque_s((int)gridDim.x)
#define cu opaque_s((int)blockIdx.x)
#define XB_  ((bf16_t*)(ws + WS_XB))
#define WT_  ((bf16_t*)(ws + WS_WT))
#define PB_  ((bf16_t*)(ws + WS_PB))
#define Y_   ((bf16_t*)(ws + WS_Y))
#define H_   ((bf16_t*)(ws + WS_H))
#define QB_  ((bf16_t*)(ws + WS_MLA))
#define KB_  (QB_ + (size_t)HM * 768)
#define VB_  (KB_ + (size_t)HM * 768)
#define R_   ((float*)(ws + WS_H))
#define ROPE_ ((float*)(ws + CTL_ROPE))
#define KMP_ ((float*)(ws + CTL_KMP))
#define STQ_ ((float*)(ws + CTL_STQ))
#define STKV_ ((float*)(ws + CTL_STKV))

    if (threadIdx.x < 2) ((volatile LAS unsigned*)(lds + LDS_IDX + 64))[threadIdx.x] = 0u;
    {
        const int tid = opaque_tid();
        KParams P = kparams(); unsigned char* ws = P->ws;
        for (int rep = 0; rep < REP_P0; ++rep) {
        convert_weights(P, 0, WT_, (LAS float*)lds);
        convert_rows(P->in[0], XB_, (size_t)M * D);
        convert_rows(P->in[1], PB_, (size_t)M * 256); }
        float* rope = ROPE_;
        for (int i = cu * 512 + tid; i < SEQ * 16; i += G * 512) {
            const int pos = i >> 4, k = i & 15;
            const float freq = __builtin_amdgcn_exp2f(-(float)k * (13.287712379549449f / 16.f));
            const float ang = (float)pos * freq;
            double rev = (double)ang * 0.15915494309189535; rev -= __builtin_rint(rev);
            const float fr = (float)rev;
            rope[2 * i] = __builtin_amdgcn_cosf(fr); rope[2 * i + 1] = __builtin_amdgcn_sinf(fr);
        }
        if (cu == 0) {
            unsigned* ctl = (unsigned*)(ws + WS_CTL); float* lamv = (float*)(ws + CTL_LAM);
            if (tid < 64) {
#pragma unroll
                for (int l = 0; l < 2; ++l) { const float* dl = P->in[7] + l * 256; float a = dl[tid] * dl[64 + tid], b = dl[128 + tid] * dl[192 + tid];
#pragma unroll
                    for (int s = 1; s < 64; s <<= 1) { a += __shfl_xor(a, s); b += __shfl_xor(b, s); }
                    const float li = (l == 0) ? 0.2f : 0.35550906759096924f;
                    if (tid == 0) lamv[l] = __builtin_amdgcn_exp2f(a * LOG2E) - __builtin_amdgcn_exp2f(b * LOG2E) + li; }
            }
            if (tid < 16) ctl[tid] = 0u;
            { unsigned* bw = (unsigned*)(ws + CTL_BAR); for (int i = tid; i < XCD_BAR_WORDS; i += 512) bw[i] = 0u; }
        }
    }
    grid.sync();
    if (threadIdx.x == 0) { unsigned char* ws = wsbase(); (void)xb_add(&((unsigned*)(ws + CTL_BAR))[XB_XCNT(xb_xcc_id())], 1u); }
#define GSYNC() do { unsigned char* _w = wsbase(); xcd_barrier((unsigned*)(_w + CTL_BAR), (volatile LAS unsigned*)(lds + LDS_IDX + 64)); } while (0)

    for (int l = 0; l < 2; ++l) {
        for (int hf = 0; hf < 2; ++hf) {
            for (int rep = 0; rep < REP_P1; ++rep)
            { unsigned char* ws = wsbase();
              pg8::Gemm g{XB_ + (size_t)hf * HM * D, WT_ + OFF_WIN, D, D}; pg8::StaticOrder S; S.init(HM, NH1, G, cu);
              pg8::EpiH E{H_, KB_, KMP_ + (size_t)hf * 32 * 2 * 512, STQ_ + (size_t)hf * HM * 8, STKV_ + (size_t)hf * HM * 4, ROPE_};
              pg8::gemm_phase(lds, g, S, E); }
            GSYNC();
            { unsigned char* ws = wsbase();
              pg8::Gemm g{H_ + C_CQL, WT_ + OFF_WUQ, HP, 384}; pg8::ListOrder S{0, 96, 3, cu, G};
              pg8::EpiUp<0> E{QB_, KB_, VB_, STQ_ + (size_t)hf * HM * 8, ROPE_}; pg8::gemm_phase(lds, g, S, E); }
            { unsigned char* ws = wsbase();
              pg8::Gemm g{H_ + C_CKV, WT_ + OFF_WUKV, HP, 256}; pg8::ListOrder S{96, 224, 4, cu, G};
              pg8::EpiUp<1> E{QB_, KB_, VB_, STKV_ + (size_t)hf * HM * 4, ROPE_}; pg8::gemm_phase(lds, g, S, E); }
            GSYNC();
            {
                for (int rep = 0; rep < REP_ATT; ++rep)
                for (int vcu = cu; vcu < 256; vcu += G)
                for (int step = 0; step < 4; ++step) {
                    KParams P = kparams(); unsigned char* ws = P->ws;
                    const int x = vcu & 7, sl_ = vcu >> 3;
                    int type, u, bh;
                    if (sl_ < 16) { if (step >= 3) break;
                        if (step < 2) { type = 2; bh = 2 * x + (sl_ >> 3); const int j = sl_ & 7; u = (step == 0) ? 15 - j : j; }
                        else { type = 1; bh = 4 * x + (sl_ >> 2); u = sl_ & 3; } }
                    else { if (step >= 3) break; const int t = sl_ - 16, j = t & 3; bh = 4 * x + (t >> 2);
                        type = (step < 2) ? 0 : 1; u = (step == 1) ? j : 7 - j; }
                    if (type == 0) {
                        const int bl = bh >> 3, h = bh & 7, bg = 4 * hf + bl; const size_t ho = (size_t)bh * SEQ * 64;
                        const float sl = __builtin_amdgcn_exp2f(-(2.f / 3.f) * (float)(h + (h >> 1) + 2)) * LOG2E;
                        attn_unit<64, 64, 64, 256, true, true, true, 4>((LAS char*)lds, H_ + HM_AQ + ho, 64, H_ + HM_AK + ho, 64, H_ + HM_AV + ho, 64,
                            H_ + (size_t)bl * SEQ * HP + C_AZ + h * 64, HP,
                            Y_ + (size_t)bg * SEQ * 512 + h * 64, 512, u * 256, sl, KMP_ + (size_t)bg * 8 * 2 * 512 + h * 64, 0.f, nullptr, 1.f);
                    } else if (type == 1) {
                        const int bl = bh >> 3, h = bh & 7, bg = 4 * hf + bl;
                        attn_unit<96, 96, 64, 256, false, false, true, 2>((LAS char*)lds, QB_ + (size_t)bh * SEQ * 96, 96, KB_ + (size_t)bh * SEQ * 96, 96,
                            VB_ + (size_t)bh * SEQ * 64, 64, H_ + (size_t)bl * SEQ * HP + C_BZ + h * 64, HP,
                            Y_ + (size_t)M * 512 + (size_t)bg * SEQ * 512 + h * 64, 512, u * 256, 0.f, nullptr, 0.f, nullptr, 1.f);
                    } else {
                        const int bl = bh >> 2, h = bh & 3, bg = 4 * hf + bl; const size_t ho = (size_t)bh * SEQ * 128;
                        const float sl = __builtin_amdgcn_exp2f(-(2.f / 3.f) * (float)(3 * h + 1)) * LOG2E;
                        const float lam = ((const float*)(ws + CTL_LAM))[l];
                        const float post = (l == 0) ? 0.8f : (1.f - 0.35550906759096924f);
                        attn_unit<64, 128, 128, 128, true, false, false, 1>((LAS char*)lds, H_ + HM_CQ + ho, 128, H_ + HM_CK + ho, 128, H_ + HM_CV + ho, 128,
                            H_ + (size_t)bl * SEQ * HP + C_CZ + h * 128, HP,
                            Y_ + (size_t)2 * M * 512 + (size_t)bg * SEQ * 512 + h * 128, 512, u * 128, sl, nullptr, lam, P->in[8] + l * 128, post);
                    }
                }
            }
            GSYNC();
        }
        { KParams P = kparams(); unsigned char* ws = P->ws;
          pg8::Gemm g{XB_, WT_ + OFF_WIN + (size_t)5376 * 1024, D, D}; pg8::StaticOrder S; S.init(M, 3072, G, cu);
          pg8::EpiG E{H_, P->in[13] + l * 3072}; pg8::gemm_phase(lds, g, S, E); }
        GSYNC();
        { unsigned char* ws = wsbase();
          pg8::Gemm g{Y_, WT_ + OFF_WABC, 512, 512}; pg8::MergeOrder S{cu, G};
          pg8::EpiMerge E{H_, XB_}; pg8::gemm_phase(lds, g, S, E); }
        GSYNC();
        { KParams P = kparams(); unsigned char* ws = P->ws;
          pg8::Gemm g{XB_, WT_ + OFF_WO, D, D}; pg8::StaticOrder S; S.init(M, D, G, cu);
          pg8::EpiR E{(l == 0) ? P->in[0] : (const float*)P->out, R_, Y_}; pg8::gemm_phase(lds, g, S, E); }
        GSYNC();
        { unsigned char* ws = wsbase();
          pg8::Gemm g{PB_, WT_ + OFF_WP, 256, 256}; pg8::StaticOrder S; S.init(M, D, G, cu);
          pg8::EpiBf E{XB_}; pg8::gemm_phase(lds, g, S, E); }
        { unsigned char* ws = wsbase();
          pg8::Gemm g{Y_, WT_ + OFF_WPG, D, D}; pg8::StaticOrder S; S.init(M, D, G, cu);
          pg8::EpiR2 E{R_, XB_}; pg8::gemm_phase(lds, g, S, E); }
        GSYNC();
        {
            KParams P = kparams(); unsigned char* ws = P->ws;
            const int tid = opaque_tid(), lane = tid & 63, wid = tid >> 6;
            const float* lg = P->in[15] + l * 1024; const float* lb = P->in[16] + l * 1024;
            float* outp = P->out; const float* R = R_; bf16_t* XB = XB_;
            const int gstep = (int)gridDim.x * 8;
            for (int row = (int)blockIdx.x * 8 + wid; row < M; row += 2 * gstep) {
                const bool two = row + gstep < M;
                const float* rp0 = R + (size_t)row * 1024; const float* rp1 = R + (size_t)(two ? row + gstep : row) * 1024;
                f32x4 v[2][4]; float s0 = 0.f, s1 = 0.f;
#pragma unroll
                for (int j = 0; j < 4; ++j) { v[0][j] = *(const f32x4*)(rp0 + 4 * lane + 256 * j); v[1][j] = *(const f32x4*)(rp1 + 4 * lane + 256 * j); }
#pragma unroll
                for (int j = 0; j < 4; ++j) { s0 += (v[0][j][0] + v[0][j][1]) + (v[0][j][2] + v[0][j][3]); s1 += (v[1][j][0] + v[1][j][1]) + (v[1][j][2] + v[1][j][3]); }
#pragma unroll
                for (int k = 1; k < 64; k <<= 1) { s0 += __shfl_xor(s0, k); s1 += __shfl_xor(s1, k); }
                const float mu0 = s0 * (1.f / 1024.f), mu1 = s1 * (1.f / 1024.f); float q0 = 0.f, q1 = 0.f;
#pragma unroll
                for (int j = 0; j < 4; ++j) { v[0][j] -= mu0; v[1][j] -= mu1;
                    q0 += (v[0][j][0] * v[0][j][0] + v[0][j][1] * v[0][j][1]) + (v[0][j][2] * v[0][j][2] + v[0][j][3] * v[0][j][3]);
                    q1 += (v[1][j][0] * v[1][j][0] + v[1][j][1] * v[1][j][1]) + (v[1][j][2] * v[1][j][2] + v[1][j][3] * v[1][j][3]); }
#pragma unroll
                for (int k = 1; k < 64; k <<= 1) { q0 += __shfl_xor(q0, k); q1 += __shfl_xor(q1, k); }
                const float rs0 = __builtin_amdgcn_rsqf(q0 * (1.f / 1024.f) + 1e-5f), rs1 = __builtin_amdgcn_rsqf(q1 * (1.f / 1024.f) + 1e-5f);
#pragma unroll
                for (int j = 0; j < 4; ++j) { const f32x4 gv = *(const f32x4*)(lg + 4 * lane + 256 * j), bv = *(const f32x4*)(lb + 4 * lane + 256 * j);
#pragma unroll
                    for (int t = 0; t < 2; ++t) { if (t == 1 && !two) break;
                        const size_t rr = (size_t)(t == 0 ? row : row + gstep);
                        const f32x4 y = v[t][j] * (t == 0 ? rs0 : rs1) * gv + bv;
                        *(f32x4*)(outp + rr * 1024 + 4 * lane + 256 * j) = y;
                        if (l == 0) { u32x2 w; w.x = pk2(y[0], y[1]); w.y = pk2(y[2], y[3]); *(u32x2*)(XB + rr * 1024 + 4 * lane + 256 * j) = w; } } }
            }
            if (l == 0) {
                __syncthreads();
                convert_weights(P, 1, WT_, (LAS float*)lds);
                convert_rows(P->in[1] + (size_t)M * 256, PB_, (size_t)M * 256);
            }
        }
        if (l == 0) GSYNC();
    }
}

#undef G
#undef cu
extern "C" void kernel_launch(void* const* d_in, const int* in_sizes, int n_in, void* d_out, int out_size, void* d_ws, size_t ws_size, hipStream_t stream) {
    static int grid_blocks = 0;
    if (grid_blocks == 0) {
        if (n_in != 19 || out_size != M * D || ws_size < WS_END) { fprintf(stderr, "kernel_launch: unexpected problem (n_in %d out %d ws %zu)\n", n_in, out_size, ws_size); grid_blocks = -1; return; }
        int dev = 0, cus = 0, per_cu = 0;
        hipGetDevice(&dev);
        hipDeviceGetAttribute(&cus, hipDeviceAttributeMultiprocessorCount, dev);
        if (hipFuncSetAttribute((const void*)fwd_megakernel, hipFuncAttributeMaxDynamicSharedMemorySize, LDS_BYTES) != hipSuccess) { fprintf(stderr, "kernel_launch: hipFuncSetAttribute failed\n"); grid_blocks = -1; return; }
        if (hipOccupancyMaxActiveBlocksPerMultiprocessor(&per_cu, (const void*)fwd_megakernel, 512, LDS_BYTES) != hipSuccess || per_cu < 1) { fprintf(stderr, "kernel_launch: occupancy query failed (%d)\n", per_cu); grid_blocks = -1; return; }
        grid_blocks = cus * per_cu;
        if (grid_blocks > 256) grid_blocks = 256;
    }
    if (grid_blocks < 0) return;
    Params p{};
    for (int i = 0; i < 19; ++i) p.in[i] = (const float*)d_in[i];
    p.out = (float*)d_out; p.ws = (unsigned char*)d_ws;
    void* args[] = {&p};
    hipError_t e = hipLaunchCooperativeKernel((const void*)fwd_megakernel, dim3(grid_blocks), dim3(512), args, LDS_BYTES, stream);
    if (e != hipSuccess) fprintf(stderr, "cooperative launch failed: %s (grid %d)\n", hipGetErrorString(e), grid_blocks);
}
```

```cpp
#include <hip/hip_runtime.h>
#include <hip/hip_cooperative_groups.h>
#include <cstdio>
#include <cstdint>
namespace cg = cooperative_groups;
#ifndef REP_ATT
#define REP_ATT 1
#endif
#ifndef REP_P1
#define REP_P1 1
#endif
#ifndef REP_P0
#define REP_P0 1
#endif

#define LAS __attribute__((address_space(3)))
#define DI __device__ __forceinline__
typedef unsigned short bf16_t;
typedef short bf16x8 __attribute__((ext_vector_type(8)));
typedef short s16x4 __attribute__((ext_vector_type(4)));
typedef float f32x2 __attribute__((ext_vector_type(2)));
typedef float f32x4 __attribute__((ext_vector_type(4)));
typedef float f32x16 __attribute__((ext_vector_type(16)));
typedef unsigned u32x4 __attribute__((ext_vector_type(4)));
typedef unsigned u32x2 __attribute__((ext_vector_type(2)));
typedef __bf16 bf16x2_t __attribute__((ext_vector_type(2)));

constexpr int M = 16384, D = 1024, SEQ = 2048, HM = 8192;
constexpr int HP = 2304;
constexpr int NH1 = 5376;
constexpr int NWIN = 8448;
constexpr float LOG2E = 1.4426950408889634f;
constexpr float QS64 = 0.125f * LOG2E;
constexpr float QS96 = 0.10206207261596575f * LOG2E;
constexpr float ALPHA = 1.4142135623730951f;
constexpr int C_AZ = 0, C_BZ = 512, C_CZ = 1024, C_CKV = 1536, C_CQL = 1792;
constexpr size_t HM_AQ = (size_t)18 * 1048576, HM_AK = (size_t)22 * 1048576, HM_AV = (size_t)26 * 1048576, HM_CQ = (size_t)30 * 1048576, HM_CK = (size_t)34 * 1048576, HM_CV = (size_t)38 * 1048576;

constexpr size_t MiB = 1048576;
constexpr size_t WS_CTL = 0, WS_XB = 2 * MiB, WS_WT = 34 * MiB, WS_PB = 60 * MiB, WS_Y = 68 * MiB, WS_H = 116 * MiB, WS_MLA = 200 * MiB, WS_END = 232 * MiB;
constexpr size_t CTL_DEP = 8192, CTL_BAR = 16384, CTL_LAM = 4096, CTL_ROPE = 65536, CTL_KMP = 384 * 1024, CTL_STQ = 640 * 1024, CTL_STKV = 1152 * 1024;
constexpr size_t OFF_WIN = 0, OFF_WUQ = 8650752, OFF_WUKV = 8945664, OFF_WABC = 9207808, OFF_WO = 10780672, OFF_WPG = 11829248, OFF_WP = 12877824;
constexpr int LDS_BYTES = 132 * 1024, LDS_IDX = 131072;

DI int opaque_s(int v) { asm volatile("" : "+s"(v)); return v; }
DI int opaque_tid() { int t = threadIdx.x; asm volatile("" : "+v"(t)); return t; }
DI unsigned pk2(float lo, float hi) { f32x2 v = {lo, hi}; bf16x2_t b = __builtin_convertvector(v, bf16x2_t); return __builtin_bit_cast(unsigned, b); }
DI float bflo(unsigned w) { return __uint_as_float(w << 16); }
DI float bfhi(unsigned w) { return __uint_as_float(w & 0xffff0000u); }
DI float bf2f(bf16_t b) { return __uint_as_float((unsigned)b << 16); }
DI bf16_t f2bf(float f) { return (bf16_t)(pk2(f, 0.f) & 0xffffu); }
DI float sigm(float x) { return __builtin_amdgcn_rcpf(1.f + __builtin_amdgcn_exp2f(-x * LOG2E)); }
DI float silu(float x) { return x * sigm(x); }
DI u32x4 pack8(const f32x4 a, const f32x4 b) { u32x4 w; w.x = pk2(a[0], a[1]); w.y = pk2(a[2], a[3]); w.z = pk2(b[0], b[1]); w.w = pk2(b[2], b[3]); return w; }
DI void unpack8(const u32x4 w, f32x4& a, f32x4& b) { a = (f32x4){bflo(w.x), bfhi(w.x), bflo(w.y), bfhi(w.y)}; b = (f32x4){bflo(w.z), bfhi(w.z), bflo(w.w), bfhi(w.w)}; }

namespace pg8 {
constexpr int BM = 256, BK = 64, HALF = 128, HTB = HALF * BK * 2, NXCD = 8, WGM = 8;
__host__ __device__ __forceinline__ int lds_byte(int r, int c) { const int st = (r >> 4) * 2 + (c >> 5), rr = r & 15, cc = c & 31, ob = rr * 64 + cc * 2; return st * 1024 + (ob ^ (((ob >> 9) & 1) << 5)); }
__host__ __device__ __forceinline__ void stage_rc(int b, int& R, int& C) { const int st = b / 1024, sb = b % 1024, swz = sb ^ (((sb >> 9) & 1) << 5); R = (st >> 1) * 16 + swz / 64; C = (st & 1) * 32 + (swz % 64) / 2; }
__host__ __device__ __forceinline__ int perm32(int rho) { const int n = rho >> 4, i = rho & 15; return 8 * (i >> 2) + 4 * n + (i & 3); }

struct Unit { int pm, pn; };
struct Gemm { const bf16_t* A; const bf16_t* Bt; int lda, K; };

struct StaticOrder {
    int nM, nN, nwg, G, c;
    DI void init(int M_, int N_, int G_, int c_) { nM = M_ / BM; nN = N_ / BM; nwg = nM * nN; G = G_; c = c_; }
    DI bool next(int i, Unit& u) const {
        const long L = (long)i * G + c; if (L >= nwg) return false;
        int wgid = (int)L; { const int q = nwg / NXCD, r = nwg % NXCD, xcd = wgid % NXCD, off = wgid / NXCD; wgid = (xcd < r ? xcd * (q + 1) : r * (q + 1) + (xcd - r) * q) + off; }
        const int nig = WGM * nN, gid = wgid / nig, fm = gid * WGM, gsz = (nM - fm) < WGM ? (nM - fm) : WGM;
        u.pm = fm + ((wgid % nig) % gsz); u.pn = (wgid % nig) / gsz; return true;
    }
};
struct P1Order {
    int G, c;
    DI bool next(int i, Unit& u) const {
        const long L = (long)i * G + c; if (L >= 672) return false;
        if (L < 96) { u.pm = (int)L / 3; u.pn = 18 + (int)L % 3; return true; }
        const int nM = 32, nN = 18, nwg = 576;
        int wgid = (int)L - 96; { const int q = nwg / NXCD, r = nwg % NXCD, xcd = wgid % NXCD, off = wgid / NXCD; wgid = (xcd < r ? xcd * (q + 1) : r * (q + 1) + (xcd - r) * q) + off; }
        const int nig = WGM * nN, gid = wgid / nig, fm = gid * WGM, gsz = (nM - fm) < WGM ? (nM - fm) : WGM;
        u.pm = fm + ((wgid % nig) % gsz); u.pn = (wgid % nig) / gsz; return true;
    }
};
struct ListOrder {
    int lo, hi, nN, c, G;
    DI bool next(int i, Unit& u) const {
        int k0 = 0; if (c < lo) k0 = (lo - c + G - 1) / G;
        const int idx = c + (k0 + i) * G; if (idx >= hi) return false;
        const int loc = idx - lo; u.pm = loc / nN; u.pn = loc % nN; return true;
    }
};
struct MergeOrder {
    int c, G;
    DI bool next(int i, Unit& u) const {
        const int tile = c + (i / 3) * G, br = i % 3; if (tile >= 256) return false;
        u.pm = br * 64 + (tile >> 2); u.pn = br * 4 + (tile & 3); return true;
    }
};

template <class Epi, class Sched>
DI void gemm_phase(LAS unsigned char* lds, const Gemm g, const Sched& S, const Epi& E) {
    const int tid = opaque_tid(), wid = __builtin_amdgcn_readfirstlane(tid >> 6), lane = tid & 63, wr = wid >> 2, wc = wid & 3, fr = lane & 15, fq = lane >> 4;
    const int K = g.K, nt = K / BK, lda = g.lda;
    unsigned voffA[2], voffB[2];
#pragma unroll
    for (int i = 0; i < 2; ++i) { int R, C; stage_rc(tid * 16 + i * 8192, R, C); const int Rb = (R & ~31) + perm32(R & 31);
        voffA[i] = (unsigned)(R * lda + C) * 2u; voffB[i] = (unsigned)(Rb * K + C) * 2u; }
    const size_t kstep = (size_t)(BK * 2);
    const size_t hstepA = (size_t)HALF * lda * 2, hstepB = (size_t)HALF * K * 2;
    const size_t tstepA = 2 * hstepA, tstepB = 2 * hstepB;
    const unsigned ldsw = (unsigned)wid * 1024u;
    const int aoff = lds_byte(wr * 64 + fr, fq * 8), boff = lds_byte(wc * 32 + fr, fq * 8);
#define PG8_SA(b, h) (((b) * 2 + (h)) * HTB)
#define PG8_SB(b, h) ((4 + (b) * 2 + (h)) * HTB)
#define PG8_STAGE(bufoff, gbase, voff) do { _Pragma("unroll") for (int _i = 0; _i < 2; ++_i) \
        __builtin_amdgcn_global_load_lds((const unsigned*)((const char*)(gbase) + (voff)[_i]), (LAS unsigned*)(lds + (bufoff) + ldsw + _i * 8192), 16, 0, 0); } while (0)
#define PG8_LDA(dst, b, h) do { _Pragma("unroll") for (int m = 0; m < 4; ++m) _Pragma("unroll") for (int k = 0; k < 2; ++k) dst[m][k] = *(const LAS bf16x8*)(lds + PG8_SA(b, h) + aoff + m * 2048 + k * 1024); } while (0)
#define PG8_LDB(dst, b, h) do { _Pragma("unroll") for (int n = 0; n < 2; ++n) _Pragma("unroll") for (int k = 0; k < 2; ++k) dst[n][k] = *(const LAS bf16x8*)(lds + PG8_SB(b, h) + boff + n * 2048 + k * 1024); } while (0)
#define PG8_MMA(ai, bj, At, Bt) do { __builtin_amdgcn_s_setprio(1); _Pragma("unroll") for (int m = 0; m < 4; ++m) _Pragma("unroll") for (int n = 0; n < 2; ++n) _Pragma("unroll") for (int k = 0; k < 2; ++k) \
        acc[ai][bj][m][n] = __builtin_amdgcn_mfma_f32_16x16x32_bf16(Bt[n][k], At[m][k], acc[ai][bj][m][n], 0, 0, 0); __builtin_amdgcn_s_setprio(0); } while (0)
#define PG8_WAIT_V(n) asm volatile("s_waitcnt vmcnt(" #n ")" ::: "memory")
#define PG8_WAIT_L(n) asm volatile("s_waitcnt lgkmcnt(" #n ")" ::: "memory")
#define PG8_BAR __builtin_amdgcn_s_barrier()
#define PG8_SCHED __builtin_amdgcn_sched_barrier(0)
    Unit cur, nxt; int ui = 0;
    if (!S.next(0, cur)) return;
    f32x4 acc[2][2][4][2];
#pragma unroll
    for (int a = 0; a < 2; ++a)
#pragma unroll
        for (int b = 0; b < 2; ++b)
#pragma unroll
            for (int m = 0; m < 4; ++m)
#pragma unroll
                for (int n = 0; n < 2; ++n) acc[a][b][m][n] = (f32x4){0.f, 0.f, 0.f, 0.f};
    bf16x8 At[4][2], B0[2][2], B1[2][2];
    const char* cA = (const char*)g.A + (size_t)cur.pm * tstepA; const char* cB = (const char*)g.Bt + (size_t)cur.pn * tstepB;
    PG8_STAGE(PG8_SB(0, 0), cB, voffB); PG8_STAGE(PG8_SB(0, 1), cB + hstepB, voffB); PG8_STAGE(PG8_SA(0, 0), cA, voffA); PG8_STAGE(PG8_SA(0, 1), cA + hstepA, voffA);
    if (wr == 1) PG8_BAR;
    PG8_WAIT_V(2); PG8_BAR;
    PG8_STAGE(PG8_SB(1, 0), cB + kstep, voffB); PG8_STAGE(PG8_SA(1, 0), cA + kstep, voffA); PG8_STAGE(PG8_SB(1, 1), cB + hstepB + kstep, voffB);
    PG8_WAIT_V(6); PG8_BAR;
    for (;;) {
        const bool has_next = S.next(ui + 1, nxt);
        const char* nA = has_next ? (const char*)g.A + (size_t)nxt.pm * tstepA : cA; const char* nB = has_next ? (const char*)g.Bt + (size_t)nxt.pn * tstepB : cB;
#pragma nounroll
        for (int t = 0; t < nt; t += 2) {
            const bool last = (t == nt - 2);
            const char* a1 = cA + (size_t)(t + 1) * kstep;
            const char* a2 = last ? nA : cA + (size_t)(t + 2) * kstep; const char* b2 = last ? nB : cB + (size_t)(t + 2) * kstep;
            const char* a3 = a2 + kstep; const char* b3 = b2 + kstep;
            PG8_LDB(B0, 0, 0); PG8_LDB(B1, 0, 1); PG8_SCHED; PG8_LDA(At, 0, 0); PG8_STAGE(PG8_SA(1, 1), a1 + hstepA, voffA);
            PG8_WAIT_V(8); PG8_WAIT_L(0); PG8_BAR; PG8_MMA(0, 0, At, B0); PG8_MMA(0, 1, At, B1); PG8_BAR; PG8_SCHED;
            PG8_LDA(At, 0, 1); PG8_STAGE(PG8_SB(0, 0), b2, voffB); PG8_STAGE(PG8_SB(0, 1), b2 + hstepB, voffB); PG8_STAGE(PG8_SA(0, 0), a2, voffA);
            PG8_WAIT_V(8); PG8_WAIT_L(0); PG8_BAR; PG8_MMA(1, 0, At, B0); PG8_MMA(1, 1, At, B1); PG8_BAR; PG8_SCHED;
            PG8_LDB(B0, 1, 0); PG8_LDB(B1, 1, 1); PG8_SCHED; PG8_LDA(At, 1, 0); PG8_STAGE(PG8_SA(0, 1), a2 + hstepA, voffA);
            PG8_WAIT_V(8); PG8_WAIT_L(0); PG8_BAR; PG8_MMA(0, 0, At, B0); PG8_MMA(0, 1, At, B1); PG8_BAR; PG8_SCHED;
            PG8_LDA(At, 1, 1); PG8_STAGE(PG8_SB(1, 0), b3, voffB); PG8_STAGE(PG8_SB(1, 1), b3 + hstepB, voffB); PG8_STAGE(PG8_SA(1, 0), a3, voffA);
            PG8_WAIT_V(8); PG8_WAIT_L(0); PG8_BAR; PG8_MMA(1, 0, At, B0); PG8_MMA(1, 1, At, B1); PG8_BAR; PG8_SCHED;
        }
        if (wr == 0) PG8_BAR;
        E(acc, cur, wr, wc, fr, fq);
        if (!has_next) break;
#pragma unroll
        for (int a = 0; a < 2; ++a)
#pragma unroll
            for (int b = 0; b < 2; ++b)
#pragma unroll
                for (int m = 0; m < 4; ++m)
#pragma unroll
                    for (int n = 0; n < 2; ++n) acc[a][b][m][n] = (f32x4){0.f, 0.f, 0.f, 0.f};
        cur = nxt; cA = nA; cB = nB; ++ui;
        if (wr == 1) PG8_BAR;
    }
    PG8_WAIT_V(0);
    PG8_BAR;
#undef PG8_SA
#undef PG8_SB
#undef PG8_STAGE
#undef PG8_LDA
#undef PG8_LDB
#undef PG8_MMA
#undef PG8_WAIT_V
#undef PG8_WAIT_L
#undef PG8_BAR
#undef PG8_SCHED
}
typedef f32x4 Acc[2][2][4][2];

struct EpiH {
    bf16_t* H; bf16_t* KB; float* KMP; float* STQ; float* STKV; const float* rope; unsigned* dep;
    DI void operator()(const Acc& acc, const Unit& u, int wr, int wc, int fr, int fq) const {
        const int row0 = u.pm * BM + wr * 64 + fr;
        {
            const int pn = u.pn; bf16_t* base; int hw = 0, cseg;
            if (pn < 6) { base = H + (pn < 2 ? HM_AQ : pn < 4 ? HM_AK : HM_AV); hw = 64; cseg = (pn & 1) * 256; }
            else if (pn < 10) { base = H + (pn < 8 ? C_AZ : C_BZ); cseg = (pn & 1) * 256; }
            else if (pn < 16) { base = H + (pn < 12 ? HM_CQ : pn < 14 ? HM_CK : HM_CV); hw = 128; cseg = (pn & 1) * 256; }
            else if (pn < 18) { base = H + C_CZ; cseg = (pn & 1) * 256; }
            else { base = H + C_CKV; cseg = (pn - 18) * 256; }
            const int bl = u.pm >> 3, s0 = (u.pm & 7) * 256 + wr * 64 + fr;
#pragma unroll
            for (int bj = 0; bj < 2; ++bj) { const int cs = cseg + bj * HALF + wc * 32 + 8 * fq;
                bf16_t* colp; size_t pitch;
                if (hw == 64) { colp = base + ((size_t)(bl * 8 + (cs >> 6)) * SEQ) * 64 + (cs & 63); pitch = 64; }
                else if (hw == 128) { colp = base + ((size_t)(bl * 4 + (cs >> 7)) * SEQ) * 128 + (cs & 127); pitch = 128; }
                else { colp = base + (size_t)bl * SEQ * HP + cs; pitch = HP; }
#pragma unroll
                for (int ai = 0; ai < 2; ++ai)
#pragma unroll
                    for (int m = 0; m < 4; ++m) *(u32x4*)(colp + (size_t)(s0 + ai * HALF + m * 16) * pitch) = pack8(acc[ai][bj][m][0], acc[ai][bj][m][1]); }
        }
        if (u.pn == 2 || u.pn == 3) {
            float* dst = KMP + (size_t)(u.pm * 2 + wr) * 512 + (u.pn - 2) * 256 + wc * 32 + 8 * fq;
#pragma unroll
            for (int bj = 0; bj < 2; ++bj)
#pragma unroll
                for (int n = 0; n < 2; ++n) { f32x4 s = (f32x4){0.f, 0.f, 0.f, 0.f};
#pragma unroll
                    for (int ai = 0; ai < 2; ++ai)
#pragma unroll
                        for (int m = 0; m < 4; ++m) s += acc[ai][bj][m][n];
#pragma unroll
                    for (int e = 0; e < 4; ++e) { float v = s[e]; v += __shfl_xor(v, 1); v += __shfl_xor(v, 2); v += __shfl_xor(v, 4); v += __shfl_xor(v, 8); s[e] = v; }
                    if (fr == 0) *(f32x4*)(dst + bj * HALF + 4 * n) = s; }
        }
        if (u.pn >= 18) {
#pragma unroll
            for (int ai = 0; ai < 2; ++ai)
#pragma unroll
                for (int m = 0; m < 4; ++m) { const int row = row0 + ai * HALF + m * 16; float ss = 0.f;
#pragma unroll
                    for (int bj = 0; bj < 2; ++bj) { if (u.pn == 20 && bj == 1) continue;
#pragma unroll
                        for (int n = 0; n < 2; ++n) { const f32x4 x = acc[ai][bj][m][n]; ss += (x[0] * x[0] + x[1] * x[1]) + (x[2] * x[2] + x[3] * x[3]); } }
                    ss += __shfl_xor(ss, 16); ss += __shfl_xor(ss, 32);
                    if (fq == 0) { if (u.pn == 18) STKV[(size_t)row * 4 + wc] = ss; else STQ[(size_t)row * 8 + (u.pn - 19) * 4 + wc] = ss; }
                    if (u.pn == 20 && wc == 0) {
                        const int pos = row & (SEQ - 1); f32x4 o[2];
#pragma unroll
                        for (int n = 0; n < 2; ++n) { const f32x4 cs = *(const f32x4*)(rope + ((size_t)pos * 16 + 4 * fq + 2 * n) * 2); const f32x4 t = acc[ai][1][m][n];
                            o[n] = (f32x4){t[0] * cs[0] - t[1] * cs[1], t[0] * cs[1] + t[1] * cs[0], t[2] * cs[2] - t[3] * cs[3], t[2] * cs[3] + t[3] * cs[2]}; }
                        const u32x4 w = pack8(o[0], o[1]);
#pragma unroll
                        for (int h = 0; h < 8; ++h) *(u32x4*)(KB + ((size_t)((row >> 11) * 8 + h) * SEQ + pos) * 96 + 64 + 8 * fq) = w;
                    }
                }
        }
        if (u.pn >= 18) {
            asm volatile("s_waitcnt vmcnt(0)" ::: "memory");
            __syncthreads();
            if (threadIdx.x == 0) {
                __builtin_amdgcn_fence(__ATOMIC_RELEASE, "agent");
                asm volatile("s_waitcnt vmcnt(0)" ::: "memory");
                __hip_atomic_fetch_add(dep + u.pm, 8u, __ATOMIC_RELAXED, __HIP_MEMORY_SCOPE_AGENT);
            }
        }
    }
};
template <int MODE> struct EpiUp {
    bf16_t* QB; bf16_t* KB; bf16_t* VB; const float* ST; const float* rope;
    DI void operator()(const Acc& acc, const Unit& u, int wr, int wc, int fr, int fq) const {
        const int row0 = u.pm * BM + wr * 64 + fr;
#pragma unroll
        for (int ai = 0; ai < 2; ++ai)
#pragma unroll
            for (int m = 0; m < 4; ++m) { const int row = row0 + ai * HALF + m * 16; float sc;
                if (MODE == 0) { const f32x4 a = *(const f32x4*)(ST + (size_t)row * 8), b = *(const f32x4*)(ST + (size_t)row * 8 + 4);
                    sc = __builtin_amdgcn_rsqf(((a[0] + a[1]) + (a[2] + a[3]) + (b[0] + b[1]) + (b[2] + b[3])) * (1.f / 384.f) + 1e-6f) * QS96; }
                else { const f32x4 a = *(const f32x4*)(ST + (size_t)row * 4); sc = __builtin_amdgcn_rsqf(((a[0] + a[1]) + (a[2] + a[3])) * (1.f / 256.f) + 1e-6f); }
                const int pos = row & (SEQ - 1);
#pragma unroll
                for (int bj = 0; bj < 2; ++bj) { const int c0 = u.pn * BM + bj * HALF + wc * 32 + 8 * fq;
                    f32x4 v0 = acc[ai][bj][m][0] * sc, v1 = acc[ai][bj][m][1] * sc;
                    if (MODE == 0) { const int j = c0 % 96;
                        if (j >= 64) { const int i0 = (j - 64) >> 1; const f32x4 ca = *(const f32x4*)(rope + ((size_t)pos * 16 + i0) * 2), cb = *(const f32x4*)(rope + ((size_t)pos * 16 + i0 + 2) * 2);
                            v0 = (f32x4){v0[0] * ca[0] - v0[1] * ca[1], v0[0] * ca[1] + v0[1] * ca[0], v0[2] * ca[2] - v0[3] * ca[3], v0[2] * ca[3] + v0[3] * ca[2]};
                            v1 = (f32x4){v1[0] * cb[0] - v1[1] * cb[1], v1[0] * cb[1] + v1[1] * cb[0], v1[2] * cb[2] - v1[3] * cb[3], v1[2] * cb[3] + v1[3] * cb[2]}; }
                        *(u32x4*)(QB + ((size_t)((row >> 11) * 8 + c0 / 96) * SEQ + pos) * 96 + j) = pack8(v0, v1); }
                    else { if (c0 < 512) *(u32x4*)(KB + ((size_t)((row >> 11) * 8 + (c0 >> 6)) * SEQ + pos) * 96 + (c0 & 63)) = pack8(v0, v1);
                           else *(u32x4*)(VB + ((size_t)((row >> 11) * 8 + ((c0 - 512) >> 6)) * SEQ + pos) * 64 + (c0 & 63)) = pack8(v0, v1); }
                }
            }
    }
};
struct EpiG {
    bf16_t* G; const float* bias;
    DI void operator()(const Acc& acc, const Unit& u, int wr, int wc, int fr, int fq) const {
        const int row0 = u.pm * BM + wr * 64 + fr, col0 = u.pn * BM + wc * 32 + 8 * fq;
        f32x4 bv[2][2];
#pragma unroll
        for (int bj = 0; bj < 2; ++bj)
#pragma unroll
            for (int n = 0; n < 2; ++n) bv[bj][n] = *(const f32x4*)(bias + col0 + bj * HALF + 4 * n);
#pragma unroll
        for (int ai = 0; ai < 2; ++ai)
#pragma unroll
            for (int m = 0; m < 4; ++m) { bf16_t* rowp = G + (size_t)(row0 + ai * HALF + m * 16) * 3072 + col0;
#pragma unroll
                for (int bj = 0; bj < 2; ++bj) { f32x4 v0 = acc[ai][bj][m][0] + bv[bj][0], v1 = acc[ai][bj][m][1] + bv[bj][1];
#pragma unroll
                    for (int e = 0; e < 4; ++e) { v0[e] = sigm(v0[e]); v1[e] = sigm(v1[e]); }
                    *(u32x4*)(rowp + bj * HALF) = pack8(v0, v1); } }
    }
};
struct EpiMerge {
    const bf16_t* G; bf16_t* MG;
    DI void operator()(const Acc& acc, const Unit& u, int wr, int wc, int fr, int fq) const {
        const int br = u.pn >> 2, pm = u.pm - 64 * br, pn = u.pn & 3;
        const int row0 = pm * BM + wr * 64 + fr, col0 = pn * BM + wc * 32 + 8 * fq;
#pragma unroll
        for (int ai = 0; ai < 2; ++ai)
#pragma unroll
            for (int m = 0; m < 4; ++m) { const size_t row = (size_t)(row0 + ai * HALF + m * 16);
#pragma unroll
                for (int bj = 0; bj < 2; ++bj) { f32x4 g0, g1; unpack8(*(const u32x4*)(G + row * 3072 + br * 1024 + col0 + bj * HALF), g0, g1);
                    f32x4 v0 = acc[ai][bj][m][0] * g0, v1 = acc[ai][bj][m][1] * g1;
                    bf16_t* dst = MG + row * 1024 + col0 + bj * HALF;
                    if (br > 0) { f32x4 p0, p1; unpack8(*(const u32x4*)dst, p0, p1); v0 += p0; v1 += p1; }
                    *(u32x4*)dst = pack8(v0, v1); } }
    }
};
struct EpiR {
    const float* X; float* R; bf16_t* RB;
    DI void operator()(const Acc& acc, const Unit& u, int wr, int wc, int fr, int fq) const {
        const int row0 = u.pm * BM + wr * 64 + fr, col0 = u.pn * BM + wc * 32 + 8 * fq;
#pragma unroll
        for (int ai = 0; ai < 2; ++ai)
#pragma unroll
            for (int m = 0; m < 4; ++m) { const size_t off = (size_t)(row0 + ai * HALF + m * 16) * 1024 + col0;
#pragma unroll
                for (int bj = 0; bj < 2; ++bj) { const f32x4 x0 = *(const f32x4*)(X + off + bj * HALF), x1 = *(const f32x4*)(X + off + bj * HALF + 4);
                    const f32x4 v0 = x0 * ALPHA + acc[ai][bj][m][0], v1 = x1 * ALPHA + acc[ai][bj][m][1];
                    *(f32x4*)(R + off + bj * HALF) = v0; *(f32x4*)(R + off + bj * HALF + 4) = v1;
                    *(u32x4*)(RB + off + bj * HALF) = pack8(v0, v1); } }
    }
};
struct EpiBf {
    bf16_t* O;
    DI void operator()(const Acc& acc, const Unit& u, int wr, int wc, int fr, int fq) const {
        const int row0 = u.pm * BM + wr * 64 + fr, col0 = u.pn * BM + wc * 32 + 8 * fq;
#pragma unroll
        for (int ai = 0; ai < 2; ++ai)
#pragma unroll
            for (int m = 0; m < 4; ++m) { bf16_t* rowp = O + (size_t)(row0 + ai * HALF + m * 16) * 1024 + col0;
#pragma unroll
                for (int bj = 0; bj < 2; ++bj) *(u32x4*)(rowp + bj * HALF) = pack8(acc[ai][bj][m][0], acc[ai][bj][m][1]); }
    }
};
struct EpiR2 {
    float* R; const bf16_t* PP;
    DI void operator()(const Acc& acc, const Unit& u, int wr, int wc, int fr, int fq) const {
        const int row0 = u.pm * BM + wr * 64 + fr, col0 = u.pn * BM + wc * 32 + 8 * fq;
#pragma unroll
        for (int ai = 0; ai < 2; ++ai)
#pragma unroll
            for (int m = 0; m < 4; ++m) { const size_t off = (size_t)(row0 + ai * HALF + m * 16) * 1024 + col0;
#pragma unroll
                for (int bj = 0; bj < 2; ++bj) { f32x4 p0, p1; unpack8(*(const u32x4*)(PP + off + bj * HALF), p0, p1);
                    f32x4 r0 = *(const f32x4*)(R + off + bj * HALF), r1 = *(const f32x4*)(R + off + bj * HALF + 4);
                    const f32x4 a0 = acc[ai][bj][m][0], a1 = acc[ai][bj][m][1];
#pragma unroll
                    for (int e = 0; e < 4; ++e) { r0[e] += sigm(a0[e]) * p0[e]; r1[e] += sigm(a1[e]) * p1[e]; }
                    *(f32x4*)(R + off + bj * HALF) = r0; *(f32x4*)(R + off + bj * HALF + 4) = r1; } }
    }
};
}

DI int crow(int r, int hi) { return (r & 3) + 8 * (r >> 2) + 4 * hi; }
DI s16x4 vtr(LAS const char* p) { typedef short v4i16_t __attribute__((ext_vector_type(4))); return __builtin_bit_cast(s16x4, __builtin_amdgcn_ds_read_tr16_b64_v4i16((LAS v4i16_t*)p)); }
constexpr int AT_SCR = 112 * 1024, AT_KM = 113 * 1024;
constexpr float NEGBIG = -1e30f;
DI float max3f(float a, float b, float c) { return fmaxf(fmaxf(a, b), c); }

template <int DQK, int KW, int DV, int NROWS, bool ALIBI, bool MOBA, bool PIPE, int NSET>
DI void attn_unit(LAS char* lds, const bf16_t* Qp, int ldq, const bf16_t* Kp, int ldk, const bf16_t* Vp, int ldv,
                  const bf16_t* Zp, int ldz, bf16_t* Yp, int ldy, int q0, float sl2, const float* kmp, float lam, const float* subg, float post) {
    constexpr int NTD = NROWS / 64, NS = DQK / 16, ND = DV / 32;
    constexpr int KPITCH = KW * 2 + 16, VPITCH = DV * 2 + 64;
    constexpr int KOFF0 = 0, VOFF0 = 3 * 64 * KPITCH;
    constexpr int KCH = KW / 8, VCH = DV / 8, NKC = 64 * KCH, NVC = 64 * VCH, KPT = (NKC + 511) / 512, VPT = (NVC + 511) / 512;
    static_assert(VOFF0 + 3 * 64 * VPITCH <= AT_SCR, "attention LDS map");
    const int tid = opaque_tid(), lane = tid & 63, r32 = lane & 31, hi = lane >> 5;
    const int wid = __builtin_amdgcn_readfirstlane(tid >> 6);
    const int ro = (NROWS == 256) ? 32 * wid : 32 * (wid & 3);
    const int map = (NROWS == 256) ? 0 : (wid >> 2);
    const int qpos = q0 + ro + r32;
    LAS float* scr = (LAS float*)(lds + AT_SCR) + wid * 32;

    bf16x8 qf[NS];
    { const bf16_t* qrow = Qp + (size_t)qpos * ldq + 64 * map + 8 * hi;
#pragma unroll
      for (int s = 0; s < NS; ++s) qf[s] = *(const bf16x8*)(qrow + 16 * s); }

    unsigned sel = 0xFFu;
    if (MOBA) {
        const int u = q0 >> 8;
        if (u > 3) {
            LAS float* km = (LAS float*)(lds + AT_KM);
            { const int j = tid >> 6, d = tid & 63; if (j < u) km[j * 64 + d] = (kmp[(size_t)(j * 2) * 512 + d] + kmp[(size_t)(j * 2 + 1) * 512 + d]) * (1.f / 256.f); }
            __syncthreads();
            float g[7];
#pragma unroll
            for (int j = 0; j < 7; ++j) { float a = 0.f;
                if (j < u) {
#pragma unroll
                    for (int s = 0; s < 4; ++s) { const f32x4 k0 = *(const LAS f32x4*)(km + j * 64 + 16 * s + 8 * hi), k1 = *(const LAS f32x4*)(km + j * 64 + 16 * s + 8 * hi + 4);
#pragma unroll
                        for (int e = 0; e < 4; ++e) { a += bf2f((bf16_t)qf[s][e]) * k0[e]; a += bf2f((bf16_t)qf[s][4 + e]) * k1[e]; } }
                }
                a += __shfl_xor(a, 32); g[j] = a; }
            sel = 0u;
#pragma unroll
            for (int k = 0; k < 3; ++k) { float best = -INFINITY; int bi = 0;
#pragma unroll
                for (int j = 0; j < 7; ++j) { const bool ok = (j < u) && !((sel >> j) & 1u) && (g[j] > best); best = ok ? g[j] : best; bi = ok ? j : bi; }
                sel |= 1u << bi; }
        }
    }

    f32x16 o[ND];
#pragma unroll
    for (int d0 = 0; d0 < ND; ++d0)
#pragma unroll
        for (int r = 0; r < 16; ++r) o[d0][r] = 0.f;
    f32x16 bias;
#pragma unroll
    for (int r = 0; r < 16; ++r) bias[r] = ALIBI ? sl2 * (float)((r & 3) + 8 * (r >> 2) + 4 * hi) : 0.f;
    const float d32 = ALIBI ? 32.f * sl2 : 0.f;
    float mrun = NEGBIG, lrun = 0.f;
    const int nt = NTD + (q0 >> 6);
    u32x4 kregA[KPT], vregA[VPT], kregB[KPT], vregB[VPT], kregC[KPT], vregC[VPT], kregD[KPT], vregD[VPT];
#define AT_TB(it) ((it) < NTD ? q0 + 64 * (it) : 64 * ((it) - NTD))
#define AT_LOAD(it, kreg, vreg) do { const int _ti = ((it) < nt) ? (it) : nt - 1; const int _kb = AT_TB(_ti); \
        _Pragma("unroll") for (int _i = 0; _i < KPT; ++_i) { const int _c = tid + 512 * _i; if (NKC % 512 == 0 || _i + 1 < KPT || _c < NKC) { const int _r = _c / KCH, _cc = _c % KCH; kreg[_i] = *(const u32x4*)(Kp + (size_t)(_kb + _r) * ldk + 8 * _cc); } } \
        _Pragma("unroll") for (int _i = 0; _i < VPT; ++_i) { const int _c = tid + 512 * _i; if (NVC % 512 == 0 || _i + 1 < VPT || _c < NVC) { const int _r = _c / VCH, _cc = _c % VCH; vreg[_i] = *(const u32x4*)(Vp + (size_t)(_kb + _r) * ldv + 8 * _cc); } } } while (0)
#define AT_STORE(buf, kreg, vreg) do { \
        _Pragma("unroll") for (int _i = 0; _i < KPT; ++_i) { const int _c = tid + 512 * _i; if (NKC % 512 == 0 || _i + 1 < KPT || _c < NKC) { const int _r = _c / KCH, _cc = _c % KCH; *(LAS u32x4*)(lds + KOFF0 + (buf) * 64 * KPITCH + _r * KPITCH + 16 * _cc) = kreg[_i]; } } \
        _Pragma("unroll") for (int _i = 0; _i < VPT; ++_i) { const int _c = tid + 512 * _i; if (NVC % 512 == 0 || _i + 1 < VPT || _c < NVC) { const int _r = _c / VCH, _cc = _c % VCH; *(LAS u32x4*)(lds + VOFF0 + (buf) * 64 * VPITCH + _r * VPITCH + 16 * _cc) = vreg[_i]; } } } while (0)
#define AT_ACTIVE(it) ((it) >= NTD || 64 * (it) <= ro + 31)
#define AT_QK(it, bufi, P0, P1) do { if (AT_ACTIVE(it)) { \
        LAS const char* _Kb = lds + KOFF0 + (bufi) * 64 * KPITCH + r32 * KPITCH + (64 * map + 8 * hi) * 2; \
        _Pragma("unroll") for (int _h = 0; _h < NS; _h += 4) { \
            bf16x8 _kf[8]; \
            _Pragma("unroll") for (int _s = 0; _s < 4; ++_s) if (_h + _s < NS) { _kf[2 * _s] = *(const LAS bf16x8*)(_Kb + 32 * (_h + _s)); _kf[2 * _s + 1] = *(const LAS bf16x8*)(_Kb + 32 * KPITCH + 32 * (_h + _s)); } \
            __builtin_amdgcn_sched_barrier(0); \
            _Pragma("unroll") for (int _s = 0; _s < 4; ++_s) if (_h + _s < NS) { \
                if (_h + _s == 0) { P0 = __builtin_amdgcn_mfma_f32_32x32x16_bf16(_kf[0], qf[0], bias, 0, 0, 0); P1 = __builtin_amdgcn_mfma_f32_32x32x16_bf16(_kf[1], qf[0], bias, 0, 0, 0); } \
                else { P0 = __builtin_amdgcn_mfma_f32_32x32x16_bf16(_kf[2 * _s], qf[_h + _s], P0, 0, 0, 0); P1 = __builtin_amdgcn_mfma_f32_32x32x16_bf16(_kf[2 * _s + 1], qf[_h + _s], P1, 0, 0, 0); } } \
            __builtin_amdgcn_sched_barrier(0); } } } while (0)
    if (NSET == 4) { AT_LOAD(0, kregA, vregA); AT_LOAD(1, kregB, vregB); AT_LOAD(2, kregC, vregC); AT_LOAD(3, kregD, vregD); AT_STORE(0, kregA, vregA); AT_STORE(1, kregB, vregB);
                     AT_LOAD(4, kregA, vregA); AT_LOAD(5, kregB, vregB); }
    else if (NSET == 2) { AT_LOAD(0, kregA, vregA); AT_LOAD(1, kregB, vregB); AT_STORE(0, kregA, vregA); AT_STORE(1, kregB, vregB); AT_LOAD(2, kregA, vregA); AT_LOAD(3, kregB, vregB); }
    else { AT_LOAD(0, kregA, vregA); AT_STORE(0, kregA, vregA); AT_LOAD(1, kregA, vregA); AT_STORE(1, kregA, vregA); AT_LOAD(2, kregA, vregA); }
    __syncthreads();
    const int i16 = lane & 15;
    const int vlane = (4 * hi + (i16 >> 2)) * VPITCH + (16 * ((lane >> 4) & 1) + 4 * (i16 & 3)) * 2;
    f32x16 pa0, pa1, pb0, pb1;
#pragma unroll
    for (int r = 0; r < 16; ++r) { pa0[r] = 0.f; pa1[r] = 0.f; pb0[r] = 0.f; pb1[r] = 0.f; }
    if (PIPE) AT_QK(0, 0, pa0, pa1);
    int bcur = 0;
#define AT_ITER(it, C0, C1, N0, N1, kreg, vreg) do { \
        const int _b1 = (bcur == 2) ? 0 : bcur + 1, _b2 = (_b1 == 2) ? 0 : _b1 + 1; \
        AT_STORE(_b2, kreg, vreg); \
        AT_LOAD((it) + 2 + NSET, kreg, vreg); \
        if (PIPE) { if ((it) + 1 < nt) AT_QK((it) + 1, _b1, N0, N1); } else AT_QK(it, bcur, C0, C1); \
        if (AT_ACTIVE(it)) { \
            const int _kb = AT_TB(it); const bool _diag = (it) < NTD; \
            if (_diag) { const int _kq = _kb + 4 * hi - qpos; \
                _Pragma("unroll") for (int _r = 0; _r < 16; ++_r) { const int _dd = _kq + (_r & 3) + 8 * (_r >> 2); if (_dd > 0) C0[_r] = NEGBIG; if (_dd + 32 > 0) C1[_r] = NEGBIG; } } \
            float _m0 = max3f(C0[0], C0[1], C0[2]), _m1 = max3f(C1[0], C1[1], C1[2]); \
            _Pragma("unroll") for (int _r = 3; _r < 15; _r += 2) { _m0 = max3f(_m0, C0[_r], C0[_r + 1]); _m1 = max3f(_m1, C1[_r], C1[_r + 1]); } \
            _m0 = fmaxf(_m0, C0[15]); _m1 = fmaxf(_m1, C1[15]); \
            const float _c0 = ALIBI ? sl2 * (float)(_kb - qpos) : 0.f; \
            float _mx = fmaxf(_m0, _m1 + d32) + _c0; \
            bool _selok = true; if (MOBA && !_diag) _selok = ((sel >> (_kb >> 8)) & 1u) != 0u; \
            if (!_selok) _mx = NEGBIG; \
            _mx = fmaxf(_mx, __shfl_xor(_mx, 32)); \
            const float _mn = fmaxf(mrun, _mx); \
            if (__any(_mn - mrun > 8.f)) { \
                const float _alpha = __builtin_amdgcn_exp2f(mrun - _mn); lrun *= _alpha; mrun = _mn; \
                scr[r32] = _alpha; \
                asm volatile("s_waitcnt lgkmcnt(0)" ::: "memory"); \
                f32x4 _a4[4]; \
                _Pragma("unroll") for (int _g = 0; _g < 4; ++_g) _a4[_g] = *(const LAS f32x4*)(scr + 8 * _g + 4 * hi); \
                asm volatile("s_waitcnt lgkmcnt(0)" ::: "memory"); \
                _Pragma("unroll") for (int _d0 = 0; _d0 < ND; ++_d0) _Pragma("unroll") for (int _r = 0; _r < 16; ++_r) o[_d0][_r] *= _a4[_r >> 2][_r & 3]; \
            } \
            const float _ms0 = _selok ? (mrun - _c0) : INFINITY, _ms1 = _ms0 - d32; \
            float _ls = 0.f; \
            _Pragma("unroll") for (int _r = 0; _r < 16; ++_r) { C0[_r] = __builtin_amdgcn_exp2f(C0[_r] - _ms0); C1[_r] = __builtin_amdgcn_exp2f(C1[_r] - _ms1); _ls += C0[_r] + C1[_r]; } \
            lrun += _ls; \
            bf16x8 _pa[4]; \
            _Pragma("unroll") for (int _ks = 0; _ks < 2; ++_ks) { u32x4 _w; \
                _w.x = pk2(C0[8 * _ks], C0[8 * _ks + 1]); _w.y = pk2(C0[8 * _ks + 2], C0[8 * _ks + 3]); _w.z = pk2(C0[8 * _ks + 4], C0[8 * _ks + 5]); _w.w = pk2(C0[8 * _ks + 6], C0[8 * _ks + 7]); \
                _pa[_ks] = __builtin_bit_cast(bf16x8, _w); \
                _w.x = pk2(C1[8 * _ks], C1[8 * _ks + 1]); _w.y = pk2(C1[8 * _ks + 2], C1[8 * _ks + 3]); _w.z = pk2(C1[8 * _ks + 4], C1[8 * _ks + 5]); _w.w = pk2(C1[8 * _ks + 6], C1[8 * _ks + 7]); \
                _pa[2 + _ks] = __builtin_bit_cast(bf16x8, _w); } \
            LAS const char* _Vb = lds + VOFF0 + bcur * 64 * VPITCH + vlane; \
            _Pragma("unroll") for (int _d0 = 0; _d0 < ND; ++_d0) { bf16x8 _vf[4]; \
                _Pragma("unroll") for (int _ks = 0; _ks < 4; ++_ks) { \
                    const s16x4 _lo = vtr(_Vb + (16 * _ks) * VPITCH + 64 * _d0), _hh = vtr(_Vb + (16 * _ks + 8) * VPITCH + 64 * _d0); \
                    _vf[_ks] = __builtin_shufflevector(_lo, _hh, 0, 1, 2, 3, 4, 5, 6, 7); } \
                __builtin_amdgcn_sched_barrier(0); \
                _Pragma("unroll") for (int _ks = 0; _ks < 4; ++_ks) o[_d0] = __builtin_amdgcn_mfma_f32_32x32x16_bf16(_pa[_ks], _vf[_ks], o[_d0], 0, 0, 0); \
                __builtin_amdgcn_sched_barrier(0); } \
        } \
        bcur = _b1; \
        asm volatile("s_waitcnt lgkmcnt(0)\n\ts_barrier" ::: "memory"); } while (0)
    if (NSET == 4) {
        for (int it = 0; it < nt; it += 4) {
            AT_ITER(it, pa0, pa1, pb0, pb1, kregC, vregC);
            AT_ITER(it + 1, pb0, pb1, pa0, pa1, kregD, vregD);
            AT_ITER(it + 2, pa0, pa1, pb0, pb1, kregA, vregA);
            AT_ITER(it + 3, pb0, pb1, pa0, pa1, kregB, vregB);
        }
    } else {
        for (int it = 0; it < nt; it += 2) {
            AT_ITER(it, pa0, pa1, pb0, pb1, kregA, vregA);
            if (NSET == 2) AT_ITER(it + 1, pb0, pb1, pa0, pa1, kregB, vregB); else AT_ITER(it + 1, pb0, pb1, pa0, pa1, kregA, vregA);
        }
    }
#undef AT_TB
#undef AT_LOAD
#undef AT_STORE
#undef AT_ACTIVE
#undef AT_QK
#undef AT_ITER
    {
        const float lt = lrun + __shfl_xor(lrun, 32);
        scr[r32] = 1.f / lt;
        asm volatile("s_waitcnt lgkmcnt(0)" ::: "memory");
        f32x4 a4[4];
#pragma unroll
        for (int g = 0; g < 4; ++g) a4[g] = *(const LAS f32x4*)(scr + 8 * g + 4 * hi);
        asm volatile("s_waitcnt lgkmcnt(0)" ::: "memory");
#pragma unroll
        for (int d0 = 0; d0 < ND; ++d0)
#pragma unroll
            for (int r = 0; r < 16; ++r) o[d0][r] *= a4[r >> 2][r & 3];
    }
    if (NROWS == 256) {
#pragma unroll
        for (int d0 = 0; d0 < ND; ++d0)
#pragma unroll
            for (int r = 0; r < 16; ++r) { const size_t row = (size_t)(q0 + ro + crow(r, hi)); const int col = 32 * d0 + r32;
                const float z = bf2f(Zp[row * ldz + col]); Yp[row * ldy + col] = f2bf(o[d0][r] * silu(z)); }
    } else {
        LAS float* xch = (LAS float*)lds;
        if (map == 1) {
#pragma unroll
            for (int d0 = 0; d0 < ND; ++d0)
#pragma unroll
                for (int r = 0; r < 16; ++r) xch[(((wid & 3) * ND + d0) * 16 + r) * 64 + lane] = o[d0][r];
        }
        __syncthreads();
        if (map == 0) {
#pragma unroll
            for (int d0 = 0; d0 < ND; ++d0)
#pragma unroll
                for (int r = 0; r < 16; ++r) o[d0][r] -= lam * xch[(((wid & 3) * ND + d0) * 16 + r) * 64 + lane];
#pragma unroll
            for (int r = 0; r < 16; ++r) { float ss = 0.f;
#pragma unroll
                for (int d0 = 0; d0 < ND; ++d0) ss += o[d0][r] * o[d0][r];
                ss += __shfl_xor(ss, 1); ss += __shfl_xor(ss, 2); ss += __shfl_xor(ss, 4); ss += __shfl_xor(ss, 8); ss += __shfl_xor(ss, 16);
                const float rs = __builtin_amdgcn_rsqf(ss * (1.f / (float)DV) + 1e-5f) * post;
                const size_t row = (size_t)(q0 + ro + crow(r, hi));
#pragma unroll
                for (int d0 = 0; d0 < ND; ++d0) { const int col = 32 * d0 + r32; const float z = bf2f(Zp[row * ldz + col]);
                    Yp[row * ldy + col] = f2bf(o[d0][r] * rs * subg[col] * silu(z)); } }
        }
        __syncthreads();
    }
}

#define XB_TMO      128
#define XB_XCNT(j)  (256  + 64 * (j))
#define XB_XSUB(j)  (1280 + 64 * (j))
#define XB_XGEN(j)  (2304 + 64 * (j))
#define XB_TOP      3328
#define XB_TOPGEN   3392
#define XCD_BAR_WORDS 3456
#define XB_SPIN_CAP (1u << 22)
DI unsigned xb_ld(unsigned* p)              { return __hip_atomic_load(p, __ATOMIC_RELAXED, __HIP_MEMORY_SCOPE_AGENT); }
DI unsigned xb_add(unsigned* p, unsigned v) { return __hip_atomic_fetch_add(p, v, __ATOMIC_RELAXED, __HIP_MEMORY_SCOPE_AGENT); }
DI unsigned xb_xcc_id() { return (unsigned)__builtin_amdgcn_s_getreg((3 << 11) | 20) & 0xFu; }
#define XB_SPIN(cond, bar) do { unsigned _sp = 0; while (cond) { __builtin_amdgcn_s_sleep(1); \
    if ((++_sp & 255u) == 0u) { if (xb_ld(&(bar)[XB_TMO])) break; if (_sp > XB_SPIN_CAP) { atomicAdd(&(bar)[XB_TMO], 1u); break; } } } } while (0)
DI void xcd_barrier_complete(unsigned* bar, unsigned x, unsigned& nloc, unsigned& nx) {
    const unsigned Gn = gridDim.x;
    unsigned sum, cnt, mine, sp = 0u;
    for (;;) {
        sum = 0u; cnt = 0u; mine = 0u;
#pragma unroll
        for (unsigned j = 0; j < 16; ++j) { const unsigned c = xb_ld(&bar[XB_XCNT(j)]); sum += c; cnt += (c > 0u) ? 1u : 0u; mine = (j == x) ? c : mine; }
        if (sum == Gn) break;
        __builtin_amdgcn_s_sleep(1);
        if ((++sp & 255u) == 0u) { if (xb_ld(&bar[XB_TMO])) break; if (sp > XB_SPIN_CAP) { atomicAdd(&bar[XB_TMO], 1u); break; } }
    }
    nloc = mine > 0u ? mine : 1u; nx = cnt > 0u ? cnt : 1u;
}
DI void xcd_barrier(unsigned* bar, volatile LAS unsigned* st) {
    asm volatile("s_waitcnt vmcnt(0)" ::: "memory");
    __syncthreads();
    if (threadIdx.x == 0) {
        __builtin_amdgcn_s_waitcnt(0);
        const unsigned x = xb_xcc_id();
        unsigned nloc = st[0], nx = st[1];
        if (nloc == 0u) { xcd_barrier_complete(bar, x, nloc, nx); st[0] = nloc; st[1] = nx; }
        const unsigned old = xb_add(&bar[XB_XSUB(x)], 1u);
        const unsigned gen = old / nloc;
        if (old + 1u == (gen + 1u) * nloc) {
            __builtin_amdgcn_fence(__ATOMIC_RELEASE, "agent");
            asm volatile("s_waitcnt vmcnt(0)" ::: "memory");
            const unsigned og = xb_add(&bar[XB_TOP], 1u);
            const unsigned tg = og / nx;
            if (og + 1u == (tg + 1u) * nx) xb_add(&bar[XB_TOPGEN], 1u);
            else XB_SPIN(xb_ld(&bar[XB_TOPGEN]) == tg, bar);
            __builtin_amdgcn_fence(__ATOMIC_ACQUIRE, "agent");
            xb_add(&bar[XB_XGEN(x)], 1u);
            asm volatile("s_waitcnt vmcnt(0)" ::: "memory");
        } else {
            XB_SPIN(xb_ld(&bar[XB_XGEN(x)]) == gen, bar);
            __builtin_amdgcn_fence(__ATOMIC_ACQUIRE, "agent");
            asm volatile("s_waitcnt vmcnt(0)" ::: "memory");
        }
    }
    __syncthreads();
}

struct Params { const float* in[19]; float* out; unsigned char* ws; };

DI void colmap(int kind, int n, int& col, float& cs) {
    cs = 1.f;
    if (kind == 0) {
        if (n < 2048) { col = n; if (n < 512) cs = QS64; }
        else if (n < 2560) col = 2720 + (n - 2048);
        else if (n < 3072) { col = 3232 + (n - 2560); cs = QS64; }
        else if (n < 3584) col = 3744 + (n - 3072);
        else if (n < 4096) col = 4256 + (n - 3584);
        else if (n < 4608) col = 4768 + (n - 4096);
        else if (n < 4864) col = 2432 + (n - 4608);
        else if (n < 5248) col = 2048 + (n - 4864);
        else if (n < 5280) { const int j = n - 5248; col = 2688 + (j >> 1) + 16 * (j & 1); }
        else col = -1;
    } else if (kind == 1) col = n;
    else if (kind == 2) { const int h = n / 96, j = n % 96; if (j < 64) col = h * 96 + j; else { const int jj = j - 64; col = h * 96 + 64 + (jj >> 1) + 16 * (jj & 1); } }
    else { if (n < 512) col = (n >> 6) * 128 + (n & 63); else { const int m = n - 512; col = (m >> 6) * 128 + 64 + (m & 63); } }
}
DI void tr_tile(const float* src, int srcN, int K, bf16_t* dst, int kind, int n0, int k0, const float* kscale, LAS float* scr, int tid) {
    { const int nl = tid & 127, kl0 = tid >> 7; int col; float cs; colmap(kind, n0 + nl, col, cs);
      float v[16];
#pragma unroll
      for (int i = 0; i < 16; ++i) { const int kl = kl0 + 4 * i; v[i] = (col >= 0) ? src[(size_t)(k0 + kl) * srcN + col] : 0.f; }
#pragma unroll
      for (int i = 0; i < 16; ++i) { const int kl = kl0 + 4 * i; float w = v[i] * cs; if (kscale) w *= kscale[k0 + kl]; scr[kl * 129 + nl] = w; } }
    __syncthreads();
    { const int kp = tid & 31;
#pragma unroll
      for (int i = 0; i < 8; ++i) { const int nl = (tid >> 5) + 16 * i;
          *(unsigned*)(dst + (size_t)(n0 + nl) * K + k0 + 2 * kp) = pk2(scr[(2 * kp) * 129 + nl], scr[(2 * kp + 1) * 129 + nl]); } }
    __syncthreads();
}
typedef const __attribute__((address_space(4))) Params* KParams0;
DI void convert_weights(KParams0 Pk, int l, bf16_t* WT, LAS float* scr) {
    const int tid = opaque_tid();
    constexpr int T0 = 42 * 16, T1 = T0 + 24 * 16, T2 = T1 + 6 * 6, T3 = T2 + 8 * 4, T4 = T3 + 8 * 8, T5 = T4 + 8 * 8, T6 = T5 + 8 * 8, T7 = T6 + 8 * 16, T8 = T7 + 8 * 16, T9 = T8 + 8 * 4;
    for (int t = blockIdx.x; t < T9; t += gridDim.x) {
        const float* src; int srcN, K, kind, loc; bf16_t* dst; const float* ks = nullptr;
        if (t < T0) { src = Pk->in[2] + (size_t)l * 1024 * 5280; srcN = 5280; K = 1024; kind = 0; loc = t; dst = WT + OFF_WIN; }
        else if (t < T1) { src = Pk->in[12] + (size_t)l * 1024 * 3072; srcN = 3072; K = 1024; kind = 1; loc = t - T0; dst = WT + OFF_WIN + (size_t)5376 * 1024; }
        else if (t < T2) { src = Pk->in[5] + (size_t)l * 384 * 768; srcN = 768; K = 384; kind = 2; loc = t - T1; dst = WT + OFF_WUQ; ks = Pk->in[3] + l * 384; }
        else if (t < T3) { src = Pk->in[6] + (size_t)l * 256 * 1024; srcN = 1024; K = 256; kind = 3; loc = t - T2; dst = WT + OFF_WUKV; ks = Pk->in[4] + l * 256; }
        else if (t < T4) { src = Pk->in[9] + (size_t)l * 512 * 1024; srcN = 1024; K = 512; kind = 1; loc = t - T3; dst = WT + OFF_WABC; }
        else if (t < T5) { src = Pk->in[10] + (size_t)l * 512 * 1024; srcN = 1024; K = 512; kind = 1; loc = t - T4; dst = WT + OFF_WABC + (size_t)1024 * 512; }
        else if (t < T6) { src = Pk->in[11] + (size_t)l * 512 * 1024; srcN = 1024; K = 512; kind = 1; loc = t - T5; dst = WT + OFF_WABC + (size_t)2048 * 512; }
        else if (t < T7) { src = Pk->in[14] + (size_t)l * 1024 * 1024; srcN = 1024; K = 1024; kind = 1; loc = t - T6; dst = WT + OFF_WO; }
        else if (t < T8) { src = Pk->in[17] + (size_t)l * 1024 * 1024; srcN = 1024; K = 1024; kind = 1; loc = t - T7; dst = WT + OFF_WPG; }
        else { src = Pk->in[18] + (size_t)l * 256 * 1024; srcN = 1024; K = 256; kind = 1; loc = t - T8; dst = WT + OFF_WP; }
        const int kt = K / 64; const int n0 = (loc / kt) * 128, k0 = (loc % kt) * 64;
        tr_tile(src, srcN, K, dst, kind, n0, k0, ks, scr, tid);
    }
}
DI void convert_rows(const float* src, bf16_t* dst, size_t n) {
    const size_t stride = (size_t)gridDim.x * blockDim.x, ng = n / 8;
    for (size_t i = (size_t)blockIdx.x * blockDim.x + opaque_tid(); i < ng; i += 4 * stride) {
        f32x4 a[4], b[4];
#pragma unroll
        for (int j = 0; j < 4; ++j) { const size_t q = i + j * stride; if (q < ng) { a[j] = *(const f32x4*)(src + q * 8); b[j] = *(const f32x4*)(src + q * 8 + 4); } }
#pragma unroll
        for (int j = 0; j < 4; ++j) { const size_t q = i + j * stride; if (q < ng) *(u32x4*)(dst + q * 8) = pack8(a[j], b[j]); }
    }
}
typedef const __attribute__((address_space(4))) Params* KParams;
DI KParams kparams() { KParams p = (KParams)__builtin_amdgcn_kernarg_segment_ptr(); asm volatile("" : "+s"(p)); return p; }
DI unsigned char* wsbase() { unsigned char* w = kparams()->ws; asm volatile("" : "+s"(w)); return w; }

__global__ void __launch_bounds__(512, 2) fwd_megakernel(Params Punused) {
    extern __shared__ __attribute__((aligned(16))) unsigned char lds_raw[];
    cg::grid_group grid = cg::this_grid();
    LAS unsigned char* lds = (LAS unsigned char*)lds_raw;
#define G opaque_s((int)gridDim.x)
#define cu opaque_s((int)blockIdx.x)
#define XB_  ((bf16_t*)(ws + WS_XB))
#define WT_  ((bf16_t*)(ws + WS_WT))
#define PB_  ((bf16_t*)(ws + WS_PB))
#define Y_   ((bf16_t*)(ws + WS_Y))
#define H_   ((bf16_t*)(ws + WS_H))
#define QB_  ((bf16_t*)(ws + WS_MLA))
#define KB_  (QB_ + (size_t)HM * 768)
#define VB_  (KB_ + (size_t)HM * 768)
#define R_   ((float*)(ws + WS_H))
#define ROPE_ ((float*)(ws + CTL_ROPE))
#define KMP_ ((float*)(ws + CTL_KMP))
#define STQ_ ((float*)(ws + CTL_STQ))
#define STKV_ ((float*)(ws + CTL_STKV))

    if (threadIdx.x < 2) ((volatile LAS unsigned*)(lds + LDS_IDX + 64))[threadIdx.x] = 0u;
    {
        const int tid = opaque_tid();
        KParams P = kparams(); unsigned char* ws = P->ws;
        for (int rep = 0; rep < REP_P0; ++rep) {
        convert_weights(P, 0, WT_, (LAS float*)lds);
        convert_rows(P->in[0], XB_, (size_t)M * D);
        convert_rows(P->in[1], PB_, (size_t)M * 256); }
        float* rope = ROPE_;
        for (int i = cu * 512 + tid; i < SEQ * 16; i += G * 512) {
            const int pos = i >> 4, k = i & 15;
            const float freq = __builtin_amdgcn_exp2f(-(float)k * (13.287712379549449f / 16.f));
            const float ang = (float)pos * freq;
            double rev = (double)ang * 0.15915494309189535; rev -= __builtin_rint(rev);
            const float fr = (float)rev;
            rope[2 * i] = __builtin_amdgcn_cosf(fr); rope[2 * i + 1] = __builtin_amdgcn_sinf(fr);
        }
        if (cu == 0) {
            unsigned* ctl = (unsigned*)(ws + WS_CTL); float* lamv = (float*)(ws + CTL_LAM);
            if (tid < 64) {
#pragma unroll
                for (int l = 0; l < 2; ++l) { const float* dl = P->in[7] + l * 256; float a = dl[tid] * dl[64 + tid], b = dl[128 + tid] * dl[192 + tid];
#pragma unroll
                    for (int s = 1; s < 64; s <<= 1) { a += __shfl_xor(a, s); b += __shfl_xor(b, s); }
                    const float li = (l == 0) ? 0.2f : 0.35550906759096924f;
                    if (tid == 0) lamv[l] = __builtin_amdgcn_exp2f(a * LOG2E) - __builtin_amdgcn_exp2f(b * LOG2E) + li; }
            }
            if (tid < 16) ctl[tid] = 0u;
            if (tid < 128) ((unsigned*)(ws + CTL_DEP))[tid] = 0u;
            { unsigned* bw = (unsigned*)(ws + CTL_BAR); for (int i = tid; i < XCD_BAR_WORDS; i += 512) bw[i] = 0u; }
        }
    }
    grid.sync();
    if (threadIdx.x == 0) { unsigned char* ws = wsbase(); (void)xb_add(&((unsigned*)(ws + CTL_BAR))[XB_XCNT(xb_xcc_id())], 1u); }
#define GSYNC() do { unsigned char* _w = wsbase(); xcd_barrier((unsigned*)(_w + CTL_BAR), (volatile LAS unsigned*)(lds + LDS_IDX + 64)); } while (0)

    for (int l = 0; l < 2; ++l) {
        for (int hf = 0; hf < 2; ++hf) {
            for (int rep = 0; rep < REP_P1; ++rep)
            { unsigned char* ws = wsbase();
              pg8::Gemm g{XB_ + (size_t)hf * HM * D, WT_ + OFF_WIN, D, D}; pg8::P1Order S{G, cu};
              pg8::EpiH E{H_, KB_, KMP_ + (size_t)hf * 32 * 2 * 512, STQ_ + (size_t)hf * HM * 8, STKV_ + (size_t)hf * HM * 4, ROPE_, (unsigned*)(ws + CTL_DEP) + (l * 2 + hf) * 32};
              pg8::gemm_phase(lds, g, S, E); }
            {
                const int Gn = G, rem = 672 % Gn, NE = Gn - rem, e = cu - rem;
                pg8::ListOrder Sq{0, (e >= 0) ? 96 : 0, 3, (e >= 0) ? e : 0, NE}, Skv{96, (e >= 0) ? 224 : 96, 4, (e >= 0) ? e : 0, NE};
                if (opaque_tid() == 0) {
                    unsigned char* ws = wsbase(); unsigned* dep = (unsigned*)(ws + CTL_DEP) + (l * 2 + hf) * 32; pg8::Unit u;
                    for (int pass = 0; pass < 2; ++pass)
                        for (int i = 0; pass == 0 ? Sq.next(i, u) : Skv.next(i, u); ++i) {
                            unsigned sp = 0;
                            while (__hip_atomic_load(dep + u.pm, __ATOMIC_RELAXED, __HIP_MEMORY_SCOPE_AGENT) < 24u) { __builtin_amdgcn_s_sleep(2); if (++sp > (1u << 24)) break; }
                        }
                    __builtin_amdgcn_fence(__ATOMIC_ACQUIRE, "agent");
                    asm volatile("s_waitcnt vmcnt(0)" ::: "memory");
                }
                __syncthreads();
                { unsigned char* ws = wsbase();
                  pg8::Gemm g{H_ + C_CQL, WT_ + OFF_WUQ, HP, 384};
                  pg8::EpiUp<0> E{QB_, KB_, VB_, STQ_ + (size_t)hf * HM * 8, ROPE_}; pg8::gemm_phase(lds, g, Sq, E); }
                { unsigned char* ws = wsbase();
                  pg8::Gemm g{H_ + C_CKV, WT_ + OFF_WUKV, HP, 256};
                  pg8::EpiUp<1> E{QB_, KB_, VB_, STKV_ + (size_t)hf * HM * 4, ROPE_}; pg8::gemm_phase(lds, g, Skv, E); }
            }
            GSYNC();
            {
                for (int rep = 0; rep < REP_ATT; ++rep)
                for (int vcu = cu; vcu < 256; vcu += G)
                for (int step = 0; step < 4; ++step) {
                    KParams P = kparams(); unsigned char* ws = P->ws;
                    const int x = vcu & 7, sl_ = vcu >> 3;
                    int type, u, bh;
                    if (sl_ < 16) { if (step >= 3) break;
                        if (step < 2) { type = 2; bh = 2 * x + (sl_ >> 3); const int j = sl_ & 7; u = (step == 0) ? 15 - j : j; }
                        else { type = 1; bh = 4 * x + (sl_ >> 2); u = sl_ & 3; } }
                    else { if (step >= 3) break; const int t = sl_ - 16, j = t & 3; bh = 4 * x + (t >> 2);
                        type = (step < 2) ? 0 : 1; u = (step == 1) ? j : 7 - j; }
                    if (type == 0) {
                        const int bl = bh >> 3, h = bh & 7, bg = 4 * hf + bl; const size_t ho = (size_t)bh * SEQ * 64;
                        const float sl = __builtin_amdgcn_exp2f(-(2.f / 3.f) * (float)(h + (h >> 1) + 2)) * LOG2E;
                        attn_unit<64, 64, 64, 256, true, true, true, 4>((LAS char*)lds, H_ + HM_AQ + ho, 64, H_ + HM_AK + ho, 64, H_ + HM_AV + ho, 64,
                            H_ + (size_t)bl * SEQ * HP + C_AZ + h * 64, HP,
                            Y_ + (size_t)bg * SEQ * 512 + h * 64, 512, u * 256, sl, KMP_ + (size_t)bg * 8 * 2 * 512 + h * 64, 0.f, nullptr, 1.f);
                    } else if (type == 1) {
                        const int bl = bh >> 3, h = bh & 7, bg = 4 * hf + bl;
                        attn_unit<96, 96, 64, 256, false, false, true, 2>((LAS char*)lds, QB_ + (size_t)bh * SEQ * 96, 96, KB_ + (size_t)bh * SEQ * 96, 96,
                            VB_ + (size_t)bh * SEQ * 64, 64, H_ + (size_t)bl * SEQ * HP + C_BZ + h * 64, HP,
                            Y_ + (size_t)M * 512 + (size_t)bg * SEQ * 512 + h * 64, 512, u * 256, 0.f, nullptr, 0.f, nullptr, 1.f);
                    } else {
                        const int bl = bh >> 2, h = bh & 3, bg = 4 * hf + bl; const size_t ho = (size_t)bh * SEQ * 128;
                        const float sl = __builtin_amdgcn_exp2f(-(2.f / 3.f) * (float)(3 * h + 1)) * LOG2E;
                        const float lam = ((const float*)(ws + CTL_LAM))[l];
                        const float post = (l == 0) ? 0.8f : (1.f - 0.35550906759096924f);
                        attn_unit<64, 128, 128, 128, true, false, false, 1>((LAS char*)lds, H_ + HM_CQ + ho, 128, H_ + HM_CK + ho, 128, H_ + HM_CV + ho, 128,
                            H_ + (size_t)bl * SEQ * HP + C_CZ + h * 128, HP,
                            Y_ + (size_t)2 * M * 512 + (size_t)bg * SEQ * 512 + h * 128, 512, u * 128, sl, nullptr, lam, P->in[8] + l * 128, post);
                    }
                }
            }
            GSYNC();
        }
        { KParams P = kparams(); unsigned char* ws = P->ws;
          pg8::Gemm g{XB_, WT_ + OFF_WIN + (size_t)5376 * 1024, D, D}; pg8::StaticOrder S; S.init(M, 3072, G, cu);
          pg8::EpiG E{H_, P->in[13] + l * 3072}; pg8::gemm_phase(lds, g, S, E); }
        GSYNC();
        { unsigned char* ws = wsbase();
          pg8::Gemm g{Y_, WT_ + OFF_WABC, 512, 512}; pg8::MergeOrder S{cu, G};
          pg8::EpiMerge E{H_, XB_}; pg8::gemm_phase(lds, g, S, E); }
        GSYNC();
        { KParams P = kparams(); unsigned char* ws = P->ws;
          pg8::Gemm g{XB_, WT_ + OFF_WO, D, D}; pg8::StaticOrder S; S.init(M, D, G, cu);
          pg8::EpiR E{(l == 0) ? P->in[0] : (const float*)P->out, R_, Y_}; pg8::gemm_phase(lds, g, S, E); }
        GSYNC();
        { unsigned char* ws = wsbase();
          pg8::Gemm g{PB_, WT_ + OFF_WP, 256, 256}; pg8::StaticOrder S; S.init(M, D, G, cu);
          pg8::EpiBf E{XB_}; pg8::gemm_phase(lds, g, S, E); }
        { unsigned char* ws = wsbase();
          pg8::Gemm g{Y_, WT_ + OFF_WPG, D, D}; pg8::StaticOrder S; S.init(M, D, G, cu);
          pg8::EpiR2 E{R_, XB_}; pg8::gemm_phase(lds, g, S, E); }
        GSYNC();
        {
            KParams P = kparams(); unsigned char* ws = P->ws;
            const int tid = opaque_tid(), lane = tid & 63, wid = tid >> 6;
            const float* lg = P->in[15] + l * 1024; const float* lb = P->in[16] + l * 1024;
            float* outp = P->out; const float* R = R_; bf16_t* XB = XB_;
            const int gstep = (int)gridDim.x * 8;
            for (int row = (int)blockIdx.x * 8 + wid; row < M; row += 2 * gstep) {
                const bool two = row + gstep < M;
                const float* rp0 = R + (size_t)row * 1024; const float* rp1 = R + (size_t)(two ? row + gstep : row) * 1024;
                f32x4 v[2][4]; float s0 = 0.f, s1 = 0.f;
#pragma unroll
                for (int j = 0; j < 4; ++j) { v[0][j] = *(const f32x4*)(rp0 + 4 * lane + 256 * j); v[1][j] = *(const f32x4*)(rp1 + 4 * lane + 256 * j); }
#pragma unroll
                for (int j = 0; j < 4; ++j) { s0 += (v[0][j][0] + v[0][j][1]) + (v[0][j][2] + v[0][j][3]); s1 += (v[1][j][0] + v[1][j][1]) + (v[1][j][2] + v[1][j][3]); }
#pragma unroll
                for (int k = 1; k < 64; k <<= 1) { s0 += __shfl_xor(s0, k); s1 += __shfl_xor(s1, k); }
                const float mu0 = s0 * (1.f / 1024.f), mu1 = s1 * (1.f / 1024.f); float q0 = 0.f, q1 = 0.f;
#pragma unroll
                for (int j = 0; j < 4; ++j) { v[0][j] -= mu0; v[1][j] -= mu1;
                    q0 += (v[0][j][0] * v[0][j][0] + v[0][j][1] * v[0][j][1]) + (v[0][j][2] * v[0][j][2] + v[0][j][3] * v[0][j][3]);
                    q1 += (v[1][j][0] * v[1][j][0] + v[1][j][1] * v[1][j][1]) + (v[1][j][2] * v[1][j][2] + v[1][j][3] * v[1][j][3]); }
#pragma unroll
                for (int k = 1; k < 64; k <<= 1) { q0 += __shfl_xor(q0, k); q1 += __shfl_xor(q1, k); }
                const float rs0 = __builtin_amdgcn_rsqf(q0 * (1.f / 1024.f) + 1e-5f), rs1 = __builtin_amdgcn_rsqf(q1 * (1.f / 1024.f) + 1e-5f);
#pragma unroll
                for (int j = 0; j < 4; ++j) { const f32x4 gv = *(const f32x4*)(lg + 4 * lane + 256 * j), bv = *(const f32x4*)(lb + 4 * lane + 256 * j);
#pragma unroll
                    for (int t = 0; t < 2; ++t) { if (t == 1 && !two) break;
                        const size_t rr = (size_t)(t == 0 ? row : row + gstep);
                        const f32x4 y = v[t][j] * (t == 0 ? rs0 : rs1) * gv + bv;
                        *(f32x4*)(outp + rr * 1024 + 4 * lane + 256 * j) = y;
                        if (l == 0) { u32x2 w; w.x = pk2(y[0], y[1]); w.y = pk2(y[2], y[3]); *(u32x2*)(XB + rr * 1024 + 4 * lane + 256 * j) = w; } } }
            }
            if (l == 0) {
                __syncthreads();
                convert_weights(P, 1, WT_, (LAS float*)lds);
                convert_rows(P->in[1] + (size_t)M * 256, PB_, (size_t)M * 256);
            }
        }
        if (l == 0) GSYNC();
    }
}

#undef G
#undef cu
extern "C" void kernel_launch(void* const* d_in, const int* in_sizes, int n_in, void* d_out, int out_size, void* d_ws, size_t ws_size, hipStream_t stream) {
    static int grid_blocks = 0;
    if (grid_blocks == 0) {
        if (n_in != 19 || out_size != M * D || ws_size < WS_END) { fprintf(stderr, "kernel_launch: unexpected problem (n_in %d out %d ws %zu)\n", n_in, out_size, ws_size); grid_blocks = -1; return; }
        int dev = 0, cus = 0, per_cu = 0;
        hipGetDevice(&dev);
        hipDeviceGetAttribute(&cus, hipDeviceAttributeMultiprocessorCount, dev);
        if (hipFuncSetAttribute((const void*)fwd_megakernel, hipFuncAttributeMaxDynamicSharedMemorySize, LDS_BYTES) != hipSuccess) { fprintf(stderr, "kernel_launch: hipFuncSetAttribute failed\n"); grid_blocks = -1; return; }
        if (hipOccupancyMaxActiveBlocksPerMultiprocessor(&per_cu, (const void*)fwd_megakernel, 512, LDS_BYTES) != hipSuccess || per_cu < 1) { fprintf(stderr, "kernel_launch: occupancy query failed (%d)\n", per_cu); grid_blocks = -1; return; }
        grid_blocks = cus * per_cu;
        if (grid_blocks > 256) grid_blocks = 256;
    }
    if (grid_blocks < 0) return;
    Params p{};
    for (int i = 0; i < 19; ++i) p.in[i] = (const float*)d_in[i];
    p.out = (float*)d_out; p.ws = (unsigned char*)d_ws;
    void* args[] = {&p};
    hipError_t e = hipLaunchCooperativeKernel((const void*)fwd_megakernel, dim3(grid_blocks), dim3(512), args, LDS_BYTES, stream);
    if (e != hipSuccess) fprintf(stderr, "cooperative launch failed: %s (grid %d)\n", hipGetErrorString(e), grid_blocks);
}
```

```cpp
#include <hip/hip_runtime.h>
#include <hip/hip_cooperative_groups.h>
#include <cstdio>
#include <cstdint>
namespace cg = cooperative_groups;
#ifndef REP_ATT
#define REP_ATT 1
#endif
#ifndef REP_P1
#define REP_P1 1
#endif
#ifndef REP_P0
#define REP_P0 1
#endif

#define LAS __attribute__((address_space(3)))
#define DI __device__ __forceinline__
typedef unsigned short bf16_t;
typedef short bf16x8 __attribute__((ext_vector_type(8)));
typedef short s16x4 __attribute__((ext_vector_type(4)));
typedef float f32x2 __attribute__((ext_vector_type(2)));
typedef float f32x4 __attribute__((ext_vector_type(4)));
typedef float f32x16 __attribute__((ext_vector_type(16)));
typedef unsigned u32x4 __attribute__((ext_vector_type(4)));
typedef unsigned u32x2 __attribute__((ext_vector_type(2)));
typedef __bf16 bf16x2_t __attribute__((ext_vector_type(2)));

constexpr int M = 16384, D = 1024, SEQ = 2048, HM = 8192;
constexpr int HP = 2304;
constexpr int NH1 = 5376;
constexpr int NWIN = 8448;
constexpr float LOG2E = 1.4426950408889634f;
constexpr float QS64 = 0.125f * LOG2E;
constexpr float QS96 = 0.10206207261596575f * LOG2E;
constexpr float ALPHA = 1.4142135623730951f;
constexpr int C_AZ = 0, C_BZ = 512, C_CZ = 1024, C_CKV = 1536, C_CQL = 1792;
constexpr size_t HM_AQ = (size_t)18 * 1048576, HM_AK = (size_t)22 * 1048576, HM_AV = (size_t)26 * 1048576, HM_CQ = (size_t)30 * 1048576, HM_CK = (size_t)34 * 1048576, HM_CV = (size_t)38 * 1048576;

constexpr size_t MiB = 1048576;
constexpr size_t WS_CTL = 0, WS_XB = 2 * MiB, WS_WT = 34 * MiB, WS_PB = 60 * MiB, WS_Y = 68 * MiB, WS_H = 116 * MiB, WS_MLA = 200 * MiB, WS_END = 232 * MiB;
constexpr size_t CTL_DEP = 8192, CTL_BAR = 16384, CTL_LAM = 4096, CTL_ROPE = 65536, CTL_KMP = 384 * 1024, CTL_STQ = 640 * 1024, CTL_STKV = 1152 * 1024;
constexpr size_t OFF_WIN = 0, OFF_WUQ = 8650752, OFF_WUKV = 8945664, OFF_WABC = 9207808, OFF_WO = 10780672, OFF_WPG = 11829248, OFF_WP = 12877824;
constexpr int LDS_BYTES = 132 * 1024, LDS_IDX = 131072;

DI int opaque_s(int v) { asm volatile("" : "+s"(v)); return v; }
DI int opaque_tid() { int t = threadIdx.x; asm volatile("" : "+v"(t)); return t; }
DI unsigned pk2(float lo, float hi) { f32x2 v = {lo, hi}; bf16x2_t b = __builtin_convertvector(v, bf16x2_t); return __builtin_bit_cast(unsigned, b); }
DI float bflo(unsigned w) { return __uint_as_float(w << 16); }
DI float bfhi(unsigned w) { return __uint_as_float(w & 0xffff0000u); }
DI float bf2f(bf16_t b) { return __uint_as_float((unsigned)b << 16); }
DI bf16_t f2bf(float f) { return (bf16_t)(pk2(f, 0.f) & 0xffffu); }
DI float sigm(float x) { return __builtin_amdgcn_rcpf(1.f + __builtin_amdgcn_exp2f(-x * LOG2E)); }
DI float silu(float x) { return x * sigm(x); }
DI u32x4 pack8(const f32x4 a, const f32x4 b) { u32x4 w; w.x = pk2(a[0], a[1]); w.y = pk2(a[2], a[3]); w.z = pk2(b[0], b[1]); w.w = pk2(b[2], b[3]); return w; }
DI void unpack8(const u32x4 w, f32x4& a, f32x4& b) { a = (f32x4){bflo(w.x), bfhi(w.x), bflo(w.y), bfhi(w.y)}; b = (f32x4){bflo(w.z), bfhi(w.z), bflo(w.w), bfhi(w.w)}; }

namespace pg8 {
constexpr int BM = 256, BK = 64, HALF = 128, HTB = HALF * BK * 2, NXCD = 8, WGM = 8;
__host__ __device__ __forceinline__ int lds_byte(int r, int c) { const int st = (r >> 4) * 2 + (c >> 5), rr = r & 15, cc = c & 31, ob = rr * 64 + cc * 2; return st * 1024 + (ob ^ (((ob >> 9) & 1) << 5)); }
__host__ __device__ __forceinline__ void stage_rc(int b, int& R, int& C) { const int st = b / 1024, sb = b % 1024, swz = sb ^ (((sb >> 9) & 1) << 5); R = (st >> 1) * 16 + swz / 64; C = (st & 1) * 32 + (swz % 64) / 2; }
__host__ __device__ __forceinline__ int perm32(int rho) { const int n = rho >> 4, i = rho & 15; return 8 * (i >> 2) + 4 * n + (i & 3); }

struct Unit { int pm, pn; };
struct Gemm { const bf16_t* A; const bf16_t* Bt; int lda, K; };

struct StaticOrder {
    int nM, nN, nwg, G, c;
    DI void init(int M_, int N_, int G_, int c_) { nM = M_ / BM; nN = N_ / BM; nwg = nM * nN; G = G_; c = c_; }
    DI bool next(int i, Unit& u) const {
        const long L = (long)i * G + c; if (L >= nwg) return false;
        int wgid = (int)L; { const int q = nwg / NXCD, r = nwg % NXCD, xcd = wgid % NXCD, off = wgid / NXCD; wgid = (xcd < r ? xcd * (q + 1) : r * (q + 1) + (xcd - r) * q) + off; }
        const int nig = WGM * nN, gid = wgid / nig, fm = gid * WGM, gsz = (nM - fm) < WGM ? (nM - fm) : WGM;
        u.pm = fm + ((wgid % nig) % gsz); u.pn = (wgid % nig) / gsz; return true;
    }
};
struct P1Order {
    int G, c;
    DI bool next(int i, Unit& u) const {
        const long L = (long)i * G + c; if (L >= 672) return false;
        if (L < 96) { u.pm = (int)L / 3; u.pn = 18 + (int)L % 3; return true; }
        const int nM = 32, nN = 18, nwg = 576;
        int wgid = (int)L - 96; { const int q = nwg / NXCD, r = nwg % NXCD, xcd = wgid % NXCD, off = wgid / NXCD; wgid = (xcd < r ? xcd * (q + 1) : r * (q + 1) + (xcd - r) * q) + off; }
        const int nig = WGM * nN, gid = wgid / nig, fm = gid * WGM, gsz = (nM - fm) < WGM ? (nM - fm) : WGM;
        u.pm = fm + ((wgid % nig) % gsz); u.pn = (wgid % nig) / gsz; return true;
    }
};
struct ListOrder {
    int lo, hi, nN, c, G;
    DI bool next(int i, Unit& u) const {
        int k0 = 0; if (c < lo) k0 = (lo - c + G - 1) / G;
        const int idx = c + (k0 + i) * G; if (idx >= hi) return false;
        const int loc = idx - lo; u.pm = loc / nN; u.pn = loc % nN; return true;
    }
};
struct MergeOrder {
    int c, G;
    DI bool next(int i, Unit& u) const {
        const int tile = c + (i / 3) * G, br = i % 3; if (tile >= 256) return false;
        u.pm = br * 64 + (tile >> 2); u.pn = br * 4 + (tile & 3); return true;
    }
};

template <class Epi, class Sched>
DI void gemm_phase(LAS unsigned char* lds, const Gemm g, const Sched& S, const Epi& E) {
    const int tid = opaque_tid(), wid = __builtin_amdgcn_readfirstlane(tid >> 6), lane = tid & 63, wr = wid >> 2, wc = wid & 3, fr = lane & 15, fq = lane >> 4;
    const int K = g.K, nt = K / BK, lda = g.lda;
    unsigned voffA[2], voffB[2];
#pragma unroll
    for (int i = 0; i < 2; ++i) { int R, C; stage_rc(tid * 16 + i * 8192, R, C); const int Rb = (R & ~31) + perm32(R & 31);
        voffA[i] = (unsigned)(R * lda + C) * 2u; voffB[i] = (unsigned)(Rb * K + C) * 2u; }
    const size_t kstep = (size_t)(BK * 2);
    const size_t hstepA = (size_t)HALF * lda * 2, hstepB = (size_t)HALF * K * 2;
    const size_t tstepA = 2 * hstepA, tstepB = 2 * hstepB;
    const unsigned ldsw = (unsigned)wid * 1024u;
    const int aoff = lds_byte(wr * 64 + fr, fq * 8), boff = lds_byte(wc * 32 + fr, fq * 8);
#define PG8_SA(b, h) (((b) * 2 + (h)) * HTB)
#define PG8_SB(b, h) ((4 + (b) * 2 + (h)) * HTB)
#define PG8_STAGE(bufoff, gbase, voff) do { _Pragma("unroll") for (int _i = 0; _i < 2; ++_i) \
        __builtin_amdgcn_global_load_lds((const unsigned*)((const char*)(gbase) + (voff)[_i]), (LAS unsigned*)(lds + (bufoff) + ldsw + _i * 8192), 16, 0, 0); } while (0)
#define PG8_LDA(dst, b, h) do { _Pragma("unroll") for (int m = 0; m < 4; ++m) _Pragma("unroll") for (int k = 0; k < 2; ++k) dst[m][k] = *(const LAS bf16x8*)(lds + PG8_SA(b, h) + aoff + m * 2048 + k * 1024); } while (0)
#define PG8_LDB(dst, b, h) do { _Pragma("unroll") for (int n = 0; n < 2; ++n) _Pragma("unroll") for (int k = 0; k < 2; ++k) dst[n][k] = *(const LAS bf16x8*)(lds + PG8_SB(b, h) + boff + n * 2048 + k * 1024); } while (0)
#define PG8_MMA(ai, bj, At, Bt) do { __builtin_amdgcn_s_setprio(1); _Pragma("unroll") for (int m = 0; m < 4; ++m) _Pragma("unroll") for (int n = 0; n < 2; ++n) _Pragma("unroll") for (int k = 0; k < 2; ++k) \
        acc[ai][bj][m][n] = __builtin_amdgcn_mfma_f32_16x16x32_bf16(Bt[n][k], At[m][k], acc[ai][bj][m][n], 0, 0, 0); __builtin_amdgcn_s_setprio(0); } while (0)
#define PG8_WAIT_V(n) asm volatile("s_waitcnt vmcnt(" #n ")" ::: "memory")
#define PG8_WAIT_L(n) asm volatile("s_waitcnt lgkmcnt(" #n ")" ::: "memory")
#define PG8_BAR __builtin_amdgcn_s_barrier()
#define PG8_SCHED __builtin_amdgcn_sched_barrier(0)
    Unit cur, nxt; int ui = 0;
    if (!S.next(0, cur)) return;
    f32x4 acc[2][2][4][2];
#pragma unroll
    for (int a = 0; a < 2; ++a)
#pragma unroll
        for (int b = 0; b < 2; ++b)
#pragma unroll
            for (int m = 0; m < 4; ++m)
#pragma unroll
                for (int n = 0; n < 2; ++n) acc[a][b][m][n] = (f32x4){0.f, 0.f, 0.f, 0.f};
    bf16x8 At[4][2], B0[2][2], B1[2][2];
    const char* cA = (const char*)g.A + (size_t)cur.pm * tstepA; const char* cB = (const char*)g.Bt + (size_t)cur.pn * tstepB;
    PG8_STAGE(PG8_SB(0, 0), cB, voffB); PG8_STAGE(PG8_SB(0, 1), cB + hstepB, voffB); PG8_STAGE(PG8_SA(0, 0), cA, voffA); PG8_STAGE(PG8_SA(0, 1), cA + hstepA, voffA);
    if (wr == 1) PG8_BAR;
    PG8_WAIT_V(2); PG8_BAR;
    PG8_STAGE(PG8_SB(1, 0), cB + kstep, voffB); PG8_STAGE(PG8_SA(1, 0), cA + kstep, voffA); PG8_STAGE(PG8_SB(1, 1), cB + hstepB + kstep, voffB);
    PG8_WAIT_V(6); PG8_BAR;
    for (;;) {
        const bool has_next = S.next(ui + 1, nxt);
        const char* nA = has_next ? (const char*)g.A + (size_t)nxt.pm * tstepA : cA; const char* nB = has_next ? (const char*)g.Bt + (size_t)nxt.pn * tstepB : cB;
#pragma nounroll
        for (int t = 0; t < nt; t += 2) {
            const bool last = (t == nt - 2);
            const char* a1 = cA + (size_t)(t + 1) * kstep;
            const char* a2 = last ? nA : cA + (size_t)(t + 2) * kstep; const char* b2 = last ? nB : cB + (size_t)(t + 2) * kstep;
            const char* a3 = a2 + kstep; const char* b3 = b2 + kstep;
            PG8_LDB(B0, 0, 0); PG8_LDB(B1, 0, 1); PG8_SCHED; PG8_LDA(At, 0, 0); PG8_STAGE(PG8_SA(1, 1), a1 + hstepA, voffA);
            PG8_WAIT_V(8); PG8_WAIT_L(0); PG8_BAR; PG8_MMA(0, 0, At, B0); PG8_MMA(0, 1, At, B1); PG8_BAR; PG8_SCHED;
            PG8_LDA(At, 0, 1); PG8_STAGE(PG8_SB(0, 0), b2, voffB); PG8_STAGE(PG8_SB(0, 1), b2 + hstepB, voffB); PG8_STAGE(PG8_SA(0, 0), a2, voffA);
            PG8_WAIT_V(8); PG8_WAIT_L(0); PG8_BAR; PG8_MMA(1, 0, At, B0); PG8_MMA(1, 1, At, B1); PG8_BAR; PG8_SCHED;
            PG8_LDB(B0, 1, 0); PG8_LDB(B1, 1, 1); PG8_SCHED; PG8_LDA(At, 1, 0); PG8_STAGE(PG8_SA(0, 1), a2 + hstepA, voffA);
            PG8_WAIT_V(8); PG8_WAIT_L(0); PG8_BAR; PG8_MMA(0, 0, At, B0); PG8_MMA(0, 1, At, B1); PG8_BAR; PG8_SCHED;
            PG8_LDA(At, 1, 1); PG8_STAGE(PG8_SB(1, 0), b3, voffB); PG8_STAGE(PG8_SB(1, 1), b3 + hstepB, voffB); PG8_STAGE(PG8_SA(1, 0), a3, voffA);
            PG8_WAIT_V(8); PG8_WAIT_L(0); PG8_BAR; PG8_MMA(1, 0, At, B0); PG8_MMA(1, 1, At, B1); PG8_BAR; PG8_SCHED;
        }
        if (wr == 0) PG8_BAR;
        E(acc, cur, wr, wc, fr, fq);
        if (!has_next) break;
#pragma unroll
        for (int a = 0; a < 2; ++a)
#pragma unroll
            for (int b = 0; b < 2; ++b)
#pragma unroll
                for (int m = 0; m < 4; ++m)
#pragma unroll
                    for (int n = 0; n < 2; ++n) acc[a][b][m][n] = (f32x4){0.f, 0.f, 0.f, 0.f};
        cur = nxt; cA = nA; cB = nB; ++ui;
        if (wr == 1) PG8_BAR;
    }
    PG8_WAIT_V(0);
    PG8_BAR;
#undef PG8_SA
#undef PG8_SB
#undef PG8_STAGE
#undef PG8_LDA
#undef PG8_LDB
#undef PG8_MMA
#undef PG8_WAIT_V
#undef PG8_WAIT_L
#undef PG8_BAR
#undef PG8_SCHED
}
typedef f32x4 Acc[2][2][4][2];

struct EpiH {
    bf16_t* H; bf16_t* KB; float* KMP; float* STQ; float* STKV; const float* rope; unsigned* dep;
    DI void operator()(const Acc& acc, const Unit& u, int wr, int wc, int fr, int fq) const {
        const int row0 = u.pm * BM + wr * 64 + fr;
        {
            const int pn = u.pn; bf16_t* base; int hw = 0, cseg;
            if (pn < 6) { base = H + (pn < 2 ? HM_AQ : pn < 4 ? HM_AK : HM_AV); hw = 64; cseg = (pn & 1) * 256; }
            else if (pn < 10) { base = H + (pn < 8 ? C_AZ : C_BZ); cseg = (pn & 1) * 256; }
            else if (pn < 16) { base = H + (pn < 12 ? HM_CQ : pn < 14 ? HM_CK : HM_CV); hw = 128; cseg = (pn & 1) * 256; }
            else if (pn < 18) { base = H + C_CZ; cseg = (pn & 1) * 256; }
            else { base = H + C_CKV; cseg = (pn - 18) * 256; }
            const int bl = u.pm >> 3, s0 = (u.pm & 7) * 256 + wr * 64 + fr;
#pragma unroll
            for (int bj = 0; bj < 2; ++bj) { const int cs = cseg + bj * HALF + wc * 32 + 8 * fq;
                bf16_t* colp; size_t pitch;
                if (hw == 64) { colp = base + ((size_t)(bl * 8 + (cs >> 6)) * SEQ) * 64 + (cs & 63); pitch = 64; }
                else if (hw == 128) { colp = base + ((size_t)(bl * 4 + (cs >> 7)) * SEQ) * 128 + (cs & 127); pitch = 128; }
                else { colp = base + (size_t)bl * SEQ * HP + cs; pitch = HP; }
#pragma unroll
                for (int ai = 0; ai < 2; ++ai)
#pragma unroll
                    for (int m = 0; m < 4; ++m) *(u32x4*)(colp + (size_t)(s0 + ai * HALF + m * 16) * pitch) = pack8(acc[ai][bj][m][0], acc[ai][bj][m][1]); }
        }
        if (u.pn == 2 || u.pn == 3) {
            float* dst = KMP + (size_t)(u.pm * 2 + wr) * 512 + (u.pn - 2) * 256 + wc * 32 + 8 * fq;
#pragma unroll
            for (int bj = 0; bj < 2; ++bj)
#pragma unroll
                for (int n = 0; n < 2; ++n) { f32x4 s = (f32x4){0.f, 0.f, 0.f, 0.f};
#pragma unroll
                    for (int ai = 0; ai < 2; ++ai)
#pragma unroll
                        for (int m = 0; m < 4; ++m) s += acc[ai][bj][m][n];
#pragma unroll
                    for (int e = 0; e < 4; ++e) { float v = s[e]; v += __shfl_xor(v, 1); v += __shfl_xor(v, 2); v += __shfl_xor(v, 4); v += __shfl_xor(v, 8); s[e] = v; }
                    if (fr == 0) *(f32x4*)(dst + bj * HALF + 4 * n) = s; }
        }
        if (u.pn >= 18) {
#pragma unroll
            for (int ai = 0; ai < 2; ++ai)
#pragma unroll
                for (int m = 0; m < 4; ++m) { const int row = row0 + ai * HALF + m * 16; float ss = 0.f;
#pragma unroll
                    for (int bj = 0; bj < 2; ++bj) { if (u.pn == 20 && bj == 1) continue;
#pragma unroll
                        for (int n = 0; n < 2; ++n) { const f32x4 x = acc[ai][bj][m][n]; ss += (x[0] * x[0] + x[1] * x[1]) + (x[2] * x[2] + x[3] * x[3]); } }
                    ss += __shfl_xor(ss, 16); ss += __shfl_xor(ss, 32);
                    if (fq == 0) { if (u.pn == 18) STKV[(size_t)row * 4 + wc] = ss; else STQ[(size_t)row * 8 + (u.pn - 19) * 4 + wc] = ss; }
                    if (u.pn == 20 && wc == 0) {
                        const int pos = row & (SEQ - 1); f32x4 o[2];
#pragma unroll
                        for (int n = 0; n < 2; ++n) { const f32x4 cs = *(const f32x4*)(rope + ((size_t)pos * 16 + 4 * fq + 2 * n) * 2); const f32x4 t = acc[ai][1][m][n];
                            o[n] = (f32x4){t[0] * cs[0] - t[1] * cs[1], t[0] * cs[1] + t[1] * cs[0], t[2] * cs[2] - t[3] * cs[3], t[2] * cs[3] + t[3] * cs[2]}; }
                        const u32x4 w = pack8(o[0], o[1]);
#pragma unroll
                        for (int h = 0; h < 8; ++h) *(u32x4*)(KB + ((size_t)((row >> 11) * 8 + h) * SEQ + pos) * 96 + 64 + 8 * fq) = w;
                    }
                }
        }
        if (u.pn >= 18) {
            asm volatile("s_waitcnt vmcnt(0)" ::: "memory");
            __syncthreads();
            if (threadIdx.x == 0) {
                __builtin_amdgcn_fence(__ATOMIC_RELEASE, "agent");
                asm volatile("s_waitcnt vmcnt(0)" ::: "memory");
                __hip_atomic_fetch_add(dep + u.pm, 8u, __ATOMIC_RELAXED, __HIP_MEMORY_SCOPE_AGENT);
            }
        }
    }
};
template <int MODE> struct EpiUp {
    bf16_t* QB; bf16_t* KB; bf16_t* VB; const float* ST; const float* rope;
    DI void operator()(const Acc& acc, const Unit& u, int wr, int wc, int fr, int fq) const {
        const int row0 = u.pm * BM + wr * 64 + fr;
#pragma unroll
        for (int ai = 0; ai < 2; ++ai)
#pragma unroll
            for (int m = 0; m < 4; ++m) { const int row = row0 + ai * HALF + m * 16; float sc;
                if (MODE == 0) { const f32x4 a = *(const f32x4*)(ST + (size_t)row * 8), b = *(const f32x4*)(ST + (size_t)row * 8 + 4);
                    sc = __builtin_amdgcn_rsqf(((a[0] + a[1]) + (a[2] + a[3]) + (b[0] + b[1]) + (b[2] + b[3])) * (1.f / 384.f) + 1e-6f) * QS96; }
                else { const f32x4 a = *(const f32x4*)(ST + (size_t)row * 4); sc = __builtin_amdgcn_rsqf(((a[0] + a[1]) + (a[2] + a[3])) * (1.f / 256.f) + 1e-6f); }
                const int pos = row & (SEQ - 1);
#pragma unroll
                for (int bj = 0; bj < 2; ++bj) { const int c0 = u.pn * BM + bj * HALF + wc * 32 + 8 * fq;
                    f32x4 v0 = acc[ai][bj][m][0] * sc, v1 = acc[ai][bj][m][1] * sc;
                    if (MODE == 0) { const int j = c0 % 96;
                        if (j >= 64) { const int i0 = (j - 64) >> 1; const f32x4 ca = *(const f32x4*)(rope + ((size_t)pos * 16 + i0) * 2), cb = *(const f32x4*)(rope + ((size_t)pos * 16 + i0 + 2) * 2);
                            v0 = (f32x4){v0[0] * ca[0] - v0[1] * ca[1], v0[0] * ca[1] + v0[1] * ca[0], v0[2] * ca[2] - v0[3] * ca[3], v0[2] * ca[3] + v0[3] * ca[2]};
                            v1 = (f32x4){v1[0] * cb[0] - v1[1] * cb[1], v1[0] * cb[1] + v1[1] * cb[0], v1[2] * cb[2] - v1[3] * cb[3], v1[2] * cb[3] + v1[3] * cb[2]}; }
                        *(u32x4*)(QB + ((size_t)((row >> 11) * 8 + c0 / 96) * SEQ + pos) * 96 + j) = pack8(v0, v1); }
                    else { if (c0 < 512) *(u32x4*)(KB + ((size_t)((row >> 11) * 8 + (c0 >> 6)) * SEQ + pos) * 96 + (c0 & 63)) = pack8(v0, v1);
                           else *(u32x4*)(VB + ((size_t)((row >> 11) * 8 + ((c0 - 512) >> 6)) * SEQ + pos) * 64 + (c0 & 63)) = pack8(v0, v1); }
                }
            }
    }
};
struct EpiG {
    bf16_t* G; const float* bias;
    DI void operator()(const Acc& acc, const Unit& u, int wr, int wc, int fr, int fq) const {
        const int row0 = u.pm * BM + wr * 64 + fr, col0 = u.pn * BM + wc * 32 + 8 * fq;
        f32x4 bv[2][2];
#pragma unroll
        for (int bj = 0; bj < 2; ++bj)
#pragma unroll
            for (int n = 0; n < 2; ++n) bv[bj][n] = *(const f32x4*)(bias + col0 + bj * HALF + 4 * n);
#pragma unroll
        for (int ai = 0; ai < 2; ++ai)
#pragma unroll
            for (int m = 0; m < 4; ++m) { bf16_t* rowp = G + (size_t)(row0 + ai * HALF + m * 16) * 3072 + col0;
#pragma unroll
                for (int bj = 0; bj < 2; ++bj) { f32x4 v0 = acc[ai][bj][m][0] + bv[bj][0], v1 = acc[ai][bj][m][1] + bv[bj][1];
#pragma unroll
                    for (int e = 0; e < 4; ++e) { v0[e] = sigm(v0[e]); v1[e] = sigm(v1[e]); }
                    *(u32x4*)(rowp + bj * HALF) = pack8(v0, v1); } }
    }
};
struct EpiMerge {
    const bf16_t* G; bf16_t* MG;
    DI void operator()(const Acc& acc, const Unit& u, int wr, int wc, int fr, int fq) const {
        const int br = u.pn >> 2, pm = u.pm - 64 * br, pn = u.pn & 3;
        const int row0 = pm * BM + wr * 64 + fr, col0 = pn * BM + wc * 32 + 8 * fq;
#pragma unroll
        for (int ai = 0; ai < 2; ++ai)
#pragma unroll
            for (int m = 0; m < 4; ++m) { const size_t row = (size_t)(row0 + ai * HALF + m * 16);
#pragma unroll
                for (int bj = 0; bj < 2; ++bj) { f32x4 g0, g1; unpack8(*(const u32x4*)(G + row * 3072 + br * 1024 + col0 + bj * HALF), g0, g1);
                    f32x4 v0 = acc[ai][bj][m][0] * g0, v1 = acc[ai][bj][m][1] * g1;
                    bf16_t* dst = MG + row * 1024 + col0 + bj * HALF;
                    if (br > 0) { f32x4 p0, p1; unpack8(*(const u32x4*)dst, p0, p1); v0 += p0; v1 += p1; }
                    *(u32x4*)dst = pack8(v0, v1); } }
    }
};
struct EpiR {
    const float* X; float* R; bf16_t* RB;
    DI void operator()(const Acc& acc, const Unit& u, int wr, int wc, int fr, int fq) const {
        const int row0 = u.pm * BM + wr * 64 + fr, col0 = u.pn * BM + wc * 32 + 8 * fq;
#pragma unroll
        for (int ai = 0; ai < 2; ++ai)
#pragma unroll
            for (int m = 0; m < 4; ++m) { const size_t off = (size_t)(row0 + ai * HALF + m * 16) * 1024 + col0;
#pragma unroll
                for (int bj = 0; bj < 2; ++bj) { const f32x4 x0 = *(const f32x4*)(X + off + bj * HALF), x1 = *(const f32x4*)(X + off + bj * HALF + 4);
                    const f32x4 v0 = x0 * ALPHA + acc[ai][bj][m][0], v1 = x1 * ALPHA + acc[ai][bj][m][1];
                    *(f32x4*)(R + off + bj * HALF) = v0; *(f32x4*)(R + off + bj * HALF + 4) = v1;
                    *(u32x4*)(RB + off + bj * HALF) = pack8(v0, v1); } }
    }
};
struct EpiBf {
    bf16_t* O;
    DI void operator()(const Acc& acc, const Unit& u, int wr, int wc, int fr, int fq) const {
        const int row0 = u.pm * BM + wr * 64 + fr, col0 = u.pn * BM + wc * 32 + 8 * fq;
#pragma unroll
        for (int ai = 0; ai < 2; ++ai)
#pragma unroll
            for (int m = 0; m < 4; ++m) { bf16_t* rowp = O + (size_t)(row0 + ai * HALF + m * 16) * 1024 + col0;
#pragma unroll
                for (int bj = 0; bj < 2; ++bj) *(u32x4*)(rowp + bj * HALF) = pack8(acc[ai][bj][m][0], acc[ai][bj][m][1]); }
    }
};
struct EpiR2 {
    float* R; const bf16_t* PP;
    DI void operator()(const Acc& acc, const Unit& u, int wr, int wc, int fr, int fq) const {
        const int row0 = u.pm * BM + wr * 64 + fr, col0 = u.pn * BM + wc * 32 + 8 * fq;
#pragma unroll
        for (int ai = 0; ai < 2; ++ai)
#pragma unroll
            for (int m = 0; m < 4; ++m) { const size_t off = (size_t)(row0 + ai * HALF + m * 16) * 1024 + col0;
#pragma unroll
                for (int bj = 0; bj < 2; ++bj) { f32x4 p0, p1; unpack8(*(const u32x4*)(PP + off + bj * HALF), p0, p1);
                    f32x4 r0 = *(const f32x4*)(R + off + bj * HALF), r1 = *(const f32x4*)(R + off + bj * HALF + 4);
                    const f32x4 a0 = acc[ai][bj][m][0], a1 = acc[ai][bj][m][1];
#pragma unroll
                    for (int e = 0; e < 4; ++e) { r0[e] += sigm(a0[e]) * p0[e]; r1[e] += sigm(a1[e]) * p1[e]; }
                    *(f32x4*)(R + off + bj * HALF) = r0; *(f32x4*)(R + off + bj * HALF + 4) = r1; } }
    }
};
}

DI int crow(int r, int hi) { return (r & 3) + 8 * (r >> 2) + 4 * hi; }
DI s16x4 vtr(LAS const char* p) { typedef short v4i16_t __attribute__((ext_vector_type(4))); return __builtin_bit_cast(s16x4, __builtin_amdgcn_ds_read_tr16_b64_v4i16((LAS v4i16_t*)p)); }
constexpr int AT_SCR = 112 * 1024, AT_KM = 113 * 1024;
constexpr float NEGBIG = -1e30f;
DI float max3f(float a, float b, float c) { return fmaxf(fmaxf(a, b), c); }

template <int DQK, int KW, int DV, int NROWS, bool ALIBI, bool MOBA, bool PIPE, int NSET>
DI void attn_unit(LAS char* lds, const bf16_t* Qp, int ldq, const bf16_t* Kp, int ldk, const bf16_t* Vp, int ldv,
                  const bf16_t* Zp, int ldz, bf16_t* Yp, int ldy, int q0, float sl2, const float* kmp, float lam, const float* subg, float post) {
    constexpr int NTD = NROWS / 64, NS = DQK / 16, ND = DV / 32, PVG = (DV == 64) ? 2 : 1;
    constexpr int KPITCH = KW * 2 + 16, VPITCH = DV * 2 + 64;
    constexpr int KOFF0 = 0, VOFF0 = 3 * 64 * KPITCH;
    constexpr int KCH = KW / 8, VCH = DV / 8, NKC = 64 * KCH, NVC = 64 * VCH, KPT = (NKC + 511) / 512, VPT = (NVC + 511) / 512;
    static_assert(VOFF0 + 3 * 64 * VPITCH <= AT_SCR, "attention LDS map");
    const int tid = opaque_tid(), lane = tid & 63, r32 = lane & 31, hi = lane >> 5;
    const int wid = __builtin_amdgcn_readfirstlane(tid >> 6);
    const int ro = (NROWS == 256) ? 32 * wid : 32 * (wid & 3);
    const int map = (NROWS == 256) ? 0 : (wid >> 2);
    const int qpos = q0 + ro + r32;
    LAS float* scr = (LAS float*)(lds + AT_SCR) + wid * 32;

    bf16x8 qf[NS];
    { const bf16_t* qrow = Qp + (size_t)qpos * ldq + 64 * map + 8 * hi;
#pragma unroll
      for (int s = 0; s < NS; ++s) qf[s] = *(const bf16x8*)(qrow + 16 * s); }

    unsigned sel = 0xFFu;
    if (MOBA) {
        const int u = q0 >> 8;
        if (u > 3) {
            LAS float* km = (LAS float*)(lds + AT_KM);
            { const int j = tid >> 6, d = tid & 63; if (j < u) km[j * 64 + d] = (kmp[(size_t)(j * 2) * 512 + d] + kmp[(size_t)(j * 2 + 1) * 512 + d]) * (1.f / 256.f); }
            __syncthreads();
            float g[7];
#pragma unroll
            for (int j = 0; j < 7; ++j) { float a = 0.f;
                if (j < u) {
#pragma unroll
                    for (int s = 0; s < 4; ++s) { const f32x4 k0 = *(const LAS f32x4*)(km + j * 64 + 16 * s + 8 * hi), k1 = *(const LAS f32x4*)(km + j * 64 + 16 * s + 8 * hi + 4);
#pragma unroll
                        for (int e = 0; e < 4; ++e) { a += bf2f((bf16_t)qf[s][e]) * k0[e]; a += bf2f((bf16_t)qf[s][4 + e]) * k1[e]; } }
                }
                a += __shfl_xor(a, 32); g[j] = a; }
            sel = 0u;
#pragma unroll
            for (int k = 0; k < 3; ++k) { float best = -INFINITY; int bi = 0;
#pragma unroll
                for (int j = 0; j < 7; ++j) { const bool ok = (j < u) && !((sel >> j) & 1u) && (g[j] > best); best = ok ? g[j] : best; bi = ok ? j : bi; }
                sel |= 1u << bi; }
        }
    }

    f32x16 o[ND];
#pragma unroll
    for (int d0 = 0; d0 < ND; ++d0)
#pragma unroll
        for (int r = 0; r < 16; ++r) o[d0][r] = 0.f;
    f32x16 bias;
#pragma unroll
    for (int r = 0; r < 16; ++r) bias[r] = ALIBI ? sl2 * (float)((r & 3) + 8 * (r >> 2) + 4 * hi) : 0.f;
    const float d32 = ALIBI ? 32.f * sl2 : 0.f;
    float mrun = NEGBIG, lrun = 0.f;
    const int nt = NTD + (q0 >> 6);
    u32x4 kregA[KPT], vregA[VPT], kregB[KPT], vregB[VPT], kregC[KPT], vregC[VPT], kregD[KPT], vregD[VPT];
#define AT_TB(it) ((it) < NTD ? q0 + 64 * (it) : 64 * ((it) - NTD))
#define AT_LOAD(it, kreg, vreg) do { const int _ti = ((it) < nt) ? (it) : nt - 1; const int _kb = AT_TB(_ti); \
        _Pragma("unroll") for (int _i = 0; _i < KPT; ++_i) { const int _c = tid + 512 * _i; if (NKC % 512 == 0 || _i + 1 < KPT || _c < NKC) { const int _r = _c / KCH, _cc = _c % KCH; kreg[_i] = *(const u32x4*)(Kp + (size_t)(_kb + _r) * ldk + 8 * _cc); } } \
        _Pragma("unroll") for (int _i = 0; _i < VPT; ++_i) { const int _c = tid + 512 * _i; if (NVC % 512 == 0 || _i + 1 < VPT || _c < NVC) { const int _r = _c / VCH, _cc = _c % VCH; vreg[_i] = *(const u32x4*)(Vp + (size_t)(_kb + _r) * ldv + 8 * _cc); } } } while (0)
#define AT_STORE(buf, kreg, vreg) do { \
        _Pragma("unroll") for (int _i = 0; _i < KPT; ++_i) { const int _c = tid + 512 * _i; if (NKC % 512 == 0 || _i + 1 < KPT || _c < NKC) { const int _r = _c / KCH, _cc = _c % KCH; *(LAS u32x4*)(lds + KOFF0 + (buf) * 64 * KPITCH + _r * KPITCH + 16 * _cc) = kreg[_i]; } } \
        _Pragma("unroll") for (int _i = 0; _i < VPT; ++_i) { const int _c = tid + 512 * _i; if (NVC % 512 == 0 || _i + 1 < VPT || _c < NVC) { const int _r = _c / VCH, _cc = _c % VCH; *(LAS u32x4*)(lds + VOFF0 + (buf) * 64 * VPITCH + _r * VPITCH + 16 * _cc) = vreg[_i]; } } } while (0)
#define AT_ACTIVE(it) ((it) >= NTD || 64 * (it) <= ro + 31)
#define AT_QK(it, bufi, P0, P1) do { if (AT_ACTIVE(it)) { \
        LAS const char* _Kb = lds + KOFF0 + (bufi) * 64 * KPITCH + r32 * KPITCH + (64 * map + 8 * hi) * 2; \
        _Pragma("unroll") for (int _h = 0; _h < NS; _h += 4) { \
            bf16x8 _kf[8]; \
            _Pragma("unroll") for (int _s = 0; _s < 4; ++_s) if (_h + _s < NS) { _kf[2 * _s] = *(const LAS bf16x8*)(_Kb + 32 * (_h + _s)); _kf[2 * _s + 1] = *(const LAS bf16x8*)(_Kb + 32 * KPITCH + 32 * (_h + _s)); } \
            __builtin_amdgcn_sched_barrier(0); \
            _Pragma("unroll") for (int _s = 0; _s < 4; ++_s) if (_h + _s < NS) { \
                if (_h + _s == 0) { P0 = __builtin_amdgcn_mfma_f32_32x32x16_bf16(_kf[0], qf[0], bias, 0, 0, 0); P1 = __builtin_amdgcn_mfma_f32_32x32x16_bf16(_kf[1], qf[0], bias, 0, 0, 0); } \
                else { P0 = __builtin_amdgcn_mfma_f32_32x32x16_bf16(_kf[2 * _s], qf[_h + _s], P0, 0, 0, 0); P1 = __builtin_amdgcn_mfma_f32_32x32x16_bf16(_kf[2 * _s + 1], qf[_h + _s], P1, 0, 0, 0); } } \
            __builtin_amdgcn_sched_barrier(0); } } } while (0)
    if (NSET == 4) { AT_LOAD(0, kregA, vregA); AT_LOAD(1, kregB, vregB); AT_LOAD(2, kregC, vregC); AT_LOAD(3, kregD, vregD); AT_STORE(0, kregA, vregA); AT_STORE(1, kregB, vregB);
                     AT_LOAD(4, kregA, vregA); AT_LOAD(5, kregB, vregB); }
    else if (NSET == 2) { AT_LOAD(0, kregA, vregA); AT_LOAD(1, kregB, vregB); AT_STORE(0, kregA, vregA); AT_STORE(1, kregB, vregB); AT_LOAD(2, kregA, vregA); AT_LOAD(3, kregB, vregB); }
    else { AT_LOAD(0, kregA, vregA); AT_STORE(0, kregA, vregA); AT_LOAD(1, kregA, vregA); AT_STORE(1, kregA, vregA); AT_LOAD(2, kregA, vregA); }
    __syncthreads();
    const int i16 = lane & 15;
    const int vlane = (4 * hi + (i16 >> 2)) * VPITCH + (16 * ((lane >> 4) & 1) + 4 * (i16 & 3)) * 2;
    f32x16 pa0, pa1, pb0, pb1;
#pragma unroll
    for (int r = 0; r < 16; ++r) { pa0[r] = 0.f; pa1[r] = 0.f; pb0[r] = 0.f; pb1[r] = 0.f; }
    if (PIPE) AT_QK(0, 0, pa0, pa1);
    int bcur = 0;
#define AT_ITER(it, C0, C1, N0, N1, kreg, vreg) do { \
        const int _b1 = (bcur == 2) ? 0 : bcur + 1, _b2 = (_b1 == 2) ? 0 : _b1 + 1; \
        AT_STORE(_b2, kreg, vreg); \
        AT_LOAD((it) + 2 + NSET, kreg, vreg); \
        if (PIPE) { if ((it) + 1 < nt) AT_QK((it) + 1, _b1, N0, N1); } else AT_QK(it, bcur, C0, C1); \
        if (AT_ACTIVE(it)) { \
            const int _kb = AT_TB(it); const bool _diag = (it) < NTD; \
            if (_diag) { const int _kq = _kb + 4 * hi - qpos; \
                _Pragma("unroll") for (int _r = 0; _r < 16; ++_r) { const int _dd = _kq + (_r & 3) + 8 * (_r >> 2); if (_dd > 0) C0[_r] = NEGBIG; if (_dd + 32 > 0) C1[_r] = NEGBIG; } } \
            float _m0 = max3f(C0[0], C0[1], C0[2]), _m1 = max3f(C1[0], C1[1], C1[2]); \
            _Pragma("unroll") for (int _r = 3; _r < 15; _r += 2) { _m0 = max3f(_m0, C0[_r], C0[_r + 1]); _m1 = max3f(_m1, C1[_r], C1[_r + 1]); } \
            _m0 = fmaxf(_m0, C0[15]); _m1 = fmaxf(_m1, C1[15]); \
            const float _c0 = ALIBI ? sl2 * (float)(_kb - qpos) : 0.f; \
            float _mx = fmaxf(_m0, _m1 + d32) + _c0; \
            bool _selok = true; if (MOBA && !_diag) _selok = ((sel >> (_kb >> 8)) & 1u) != 0u; \
            if (!_selok) _mx = NEGBIG; \
            _mx = fmaxf(_mx, __shfl_xor(_mx, 32)); \
            const float _mn = fmaxf(mrun, _mx); \
            if (__any(_mn - mrun > 8.f)) { \
                const float _alpha = __builtin_amdgcn_exp2f(mrun - _mn); lrun *= _alpha; mrun = _mn; \
                scr[r32] = _alpha; \
                asm volatile("s_waitcnt lgkmcnt(0)" ::: "memory"); \
                f32x4 _a4[4]; \
                _Pragma("unroll") for (int _g = 0; _g < 4; ++_g) _a4[_g] = *(const LAS f32x4*)(scr + 8 * _g + 4 * hi); \
                asm volatile("s_waitcnt lgkmcnt(0)" ::: "memory"); \
                _Pragma("unroll") for (int _d0 = 0; _d0 < ND; ++_d0) _Pragma("unroll") for (int _r = 0; _r < 16; ++_r) o[_d0][_r] *= _a4[_r >> 2][_r & 3]; \
            } \
            const float _ms0 = _selok ? (mrun - _c0) : INFINITY, _ms1 = _ms0 - d32; \
            float _ls = 0.f; \
            _Pragma("unroll") for (int _r = 0; _r < 16; ++_r) { C0[_r] = __builtin_amdgcn_exp2f(C0[_r] - _ms0); C1[_r] = __builtin_amdgcn_exp2f(C1[_r] - _ms1); _ls += C0[_r] + C1[_r]; } \
            lrun += _ls; \
            bf16x8 _pa[4]; \
            _Pragma("unroll") for (int _ks = 0; _ks < 2; ++_ks) { u32x4 _w; \
                _w.x = pk2(C0[8 * _ks], C0[8 * _ks + 1]); _w.y = pk2(C0[8 * _ks + 2], C0[8 * _ks + 3]); _w.z = pk2(C0[8 * _ks + 4], C0[8 * _ks + 5]); _w.w = pk2(C0[8 * _ks + 6], C0[8 * _ks + 7]); \
                _pa[_ks] = __builtin_bit_cast(bf16x8, _w); \
                _w.x = pk2(C1[8 * _ks], C1[8 * _ks + 1]); _w.y = pk2(C1[8 * _ks + 2], C1[8 * _ks + 3]); _w.z = pk2(C1[8 * _ks + 4], C1[8 * _ks + 5]); _w.w = pk2(C1[8 * _ks + 6], C1[8 * _ks + 7]); \
                _pa[2 + _ks] = __builtin_bit_cast(bf16x8, _w); } \
            LAS const char* _Vb = lds + VOFF0 + bcur * 64 * VPITCH + vlane; \
            _Pragma("unroll") for (int _d0 = 0; _d0 < ND; _d0 += PVG) { bf16x8 _vf[4 * PVG];        \
                _Pragma("unroll") for (int _e = 0; _e < PVG; ++_e) _Pragma("unroll") for (int _ks = 0; _ks < 4; ++_ks) { \
                    const s16x4 _lo = vtr(_Vb + (16 * _ks) * VPITCH + 64 * (_d0 + _e)), _hh = vtr(_Vb + (16 * _ks + 8) * VPITCH + 64 * (_d0 + _e)); \
                    _vf[4 * _e + _ks] = __builtin_shufflevector(_lo, _hh, 0, 1, 2, 3, 4, 5, 6, 7); } \
                __builtin_amdgcn_sched_barrier(0); \
                _Pragma("unroll") for (int _ks = 0; _ks < 4; ++_ks) _Pragma("unroll") for (int _e = 0; _e < PVG; ++_e) \
                    o[_d0 + _e] = __builtin_amdgcn_mfma_f32_32x32x16_bf16(_pa[_ks], _vf[4 * _e + _ks], o[_d0 + _e], 0, 0, 0); \
                __builtin_amdgcn_sched_barrier(0); } \
        } \
        bcur = _b1; \
        asm volatile("s_waitcnt lgkmcnt(0)\n\ts_barrier" ::: "memory"); } while (0)
    if (NSET == 4) {
        for (int it = 0; it < nt; it += 4) {
            AT_ITER(it, pa0, pa1, pb0, pb1, kregC, vregC);
            AT_ITER(it + 1, pb0, pb1, pa0, pa1, kregD, vregD);
            AT_ITER(it + 2, pa0, pa1, pb0, pb1, kregA, vregA);
            AT_ITER(it + 3, pb0, pb1, pa0, pa1, kregB, vregB);
        }
    } else {
        for (int it = 0; it < nt; it += 2) {
            AT_ITER(it, pa0, pa1, pb0, pb1, kregA, vregA);
            if (NSET == 2) AT_ITER(it + 1, pb0, pb1, pa0, pa1, kregB, vregB); else AT_ITER(it + 1, pb0, pb1, pa0, pa1, kregA, vregA);
        }
    }
#undef AT_TB
#undef AT_LOAD
#undef AT_STORE
#undef AT_ACTIVE
#undef AT_QK
#undef AT_ITER
    {
        const float lt = lrun + __shfl_xor(lrun, 32);
        scr[r32] = 1.f / lt;
        asm volatile("s_waitcnt lgkmcnt(0)" ::: "memory");
        f32x4 a4[4];
#pragma unroll
        for (int g = 0; g < 4; ++g) a4[g] = *(const LAS f32x4*)(scr + 8 * g + 4 * hi);
        asm volatile("s_waitcnt lgkmcnt(0)" ::: "memory");
#pragma unroll
        for (int d0 = 0; d0 < ND; ++d0)
#pragma unroll
            for (int r = 0; r < 16; ++r) o[d0][r] *= a4[r >> 2][r & 3];
    }
    if (NROWS == 256) {
#pragma unroll
        for (int d0 = 0; d0 < ND; ++d0)
#pragma unroll
            for (int r = 0; r < 16; ++r) { const size_t row = (size_t)(q0 + ro + crow(r, hi)); const int col = 32 * d0 + r32;
                const float z = bf2f(Zp[row * ldz + col]); Yp[row * ldy + col] = f2bf(o[d0][r] * silu(z)); }
    } else {
        LAS float* xch = (LAS float*)lds;
        if (map == 1) {
#pragma unroll
            for (int d0 = 0; d0 < ND; ++d0)
#pragma unroll
                for (int r = 0; r < 16; ++r) xch[(((wid & 3) * ND + d0) * 16 + r) * 64 + lane] = o[d0][r];
        }
        __syncthreads();
        if (map == 0) {
#pragma unroll
            for (int d0 = 0; d0 < ND; ++d0)
#pragma unroll
                for (int r = 0; r < 16; ++r) o[d0][r] -= lam * xch[(((wid & 3) * ND + d0) * 16 + r) * 64 + lane];
#pragma unroll
            for (int r = 0; r < 16; ++r) { float ss = 0.f;
#pragma unroll
                for (int d0 = 0; d0 < ND; ++d0) ss += o[d0][r] * o[d0][r];
                ss += __shfl_xor(ss, 1); ss += __shfl_xor(ss, 2); ss += __shfl_xor(ss, 4); ss += __shfl_xor(ss, 8); ss += __shfl_xor(ss, 16);
                const float rs = __builtin_amdgcn_rsqf(ss * (1.f / (float)DV) + 1e-5f) * post;
                const size_t row = (size_t)(q0 + ro + crow(r, hi));
#pragma unroll
                for (int d0 = 0; d0 < ND; ++d0) { const int col = 32 * d0 + r32; const float z = bf2f(Zp[row * ldz + col]);
                    Yp[row * ldy + col] = f2bf(o[d0][r] * rs * subg[col] * silu(z)); } }
        }
        __syncthreads();
    }
}

#define XB_TMO      128
#define XB_XCNT(j)  (256  + 64 * (j))
#define XB_XSUB(j)  (1280 + 64 * (j))
#define XB_XGEN(j)  (2304 + 64 * (j))
#define XB_TOP      3328
#define XB_TOPGEN   3392
#define XCD_BAR_WORDS 3456
#define XB_SPIN_CAP (1u << 22)
DI unsigned xb_ld(unsigned* p)              { return __hip_atomic_load(p, __ATOMIC_RELAXED, __HIP_MEMORY_SCOPE_AGENT); }
DI unsigned xb_add(unsigned* p, unsigned v) { return __hip_atomic_fetch_add(p, v, __ATOMIC_RELAXED, __HIP_MEMORY_SCOPE_AGENT); }
DI unsigned xb_xcc_id() { return (unsigned)__builtin_amdgcn_s_getreg((3 << 11) | 20) & 0xFu; }
#define XB_SPIN(cond, bar) do { unsigned _sp = 0; while (cond) { __builtin_amdgcn_s_sleep(1); \
    if ((++_sp & 255u) == 0u) { if (xb_ld(&(bar)[XB_TMO])) break; if (_sp > XB_SPIN_CAP) { atomicAdd(&(bar)[XB_TMO], 1u); break; } } } } while (0)
DI void xcd_barrier_complete(unsigned* bar, unsigned x, unsigned& nloc, unsigned& nx) {
    const unsigned Gn = gridDim.x;
    unsigned sum, cnt, mine, sp = 0u;
    for (;;) {
        sum = 0u; cnt = 0u; mine = 0u;
#pragma unroll
        for (unsigned j = 0; j < 16; ++j) { const unsigned c = xb_ld(&bar[XB_XCNT(j)]); sum += c; cnt += (c > 0u) ? 1u : 0u; mine = (j == x) ? c : mine; }
        if (sum == Gn) break;
        __builtin_amdgcn_s_sleep(1);
        if ((++sp & 255u) == 0u) { if (xb_ld(&bar[XB_TMO])) break; if (sp > XB_SPIN_CAP) { atomicAdd(&bar[XB_TMO], 1u); break; } }
    }
    nloc = mine > 0u ? mine : 1u; nx = cnt > 0u ? cnt : 1u;
}
DI void xcd_barrier(unsigned* bar, volatile LAS unsigned* st) {
    asm volatile("s_waitcnt vmcnt(0)" ::: "memory");
    __syncthreads();
    if (threadIdx.x == 0) {
        __builtin_amdgcn_s_waitcnt(0);
        const unsigned x = xb_xcc_id();
        unsigned nloc = st[0], nx = st[1];
        if (nloc == 0u) { xcd_barrier_complete(bar, x, nloc, nx); st[0] = nloc; st[1] = nx; }
        const unsigned old = xb_add(&bar[XB_XSUB(x)], 1u);
        const unsigned gen = old / nloc;
        if (old + 1u == (gen + 1u) * nloc) {
            __builtin_amdgcn_fence(__ATOMIC_RELEASE, "agent");
            asm volatile("s_waitcnt vmcnt(0)" ::: "memory");
            const unsigned og = xb_add(&bar[XB_TOP], 1u);
            const unsigned tg = og / nx;
            if (og + 1u == (tg + 1u) * nx) xb_add(&bar[XB_TOPGEN], 1u);
            else XB_SPIN(xb_ld(&bar[XB_TOPGEN]) == tg, bar);
            __builtin_amdgcn_fence(__ATOMIC_ACQUIRE, "agent");
            xb_add(&bar[XB_XGEN(x)], 1u);
            asm volatile("s_waitcnt vmcnt(0)" ::: "memory");
        } else {
            XB_SPIN(xb_ld(&bar[XB_XGEN(x)]) == gen, bar);
            __builtin_amdgcn_fence(__ATOMIC_ACQUIRE, "agent");
            asm volatile("s_waitcnt vmcnt(0)" ::: "memory");
        }
    }
    __syncthreads();
}

struct Params { const float* in[19]; float* out; unsigned char* ws; };

DI void colmap(int kind, int n, int& col, float& cs) {
    cs = 1.f;
    if (kind == 0) {
        if (n < 2048) { col = n; if (n < 512) cs = QS64; }
        else if (n < 2560) col = 2720 + (n - 2048);
        else if (n < 3072) { col = 3232 + (n - 2560); cs = QS64; }
        else if (n < 3584) col = 3744 + (n - 3072);
        else if (n < 4096) col = 4256 + (n - 3584);
        else if (n < 4608) col = 4768 + (n - 4096);
        else if (n < 4864) col = 2432 + (n - 4608);
        else if (n < 5248) col = 2048 + (n - 4864);
        else if (n < 5280) { const int j = n - 5248; col = 2688 + (j >> 1) + 16 * (j & 1); }
        else col = -1;
    } else if (kind == 1) col = n;
    else if (kind == 2) { const int h = n / 96, j = n % 96; if (j < 64) col = h * 96 + j; else { const int jj = j - 64; col = h * 96 + 64 + (jj >> 1) + 16 * (jj & 1); } }
    else { if (n < 512) col = (n >> 6) * 128 + (n & 63); else { const int m = n - 512; col = (m >> 6) * 128 + 64 + (m & 63); } }
}
DI void tr_tile(const float* src, int srcN, int K, bf16_t* dst, int kind, int n0, int k0, const float* kscale, LAS float* scr, int tid) {
    { const int nl = tid & 127, kl0 = tid >> 7; int col; float cs; colmap(kind, n0 + nl, col, cs);
      float v[16];
#pragma unroll
      for (int i = 0; i < 16; ++i) { const int kl = kl0 + 4 * i; v[i] = (col >= 0) ? src[(size_t)(k0 + kl) * srcN + col] : 0.f; }
#pragma unroll
      for (int i = 0; i < 16; ++i) { const int kl = kl0 + 4 * i; float w = v[i] * cs; if (kscale) w *= kscale[k0 + kl]; scr[kl * 129 + nl] = w; } }
    __syncthreads();
    { const int kp = tid & 31;
#pragma unroll
      for (int i = 0; i < 8; ++i) { const int nl = (tid >> 5) + 16 * i;
          *(unsigned*)(dst + (size_t)(n0 + nl) * K + k0 + 2 * kp) = pk2(scr[(2 * kp) * 129 + nl], scr[(2 * kp + 1) * 129 + nl]); } }
    __syncthreads();
}
typedef const __attribute__((address_space(4))) Params* KParams0;
DI void convert_weights(KParams0 Pk, int l, bf16_t* WT, LAS float* scr) {
    const int tid = opaque_tid();
    constexpr int T0 = 42 * 16, T1 = T0 + 24 * 16, T2 = T1 + 6 * 6, T3 = T2 + 8 * 4, T4 = T3 + 8 * 8, T5 = T4 + 8 * 8, T6 = T5 + 8 * 8, T7 = T6 + 8 * 16, T8 = T7 + 8 * 16, T9 = T8 + 8 * 4;
    for (int t = blockIdx.x; t < T9; t += gridDim.x) {
        const float* src; int srcN, K, kind, loc; bf16_t* dst; const float* ks = nullptr;
        if (t < T0) { src = Pk->in[2] + (size_t)l * 1024 * 5280; srcN = 5280; K = 1024; kind = 0; loc = t; dst = WT + OFF_WIN; }
        else if (t < T1) { src = Pk->in[12] + (size_t)l * 1024 * 3072; srcN = 3072; K = 1024; kind = 1; loc = t - T0; dst = WT + OFF_WIN + (size_t)5376 * 1024; }
        else if (t < T2) { src = Pk->in[5] + (size_t)l * 384 * 768; srcN = 768; K = 384; kind = 2; loc = t - T1; dst = WT + OFF_WUQ; ks = Pk->in[3] + l * 384; }
        else if (t < T3) { src = Pk->in[6] + (size_t)l * 256 * 1024; srcN = 1024; K = 256; kind = 3; loc = t - T2; dst = WT + OFF_WUKV; ks = Pk->in[4] + l * 256; }
        else if (t < T4) { src = Pk->in[9] + (size_t)l * 512 * 1024; srcN = 1024; K = 512; kind = 1; loc = t - T3; dst = WT + OFF_WABC; }
        else if (t < T5) { src = Pk->in[10] + (size_t)l * 512 * 1024; srcN = 1024; K = 512; kind = 1; loc = t - T4; dst = WT + OFF_WABC + (size_t)1024 * 512; }
        else if (t < T6) { src = Pk->in[11] + (size_t)l * 512 * 1024; srcN = 1024; K = 512; kind = 1; loc = t - T5; dst = WT + OFF_WABC + (size_t)2048 * 512; }
        else if (t < T7) { src = Pk->in[14] + (size_t)l * 1024 * 1024; srcN = 1024; K = 1024; kind = 1; loc = t - T6; dst = WT + OFF_WO; }
        else if (t < T8) { src = Pk->in[17] + (size_t)l * 1024 * 1024; srcN = 1024; K = 1024; kind = 1; loc = t - T7; dst = WT + OFF_WPG; }
        else { src = Pk->in[18] + (size_t)l * 256 * 1024; srcN = 1024; K = 256; kind = 1; loc = t - T8; dst = WT + OFF_WP; }
        const int kt = K / 64; const int n0 = (loc / kt) * 128, k0 = (loc % kt) * 64;
        tr_tile(src, srcN, K, dst, kind, n0, k0, ks, scr, tid);
    }
}
DI void convert_rows(const float* src, bf16_t* dst, size_t n) {
    const size_t stride = (size_t)gridDim.x * blockDim.x, ng = n / 8;
    for (size_t i = (size_t)blockIdx.x * blockDim.x + opaque_tid(); i < ng; i += 4 * stride) {
        f32x4 a[4], b[4];
#pragma unroll
        for (int j = 0; j < 4; ++j) { const size_t q = i + j * stride; if (q < ng) { a[j] = *(const f32x4*)(src + q * 8); b[j] = *(const f32x4*)(src + q * 8 + 4); } }
#pragma unroll
        for (int j = 0; j < 4; ++j) { const size_t q = i + j * stride; if (q < ng) *(u32x4*)(dst + q * 8) = pack8(a[j], b[j]); }
    }
}
typedef const __attribute__((address_space(4))) Params* KParams;
DI KParams kparams() { KParams p = (KParams)__builtin_amdgcn_kernarg_segment_ptr(); asm volatile("" : "+s"(p)); return p; }
DI unsigned char* wsbase() { unsigned char* w = kparams()->ws; asm volatile("" : "+s"(w)); return w; }

__global__ void __launch_bounds__(512, 2) fwd_megakernel(Params Punused) {
    extern __shared__ __attribute__((aligned(16))) unsigned char lds_raw[];
    cg::grid_group grid = cg::this_grid();
    LAS unsigned char* lds = (LAS unsigned char*)lds_raw;
#define G opaque_s((int)gridDim.x)
#define cu opaque_s((int)blockIdx.x)
#define XB_  ((bf16_t*)(ws + WS_XB))
#define WT_  ((bf16_t*)(ws + WS_WT))
#define PB_  ((bf16_t*)(ws + WS_PB))
#define Y_   ((bf16_t*)(ws + WS_Y))
#define H_   ((bf16_t*)(ws + WS_H))
#define QB_  ((bf16_t*)(ws + WS_MLA))
#define KB_  (QB_ + (size_t)HM * 768)
#define VB_  (KB_ + (size_t)HM * 768)
#define R_   ((float*)(ws + WS_H))
#define ROPE_ ((float*)(ws + CTL_ROPE))
#define KMP_ ((float*)(ws + CTL_KMP))
#define STQ_ ((float*)(ws + CTL_STQ))
#define STKV_ ((float*)(ws + CTL_STKV))

    if (threadIdx.x < 2) ((volatile LAS unsigned*)(lds + LDS_IDX + 64))[threadIdx.x] = 0u;
    {
        const int tid = opaque_tid();
        KParams P = kparams(); unsigned char* ws = P->ws;
        for (int rep = 0; rep < REP_P0; ++rep) {
        convert_weights(P, 0, WT_, (LAS float*)lds);
        convert_rows(P->in[0], XB_, (size_t)M * D);
        convert_rows(P->in[1], PB_, (size_t)M * 256); }
        float* rope = ROPE_;
        for (int i = cu * 512 + tid; i < SEQ * 16; i += G * 512) {
            const int pos = i >> 4, k = i & 15;
            const float freq = __builtin_amdgcn_exp2f(-(float)k * (13.287712379549449f / 16.f));
            const float ang = (float)pos * freq;
            double rev = (double)ang * 0.15915494309189535; rev -= __builtin_rint(rev);
            const float fr = (float)rev;
            rope[2 * i] = __builtin_amdgcn_cosf(fr); rope[2 * i + 1] = __builtin_amdgcn_sinf(fr);
        }
        if (cu == 0) {
            unsigned* ctl = (unsigned*)(ws + WS_CTL); float* lamv = (float*)(ws + CTL_LAM);
            if (tid < 64) {
#pragma unroll
                for (int l = 0; l < 2; ++l) { const float* dl = P->in[7] + l * 256; float a = dl[tid] * dl[64 + tid], b = dl[128 + tid] * dl[192 + tid];
#pragma unroll
                    for (int s = 1; s < 64; s <<= 1) { a += __shfl_xor(a, s); b += __shfl_xor(b, s); }
                    const float li = (l == 0) ? 0.2f : 0.35550906759096924f;
                    if (tid == 0) lamv[l] = __builtin_amdgcn_exp2f(a * LOG2E) - __builtin_amdgcn_exp2f(b * LOG2E) + li; }
            }
            if (tid < 64) ctl[tid] = 0u;
            if (tid < 128) ((unsigned*)(ws + CTL_DEP))[tid] = 0u;
            { unsigned* bw = (unsigned*)(ws + CTL_BAR); for (int i = tid; i < XCD_BAR_WORDS; i += 512) bw[i] = 0u; }
        }
    }
    grid.sync();
    if (threadIdx.x == 0) { unsigned char* ws = wsbase(); (void)xb_add(&((unsigned*)(ws + CTL_BAR))[XB_XCNT(xb_xcc_id())], 1u); }
#define GSYNC() do { unsigned char* _w = wsbase(); xcd_barrier((unsigned*)(_w + CTL_BAR), (volatile LAS unsigned*)(lds + LDS_IDX + 64)); } while (0)

    for (int l = 0; l < 2; ++l) {
        for (int hf = 0; hf < 2; ++hf) {
            for (int rep = 0; rep < REP_P1; ++rep)
            { unsigned char* ws = wsbase();
              pg8::Gemm g{XB_ + (size_t)hf * HM * D, WT_ + OFF_WIN, D, D}; pg8::P1Order S{G, cu};
              pg8::EpiH E{H_, KB_, KMP_ + (size_t)hf * 32 * 2 * 512, STQ_ + (size_t)hf * HM * 8, STKV_ + (size_t)hf * HM * 4, ROPE_, (unsigned*)(ws + CTL_DEP) + (l * 2 + hf) * 32};
              pg8::gemm_phase(lds, g, S, E); }
            {
                const int Gn = G, rem = 672 % Gn, NE = Gn - rem, e = cu - rem;
                pg8::ListOrder Sq{0, (e >= 0) ? 96 : 0, 3, (e >= 0) ? e : 0, NE}, Skv{96, (e >= 0) ? 224 : 96, 4, (e >= 0) ? e : 0, NE};
                if (opaque_tid() == 0) {
                    unsigned char* ws = wsbase(); unsigned* dep = (unsigned*)(ws + CTL_DEP) + (l * 2 + hf) * 32; pg8::Unit u;
                    for (int pass = 0; pass < 2; ++pass)
                        for (int i = 0; pass == 0 ? Sq.next(i, u) : Skv.next(i, u); ++i) {
                            unsigned sp = 0;
                            while (__hip_atomic_load(dep + u.pm, __ATOMIC_RELAXED, __HIP_MEMORY_SCOPE_AGENT) < 24u) { __builtin_amdgcn_s_sleep(2); if (++sp > (1u << 24)) break; }
                        }
                    __builtin_amdgcn_fence(__ATOMIC_ACQUIRE, "agent");
                    asm volatile("s_waitcnt vmcnt(0)" ::: "memory");
                }
                __syncthreads();
                { unsigned char* ws = wsbase();
                  pg8::Gemm g{H_ + C_CQL, WT_ + OFF_WUQ, HP, 384};
                  pg8::EpiUp<0> E{QB_, KB_, VB_, STQ_ + (size_t)hf * HM * 8, ROPE_}; pg8::gemm_phase(lds, g, Sq, E); }
                { unsigned char* ws = wsbase();
                  pg8::Gemm g{H_ + C_CKV, WT_ + OFF_WUKV, HP, 256};
                  pg8::EpiUp<1> E{QB_, KB_, VB_, STKV_ + (size_t)hf * HM * 4, ROPE_}; pg8::gemm_phase(lds, g, Skv, E); }
            }
            GSYNC();
            {
                for (int vcu = cu; vcu < 256; vcu += G)
                for (int step = 0; ; ++step) {
                    KParams P = kparams(); unsigned char* ws = P->ws;
                    const int x = vcu & 7, sl_ = vcu >> 3;
                    int type, u, bh;
                    if (step < 2) {
                        if (sl_ < 16) { type = 2; bh = 2 * x + (sl_ >> 3); const int j = sl_ & 7; u = (step == 0) ? 15 - j : j; }
                        else { const int t = sl_ - 16; bh = 4 * x + (t >> 2); type = step; u = 7 - (t & 3); }
                    } else {
                        if (opaque_tid() == 0) *(LAS int*)(lds + LDS_IDX) = (int)atomicAdd((unsigned*)(ws + WS_CTL) + 16 + (l * 2 + hf) * 8 + x, 1u);
                        __syncthreads();
                        const int k = *(LAS int*)(lds + LDS_IDX);
                        __syncthreads();
                        if (k >= 32) break;
                        u = 3 - (k >> 3); type = (k & 4) ? 0 : 1; bh = 4 * x + (k & 3);
                    }
                    if (type == 0) {
                        const int bl = bh >> 3, h = bh & 7, bg = 4 * hf + bl; const size_t ho = (size_t)bh * SEQ * 64;
                        const float sl = __builtin_amdgcn_exp2f(-(2.f / 3.f) * (float)(h + (h >> 1) + 2)) * LOG2E;
                        attn_unit<64, 64, 64, 256, true, true, true, 2>((LAS char*)lds, H_ + HM_AQ + ho, 64, H_ + HM_AK + ho, 64, H_ + HM_AV + ho, 64,
                            H_ + (size_t)bl * SEQ * HP + C_AZ + h * 64, HP,
                            Y_ + (size_t)bg * SEQ * 512 + h * 64, 512, u * 256, sl, KMP_ + (size_t)bg * 8 * 2 * 512 + h * 64, 0.f, nullptr, 1.f);
                    } else if (type == 1) {
                        const int bl = bh >> 3, h = bh & 7, bg = 4 * hf + bl;
                        attn_unit<96, 96, 64, 256, false, false, true, 2>((LAS char*)lds, QB_ + (size_t)bh * SEQ * 96, 96, KB_ + (size_t)bh * SEQ * 96, 96,
                            VB_ + (size_t)bh * SEQ * 64, 64, H_ + (size_t)bl * SEQ * HP + C_BZ + h * 64, HP,
                            Y_ + (size_t)M * 512 + (size_t)bg * SEQ * 512 + h * 64, 512, u * 256, 0.f, nullptr, 0.f, nullptr, 1.f);
                    } else {
                        const int bl = bh >> 2, h = bh & 3, bg = 4 * hf + bl; const size_t ho = (size_t)bh * SEQ * 128;
                        const float sl = __builtin_amdgcn_exp2f(-(2.f / 3.f) * (float)(3 * h + 1)) * LOG2E;
                        const float lam = ((const float*)(ws + CTL_LAM))[l];
                        const float post = (l == 0) ? 0.8f : (1.f - 0.35550906759096924f);
                        attn_unit<64, 128, 128, 128, true, false, false, 1>((LAS char*)lds, H_ + HM_CQ + ho, 128, H_ + HM_CK + ho, 128, H_ + HM_CV + ho, 128,
                            H_ + (size_t)bl * SEQ * HP + C_CZ + h * 128, HP,
                            Y_ + (size_t)2 * M * 512 + (size_t)bg * SEQ * 512 + h * 128, 512, u * 128, sl, nullptr, lam, P->in[8] + l * 128, post);
                    }
                }
            }
            GSYNC();
        }
        { KParams P = kparams(); unsigned char* ws = P->ws;
          pg8::Gemm g{XB_, WT_ + OFF_WIN + (size_t)5376 * 1024, D, D}; pg8::StaticOrder S; S.init(M, 3072, G, cu);
          pg8::EpiG E{H_, P->in[13] + l * 3072}; pg8::gemm_phase(lds, g, S, E); }
        GSYNC();
        { unsigned char* ws = wsbase();
          pg8::Gemm g{Y_, WT_ + OFF_WABC, 512, 512}; pg8::MergeOrder S{cu, G};
          pg8::EpiMerge E{H_, XB_}; pg8::gemm_phase(lds, g, S, E); }
        GSYNC();
        { KParams P = kparams(); unsigned char* ws = P->ws;
          pg8::Gemm g{XB_, WT_ + OFF_WO, D, D}; pg8::StaticOrder S; S.init(M, D, G, cu);
          pg8::EpiR E{(l == 0) ? P->in[0] : (const float*)P->out, R_, Y_}; pg8::gemm_phase(lds, g, S, E); }
        GSYNC();
        { unsigned char* ws = wsbase();
          pg8::Gemm g{PB_, WT_ + OFF_WP, 256, 256}; pg8::StaticOrder S; S.init(M, D, G, cu);
          pg8::EpiBf E{XB_}; pg8::gemm_phase(lds, g, S, E); }
        { unsigned char* ws = wsbase();
          pg8::Gemm g{Y_, WT_ + OFF_WPG, D, D}; pg8::StaticOrder S; S.init(M, D, G, cu);
          pg8::EpiR2 E{R_, XB_}; pg8::gemm_phase(lds, g, S, E); }
        GSYNC();
        {
            KParams P = kparams(); unsigned char* ws = P->ws;
            const int tid = opaque_tid(), lane = tid & 63, wid = tid >> 6;
            const float* lg = P->in[15] + l * 1024; const float* lb = P->in[16] + l * 1024;
            float* outp = P->out; const float* R = R_; bf16_t* XB = XB_;
            const int gstep = (int)gridDim.x * 8;
            for (int row = (int)blockIdx.x * 8 + wid; row < M; row += 2 * gstep) {
                const bool two = row + gstep < M;
                const float* rp0 = R + (size_t)row * 1024; const float* rp1 = R + (size_t)(two ? row + gstep : row) * 1024;
                f32x4 v[2][4]; float s0 = 0.f, s1 = 0.f;
#pragma unroll
                for (int j = 0; j < 4; ++j) { v[0][j] = *(const f32x4*)(rp0 + 4 * lane + 256 * j); v[1][j] = *(const f32x4*)(rp1 + 4 * lane + 256 * j); }
#pragma unroll
                for (int j = 0; j < 4; ++j) { s0 += (v[0][j][0] + v[0][j][1]) + (v[0][j][2] + v[0][j][3]); s1 += (v[1][j][0] + v[1][j][1]) + (v[1][j][2] + v[1][j][3]); }
#pragma unroll
                for (int k = 1; k < 64; k <<= 1) { s0 += __shfl_xor(s0, k); s1 += __shfl_xor(s1, k); }
                const float mu0 = s0 * (1.f / 1024.f), mu1 = s1 * (1.f / 1024.f); float q0 = 0.f, q1 = 0.f;
#pragma unroll
                for (int j = 0; j < 4; ++j) { v[0][j] -= mu0; v[1][j] -= mu1;
                    q0 += (v[0][j][0] * v[0][j][0] + v[0][j][1] * v[0][j][1]) + (v[0][j][2] * v[0][j][2] + v[0][j][3] * v[0][j][3]);
                    q1 += (v[1][j][0] * v[1][j][0] + v[1][j][1] * v[1][j][1]) + (v[1][j][2] * v[1][j][2] + v[1][j][3] * v[1][j][3]); }
#pragma unroll
                for (int k = 1; k < 64; k <<= 1) { q0 += __shfl_xor(q0, k); q1 += __shfl_xor(q1, k); }
                const float rs0 = __builtin_amdgcn_rsqf(q0 * (1.f / 1024.f) + 1e-5f), rs1 = __builtin_amdgcn_rsqf(q1 * (1.f / 1024.f) + 1e-5f);
#pragma unroll
                for (int j = 0; j < 4; ++j) { const f32x4 gv = *(const f32x4*)(lg + 4 * lane + 256 * j), bv = *(const f32x4*)(lb + 4 * lane + 256 * j);
#pragma unroll
                    for (int t = 0; t < 2; ++t) { if (t == 1 && !two) break;
                        const size_t rr = (size_t)(t == 0 ? row : row + gstep);
                        const f32x4 y = v[t][j] * (t == 0 ? rs0 : rs1) * gv + bv;
                        *(f32x4*)(outp + rr * 1024 + 4 * lane + 256 * j) = y;
                        if (l == 0) { u32x2 w; w.x = pk2(y[0], y[1]); w.y = pk2(y[2], y[3]); *(u32x2*)(XB + rr * 1024 + 4 * lane + 256 * j) = w; } } }
            }
            if (l == 0) {
                __syncthreads();
                convert_weights(P, 1, WT_, (LAS float*)lds);
                convert_rows(P->in[1] + (size_t)M * 256, PB_, (size_t)M * 256);
            }
        }
        if (l == 0) GSYNC();
    }
}

#undef G
#undef cu
extern "C" void kernel_launch(void* const* d_in, const int* in_sizes, int n_in, void* d_out, int out_size, void* d_ws, size_t ws_size, hipStream_t stream) {
    static int grid_blocks = 0;
    if (grid_blocks == 0) {
        if (n_in != 19 || out_size != M * D || ws_size < WS_END) { fprintf(stderr, "kernel_launch: unexpected problem (n_in %d out %d ws %zu)\n", n_in, out_size, ws_size); grid_blocks = -1; return; }
        int dev = 0, cus = 0, per_cu = 0;
        hipGetDevice(&dev);
        hipDeviceGetAttribute(&cus, hipDeviceAttributeMultiprocessorCount, dev);
        if (hipFuncSetAttribute((const void*)fwd_megakernel, hipFuncAttributeMaxDynamicSharedMemorySize, LDS_BYTES) != hipSuccess) { fprintf(stderr, "kernel_launch: hipFuncSetAttribute failed\n"); grid_blocks = -1; return; }
        if (hipOccupancyMaxActiveBlocksPerMultiprocessor(&per_cu, (const void*)fwd_megakernel, 512, LDS_BYTES) != hipSuccess || per_cu < 1) { fprintf(stderr, "kernel_launch: occupancy query failed (%d)\n", per_cu); grid_blocks = -1; return; }
        grid_blocks = cus * per_cu;
        if (grid_blocks > 256) grid_blocks = 256;
    }
    if (grid_blocks < 0) return;
    Params p{};
    for (int i = 0; i < 19; ++i) p.in[i] = (const float*)d_in[i];
    p.out = (float*)d_out; p.ws = (unsigned char*)d_ws;
    void* args[] = {&p};
    hipError_t e = hipLaunchCooperativeKernel((const void*)fwd_megakernel, dim3(grid_blocks), dim3(512), args, LDS_BYTES, stream);
    if (e != hipSuccess) fprintf(stderr, "cooperative launch failed: %s (grid %d)\n", hipGetErrorString(e), grid_blocks);
}
```

```cpp
#include <hip/hip_runtime.h>
#include <hip/hip_cooperative_groups.h>
#include <cstdio>
#include <cstdint>
namespace cg = cooperative_groups;
#ifndef REP_ATT
#define REP_ATT 1
#endif
#ifndef REP_P1
#define REP_P1 1
#endif
#ifndef REP_P0
#define REP_P0 1
#endif

#define LAS __attribute__((address_space(3)))
#define DI __device__ __forceinline__
typedef unsigned short bf16_t;
typedef short bf16x8 __attribute__((ext_vector_type(8)));
typedef short s16x4 __attribute__((ext_vector_type(4)));
typedef float f32x2 __attribute__((ext_vector_type(2)));
typedef float f32x4 __attribute__((ext_vector_type(4)));
typedef float f32x16 __attribute__((ext_vector_type(16)));
typedef unsigned u32x4 __attribute__((ext_vector_type(4)));
typedef unsigned u32x2 __attribute__((ext_vector_type(2)));
typedef __bf16 bf16x2_t __attribute__((ext_vector_type(2)));

constexpr int M = 16384, D = 1024, SEQ = 2048, HM = 8192;
constexpr int HP = 2304;
constexpr int NH1 = 5376;
constexpr int NWIN = 8448;
constexpr float LOG2E = 1.4426950408889634f;
constexpr float QS64 = 0.125f * LOG2E;
constexpr float QS96 = 0.10206207261596575f * LOG2E;
constexpr float ALPHA = 1.4142135623730951f;
constexpr int C_AZ = 0, C_BZ = 512, C_CZ = 1024, C_CKV = 1536, C_CQL = 1792;
constexpr size_t HM_AQ = (size_t)18 * 1048576, HM_AK = (size_t)22 * 1048576, HM_AV = (size_t)26 * 1048576, HM_CQ = (size_t)30 * 1048576, HM_CK = (size_t)34 * 1048576, HM_CV = (size_t)38 * 1048576;

constexpr size_t MiB = 1048576;
constexpr size_t WS_CTL = 0, WS_XB = 2 * MiB, WS_WT = 34 * MiB, WS_PB = 60 * MiB, WS_Y = 68 * MiB, WS_H = 116 * MiB, WS_MLA = 200 * MiB, WS_END = 232 * MiB;
constexpr size_t CTL_DEP = 8192, CTL_BAR = 16384, CTL_LAM = 4096, CTL_ROPE = 65536, CTL_KMP = 384 * 1024, CTL_STQ = 640 * 1024, CTL_STKV = 1152 * 1024;
constexpr size_t OFF_WIN = 0, OFF_WUQ = 8650752, OFF_WUKV = 8945664, OFF_WABC = 9207808, OFF_WO = 10780672, OFF_WPG = 11829248, OFF_WP = 12877824;
constexpr int LDS_BYTES = 132 * 1024, LDS_IDX = 131072;

DI int opaque_s(int v) { asm volatile("" : "+s"(v)); return v; }
DI int opaque_tid() { int t = threadIdx.x; asm volatile("" : "+v"(t)); return t; }
DI unsigned pk2(float lo, float hi) { f32x2 v = {lo, hi}; bf16x2_t b = __builtin_convertvector(v, bf16x2_t); return __builtin_bit_cast(unsigned, b); }
DI float bflo(unsigned w) { return __uint_as_float(w << 16); }
DI float bfhi(unsigned w) { return __uint_as_float(w & 0xffff0000u); }
DI float bf2f(bf16_t b) { return __uint_as_float((unsigned)b << 16); }
DI bf16_t f2bf(float f) { return (bf16_t)(pk2(f, 0.f) & 0xffffu); }
DI float sigm(float x) { return __builtin_amdgcn_rcpf(1.f + __builtin_amdgcn_exp2f(-x * LOG2E)); }
DI float silu(float x) { return x * sigm(x); }
DI u32x4 pack8(const f32x4 a, const f32x4 b) { u32x4 w; w.x = pk2(a[0], a[1]); w.y = pk2(a[2], a[3]); w.z = pk2(b[0], b[1]); w.w = pk2(b[2], b[3]); return w; }
DI void unpack8(const u32x4 w, f32x4& a, f32x4& b) { a = (f32x4){bflo(w.x), bfhi(w.x), bflo(w.y), bfhi(w.y)}; b = (f32x4){bflo(w.z), bfhi(w.z), bflo(w.w), bfhi(w.w)}; }

namespace pg8 {
constexpr int BM = 256, BK = 64, HALF = 128, HTB = HALF * BK * 2, NXCD = 8, WGM = 8;
__host__ __device__ __forceinline__ int lds_byte(int r, int c) { const int st = (r >> 4) * 2 + (c >> 5), rr = r & 15, cc = c & 31, ob = rr * 64 + cc * 2; return st * 1024 + (ob ^ (((ob >> 9) & 1) << 5)); }
__host__ __device__ __forceinline__ void stage_rc(int b, int& R, int& C) { const int st = b / 1024, sb = b % 1024, swz = sb ^ (((sb >> 9) & 1) << 5); R = (st >> 1) * 16 + swz / 64; C = (st & 1) * 32 + (swz % 64) / 2; }
__host__ __device__ __forceinline__ int perm32(int rho) { const int n = rho >> 4, i = rho & 15; return 8 * (i >> 2) + 4 * n + (i & 3); }

struct Unit { int pm, pn; };
struct Gemm { const bf16_t* A; const bf16_t* Bt; int lda, K; };

struct StaticOrder {
    int nM, nN, nwg, G, c;
    DI void init(int M_, int N_, int G_, int c_) { nM = M_ / BM; nN = N_ / BM; nwg = nM * nN; G = G_; c = c_; }
    DI bool next(int i, Unit& u) const {
        const long L = (long)i * G + c; if (L >= nwg) return false;
        int wgid = (int)L; { const int q = nwg / NXCD, r = nwg % NXCD, xcd = wgid % NXCD, off = wgid / NXCD; wgid = (xcd < r ? xcd * (q + 1) : r * (q + 1) + (xcd - r) * q) + off; }
        const int nig = WGM * nN, gid = wgid / nig, fm = gid * WGM, gsz = (nM - fm) < WGM ? (nM - fm) : WGM;
        u.pm = fm + ((wgid % nig) % gsz); u.pn = (wgid % nig) / gsz; return true;
    }
};
struct P1Order {
    int G, c;
    DI bool next(int i, Unit& u) const {
        const long L = (long)i * G + c; if (L >= 672) return false;
        if (L < 96) { u.pm = (int)L / 3; u.pn = 18 + (int)L % 3; return true; }
        const int nM = 32, nN = 18, nwg = 576;
        int wgid = (int)L - 96; { const int q = nwg / NXCD, r = nwg % NXCD, xcd = wgid % NXCD, off = wgid / NXCD; wgid = (xcd < r ? xcd * (q + 1) : r * (q + 1) + (xcd - r) * q) + off; }
        const int nig = WGM * nN, gid = wgid / nig, fm = gid * WGM, gsz = (nM - fm) < WGM ? (nM - fm) : WGM;
        u.pm = fm + ((wgid % nig) % gsz); u.pn = (wgid % nig) / gsz; return true;
    }
};
struct ListOrder {
    int lo, hi, nN, c, G;
    DI bool next(int i, Unit& u) const {
        int k0 = 0; if (c < lo) k0 = (lo - c + G - 1) / G;
        const int idx = c + (k0 + i) * G; if (idx >= hi) return false;
        const int loc = idx - lo; u.pm = loc / nN; u.pn = loc % nN; return true;
    }
};
struct MergeOrder {
    int c, G;
    DI bool next(int i, Unit& u) const {
        const int tile = c + (i / 3) * G, br = i % 3; if (tile >= 256) return false;
        u.pm = br * 64 + (tile >> 2); u.pn = br * 4 + (tile & 3); return true;
    }
};

template <class Epi, class Sched>
DI void gemm_phase(LAS unsigned char* lds, const Gemm g, const Sched& S, const Epi& E) {
    const int tid = opaque_tid(), wid = __builtin_amdgcn_readfirstlane(tid >> 6), lane = tid & 63, wr = wid >> 2, wc = wid & 3, fr = lane & 15, fq = lane >> 4;
    const int K = g.K, nt = K / BK, lda = g.lda;
    unsigned voffA[2], voffB[2];
#pragma unroll
    for (int i = 0; i < 2; ++i) { int R, C; stage_rc(tid * 16 + i * 8192, R, C); const int Rb = (R & ~31) + perm32(R & 31);
        voffA[i] = (unsigned)(R * lda + C) * 2u; voffB[i] = (unsigned)(Rb * K + C) * 2u; }
    const size_t kstep = (size_t)(BK * 2);
    const size_t hstepA = (size_t)HALF * lda * 2, hstepB = (size_t)HALF * K * 2;
    const size_t tstepA = 2 * hstepA, tstepB = 2 * hstepB;
    const unsigned ldsw = (unsigned)wid * 1024u;
    const int aoff = lds_byte(wr * 64 + fr, fq * 8), boff = lds_byte(wc * 32 + fr, fq * 8);
#define PG8_SA(b, h) (((b) * 2 + (h)) * HTB)
#define PG8_SB(b, h) ((4 + (b) * 2 + (h)) * HTB)
#define PG8_STAGE(bufoff, gbase, voff) do { _Pragma("unroll") for (int _i = 0; _i < 2; ++_i) \
        __builtin_amdgcn_global_load_lds((const unsigned*)((const char*)(gbase) + (voff)[_i]), (LAS unsigned*)(lds + (bufoff) + ldsw + _i * 8192), 16, 0, 0); } while (0)
#define PG8_LDA(dst, b, h) do { _Pragma("unroll") for (int m = 0; m < 4; ++m) _Pragma("unroll") for (int k = 0; k < 2; ++k) dst[m][k] = *(const LAS bf16x8*)(lds + PG8_SA(b, h) + aoff + m * 2048 + k * 1024); } while (0)
#define PG8_LDB(dst, b, h) do { _Pragma("unroll") for (int n = 0; n < 2; ++n) _Pragma("unroll") for (int k = 0; k < 2; ++k) dst[n][k] = *(const LAS bf16x8*)(lds + PG8_SB(b, h) + boff + n * 2048 + k * 1024); } while (0)
#define PG8_MMA(ai, bj, At, Bt) do { __builtin_amdgcn_s_setprio(1); _Pragma("unroll") for (int m = 0; m < 4; ++m) _Pragma("unroll") for (int n = 0; n < 2; ++n) _Pragma("unroll") for (int k = 0; k < 2; ++k) \
        acc[ai][bj][m][n] = __builtin_amdgcn_mfma_f32_16x16x32_bf16(Bt[n][k], At[m][k], acc[ai][bj][m][n], 0, 0, 0); __builtin_amdgcn_s_setprio(0); } while (0)
#define PG8_WAIT_V(n) asm volatile("s_waitcnt vmcnt(" #n ")" ::: "memory")
#define PG8_WAIT_L(n) asm volatile("s_waitcnt lgkmcnt(" #n ")" ::: "memory")
#define PG8_BAR __builtin_amdgcn_s_barrier()
#define PG8_SCHED __builtin_amdgcn_sched_barrier(0)
    Unit cur, nxt; int ui = 0;
    if (!S.next(0, cur)) return;
    f32x4 acc[2][2][4][2];
#pragma unroll
    for (int a = 0; a < 2; ++a)
#pragma unroll
        for (int b = 0; b < 2; ++b)
#pragma unroll
            for (int m = 0; m < 4; ++m)
#pragma unroll
                for (int n = 0; n < 2; ++n) acc[a][b][m][n] = (f32x4){0.f, 0.f, 0.f, 0.f};
    bf16x8 At[4][2], B0[2][2], B1[2][2];
    const char* cA = (const char*)g.A + (size_t)cur.pm * tstepA; const char* cB = (const char*)g.Bt + (size_t)cur.pn * tstepB;
    PG8_STAGE(PG8_SB(0, 0), cB, voffB); PG8_STAGE(PG8_SB(0, 1), cB + hstepB, voffB); PG8_STAGE(PG8_SA(0, 0), cA, voffA); PG8_STAGE(PG8_SA(0, 1), cA + hstepA, voffA);
    if (wr == 1) PG8_BAR;
    PG8_WAIT_V(2); PG8_BAR;
    PG8_STAGE(PG8_SB(1, 0), cB + kstep, voffB); PG8_STAGE(PG8_SA(1, 0), cA + kstep, voffA); PG8_STAGE(PG8_SB(1, 1), cB + hstepB + kstep, voffB);
    PG8_WAIT_V(6); PG8_BAR;
    for (;;) {
        const bool has_next = S.next(ui + 1, nxt);
        const char* nA = has_next ? (const char*)g.A + (size_t)nxt.pm * tstepA : cA; const char* nB = has_next ? (const char*)g.Bt + (size_t)nxt.pn * tstepB : cB;
#pragma nounroll
        for (int t = 0; t < nt; t += 2) {
            const bool last = (t == nt - 2);
            const char* a1 = cA + (size_t)(t + 1) * kstep;
            const char* a2 = last ? nA : cA + (size_t)(t + 2) * kstep; const char* b2 = last ? nB : cB + (size_t)(t + 2) * kstep;
            const char* a3 = a2 + kstep; const char* b3 = b2 + kstep;
            PG8_LDB(B0, 0, 0); PG8_LDB(B1, 0, 1); PG8_SCHED; PG8_LDA(At, 0, 0); PG8_STAGE(PG8_SA(1, 1), a1 + hstepA, voffA);
            PG8_WAIT_V(8); PG8_WAIT_L(0); PG8_BAR; PG8_MMA(0, 0, At, B0); PG8_MMA(0, 1, At, B1); PG8_BAR; PG8_SCHED;
            PG8_LDA(At, 0, 1); PG8_STAGE(PG8_SB(0, 0), b2, voffB); PG8_STAGE(PG8_SB(0, 1), b2 + hstepB, voffB); PG8_STAGE(PG8_SA(0, 0), a2, voffA);
            PG8_WAIT_V(8); PG8_WAIT_L(0); PG8_BAR; PG8_MMA(1, 0, At, B0); PG8_MMA(1, 1, At, B1); PG8_BAR; PG8_SCHED;
            PG8_LDB(B0, 1, 0); PG8_LDB(B1, 1, 1); PG8_SCHED; PG8_LDA(At, 1, 0); PG8_STAGE(PG8_SA(0, 1), a2 + hstepA, voffA);
            PG8_WAIT_V(8); PG8_WAIT_L(0); PG8_BAR; PG8_MMA(0, 0, At, B0); PG8_MMA(0, 1, At, B1); PG8_BAR; PG8_SCHED;
            PG8_LDA(At, 1, 1); PG8_STAGE(PG8_SB(1, 0), b3, voffB); PG8_STAGE(PG8_SB(1, 1), b3 + hstepB, voffB); PG8_STAGE(PG8_SA(1, 0), a3, voffA);
            PG8_WAIT_V(8); PG8_WAIT_L(0); PG8_BAR; PG8_MMA(1, 0, At, B0); PG8_MMA(1, 1, At, B1); PG8_BAR; PG8_SCHED;
        }
        if (wr == 0) PG8_BAR;
        E(acc, cur, wr, wc, fr, fq);
        if (!has_next) break;
#pragma unroll
        for (int a = 0; a < 2; ++a)
#pragma unroll
            for (int b = 0; b < 2; ++b)
#pragma unroll
                for (int m = 0; m < 4; ++m)
#pragma unroll
                    for (int n = 0; n < 2; ++n) acc[a][b][m][n] = (f32x4){0.f, 0.f, 0.f, 0.f};
        cur = nxt; cA = nA; cB = nB; ++ui;
        if (wr == 1) PG8_BAR;
    }
    PG8_WAIT_V(0);
    PG8_BAR;
#undef PG8_SA
#undef PG8_SB
#undef PG8_STAGE
#undef PG8_LDA
#undef PG8_LDB
#undef PG8_MMA
#undef PG8_WAIT_V
#undef PG8_WAIT_L
#undef PG8_BAR
#undef PG8_SCHED
}
typedef f32x4 Acc[2][2][4][2];

struct EpiH {
    bf16_t* H; bf16_t* KB; float* KMP; float* STQ; float* STKV; const float* rope; unsigned* dep;
    DI void operator()(const Acc& acc, const Unit& u, int wr, int wc, int fr, int fq) const {
        const int row0 = u.pm * BM + wr * 64 + fr;
        {
            const int pn = u.pn; bf16_t* base; int hw = 0, cseg;
            if (pn < 6) { base = H + (pn < 2 ? HM_AQ : pn < 4 ? HM_AK : HM_AV); hw = 64; cseg = (pn & 1) * 256; }
            else if (pn < 10) { base = H + (pn < 8 ? C_AZ : C_BZ); cseg = (pn & 1) * 256; }
            else if (pn < 16) { base = H + (pn < 12 ? HM_CQ : pn < 14 ? HM_CK : HM_CV); hw = 128; cseg = (pn & 1) * 256; }
            else if (pn < 18) { base = H + C_CZ; cseg = (pn & 1) * 256; }
            else { base = H + C_CKV; cseg = (pn - 18) * 256; }
            const int bl = u.pm >> 3, s0 = (u.pm & 7) * 256 + wr * 64 + fr;
#pragma unroll
            for (int bj = 0; bj < 2; ++bj) { const int cs = cseg + bj * HALF + wc * 32 + 8 * fq;
                bf16_t* colp; size_t pitch;
                if (hw == 64) { colp = base + ((size_t)(bl * 8 + (cs >> 6)) * SEQ) * 64 + (cs & 63); pitch = 64; }
                else if (hw == 128) { colp = base + ((size_t)(bl * 4 + (cs >> 7)) * SEQ) * 128 + (cs & 127); pitch = 128; }
                else { colp = base + (size_t)bl * SEQ * HP + cs; pitch = HP; }
#pragma unroll
                for (int ai = 0; ai < 2; ++ai)
#pragma unroll
                    for (int m = 0; m < 4; ++m) *(u32x4*)(colp + (size_t)(s0 + ai * HALF + m * 16) * pitch) = pack8(acc[ai][bj][m][0], acc[ai][bj][m][1]); }
        }
        if (u.pn == 2 || u.pn == 3) {
            float* dst = KMP + (size_t)(u.pm * 2 + wr) * 512 + (u.pn - 2) * 256 + wc * 32 + 8 * fq;
#pragma unroll
            for (int bj = 0; bj < 2; ++bj)
#pragma unroll
                for (int n = 0; n < 2; ++n) { f32x4 s = (f32x4){0.f, 0.f, 0.f, 0.f};
#pragma unroll
                    for (int ai = 0; ai < 2; ++ai)
#pragma unroll
                        for (int m = 0; m < 4; ++m) s += acc[ai][bj][m][n];
#pragma unroll
                    for (int e = 0; e < 4; ++e) { float v = s[e]; v += __shfl_xor(v, 1); v += __shfl_xor(v, 2); v += __shfl_xor(v, 4); v += __shfl_xor(v, 8); s[e] = v; }
                    if (fr == 0) *(f32x4*)(dst + bj * HALF + 4 * n) = s; }
        }
        if (u.pn >= 18) {
#pragma unroll
            for (int ai = 0; ai < 2; ++ai)
#pragma unroll
                for (int m = 0; m < 4; ++m) { const int row = row0 + ai * HALF + m * 16; float ss = 0.f;
#pragma unroll
                    for (int bj = 0; bj < 2; ++bj) { if (u.pn == 20 && bj == 1) continue;
#pragma unroll
                        for (int n = 0; n < 2; ++n) { const f32x4 x = acc[ai][bj][m][n]; ss += (x[0] * x[0] + x[1] * x[1]) + (x[2] * x[2] + x[3] * x[3]); } }
                    ss += __shfl_xor(ss, 16); ss += __shfl_xor(ss, 32);
                    if (fq == 0) { if (u.pn == 18) STKV[(size_t)row * 4 + wc] = ss; else STQ[(size_t)row * 8 + (u.pn - 19) * 4 + wc] = ss; }
                    if (u.pn == 20 && wc == 0) {
                        const int pos = row & (SEQ - 1); f32x4 o[2];
#pragma unroll
                        for (int n = 0; n < 2; ++n) { const f32x4 cs = *(const f32x4*)(rope + ((size_t)pos * 16 + 4 * fq + 2 * n) * 2); const f32x4 t = acc[ai][1][m][n];
                            o[n] = (f32x4){t[0] * cs[0] - t[1] * cs[1], t[0] * cs[1] + t[1] * cs[0], t[2] * cs[2] - t[3] * cs[3], t[2] * cs[3] + t[3] * cs[2]}; }
                        const u32x4 w = pack8(o[0], o[1]);
#pragma unroll
                        for (int h = 0; h < 8; ++h) *(u32x4*)(KB + ((size_t)((row >> 11) * 8 + h) * SEQ + pos) * 96 + 64 + 8 * fq) = w;
                    }
                }
        }
        if (u.pn >= 18) {
            asm volatile("s_waitcnt vmcnt(0)" ::: "memory");
            __syncthreads();
            if (threadIdx.x == 0) {
                __builtin_amdgcn_fence(__ATOMIC_RELEASE, "agent");
                asm volatile("s_waitcnt vmcnt(0)" ::: "memory");
                __hip_atomic_fetch_add(dep + u.pm, 8u, __ATOMIC_RELAXED, __HIP_MEMORY_SCOPE_AGENT);
            }
        }
    }
};
template <int MODE> struct EpiUp {
    bf16_t* QB; bf16_t* KB; bf16_t* VB; const float* ST; const float* rope;
    DI void operator()(const Acc& acc, const Unit& u, int wr, int wc, int fr, int fq) const {
        const int row0 = u.pm * BM + wr * 64 + fr;
#pragma unroll
        for (int ai = 0; ai < 2; ++ai)
#pragma unroll
            for (int m = 0; m < 4; ++m) { const int row = row0 + ai * HALF + m * 16; float sc;
                if (MODE == 0) { const f32x4 a = *(const f32x4*)(ST + (size_t)row * 8), b = *(const f32x4*)(ST + (size_t)row * 8 + 4);
                    sc = __builtin_amdgcn_rsqf(((a[0] + a[1]) + (a[2] + a[3]) + (b[0] + b[1]) + (b[2] + b[3])) * (1.f / 384.f) + 1e-6f) * QS96; }
                else { const f32x4 a = *(const f32x4*)(ST + (size_t)row * 4); sc = __builtin_amdgcn_rsqf(((a[0] + a[1]) + (a[2] + a[3])) * (1.f / 256.f) + 1e-6f); }
                const int pos = row & (SEQ - 1);
#pragma unroll
                for (int bj = 0; bj < 2; ++bj) { const int c0 = u.pn * BM + bj * HALF + wc * 32 + 8 * fq;
                    f32x4 v0 = acc[ai][bj][m][0] * sc, v1 = acc[ai][bj][m][1] * sc;
                    if (MODE == 0) { const int j = c0 % 96;
                        if (j >= 64) { const int i0 = (j - 64) >> 1; const f32x4 ca = *(const f32x4*)(rope + ((size_t)pos * 16 + i0) * 2), cb = *(const f32x4*)(rope + ((size_t)pos * 16 + i0 + 2) * 2);
                            v0 = (f32x4){v0[0] * ca[0] - v0[1] * ca[1], v0[0] * ca[1] + v0[1] * ca[0], v0[2] * ca[2] - v0[3] * ca[3], v0[2] * ca[3] + v0[3] * ca[2]};
                            v1 = (f32x4){v1[0] * cb[0] - v1[1] * cb[1], v1[0] * cb[1] + v1[1] * cb[0], v1[2] * cb[2] - v1[3] * cb[3], v1[2] * cb[3] + v1[3] * cb[2]}; }
                        *(u32x4*)(QB + ((size_t)((row >> 11) * 8 + c0 / 96) * SEQ + pos) * 96 + j) = pack8(v0, v1); }
                    else { if (c0 < 512) *(u32x4*)(KB + ((size_t)((row >> 11) * 8 + (c0 >> 6)) * SEQ + pos) * 96 + (c0 & 63)) = pack8(v0, v1);
                           else *(u32x4*)(VB + ((size_t)((row >> 11) * 8 + ((c0 - 512) >> 6)) * SEQ + pos) * 64 + (c0 & 63)) = pack8(v0, v1); }
                }
            }
    }
};
struct EpiG {
    bf16_t* G; const float* bias;
    DI void operator()(const Acc& acc, const Unit& u, int wr, int wc, int fr, int fq) const {
        const int row0 = u.pm * BM + wr * 64 + fr, col0 = u.pn * BM + wc * 32 + 8 * fq;
        f32x4 bv[2][2];
#pragma unroll
        for (int bj = 0; bj < 2; ++bj)
#pragma unroll
            for (int n = 0; n < 2; ++n) bv[bj][n] = *(const f32x4*)(bias + col0 + bj * HALF + 4 * n);
#pragma unroll
        for (int ai = 0; ai < 2; ++ai)
#pragma unroll
            for (int m = 0; m < 4; ++m) { bf16_t* rowp = G + (size_t)(row0 + ai * HALF + m * 16) * 3072 + col0;
#pragma unroll
                for (int bj = 0; bj < 2; ++bj) { f32x4 v0 = acc[ai][bj][m][0] + bv[bj][0], v1 = acc[ai][bj][m][1] + bv[bj][1];
#pragma unroll
                    for (int e = 0; e < 4; ++e) { v0[e] = sigm(v0[e]); v1[e] = sigm(v1[e]); }
                    *(u32x4*)(rowp + bj * HALF) = pack8(v0, v1); } }
    }
};
struct EpiMerge {
    const bf16_t* G; bf16_t* MG;
    DI void operator()(const Acc& acc, const Unit& u, int wr, int wc, int fr, int fq) const {
        const int br = u.pn >> 2, pm = u.pm - 64 * br, pn = u.pn & 3;
        const int row0 = pm * BM + wr * 64 + fr, col0 = pn * BM + wc * 32 + 8 * fq;
#pragma unroll
        for (int ai = 0; ai < 2; ++ai)
#pragma unroll
            for (int m = 0; m < 4; ++m) { const size_t row = (size_t)(row0 + ai * HALF + m * 16);
#pragma unroll
                for (int bj = 0; bj < 2; ++bj) { f32x4 g0, g1; unpack8(*(const u32x4*)(G + row * 3072 + br * 1024 + col0 + bj * HALF), g0, g1);
                    f32x4 v0 = acc[ai][bj][m][0] * g0, v1 = acc[ai][bj][m][1] * g1;
                    bf16_t* dst = MG + row * 1024 + col0 + bj * HALF;
                    if (br > 0) { f32x4 p0, p1; unpack8(*(const u32x4*)dst, p0, p1); v0 += p0; v1 += p1; }
                    *(u32x4*)dst = pack8(v0, v1); } }
    }
};
struct EpiR {
    const float* X; float* R; bf16_t* RB;
    DI void operator()(const Acc& acc, const Unit& u, int wr, int wc, int fr, int fq) const {
        const int row0 = u.pm * BM + wr * 64 + fr, col0 = u.pn * BM + wc * 32 + 8 * fq;
#pragma unroll
        for (int ai = 0; ai < 2; ++ai)
#pragma unroll
            for (int m = 0; m < 4; ++m) { const size_t off = (size_t)(row0 + ai * HALF + m * 16) * 1024 + col0;
#pragma unroll
                for (int bj = 0; bj < 2; ++bj) { const f32x4 x0 = *(const f32x4*)(X + off + bj * HALF), x1 = *(const f32x4*)(X + off + bj * HALF + 4);
                    const f32x4 v0 = x0 * ALPHA + acc[ai][bj][m][0], v1 = x1 * ALPHA + acc[ai][bj][m][1];
                    *(f32x4*)(R + off + bj * HALF) = v0; *(f32x4*)(R + off + bj * HALF + 4) = v1;
                    *(u32x4*)(RB + off + bj * HALF) = pack8(v0, v1); } }
    }
};
struct EpiBf {
    bf16_t* O;
    DI void operator()(const Acc& acc, const Unit& u, int wr, int wc, int fr, int fq) const {
        const int row0 = u.pm * BM + wr * 64 + fr, col0 = u.pn * BM + wc * 32 + 8 * fq;
#pragma unroll
        for (int ai = 0; ai < 2; ++ai)
#pragma unroll
            for (int m = 0; m < 4; ++m) { bf16_t* rowp = O + (size_t)(row0 + ai * HALF + m * 16) * 1024 + col0;
#pragma unroll
                for (int bj = 0; bj < 2; ++bj) *(u32x4*)(rowp + bj * HALF) = pack8(acc[ai][bj][m][0], acc[ai][bj][m][1]); }
    }
};
struct EpiR2 {
    float* R; const bf16_t* PP;
    DI void operator()(const Acc& acc, const Unit& u, int wr, int wc, int fr, int fq) const {
        const int row0 = u.pm * BM + wr * 64 + fr, col0 = u.pn * BM + wc * 32 + 8 * fq;
#pragma unroll
        for (int ai = 0; ai < 2; ++ai)
#pragma unroll
            for (int m = 0; m < 4; ++m) { const size_t off = (size_t)(row0 + ai * HALF + m * 16) * 1024 + col0;
#pragma unroll
                for (int bj = 0; bj < 2; ++bj) { f32x4 p0, p1; unpack8(*(const u32x4*)(PP + off + bj * HALF), p0, p1);
                    f32x4 r0 = *(const f32x4*)(R + off + bj * HALF), r1 = *(const f32x4*)(R + off + bj * HALF + 4);
                    const f32x4 a0 = acc[ai][bj][m][0], a1 = acc[ai][bj][m][1];
#pragma unroll
                    for (int e = 0; e < 4; ++e) { r0[e] += sigm(a0[e]) * p0[e]; r1[e] += sigm(a1[e]) * p1[e]; }
                    *(f32x4*)(R + off + bj * HALF) = r0; *(f32x4*)(R + off + bj * HALF + 4) = r1; } }
    }
};
}

DI int crow(int r, int hi) { return (r & 3) + 8 * (r >> 2) + 4 * hi; }
DI s16x4 vtr(LAS const char* p) { typedef short v4i16_t __attribute__((ext_vector_type(4))); return __builtin_bit_cast(s16x4, __builtin_amdgcn_ds_read_tr16_b64_v4i16((LAS v4i16_t*)p)); }
constexpr int AT_SCR = 112 * 1024, AT_KM = 113 * 1024;
constexpr float NEGBIG = -1e30f;
DI float max3f(float a, float b, float c) { return fmaxf(fmaxf(a, b), c); }

template <int DQK, int KW, int DV, int NROWS, bool ALIBI, bool MOBA, bool PIPE, int NSET>
DI void attn_unit(LAS char* lds, const bf16_t* Qp, int ldq, const bf16_t* Kp, int ldk, const bf16_t* Vp, int ldv,
                  const bf16_t* Zp, int ldz, bf16_t* Yp, int ldy, int q0, float sl2, const float* kmp, float lam, const float* subg, float post) {
    constexpr int NTD = NROWS / 64, NS = DQK / 16, ND = DV / 32, PVG = (DV == 64) ? 2 : 1;
    constexpr int KPITCH = KW * 2 + 16, VPITCH = DV * 2 + 64;
    constexpr int KOFF0 = 0, VOFF0 = 3 * 64 * KPITCH;
    constexpr int KCH = KW / 8, VCH = DV / 8, NKC = 64 * KCH, NVC = 64 * VCH, KPT = (NKC + 511) / 512, VPT = (NVC + 511) / 512;
    static_assert(VOFF0 + 3 * 64 * VPITCH <= AT_SCR, "attention LDS map");
    const int tid = opaque_tid(), lane = tid & 63, r32 = lane & 31, hi = lane >> 5;
    const int wid = __builtin_amdgcn_readfirstlane(tid >> 6);
    const int ro = (NROWS == 256) ? 32 * wid : 32 * (wid & 3);
    const int map = (NROWS == 256) ? 0 : (wid >> 2);
    const int qpos = q0 + ro + r32;
    LAS float* scr = (LAS float*)(lds + AT_SCR) + wid * 32;

    bf16x8 qf[NS];
    { const bf16_t* qrow = Qp + (size_t)qpos * ldq + 64 * map + 8 * hi;
#pragma unroll
      for (int s = 0; s < NS; ++s) qf[s] = *(const bf16x8*)(qrow + 16 * s); }

    unsigned sel = 0xFFu;
    if (MOBA) {
        const int u = q0 >> 8;
        if (u > 3) {
            LAS float* km = (LAS float*)(lds + AT_KM);
            { const int j = tid >> 6, d = tid & 63; if (j < u) km[j * 64 + d] = (kmp[(size_t)(j * 2) * 512 + d] + kmp[(size_t)(j * 2 + 1) * 512 + d]) * (1.f / 256.f); }
            __syncthreads();
            float g[7];
#pragma unroll
            for (int j = 0; j < 7; ++j) { float a = 0.f;
                if (j < u) {
#pragma unroll
                    for (int s = 0; s < 4; ++s) { const f32x4 k0 = *(const LAS f32x4*)(km + j * 64 + 16 * s + 8 * hi), k1 = *(const LAS f32x4*)(km + j * 64 + 16 * s + 8 * hi + 4);
#pragma unroll
                        for (int e = 0; e < 4; ++e) { a += bf2f((bf16_t)qf[s][e]) * k0[e]; a += bf2f((bf16_t)qf[s][4 + e]) * k1[e]; } }
                }
                a += __shfl_xor(a, 32); g[j] = a; }
            sel = 0u;
#pragma unroll
            for (int k = 0; k < 3; ++k) { float best = -INFINITY; int bi = 0;
#pragma unroll
                for (int j = 0; j < 7; ++j) { const bool ok = (j < u) && !((sel >> j) & 1u) && (g[j] > best); best = ok ? g[j] : best; bi = ok ? j : bi; }
                sel |= 1u << bi; }
        }
    }

    f32x16 o[ND];
#pragma unroll
    for (int d0 = 0; d0 < ND; ++d0)
#pragma unroll
        for (int r = 0; r < 16; ++r) o[d0][r] = 0.f;
    f32x16 bias;
#pragma unroll
    for (int r = 0; r < 16; ++r) bias[r] = ALIBI ? sl2 * (float)((r & 3) + 8 * (r >> 2) + 4 * hi) : 0.f;
    const float d32 = ALIBI ? 32.f * sl2 : 0.f;
    float mrun = NEGBIG, lrun = 0.f;
    const int nt = NTD + (q0 >> 6);
    u32x4 kregA[KPT], vregA[VPT], kregB[KPT], vregB[VPT], kregC[KPT], vregC[VPT], kregD[KPT], vregD[VPT];
#define AT_TB(it) ((it) < NTD ? q0 + 64 * (it) : 64 * ((it) - NTD))
#define AT_LOAD(it, kreg, vreg) do { const int _ti = ((it) < nt) ? (it) : nt - 1; const int _kb = AT_TB(_ti); \
        _Pragma("unroll") for (int _i = 0; _i < KPT; ++_i) { const int _c = tid + 512 * _i; if (NKC % 512 == 0 || _i + 1 < KPT || _c < NKC) { const int _r = _c / KCH, _cc = _c % KCH; kreg[_i] = *(const u32x4*)(Kp + (size_t)(_kb + _r) * ldk + 8 * _cc); } } \
        _Pragma("unroll") for (int _i = 0; _i < VPT; ++_i) { const int _c = tid + 512 * _i; if (NVC % 512 == 0 || _i + 1 < VPT || _c < NVC) { const int _r = _c / VCH, _cc = _c % VCH; vreg[_i] = *(const u32x4*)(Vp + (size_t)(_kb + _r) * ldv + 8 * _cc); } } } while (0)
#define AT_STORE(buf, kreg, vreg) do { \
        _Pragma("unroll") for (int _i = 0; _i < KPT; ++_i) { const int _c = tid + 512 * _i; if (NKC % 512 == 0 || _i + 1 < KPT || _c < NKC) { const int _r = _c / KCH, _cc = _c % KCH; *(LAS u32x4*)(lds + KOFF0 + (buf) * 64 * KPITCH + _r * KPITCH + 16 * _cc) = kreg[_i]; } } \
        _Pragma("unroll") for (int _i = 0; _i < VPT; ++_i) { const int _c = tid + 512 * _i; if (NVC % 512 == 0 || _i + 1 < VPT || _c < NVC) { const int _r = _c / VCH, _cc = _c % VCH; *(LAS u32x4*)(lds + VOFF0 + (buf) * 64 * VPITCH + _r * VPITCH + 16 * _cc) = vreg[_i]; } } } while (0)
#define AT_ACTIVE(it) ((it) >= NTD || 64 * (it) <= ro + 31)
#define AT_QK(it, bufi, P0, P1) do { if (AT_ACTIVE(it)) { \
        LAS const char* _Kb = lds + KOFF0 + (bufi) * 64 * KPITCH + r32 * KPITCH + (64 * map + 8 * hi) * 2; \
        _Pragma("unroll") for (int _h = 0; _h < NS; _h += 4) { \
            bf16x8 _kf[8]; \
            _Pragma("unroll") for (int _s = 0; _s < 4; ++_s) if (_h + _s < NS) { _kf[2 * _s] = *(const LAS bf16x8*)(_Kb + 32 * (_h + _s)); _kf[2 * _s + 1] = *(const LAS bf16x8*)(_Kb + 32 * KPITCH + 32 * (_h + _s)); } \
            __builtin_amdgcn_sched_barrier(0); \
            _Pragma("unroll") for (int _s = 0; _s < 4; ++_s) if (_h + _s < NS) { \
                if (_h + _s == 0) { P0 = __builtin_amdgcn_mfma_f32_32x32x16_bf16(_kf[0], qf[0], bias, 0, 0, 0); P1 = __builtin_amdgcn_mfma_f32_32x32x16_bf16(_kf[1], qf[0], bias, 0, 0, 0); } \
                else { P0 = __builtin_amdgcn_mfma_f32_32x32x16_bf16(_kf[2 * _s], qf[_h + _s], P0, 0, 0, 0); P1 = __builtin_amdgcn_mfma_f32_32x32x16_bf16(_kf[2 * _s + 1], qf[_h + _s], P1, 0, 0, 0); } } \
            __builtin_amdgcn_sched_barrier(0); } } } while (0)
    if (NSET == 4) { AT_LOAD(0, kregA, vregA); AT_LOAD(1, kregB, vregB); AT_LOAD(2, kregC, vregC); AT_LOAD(3, kregD, vregD); AT_STORE(0, kregA, vregA); AT_STORE(1, kregB, vregB);
                     AT_LOAD(4, kregA, vregA); AT_LOAD(5, kregB, vregB); }
    else if (NSET == 2) { AT_LOAD(0, kregA, vregA); AT_LOAD(1, kregB, vregB); AT_STORE(0, kregA, vregA); AT_STORE(1, kregB, vregB); AT_LOAD(2, kregA, vregA); AT_LOAD(3, kregB, vregB); }
    else { AT_LOAD(0, kregA, vregA); AT_STORE(0, kregA, vregA); AT_LOAD(1, kregA, vregA); AT_STORE(1, kregA, vregA); AT_LOAD(2, kregA, vregA); }
    __syncthreads();
    const int i16 = lane & 15;
    const int vlane = (4 * hi + (i16 >> 2)) * VPITCH + (16 * ((lane >> 4) & 1) + 4 * (i16 & 3)) * 2;
    f32x16 pa0, pa1, pb0, pb1;
#pragma unroll
    for (int r = 0; r < 16; ++r) { pa0[r] = 0.f; pa1[r] = 0.f; pb0[r] = 0.f; pb1[r] = 0.f; }
    if (PIPE) AT_QK(0, 0, pa0, pa1);
    int bcur = 0;
#define AT_ITER(it, C0, C1, N0, N1, kreg, vreg) do { \
        const int _b1 = (bcur == 2) ? 0 : bcur + 1, _b2 = (_b1 == 2) ? 0 : _b1 + 1; \
        AT_STORE(_b2, kreg, vreg); \
        AT_LOAD((it) + 2 + NSET, kreg, vreg); \
        if (PIPE) { if ((it) + 1 < nt) AT_QK((it) + 1, _b1, N0, N1); } else AT_QK(it, bcur, C0, C1); \
        if (AT_ACTIVE(it)) { \
            LAS const char* _Vb = lds + VOFF0 + bcur * 64 * VPITCH + vlane; \
            bf16x8 _vf[4 * PVG];                      \
            _Pragma("unroll") for (int _e = 0; _e < PVG; ++_e) _Pragma("unroll") for (int _ks = 0; _ks < 4; ++_ks) { \
                const s16x4 _lo = vtr(_Vb + (16 * _ks) * VPITCH + 64 * _e), _hh = vtr(_Vb + (16 * _ks + 8) * VPITCH + 64 * _e); \
                _vf[4 * _e + _ks] = __builtin_shufflevector(_lo, _hh, 0, 1, 2, 3, 4, 5, 6, 7); } \
            __builtin_amdgcn_sched_barrier(0); \
            const int _kb = AT_TB(it); const bool _diag = (it) < NTD; \
            if (_diag) { const int _kq = _kb + 4 * hi - qpos; \
                _Pragma("unroll") for (int _r = 0; _r < 16; ++_r) { const int _dd = _kq + (_r & 3) + 8 * (_r >> 2); if (_dd > 0) C0[_r] = NEGBIG; if (_dd + 32 > 0) C1[_r] = NEGBIG; } } \
            float _m0 = max3f(C0[0], C0[1], C0[2]), _m1 = max3f(C1[0], C1[1], C1[2]); \
            _Pragma("unroll") for (int _r = 3; _r < 15; _r += 2) { _m0 = max3f(_m0, C0[_r], C0[_r + 1]); _m1 = max3f(_m1, C1[_r], C1[_r + 1]); } \
            _m0 = fmaxf(_m0, C0[15]); _m1 = fmaxf(_m1, C1[15]); \
            const float _c0 = ALIBI ? sl2 * (float)(_kb - qpos) : 0.f; \
            float _mx = fmaxf(_m0, _m1 + d32) + _c0; \
            bool _selok = true; if (MOBA && !_diag) _selok = ((sel >> (_kb >> 8)) & 1u) != 0u; \
            if (!_selok) _mx = NEGBIG; \
            { const auto _rr = __builtin_amdgcn_permlane32_swap(__float_as_uint(_mx), __float_as_uint(_mx), false, false); _mx = fmaxf(__uint_as_float(_rr[0]), __uint_as_float(_rr[1])); }     \
            const float _mn = fmaxf(mrun, _mx); \
            if (__any(_mn - mrun > 8.f)) { \
                const float _alpha = __builtin_amdgcn_exp2f(mrun - _mn); lrun *= _alpha; mrun = _mn; \
                scr[r32] = _alpha; \
                asm volatile("s_waitcnt lgkmcnt(0)" ::: "memory"); \
                f32x4 _a4[4]; \
                _Pragma("unroll") for (int _g = 0; _g < 4; ++_g) _a4[_g] = *(const LAS f32x4*)(scr + 8 * _g + 4 * hi); \
                asm volatile("s_waitcnt lgkmcnt(0)" ::: "memory"); \
                _Pragma("unroll") for (int _d0 = 0; _d0 < ND; ++_d0) _Pragma("unroll") for (int _r = 0; _r < 16; ++_r) o[_d0][_r] *= _a4[_r >> 2][_r & 3]; \
            } \
            const float _ms0 = _selok ? (mrun - _c0) : INFINITY, _ms1 = _ms0 - d32; \
            float _ls = 0.f; \
            _Pragma("unroll") for (int _r = 0; _r < 16; ++_r) { C0[_r] = __builtin_amdgcn_exp2f(C0[_r] - _ms0); C1[_r] = __builtin_amdgcn_exp2f(C1[_r] - _ms1); _ls += C0[_r] + C1[_r]; } \
            lrun += _ls; \
            bf16x8 _pa[4]; \
            _Pragma("unroll") for (int _ks = 0; _ks < 2; ++_ks) { u32x4 _w; \
                _w.x = pk2(C0[8 * _ks], C0[8 * _ks + 1]); _w.y = pk2(C0[8 * _ks + 2], C0[8 * _ks + 3]); _w.z = pk2(C0[8 * _ks + 4], C0[8 * _ks + 5]); _w.w = pk2(C0[8 * _ks + 6], C0[8 * _ks + 7]); \
                _pa[_ks] = __builtin_bit_cast(bf16x8, _w); \
                _w.x = pk2(C1[8 * _ks], C1[8 * _ks + 1]); _w.y = pk2(C1[8 * _ks + 2], C1[8 * _ks + 3]); _w.z = pk2(C1[8 * _ks + 4], C1[8 * _ks + 5]); _w.w = pk2(C1[8 * _ks + 6], C1[8 * _ks + 7]); \
                _pa[2 + _ks] = __builtin_bit_cast(bf16x8, _w); } \
            _Pragma("unroll") for (int _d0 = 0; _d0 < ND; _d0 += PVG) { \
                if (_d0 > 0) { \
                    _Pragma("unroll") for (int _e = 0; _e < PVG; ++_e) _Pragma("unroll") for (int _ks = 0; _ks < 4; ++_ks) { \
                        const s16x4 _lo = vtr(_Vb + (16 * _ks) * VPITCH + 64 * (_d0 + _e)), _hh = vtr(_Vb + (16 * _ks + 8) * VPITCH + 64 * (_d0 + _e)); \
                        _vf[4 * _e + _ks] = __builtin_shufflevector(_lo, _hh, 0, 1, 2, 3, 4, 5, 6, 7); } \
                    __builtin_amdgcn_sched_barrier(0); } \
                _Pragma("unroll") for (int _ks = 0; _ks < 4; ++_ks) _Pragma("unroll") for (int _e = 0; _e < PVG; ++_e) \
                    o[_d0 + _e] = __builtin_amdgcn_mfma_f32_32x32x16_bf16(_pa[_ks], _vf[4 * _e + _ks], o[_d0 + _e], 0, 0, 0); \
                __builtin_amdgcn_sched_barrier(0); } \
        } \
        bcur = _b1; \
        asm volatile("s_waitcnt lgkmcnt(0)\n\ts_barrier" ::: "memory"); } while (0)
    if (NSET == 4) {
        for (int it = 0; it < nt; it += 4) {
            AT_ITER(it, pa0, pa1, pb0, pb1, kregC, vregC);
            AT_ITER(it + 1, pb0, pb1, pa0, pa1, kregD, vregD);
            AT_ITER(it + 2, pa0, pa1, pb0, pb1, kregA, vregA);
            AT_ITER(it + 3, pb0, pb1, pa0, pa1, kregB, vregB);
        }
    } else {
        for (int it = 0; it < nt; it += 2) {
            AT_ITER(it, pa0, pa1, pb0, pb1, kregA, vregA);
            if (NSET == 2) AT_ITER(it + 1, pb0, pb1, pa0, pa1, kregB, vregB); else AT_ITER(it + 1, pb0, pb1, pa0, pa1, kregA, vregA);
        }
    }
#undef AT_TB
#undef AT_LOAD
#undef AT_STORE
#undef AT_ACTIVE
#undef AT_QK
#undef AT_ITER
    {
        const float lt = lrun + __shfl_xor(lrun, 32);
        scr[r32] = 1.f / lt;
        asm volatile("s_waitcnt lgkmcnt(0)" ::: "memory");
        f32x4 a4[4];
#pragma unroll
        for (int g = 0; g < 4; ++g) a4[g] = *(const LAS f32x4*)(scr + 8 * g + 4 * hi);
        asm volatile("s_waitcnt lgkmcnt(0)" ::: "memory");
#pragma unroll
        for (int d0 = 0; d0 < ND; ++d0)
#pragma unroll
            for (int r = 0; r < 16; ++r) o[d0][r] *= a4[r >> 2][r & 3];
    }
    if (NROWS == 256) {
#pragma unroll
        for (int d0 = 0; d0 < ND; ++d0)
#pragma unroll
            for (int r = 0; r < 16; ++r) { const size_t row = (size_t)(q0 + ro + crow(r, hi)); const int col = 32 * d0 + r32;
                const float z = bf2f(Zp[row * ldz + col]); Yp[row * ldy + col] = f2bf(o[d0][r] * silu(z)); }
    } else {
        LAS float* xch = (LAS float*)lds;
        if (map == 1) {
#pragma unroll
            for (int d0 = 0; d0 < ND; ++d0)
#pragma unroll
                for (int r = 0; r < 16; ++r) xch[(((wid & 3) * ND + d0) * 16 + r) * 64 + lane] = o[d0][r];
        }
        __syncthreads();
        if (map == 0) {
#pragma unroll
            for (int d0 = 0; d0 < ND; ++d0)
#pragma unroll
                for (int r = 0; r < 16; ++r) o[d0][r] -= lam * xch[(((wid & 3) * ND + d0) * 16 + r) * 64 + lane];
#pragma unroll
            for (int r = 0; r < 16; ++r) { float ss = 0.f;
#pragma unroll
                for (int d0 = 0; d0 < ND; ++d0) ss += o[d0][r] * o[d0][r];
                ss += __shfl_xor(ss, 1); ss += __shfl_xor(ss, 2); ss += __shfl_xor(ss, 4); ss += __shfl_xor(ss, 8); ss += __shfl_xor(ss, 16);
                const float rs = __builtin_amdgcn_rsqf(ss * (1.f / (float)DV) + 1e-5f) * post;
                const size_t row = (size_t)(q0 + ro + crow(r, hi));
#pragma unroll
                for (int d0 = 0; d0 < ND; ++d0) { const int col = 32 * d0 + r32; const float z = bf2f(Zp[row * ldz + col]);
                    Yp[row * ldy + col] = f2bf(o[d0][r] * rs * subg[col] * silu(z)); } }
        }
        __syncthreads();
    }
}

#define XB_TMO      128
#define XB_XCNT(j)  (256  + 64 * (j))
#define XB_XSUB(j)  (1280 + 64 * (j))
#define XB_XGEN(j)  (2304 + 64 * (j))
#define XB_TOP      3328
#define XB_TOPGEN   3392
#define XCD_BAR_WORDS 3456
#define XB_SPIN_CAP (1u << 22)
DI unsigned xb_ld(unsigned* p)              { return __hip_atomic_load(p, __ATOMIC_RELAXED, __HIP_MEMORY_SCOPE_AGENT); }
DI unsigned xb_add(unsigned* p, unsigned v) { return __hip_atomic_fetch_add(p, v, __ATOMIC_RELAXED, __HIP_MEMORY_SCOPE_AGENT); }
DI unsigned xb_xcc_id() { return (unsigned)__builtin_amdgcn_s_getreg((3 << 11) | 20) & 0xFu; }
#define XB_SPIN(cond, bar) do { unsigned _sp = 0; while (cond) { __builtin_amdgcn_s_sleep(1); \
    if ((++_sp & 255u) == 0u) { if (xb_ld(&(bar)[XB_TMO])) break; if (_sp > XB_SPIN_CAP) { atomicAdd(&(bar)[XB_TMO], 1u); break; } } } } while (0)
DI void xcd_barrier_complete(unsigned* bar, unsigned x, unsigned& nloc, unsigned& nx) {
    const unsigned Gn = gridDim.x;
    unsigned sum, cnt, mine, sp = 0u;
    for (;;) {
        sum = 0u; cnt = 0u; mine = 0u;
#pragma unroll
        for (unsigned j = 0; j < 16; ++j) { const unsigned c = xb_ld(&bar[XB_XCNT(j)]); sum += c; cnt += (c > 0u) ? 1u : 0u; mine = (j == x) ? c : mine; }
        if (sum == Gn) break;
        __builtin_amdgcn_s_sleep(1);
        if ((++sp & 255u) == 0u) { if (xb_ld(&bar[XB_TMO])) break; if (sp > XB_SPIN_CAP) { atomicAdd(&bar[XB_TMO], 1u); break; } }
    }
    nloc = mine > 0u ? mine : 1u; nx = cnt > 0u ? cnt : 1u;
}
DI void xcd_barrier(unsigned* bar, volatile LAS unsigned* st) {
    asm volatile("s_waitcnt vmcnt(0)" ::: "memory");
    __syncthreads();
    if (threadIdx.x == 0) {
        __builtin_amdgcn_s_waitcnt(0);
        const unsigned x = xb_xcc_id();
        unsigned nloc = st[0], nx = st[1];
        if (nloc == 0u) { xcd_barrier_complete(bar, x, nloc, nx); st[0] = nloc; st[1] = nx; }
        const unsigned old = xb_add(&bar[XB_XSUB(x)], 1u);
        const unsigned gen = old / nloc;
        if (old + 1u == (gen + 1u) * nloc) {
            __builtin_amdgcn_fence(__ATOMIC_RELEASE, "agent");
            asm volatile("s_waitcnt vmcnt(0)" ::: "memory");
            const unsigned og = xb_add(&bar[XB_TOP], 1u);
            const unsigned tg = og / nx;
            if (og + 1u == (tg + 1u) * nx) xb_add(&bar[XB_TOPGEN], 1u);
            else XB_SPIN(xb_ld(&bar[XB_TOPGEN]) == tg, bar);
            __builtin_amdgcn_fence(__ATOMIC_ACQUIRE, "agent");
            xb_add(&bar[XB_XGEN(x)], 1u);
            asm volatile("s_waitcnt vmcnt(0)" ::: "memory");
        } else {
            XB_SPIN(xb_ld(&bar[XB_XGEN(x)]) == gen, bar);
            __builtin_amdgcn_fence(__ATOMIC_ACQUIRE, "agent");
            asm volatile("s_waitcnt vmcnt(0)" ::: "memory");
        }
    }
    __syncthreads();
}

struct Params { const float* in[19]; float* out; unsigned char* ws; };

DI void colmap(int kind, int n, int& col, float& cs) {
    cs = 1.f;
    if (kind == 0) {
        if (n < 2048) { col = n; if (n < 512) cs = QS64; }
        else if (n < 2560) col = 2720 + (n - 2048);
        else if (n < 3072) { col = 3232 + (n - 2560); cs = QS64; }
        else if (n < 3584) col = 3744 + (n - 3072);
        else if (n < 4096) col = 4256 + (n - 3584);
        else if (n < 4608) col = 4768 + (n - 4096);
        else if (n < 4864) col = 2432 + (n - 4608);
        else if (n < 5248) col = 2048 + (n - 4864);
        else if (n < 5280) { const int j = n - 5248; col = 2688 + (j >> 1) + 16 * (j & 1); }
        else col = -1;
    } else if (kind == 1) col = n;
    else if (kind == 2) { const int h = n / 96, j = n % 96; if (j < 64) col = h * 96 + j; else { const int jj = j - 64; col = h * 96 + 64 + (jj >> 1) + 16 * (jj & 1); } }
    else { if (n < 512) col = (n >> 6) * 128 + (n & 63); else { const int m = n - 512; col = (m >> 6) * 128 + 64 + (m & 63); } }
}
DI void tr_tile(const float* src, int srcN, int K, bf16_t* dst, int kind, int n0, int k0, const float* kscale, LAS float* scr, int tid) {
    { const int nl = tid & 127, kl0 = tid >> 7; int col; float cs; colmap(kind, n0 + nl, col, cs);
      float v[16];
#pragma unroll
      for (int i = 0; i < 16; ++i) { const int kl = kl0 + 4 * i; v[i] = (col >= 0) ? src[(size_t)(k0 + kl) * srcN + col] : 0.f; }
#pragma unroll
      for (int i = 0; i < 16; ++i) { const int kl = kl0 + 4 * i; float w = v[i] * cs; if (kscale) w *= kscale[k0 + kl]; scr[kl * 129 + nl] = w; } }
    __syncthreads();
    { const int kp = tid & 31;
#pragma unroll
      for (int i = 0; i < 8; ++i) { const int nl = (tid >> 5) + 16 * i;
          *(unsigned*)(dst + (size_t)(n0 + nl) * K + k0 + 2 * kp) = pk2(scr[(2 * kp) * 129 + nl], scr[(2 * kp + 1) * 129 + nl]); } }
    __syncthreads();
}
typedef const __attribute__((address_space(4))) Params* KParams0;
DI void convert_weights(KParams0 Pk, int l, bf16_t* WT, LAS float* scr) {
    const int tid = opaque_tid();
    constexpr int T0 = 42 * 16, T1 = T0 + 24 * 16, T2 = T1 + 6 * 6, T3 = T2 + 8 * 4, T4 = T3 + 8 * 8, T5 = T4 + 8 * 8, T6 = T5 + 8 * 8, T7 = T6 + 8 * 16, T8 = T7 + 8 * 16, T9 = T8 + 8 * 4;
    for (int t = blockIdx.x; t < T9; t += gridDim.x) {
        const float* src; int srcN, K, kind, loc; bf16_t* dst; const float* ks = nullptr;
        if (t < T0) { src = Pk->in[2] + (size_t)l * 1024 * 5280; srcN = 5280; K = 1024; kind = 0; loc = t; dst = WT + OFF_WIN; }
        else if (t < T1) { src = Pk->in[12] + (size_t)l * 1024 * 3072; srcN = 3072; K = 1024; kind = 1; loc = t - T0; dst = WT + OFF_WIN + (size_t)5376 * 1024; }
        else if (t < T2) { src = Pk->in[5] + (size_t)l * 384 * 768; srcN = 768; K = 384; kind = 2; loc = t - T1; dst = WT + OFF_WUQ; ks = Pk->in[3] + l * 384; }
        else if (t < T3) { src = Pk->in[6] + (size_t)l * 256 * 1024; srcN = 1024; K = 256; kind = 3; loc = t - T2; dst = WT + OFF_WUKV; ks = Pk->in[4] + l * 256; }
        else if (t < T4) { src = Pk->in[9] + (size_t)l * 512 * 1024; srcN = 1024; K = 512; kind = 1; loc = t - T3; dst = WT + OFF_WABC; }
        else if (t < T5) { src = Pk->in[10] + (size_t)l * 512 * 1024; srcN = 1024; K = 512; kind = 1; loc = t - T4; dst = WT + OFF_WABC + (size_t)1024 * 512; }
        else if (t < T6) { src = Pk->in[11] + (size_t)l * 512 * 1024; srcN = 1024; K = 512; kind = 1; loc = t - T5; dst = WT + OFF_WABC + (size_t)2048 * 512; }
        else if (t < T7) { src = Pk->in[14] + (size_t)l * 1024 * 1024; srcN = 1024; K = 1024; kind = 1; loc = t - T6; dst = WT + OFF_WO; }
        else if (t < T8) { src = Pk->in[17] + (size_t)l * 1024 * 1024; srcN = 1024; K = 1024; kind = 1; loc = t - T7; dst = WT + OFF_WPG; }
        else { src = Pk->in[18] + (size_t)l * 256 * 1024; srcN = 1024; K = 256; kind = 1; loc = t - T8; dst = WT + OFF_WP; }
        const int kt = K / 64; const int n0 = (loc / kt) * 128, k0 = (loc % kt) * 64;
        tr_tile(src, srcN, K, dst, kind, n0, k0, ks, scr, tid);
    }
}
DI void convert_rows(const float* src, bf16_t* dst, size_t n) {
    const size_t stride = (size_t)gridDim.x * blockDim.x, ng = n / 8;
    for (size_t i = (size_t)blockIdx.x * blockDim.x + opaque_tid(); i < ng; i += 4 * stride) {
        f32x4 a[4], b[4];
#pragma unroll
        for (int j = 0; j < 4; ++j) { const size_t q = i + j * stride; if (q < ng) { a[j] = *(const f32x4*)(src + q * 8); b[j] = *(const f32x4*)(src + q * 8 + 4); } }
#pragma unroll
        for (int j = 0; j < 4; ++j) { const size_t q = i + j * stride; if (q < ng) *(u32x4*)(dst + q * 8) = pack8(a[j], b[j]); }
    }
}
typedef const __attribute__((address_space(4))) Params* KParams;
DI KParams kparams() { KParams p = (KParams)__builtin_amdgcn_kernarg_segment_ptr(); asm volatile("" : "+s"(p)); return p; }
DI unsigned char* wsbase() { unsigned char* w = kparams()->ws; asm volatile("" : "+s"(w)); return w; }

__global__ void __launch_bounds__(512, 2) fwd_megakernel(Params Punused) {
    extern __shared__ __attribute__((aligned(16))) unsigned char lds_raw[];
    cg::grid_group grid = cg::this_grid();
    LAS unsigned char* lds = (LAS unsigned char*)lds_raw;
#define G opaque_s((int)gridDim.x)
#define cu opaque_s((int)blockIdx.x)
#define XB_  ((bf16_t*)(ws + WS_XB))
#define WT_  ((bf16_t*)(ws + WS_WT))
#define PB_  ((bf16_t*)(ws + WS_PB))
#define Y_   ((bf16_t*)(ws + WS_Y))
#define H_   ((bf16_t*)(ws + WS_H))
#define QB_  ((bf16_t*)(ws + WS_MLA))
#define KB_  (QB_ + (size_t)HM * 768)
#define VB_  (KB_ + (size_t)HM * 768)
#define R_   ((float*)(ws + WS_H))
#define ROPE_ ((float*)(ws + CTL_ROPE))
#define KMP_ ((float*)(ws + CTL_KMP))
#define STQ_ ((float*)(ws + CTL_STQ))
#define STKV_ ((float*)(ws + CTL_STKV))

    if (threadIdx.x < 2) ((volatile LAS unsigned*)(lds + LDS_IDX + 64))[threadIdx.x] = 0u;
    {
        const int tid = opaque_tid();
        KParams P = kparams(); unsigned char* ws = P->ws;
        for (int rep = 0; rep < REP_P0; ++rep) {
        convert_weights(P, 0, WT_, (LAS float*)lds);
        convert_rows(P->in[0], XB_, (size_t)M * D);
        convert_rows(P->in[1], PB_, (size_t)M * 256); }
        float* rope = ROPE_;
        for (int i = cu * 512 + tid; i < SEQ * 16; i += G * 512) {
            const int pos = i >> 4, k = i & 15;
            const float freq = __builtin_amdgcn_exp2f(-(float)k * (13.287712379549449f / 16.f));
            const float ang = (float)pos * freq;
            double rev = (double)ang * 0.15915494309189535; rev -= __builtin_rint(rev);
            const float fr = (float)rev;
            rope[2 * i] = __builtin_amdgcn_cosf(fr); rope[2 * i + 1] = __builtin_amdgcn_sinf(fr);
        }
        if (cu == 0) {
            unsigned* ctl = (unsigned*)(ws + WS_CTL); float* lamv = (float*)(ws + CTL_LAM);
            if (tid < 64) {
#pragma unroll
                for (int l = 0; l < 2; ++l) { const float* dl = P->in[7] + l * 256; float a = dl[tid] * dl[64 + tid], b = dl[128 + tid] * dl[192 + tid];
#pragma unroll
                    for (int s = 1; s < 64; s <<= 1) { a += __shfl_xor(a, s); b += __shfl_xor(b, s); }
                    const float li = (l == 0) ? 0.2f : 0.35550906759096924f;
                    if (tid == 0) lamv[l] = __builtin_amdgcn_exp2f(a * LOG2E) - __builtin_amdgcn_exp2f(b * LOG2E) + li; }
            }
            if (tid < 64) ctl[tid] = 0u;
            if (tid < 128) ((unsigned*)(ws + CTL_DEP))[tid] = 0u;
            { unsigned* bw = (unsigned*)(ws + CTL_BAR); for (int i = tid; i < XCD_BAR_WORDS; i += 512) bw[i] = 0u; }
        }
    }
    grid.sync();
    if (threadIdx.x == 0) { unsigned char* ws = wsbase(); (void)xb_add(&((unsigned*)(ws + CTL_BAR))[XB_XCNT(xb_xcc_id())], 1u); }
#define GSYNC() do { unsigned char* _w = wsbase(); xcd_barrier((unsigned*)(_w + CTL_BAR), (volatile LAS unsigned*)(lds + LDS_IDX + 64)); } while (0)

    for (int l = 0; l < 2; ++l) {
        for (int hf = 0; hf < 2; ++hf) {
            for (int rep = 0; rep < REP_P1; ++rep)
            { unsigned char* ws = wsbase();
              pg8::Gemm g{XB_ + (size_t)hf * HM * D, WT_ + OFF_WIN, D, D}; pg8::P1Order S{G, cu};
              pg8::EpiH E{H_, KB_, KMP_ + (size_t)hf * 32 * 2 * 512, STQ_ + (size_t)hf * HM * 8, STKV_ + (size_t)hf * HM * 4, ROPE_, (unsigned*)(ws + CTL_DEP) + (l * 2 + hf) * 32};
              pg8::gemm_phase(lds, g, S, E); }
            {
                const int Gn = G, rem = 672 % Gn, NE = Gn - rem, e = cu - rem;
                pg8::ListOrder Sq{0, (e >= 0) ? 96 : 0, 3, (e >= 0) ? e : 0, NE}, Skv{96, (e >= 0) ? 224 : 96, 4, (e >= 0) ? e : 0, NE};
                if (opaque_tid() == 0) {
                    unsigned char* ws = wsbase(); unsigned* dep = (unsigned*)(ws + CTL_DEP) + (l * 2 + hf) * 32; pg8::Unit u;
                    for (int pass = 0; pass < 2; ++pass)
                        for (int i = 0; pass == 0 ? Sq.next(i, u) : Skv.next(i, u); ++i) {
                            unsigned sp = 0;
                            while (__hip_atomic_load(dep + u.pm, __ATOMIC_RELAXED, __HIP_MEMORY_SCOPE_AGENT) < 24u) { __builtin_amdgcn_s_sleep(2); if (++sp > (1u << 24)) break; }
                        }
                    __builtin_amdgcn_fence(__ATOMIC_ACQUIRE, "agent");
                    asm volatile("s_waitcnt vmcnt(0)" ::: "memory");
                }
                __syncthreads();
                { unsigned char* ws = wsbase();
                  pg8::Gemm g{H_ + C_CQL, WT_ + OFF_WUQ, HP, 384};
                  pg8::EpiUp<0> E{QB_, KB_, VB_, STQ_ + (size_t)hf * HM * 8, ROPE_}; pg8::gemm_phase(lds, g, Sq, E); }
                { unsigned char* ws = wsbase();
                  pg8::Gemm g{H_ + C_CKV, WT_ + OFF_WUKV, HP, 256};
                  pg8::EpiUp<1> E{QB_, KB_, VB_, STKV_ + (size_t)hf * HM * 4, ROPE_}; pg8::gemm_phase(lds, g, Skv, E); }
            }
            GSYNC();
            {
                for (int vcu = cu; vcu < 256; vcu += G)
                for (int step = 0; ; ++step) {
                    KParams P = kparams(); unsigned char* ws = P->ws;
                    const int x = vcu & 7, sl_ = vcu >> 3;
                    int type, u, bh;
                    if (step < 2) {
                        if (sl_ < 16) { type = 2; bh = 2 * x + (sl_ >> 3); const int j = sl_ & 7; u = (step == 0) ? 15 - j : j; }
                        else { const int t = sl_ - 16; bh = 4 * x + (t >> 2); type = step; u = 7 - (t & 3); }
                    } else {
                        if (opaque_tid() == 0) *(LAS int*)(lds + LDS_IDX) = (int)atomicAdd((unsigned*)(ws + WS_CTL) + 16 + (l * 2 + hf) * 8 + x, 1u);
                        __syncthreads();
                        const int k = *(LAS int*)(lds + LDS_IDX);
                        __syncthreads();
                        if (k >= 32) break;
                        u = 3 - (k >> 3); type = (k & 4) ? 0 : 1; bh = 4 * x + (k & 3);
                    }
                    if (type == 0) {
                        const int bl = bh >> 3, h = bh & 7, bg = 4 * hf + bl; const size_t ho = (size_t)bh * SEQ * 64;
                        const float sl = __builtin_amdgcn_exp2f(-(2.f / 3.f) * (float)(h + (h >> 1) + 2)) * LOG2E;
                        attn_unit<64, 64, 64, 256, true, true, true, 2>((LAS char*)lds, H_ + HM_AQ + ho, 64, H_ + HM_AK + ho, 64, H_ + HM_AV + ho, 64,
                            H_ + (size_t)bl * SEQ * HP + C_AZ + h * 64, HP,
                            Y_ + (size_t)bg * SEQ * 512 + h * 64, 512, u * 256, sl, KMP_ + (size_t)bg * 8 * 2 * 512 + h * 64, 0.f, nullptr, 1.f);
                    } else if (type == 1) {
                        const int bl = bh >> 3, h = bh & 7, bg = 4 * hf + bl;
                        attn_unit<96, 96, 64, 256, false, false, true, 2>((LAS char*)lds, QB_ + (size_t)bh * SEQ * 96, 96, KB_ + (size_t)bh * SEQ * 96, 96,
                            VB_ + (size_t)bh * SEQ * 64, 64, H_ + (size_t)bl * SEQ * HP + C_BZ + h * 64, HP,
                            Y_ + (size_t)M * 512 + (size_t)bg * SEQ * 512 + h * 64, 512, u * 256, 0.f, nullptr, 0.f, nullptr, 1.f);
                    } else {
                        const int bl = bh >> 2, h = bh & 3, bg = 4 * hf + bl; const size_t ho = (size_t)bh * SEQ * 128;
                        const float sl = __builtin_amdgcn_exp2f(-(2.f / 3.f) * (float)(3 * h + 1)) * LOG2E;
                        const float lam = ((const float*)(ws + CTL_LAM))[l];
                        const float post = (l == 0) ? 0.8f : (1.f - 0.35550906759096924f);
                        attn_unit<64, 128, 128, 128, true, false, false, 1>((LAS char*)lds, H_ + HM_CQ + ho, 128, H_ + HM_CK + ho, 128, H_ + HM_CV + ho, 128,
                            H_ + (size_t)bl * SEQ * HP + C_CZ + h * 128, HP,
                            Y_ + (size_t)2 * M * 512 + (size_t)bg * SEQ * 512 + h * 128, 512, u * 128, sl, nullptr, lam, P->in[8] + l * 128, post);
                    }
                }
            }
            GSYNC();
        }
        { KParams P = kparams(); unsigned char* ws = P->ws;
          pg8::Gemm g{XB_, WT_ + OFF_WIN + (size_t)5376 * 1024, D, D}; pg8::StaticOrder S; S.init(M, 3072, G, cu);
          pg8::EpiG E{H_, P->in[13] + l * 3072}; pg8::gemm_phase(lds, g, S, E); }
        GSYNC();
        { unsigned char* ws = wsbase();
          pg8::Gemm g{Y_, WT_ + OFF_WABC, 512, 512}; pg8::MergeOrder S{cu, G};
          pg8::EpiMerge E{H_, XB_}; pg8::gemm_phase(lds, g, S, E); }
        GSYNC();
        { KParams P = kparams(); unsigned char* ws = P->ws;
          pg8::Gemm g{XB_, WT_ + OFF_WO, D, D}; pg8::StaticOrder S; S.init(M, D, G, cu);
          pg8::EpiR E{(l == 0) ? P->in[0] : (const float*)P->out, R_, Y_}; pg8::gemm_phase(lds, g, S, E); }
        GSYNC();
        { unsigned char* ws = wsbase();
          pg8::Gemm g{PB_, WT_ + OFF_WP, 256, 256}; pg8::StaticOrder S; S.init(M, D, G, cu);
          pg8::EpiBf E{XB_}; pg8::gemm_phase(lds, g, S, E); }
        { unsigned char* ws = wsbase();
          pg8::Gemm g{Y_, WT_ + OFF_WPG, D, D}; pg8::StaticOrder S; S.init(M, D, G, cu);
          pg8::EpiR2 E{R_, XB_}; pg8::gemm_phase(lds, g, S, E); }
        GSYNC();
        {
            KParams P = kparams(); unsigned char* ws = P->ws;
            const int tid = opaque_tid(), lane = tid & 63, wid = tid >> 6;
            const float* lg = P->in[15] + l * 1024; const float* lb = P->in[16] + l * 1024;
            float* outp = P->out; const float* R = R_; bf16_t* XB = XB_;
            const int gstep = (int)gridDim.x * 8;
            for (int row = (int)blockIdx.x * 8 + wid; row < M; row += 2 * gstep) {
                const bool two = row + gstep < M;
                const float* rp0 = R + (size_t)row * 1024; const float* rp1 = R + (size_t)(two ? row + gstep : row) * 1024;
                f32x4 v[2][4]; float s0 = 0.f, s1 = 0.f;
#pragma unroll
                for (int j = 0; j < 4; ++j) { v[0][j] = *(const f32x4*)(rp0 + 4 * lane + 256 * j); v[1][j] = *(const f32x4*)(rp1 + 4 * lane + 256 * j); }
#pragma unroll
                for (int j = 0; j < 4; ++j) { s0 += (v[0][j][0] + v[0][j][1]) + (v[0][j][2] + v[0][j][3]); s1 += (v[1][j][0] + v[1][j][1]) + (v[1][j][2] + v[1][j][3]); }
#pragma unroll
                for (int k = 1; k < 64; k <<= 1) { s0 += __shfl_xor(s0, k); s1 += __shfl_xor(s1, k); }
                const float mu0 = s0 * (1.f / 1024.f), mu1 = s1 * (1.f / 1024.f); float q0 = 0.f, q1 = 0.f;
#pragma unroll
                for (int j = 0; j < 4; ++j) { v[0][j] -= mu0; v[1][j] -= mu1;
                    q0 += (v[0][j][0] * v[0][j][0] + v[0][j][1] * v[0][j][1]) + (v[0][j][2] * v[0][j][2] + v[0][j][3] * v[0][j][3]);
                    q1 += (v[1][j][0] * v[1][j][0] + v[1][j][1] * v[1][j][1]) + (v[1][j][2] * v[1][j][2] + v[1][j][3] * v[1][j][3]); }
#pragma unroll
                for (int k = 1; k < 64; k <<= 1) { q0 += __shfl_xor(q0, k); q1 += __shfl_xor(q1, k); }
                const float rs0 = __builtin_amdgcn_rsqf(q0 * (1.f / 1024.f) + 1e-5f), rs1 = __builtin_amdgcn_rsqf(q1 * (1.f / 1024.f) + 1e-5f);
#pragma unroll
                for (int j = 0; j < 4; ++j) { const f32x4 gv = *(const f32x4*)(lg + 4 * lane + 256 * j), bv = *(const f32x4*)(lb + 4 * lane + 256 * j);
#pragma unroll
                    for (int t = 0; t < 2; ++t) { if (t == 1 && !two) break;
                        const size_t rr = (size_t)(t == 0 ? row : row + gstep);
                        const f32x4 y = v[t][j] * (t == 0 ? rs0 : rs1) * gv + bv;
                        *(f32x4*)(outp + rr * 1024 + 4 * lane + 256 * j) = y;
                        if (l == 0) { u32x2 w; w.x = pk2(y[0], y[1]); w.y = pk2(y[2], y[3]); *(u32x2*)(XB + rr * 1024 + 4 * lane + 256 * j) = w; } } }
            }
            if (l == 0) {
                __syncthreads();
                convert_weights(P, 1, WT_, (LAS float*)lds);
                convert_rows(P->in[1] + (size_t)M * 256, PB_, (size_t)M * 256);
            }
        }
        if (l == 0) GSYNC();
    }
}

#undef G
#undef cu
extern "C" void kernel_launch(void* const* d_in, const int* in_sizes, int n_in, void* d_out, int out_size, void* d_ws, size_t ws_size, hipStream_t stream) {
    static int grid_blocks = 0;
    if (grid_blocks == 0) {
        if (n_in != 19 || out_size != M * D || ws_size < WS_END) { fprintf(stderr, "kernel_launch: unexpected problem (n_in %d out %d ws %zu)\n", n_in, out_size, ws_size); grid_blocks = -1; return; }
        int dev = 0, cus = 0, per_cu = 0;
        hipGetDevice(&dev);
        hipDeviceGetAttribute(&cus, hipDeviceAttributeMultiprocessorCount, dev);
        if (hipFuncSetAttribute((const void*)fwd_megakernel, hipFuncAttributeMaxDynamicSharedMemorySize, LDS_BYTES) != hipSuccess) { fprintf(stderr, "kernel_launch: hipFuncSetAttribute failed\n"); grid_blocks = -1; return; }
        if (hipOccupancyMaxActiveBlocksPerMultiprocessor(&per_cu, (const void*)fwd_megakernel, 512, LDS_BYTES) != hipSuccess || per_cu < 1) { fprintf(stderr, "kernel_launch: occupancy query failed (%d)\n", per_cu); grid_blocks = -1; return; }
        grid_blocks = cus * per_cu;
        if (grid_blocks > 256) grid_blocks = 256;
    }
    if (grid_blocks < 0) return;
    Params p{};
    for (int i = 0; i < 19; ++i) p.in[i] = (const float*)d_in[i];
    p.out = (float*)d_out; p.ws = (unsigned char*)d_ws;
    void* args[] = {&p};
    hipError_t e = hipLaunchCooperativeKernel((const void*)fwd_megakernel, dim3(grid_blocks), dim3(512), args, LDS_BYTES, stream);
    if (e != hipSuccess) fprintf(stderr, "cooperative launch failed: %s (grid %d)\n", hipGetErrorString(e), grid_blocks);
}
```

```cpp
#include <hip/hip_runtime.h>
#include <hip/hip_cooperative_groups.h>
#include <cstdio>
#include <cstdint>
namespace cg = cooperative_groups;
#ifndef REP_ATT
#define REP_ATT 1
#endif
#ifndef REP_P1
#define REP_P1 1
#endif
#ifndef REP_P0
#define REP_P0 1
#endif

#define LAS __attribute__((address_space(3)))
#define DI __device__ __forceinline__
typedef unsigned short bf16_t;
typedef short bf16x8 __attribute__((ext_vector_type(8)));
typedef short s16x4 __attribute__((ext_vector_type(4)));
typedef float f32x2 __attribute__((ext_vector_type(2)));
typedef float f32x4 __attribute__((ext_vector_type(4)));
typedef float f32x16 __attribute__((ext_vector_type(16)));
typedef unsigned u32x4 __attribute__((ext_vector_type(4)));
typedef unsigned u32x2 __attribute__((ext_vector_type(2)));
typedef __bf16 bf16x2_t __attribute__((ext_vector_type(2)));

constexpr int M = 16384, D = 1024, SEQ = 2048, HM = 8192;
constexpr int HP = 2304;
constexpr int NH1 = 5376;
constexpr int NWIN = 8448;
constexpr float LOG2E = 1.4426950408889634f;
constexpr float QS64 = 0.125f * LOG2E;
constexpr float QS96 = 0.10206207261596575f * LOG2E;
constexpr float ALPHA = 1.4142135623730951f;
constexpr int C_AZ = 0, C_BZ = 512, C_CZ = 1024, C_CKV = 1536, C_CQL = 1792;
constexpr size_t HM_AQ = (size_t)18 * 1048576, HM_AK = (size_t)22 * 1048576, HM_AV = (size_t)26 * 1048576, HM_CQ = (size_t)30 * 1048576, HM_CK = (size_t)34 * 1048576, HM_CV = (size_t)38 * 1048576;

constexpr size_t MiB = 1048576;
constexpr size_t WS_CTL = 0, WS_XB = 2 * MiB, WS_WT = 34 * MiB, WS_PB = 60 * MiB, WS_Y = 68 * MiB, WS_H = 116 * MiB, WS_MLA = 200 * MiB, WS_END = 232 * MiB;
constexpr size_t CTL_DEP = 8192, CTL_BAR = 16384, CTL_LAM = 4096, CTL_ROPE = 65536, CTL_KMP = 384 * 1024, CTL_STQ = 640 * 1024, CTL_STKV = 1152 * 1024;
constexpr size_t OFF_WIN = 0, OFF_WUQ = 8650752, OFF_WUKV = 8945664, OFF_WABC = 9207808, OFF_WO = 10780672, OFF_WPG = 11829248, OFF_WP = 12877824;
constexpr int LDS_BYTES = 132 * 1024, LDS_IDX = 131072;

DI int opaque_s(int v) { asm volatile("" : "+s"(v)); return v; }
DI int opaque_tid() { int t = threadIdx.x; asm volatile("" : "+v"(t)); return t; }
DI unsigned pk2(float lo, float hi) { f32x2 v = {lo, hi}; bf16x2_t b = __builtin_convertvector(v, bf16x2_t); return __builtin_bit_cast(unsigned, b); }
DI float bflo(unsigned w) { return __uint_as_float(w << 16); }
DI float bfhi(unsigned w) { return __uint_as_float(w & 0xffff0000u); }
DI float bf2f(bf16_t b) { return __uint_as_float((unsigned)b << 16); }
DI bf16_t f2bf(float f) { return (bf16_t)(pk2(f, 0.f) & 0xffffu); }
DI float sigm(float x) { return __builtin_amdgcn_rcpf(1.f + __builtin_amdgcn_exp2f(-x * LOG2E)); }
DI float silu(float x) { return x * sigm(x); }
DI u32x4 pack8(const f32x4 a, const f32x4 b) { u32x4 w; w.x = pk2(a[0], a[1]); w.y = pk2(a[2], a[3]); w.z = pk2(b[0], b[1]); w.w = pk2(b[2], b[3]); return w; }
DI void unpack8(const u32x4 w, f32x4& a, f32x4& b) { a = (f32x4){bflo(w.x), bfhi(w.x), bflo(w.y), bfhi(w.y)}; b = (f32x4){bflo(w.z), bfhi(w.z), bflo(w.w), bfhi(w.w)}; }

namespace pg8 {
constexpr int BM = 256, BK = 64, HALF = 128, HTB = HALF * BK * 2, NXCD = 8, WGM = 8;
__host__ __device__ __forceinline__ int lds_byte(int r, int c) { const int st = (r >> 4) * 2 + (c >> 5), rr = r & 15, cc = c & 31, ob = rr * 64 + cc * 2; return st * 1024 + (ob ^ (((ob >> 9) & 1) << 5)); }
__host__ __device__ __forceinline__ void stage_rc(int b, int& R, int& C) { const int st = b / 1024, sb = b % 1024, swz = sb ^ (((sb >> 9) & 1) << 5); R = (st >> 1) * 16 + swz / 64; C = (st & 1) * 32 + (swz % 64) / 2; }
__host__ __device__ __forceinline__ int perm32(int rho) { const int n = rho >> 4, i = rho & 15; return 8 * (i >> 2) + 4 * n + (i & 3); }

struct Unit { int pm, pn; };
struct Gemm { const bf16_t* A; const bf16_t* Bt; int lda, K; };

struct StaticOrder {
    int nM, nN, nwg, G, c;
    DI void init(int M_, int N_, int G_, int c_) { nM = M_ / BM; nN = N_ / BM; nwg = nM * nN; G = G_; c = c_; }
    DI bool next(int i, Unit& u) const {
        const long L = (long)i * G + c; if (L >= nwg) return false;
        int wgid = (int)L; { const int q = nwg / NXCD, r = nwg % NXCD, xcd = wgid % NXCD, off = wgid / NXCD; wgid = (xcd < r ? xcd * (q + 1) : r * (q + 1) + (xcd - r) * q) + off; }
        const int nig = WGM * nN, gid = wgid / nig, fm = gid * WGM, gsz = (nM - fm) < WGM ? (nM - fm) : WGM;
        u.pm = fm + ((wgid % nig) % gsz); u.pn = (wgid % nig) / gsz; return true;
    }
};
struct P1Order {
    int G, c;
    DI bool next(int i, Unit& u) const {
        const long L = (long)i * G + c; if (L >= 672) return false;
        if (L < 96) { u.pm = (int)L / 3; u.pn = 18 + (int)L % 3; return true; }
        const int nM = 32, nN = 18, nwg = 576;
        int wgid = (int)L - 96; { const int q = nwg / NXCD, r = nwg % NXCD, xcd = wgid % NXCD, off = wgid / NXCD; wgid = (xcd < r ? xcd * (q + 1) : r * (q + 1) + (xcd - r) * q) + off; }
        const int nig = WGM * nN, gid = wgid / nig, fm = gid * WGM, gsz = (nM - fm) < WGM ? (nM - fm) : WGM;
        u.pm = fm + ((wgid % nig) % gsz); u.pn = (wgid % nig) / gsz; return true;
    }
};
struct ListOrder {
    int lo, hi, nN, c, G;
    DI bool next(int i, Unit& u) const {
        int k0 = 0; if (c < lo) k0 = (lo - c + G - 1) / G;
        const int idx = c + (k0 + i) * G; if (idx >= hi) return false;
        const int loc = idx - lo; u.pm = loc / nN; u.pn = loc % nN; return true;
    }
};
struct MergeOrder {
    int c, G;
    DI bool next(int i, Unit& u) const {
        int tile = c + (i / 3) * G; const int br = i % 3; if (tile >= 256) return false;
        if (G == 256) tile = (c & 7) * 32 + (c >> 3);
        u.pm = br * 64 + (tile >> 2); u.pn = br * 4 + (tile & 3); return true;
    }
};

template <class Epi, class Sched>
DI void gemm_phase(LAS unsigned char* lds, const Gemm g, const Sched& S, const Epi& E) {
    const int tid = opaque_tid(), wid = __builtin_amdgcn_readfirstlane(tid >> 6), lane = tid & 63, wr = wid >> 2, wc = wid & 3, fr = lane & 15, fq = lane >> 4;
    const int K = g.K, nt = K / BK, lda = g.lda;
    unsigned voffA[2], voffB[2];
#pragma unroll
    for (int i = 0; i < 2; ++i) { int R, C; stage_rc(tid * 16 + i * 8192, R, C); const int Rb = (R & ~31) + perm32(R & 31);
        voffA[i] = (unsigned)(R * lda + C) * 2u; voffB[i] = (unsigned)(Rb * K + C) * 2u; }
    const size_t kstep = (size_t)(BK * 2);
    const size_t hstepA = (size_t)HALF * lda * 2, hstepB = (size_t)HALF * K * 2;
    const size_t tstepA = 2 * hstepA, tstepB = 2 * hstepB;
    const unsigned ldsw = (unsigned)wid * 1024u;
    const int aoff = lds_byte(wr * 64 + fr, fq * 8), boff = lds_byte(wc * 32 + fr, fq * 8);
#define PG8_SA(b, h) (((b) * 2 + (h)) * HTB)
#define PG8_SB(b, h) ((4 + (b) * 2 + (h)) * HTB)
#define PG8_STAGE(bufoff, gbase, voff) do { _Pragma("unroll") for (int _i = 0; _i < 2; ++_i) \
        __builtin_amdgcn_global_load_lds((const unsigned*)((const char*)(gbase) + (voff)[_i]), (LAS unsigned*)(lds + (bufoff) + ldsw + _i * 8192), 16, 0, 0); } while (0)
#define PG8_LDA(dst, b, h) do { _Pragma("unroll") for (int m = 0; m < 4; ++m) _Pragma("unroll") for (int k = 0; k < 2; ++k) dst[m][k] = *(const LAS bf16x8*)(lds + PG8_SA(b, h) + aoff + m * 2048 + k * 1024); } while (0)
#define PG8_LDB(dst, b, h) do { _Pragma("unroll") for (int n = 0; n < 2; ++n) _Pragma("unroll") for (int k = 0; k < 2; ++k) dst[n][k] = *(const LAS bf16x8*)(lds + PG8_SB(b, h) + boff + n * 2048 + k * 1024); } while (0)
#define PG8_MMA(ai, bj, At, Bt) do { __builtin_amdgcn_s_setprio(1); _Pragma("unroll") for (int m = 0; m < 4; ++m) _Pragma("unroll") for (int n = 0; n < 2; ++n) _Pragma("unroll") for (int k = 0; k < 2; ++k) \
        acc[ai][bj][m][n] = __builtin_amdgcn_mfma_f32_16x16x32_bf16(Bt[n][k], At[m][k], acc[ai][bj][m][n], 0, 0, 0); __builtin_amdgcn_s_setprio(0); } while (0)
#define PG8_WAIT_V(n) asm volatile("s_waitcnt vmcnt(" #n ")" ::: "memory")
#define PG8_WAIT_L(n) asm volatile("s_waitcnt lgkmcnt(" #n ")" ::: "memory")
#define PG8_BAR __builtin_amdgcn_s_barrier()
#define PG8_SCHED __builtin_amdgcn_sched_barrier(0)
    Unit cur, nxt; int ui = 0;
    if (!S.next(0, cur)) return;
    f32x4 acc[2][2][4][2];
#pragma unroll
    for (int a = 0; a < 2; ++a)
#pragma unroll
        for (int b = 0; b < 2; ++b)
#pragma unroll
            for (int m = 0; m < 4; ++m)
#pragma unroll
                for (int n = 0; n < 2; ++n) acc[a][b][m][n] = (f32x4){0.f, 0.f, 0.f, 0.f};
    bf16x8 At[4][2], B0[2][2], B1[2][2];
    const char* cA = (const char*)g.A + (size_t)cur.pm * tstepA; const char* cB = (const char*)g.Bt + (size_t)cur.pn * tstepB;
    PG8_STAGE(PG8_SB(0, 0), cB, voffB); PG8_STAGE(PG8_SB(0, 1), cB + hstepB, voffB); PG8_STAGE(PG8_SA(0, 0), cA, voffA); PG8_STAGE(PG8_SA(0, 1), cA + hstepA, voffA);
    if (wr == 1) PG8_BAR;
    PG8_WAIT_V(2); PG8_BAR;
    PG8_STAGE(PG8_SB(1, 0), cB + kstep, voffB); PG8_STAGE(PG8_SA(1, 0), cA + kstep, voffA); PG8_STAGE(PG8_SB(1, 1), cB + hstepB + kstep, voffB);
    PG8_WAIT_V(6); PG8_BAR;
    for (;;) {
        const bool has_next = S.next(ui + 1, nxt);
        const char* nA = has_next ? (const char*)g.A + (size_t)nxt.pm * tstepA : cA; const char* nB = has_next ? (const char*)g.Bt + (size_t)nxt.pn * tstepB : cB;
#pragma nounroll
        for (int t = 0; t < nt; t += 2) {
            const bool last = (t == nt - 2);
            const char* a1 = cA + (size_t)(t + 1) * kstep;
            const char* a2 = last ? nA : cA + (size_t)(t + 2) * kstep; const char* b2 = last ? nB : cB + (size_t)(t + 2) * kstep;
            const char* a3 = a2 + kstep; const char* b3 = b2 + kstep;
            PG8_LDB(B0, 0, 0); PG8_LDB(B1, 0, 1); PG8_SCHED; PG8_LDA(At, 0, 0); PG8_STAGE(PG8_SA(1, 1), a1 + hstepA, voffA);
            PG8_WAIT_V(8); PG8_WAIT_L(0); PG8_BAR; PG8_MMA(0, 0, At, B0); PG8_MMA(0, 1, At, B1); PG8_BAR; PG8_SCHED;
            PG8_LDA(At, 0, 1); PG8_STAGE(PG8_SB(0, 0), b2, voffB); PG8_STAGE(PG8_SB(0, 1), b2 + hstepB, voffB); PG8_STAGE(PG8_SA(0, 0), a2, voffA);
            PG8_WAIT_V(8); PG8_WAIT_L(0); PG8_BAR; PG8_MMA(1, 0, At, B0); PG8_MMA(1, 1, At, B1); PG8_BAR; PG8_SCHED;
            PG8_LDB(B0, 1, 0); PG8_LDB(B1, 1, 1); PG8_SCHED; PG8_LDA(At, 1, 0); PG8_STAGE(PG8_SA(0, 1), a2 + hstepA, voffA);
            PG8_WAIT_V(8); PG8_WAIT_L(0); PG8_BAR; PG8_MMA(0, 0, At, B0); PG8_MMA(0, 1, At, B1); PG8_BAR; PG8_SCHED;
            PG8_LDA(At, 1, 1); PG8_STAGE(PG8_SB(1, 0), b3, voffB); PG8_STAGE(PG8_SB(1, 1), b3 + hstepB, voffB); PG8_STAGE(PG8_SA(1, 0), a3, voffA);
            PG8_WAIT_V(8); PG8_WAIT_L(0); PG8_BAR; PG8_MMA(1, 0, At, B0); PG8_MMA(1, 1, At, B1); PG8_BAR; PG8_SCHED;
        }
        if (wr == 0) PG8_BAR;
        E(acc, cur, wr, wc, fr, fq);
        if (!has_next) break;
#pragma unroll
        for (int a = 0; a < 2; ++a)
#pragma unroll
            for (int b = 0; b < 2; ++b)
#pragma unroll
                for (int m = 0; m < 4; ++m)
#pragma unroll
                    for (int n = 0; n < 2; ++n) acc[a][b][m][n] = (f32x4){0.f, 0.f, 0.f, 0.f};
        cur = nxt; cA = nA; cB = nB; ++ui;
        if (wr == 1) PG8_BAR;
    }
    PG8_WAIT_V(0);
    PG8_BAR;
#undef PG8_SA
#undef PG8_SB
#undef PG8_STAGE
#undef PG8_LDA
#undef PG8_LDB
#undef PG8_MMA
#undef PG8_WAIT_V
#undef PG8_WAIT_L
#undef PG8_BAR
#undef PG8_SCHED
}
typedef f32x4 Acc[2][2][4][2];

struct EpiH {
    bf16_t* H; bf16_t* KB; float* KMP; float* STQ; float* STKV; const float* rope; unsigned* dep;
    DI void operator()(const Acc& acc, const Unit& u, int wr, int wc, int fr, int fq) const {
        const int row0 = u.pm * BM + wr * 64 + fr;
        {
            const int pn = u.pn; bf16_t* base; int hw = 0, cseg;
            if (pn < 6) { base = H + (pn < 2 ? HM_AQ : pn < 4 ? HM_AK : HM_AV); hw = 64; cseg = (pn & 1) * 256; }
            else if (pn < 10) { base = H + (pn < 8 ? C_AZ : C_BZ); cseg = (pn & 1) * 256; }
            else if (pn < 16) { base = H + (pn < 12 ? HM_CQ : pn < 14 ? HM_CK : HM_CV); hw = 128; cseg = (pn & 1) * 256; }
            else if (pn < 18) { base = H + C_CZ; cseg = (pn & 1) * 256; }
            else { base = H + C_CKV; cseg = (pn - 18) * 256; }
            const int bl = u.pm >> 3, s0 = (u.pm & 7) * 256 + wr * 64 + fr;
#pragma unroll
            for (int bj = 0; bj < 2; ++bj) { const int cs = cseg + bj * HALF + wc * 32 + 8 * fq;
                bf16_t* colp; size_t pitch;
                if (hw == 64) { colp = base + ((size_t)(bl * 8 + (cs >> 6)) * SEQ) * 64 + (cs & 63); pitch = 64; }
                else if (hw == 128) { colp = base + ((size_t)(bl * 4 + (cs >> 7)) * SEQ) * 128 + (cs & 127); pitch = 128; }
                else { colp = base + (size_t)bl * SEQ * HP + cs; pitch = HP; }
#pragma unroll
                for (int ai = 0; ai < 2; ++ai)
#pragma unroll
                    for (int m = 0; m < 4; ++m) *(u32x4*)(colp + (size_t)(s0 + ai * HALF + m * 16) * pitch) = pack8(acc[ai][bj][m][0], acc[ai][bj][m][1]); }
        }
        if (u.pn == 2 || u.pn == 3) {
            float* dst = KMP + (size_t)(u.pm * 2 + wr) * 512 + (u.pn - 2) * 256 + wc * 32 + 8 * fq;
#pragma unroll
            for (int bj = 0; bj < 2; ++bj)
#pragma unroll
                for (int n = 0; n < 2; ++n) { f32x4 s = (f32x4){0.f, 0.f, 0.f, 0.f};
#pragma unroll
                    for (int ai = 0; ai < 2; ++ai)
#pragma unroll
                        for (int m = 0; m < 4; ++m) s += acc[ai][bj][m][n];
#pragma unroll
                    for (int e = 0; e < 4; ++e) { float v = s[e]; v += __shfl_xor(v, 1); v += __shfl_xor(v, 2); v += __shfl_xor(v, 4); v += __shfl_xor(v, 8); s[e] = v; }
                    if (fr == 0) *(f32x4*)(dst + bj * HALF + 4 * n) = s; }
        }
        if (u.pn >= 18) {
#pragma unroll
            for (int ai = 0; ai < 2; ++ai)
#pragma unroll
                for (int m = 0; m < 4; ++m) { const int row = row0 + ai * HALF + m * 16; float ss = 0.f;
#pragma unroll
                    for (int bj = 0; bj < 2; ++bj) { if (u.pn == 20 && bj == 1) continue;
#pragma unroll
                        for (int n = 0; n < 2; ++n) { const f32x4 x = acc[ai][bj][m][n]; ss += (x[0] * x[0] + x[1] * x[1]) + (x[2] * x[2] + x[3] * x[3]); } }
                    ss += __shfl_xor(ss, 16); ss += __shfl_xor(ss, 32);
                    if (fq == 0) { if (u.pn == 18) STKV[(size_t)row * 4 + wc] = ss; else STQ[(size_t)row * 8 + (u.pn - 19) * 4 + wc] = ss; }
                    if (u.pn == 20 && wc == 0) {
                        const int pos = row & (SEQ - 1); f32x4 o[2];
#pragma unroll
                        for (int n = 0; n < 2; ++n) { const f32x4 cs = *(const f32x4*)(rope + ((size_t)pos * 16 + 4 * fq + 2 * n) * 2); const f32x4 t = acc[ai][1][m][n];
                            o[n] = (f32x4){t[0] * cs[0] - t[1] * cs[1], t[0] * cs[1] + t[1] * cs[0], t[2] * cs[2] - t[3] * cs[3], t[2] * cs[3] + t[3] * cs[2]}; }
                        const u32x4 w = pack8(o[0], o[1]);
#pragma unroll
                        for (int h = 0; h < 8; ++h) *(u32x4*)(KB + ((size_t)((row >> 11) * 8 + h) * SEQ + pos) * 96 + 64 + 8 * fq) = w;
                    }
                }
        }
        if (u.pn >= 18) {
            asm volatile("s_waitcnt vmcnt(0)" ::: "memory");
            __syncthreads();
            if (threadIdx.x == 0) {
                __builtin_amdgcn_fence(__ATOMIC_RELEASE, "agent");
                asm volatile("s_waitcnt vmcnt(0)" ::: "memory");
                __hip_atomic_fetch_add(dep + u.pm, 8u, __ATOMIC_RELAXED, __HIP_MEMORY_SCOPE_AGENT);
            }
        }
    }
};
template <int MODE> struct EpiUp {
    bf16_t* QB; bf16_t* KB; bf16_t* VB; const float* ST; const float* rope;
    DI void operator()(const Acc& acc, const Unit& u, int wr, int wc, int fr, int fq) const {
        const int row0 = u.pm * BM + wr * 64 + fr;
#pragma unroll
        for (int ai = 0; ai < 2; ++ai)
#pragma unroll
            for (int m = 0; m < 4; ++m) { const int row = row0 + ai * HALF + m * 16; float sc;
                if (MODE == 0) { const f32x4 a = *(const f32x4*)(ST + (size_t)row * 8), b = *(const f32x4*)(ST + (size_t)row * 8 + 4);
                    sc = __builtin_amdgcn_rsqf(((a[0] + a[1]) + (a[2] + a[3]) + (b[0] + b[1]) + (b[2] + b[3])) * (1.f / 384.f) + 1e-6f) * QS96; }
                else { const f32x4 a = *(const f32x4*)(ST + (size_t)row * 4); sc = __builtin_amdgcn_rsqf(((a[0] + a[1]) + (a[2] + a[3])) * (1.f / 256.f) + 1e-6f); }
                const int pos = row & (SEQ - 1);
#pragma unroll
                for (int bj = 0; bj < 2; ++bj) { const int c0 = u.pn * BM + bj * HALF + wc * 32 + 8 * fq;
                    f32x4 v0 = acc[ai][bj][m][0] * sc, v1 = acc[ai][bj][m][1] * sc;
                    if (MODE == 0) { const int j = c0 % 96;
                        if (j >= 64) { const int i0 = (j - 64) >> 1; const f32x4 ca = *(const f32x4*)(rope + ((size_t)pos * 16 + i0) * 2), cb = *(const f32x4*)(rope + ((size_t)pos * 16 + i0 + 2) * 2);
                            v0 = (f32x4){v0[0] * ca[0] - v0[1] * ca[1], v0[0] * ca[1] + v0[1] * ca[0], v0[2] * ca[2] - v0[3] * ca[3], v0[2] * ca[3] + v0[3] * ca[2]};
                            v1 = (f32x4){v1[0] * cb[0] - v1[1] * cb[1], v1[0] * cb[1] + v1[1] * cb[0], v1[2] * cb[2] - v1[3] * cb[3], v1[2] * cb[3] + v1[3] * cb[2]}; }
                        *(u32x4*)(QB + ((size_t)((row >> 11) * 8 + c0 / 96) * SEQ + pos) * 96 + j) = pack8(v0, v1); }
                    else { if (c0 < 512) *(u32x4*)(KB + ((size_t)((row >> 11) * 8 + (c0 >> 6)) * SEQ + pos) * 96 + (c0 & 63)) = pack8(v0, v1);
                           else *(u32x4*)(VB + ((size_t)((row >> 11) * 8 + ((c0 - 512) >> 6)) * SEQ + pos) * 64 + (c0 & 63)) = pack8(v0, v1); }
                }
            }
    }
};
struct EpiG {
    bf16_t* G; const float* bias;
    DI void operator()(const Acc& acc, const Unit& u, int wr, int wc, int fr, int fq) const {
        const int row0 = u.pm * BM + wr * 64 + fr, col0 = u.pn * BM + wc * 32 + 8 * fq;
        f32x4 bv[2][2];
#pragma unroll
        for (int bj = 0; bj < 2; ++bj)
#pragma unroll
            for (int n = 0; n < 2; ++n) bv[bj][n] = *(const f32x4*)(bias + col0 + bj * HALF + 4 * n);
#pragma unroll
        for (int ai = 0; ai < 2; ++ai)
#pragma unroll
            for (int m = 0; m < 4; ++m) { bf16_t* rowp = G + (size_t)(row0 + ai * HALF + m * 16) * 3072 + col0;
#pragma unroll
                for (int bj = 0; bj < 2; ++bj) { f32x4 v0 = acc[ai][bj][m][0] + bv[bj][0], v1 = acc[ai][bj][m][1] + bv[bj][1];
#pragma unroll
                    for (int e = 0; e < 4; ++e) { v0[e] = sigm(v0[e]); v1[e] = sigm(v1[e]); }
                    *(u32x4*)(rowp + bj * HALF) = pack8(v0, v1); } }
    }
};
struct EpiMerge {
    const bf16_t* G; bf16_t* MG;
    DI void operator()(const Acc& acc, const Unit& u, int wr, int wc, int fr, int fq) const {
        const int br = u.pn >> 2, pm = u.pm - 64 * br, pn = u.pn & 3;
        const int row0 = pm * BM + wr * 64 + fr, col0 = pn * BM + wc * 32 + 8 * fq;
        const bf16_t* gp = G + (size_t)row0 * 3072 + br * 1024 + col0; bf16_t* mp = MG + (size_t)row0 * 1024 + col0;
#pragma unroll
        for (int ai = 0; ai < 2; ++ai) {
            u32x4 gq[8], pq[8];
#pragma unroll
            for (int m = 0; m < 4; ++m)
#pragma unroll
                for (int bj = 0; bj < 2; ++bj) { gq[m * 2 + bj] = *(const u32x4*)(gp + (size_t)(ai * HALF + m * 16) * 3072 + bj * HALF);
                    if (br > 0) pq[m * 2 + bj] = *(const u32x4*)(mp + (size_t)(ai * HALF + m * 16) * 1024 + bj * HALF); }
            __builtin_amdgcn_sched_barrier(0);
#pragma unroll
            for (int m = 0; m < 4; ++m)
#pragma unroll
                for (int bj = 0; bj < 2; ++bj) { f32x4 g0, g1; unpack8(gq[m * 2 + bj], g0, g1);
                    f32x4 v0 = acc[ai][bj][m][0] * g0, v1 = acc[ai][bj][m][1] * g1;
                    if (br > 0) { f32x4 p0, p1; unpack8(pq[m * 2 + bj], p0, p1); v0 += p0; v1 += p1; }
                    *(u32x4*)(mp + (size_t)(ai * HALF + m * 16) * 1024 + bj * HALF) = pack8(v0, v1); }
            __builtin_amdgcn_sched_barrier(0);
        }
    }
};
struct EpiR {
    const float* X; float* R; bf16_t* RB;
    DI void operator()(const Acc& acc, const Unit& u, int wr, int wc, int fr, int fq) const {
        const int row0 = u.pm * BM + wr * 64 + fr, col0 = u.pn * BM + wc * 32 + 8 * fq;
        const size_t base = (size_t)row0 * 1024 + col0;
#pragma unroll
        for (int hb = 0; hb < 4; ++hb) {
            const int ai = hb >> 1, m0 = (hb & 1) * 2;
            f32x4 xq[8];
#pragma unroll
            for (int mm = 0; mm < 2; ++mm)
#pragma unroll
                for (int bj = 0; bj < 2; ++bj) { const size_t off = base + (size_t)(ai * HALF + (m0 + mm) * 16) * 1024 + bj * HALF;
                    xq[(mm * 2 + bj) * 2] = *(const f32x4*)(X + off); xq[(mm * 2 + bj) * 2 + 1] = *(const f32x4*)(X + off + 4); }
            __builtin_amdgcn_sched_barrier(0);
#pragma unroll
            for (int mm = 0; mm < 2; ++mm)
#pragma unroll
                for (int bj = 0; bj < 2; ++bj) { const size_t off = base + (size_t)(ai * HALF + (m0 + mm) * 16) * 1024 + bj * HALF;
                    const f32x4 v0 = xq[(mm * 2 + bj) * 2] * ALPHA + acc[ai][bj][m0 + mm][0], v1 = xq[(mm * 2 + bj) * 2 + 1] * ALPHA + acc[ai][bj][m0 + mm][1];
                    *(f32x4*)(R + off) = v0; *(f32x4*)(R + off + 4) = v1;
                    *(u32x4*)(RB + off) = pack8(v0, v1); }
            __builtin_amdgcn_sched_barrier(0);
        }
    }
};
struct EpiBf {
    bf16_t* O;
    DI void operator()(const Acc& acc, const Unit& u, int wr, int wc, int fr, int fq) const {
        const int row0 = u.pm * BM + wr * 64 + fr, col0 = u.pn * BM + wc * 32 + 8 * fq;
#pragma unroll
        for (int ai = 0; ai < 2; ++ai)
#pragma unroll
            for (int m = 0; m < 4; ++m) { bf16_t* rowp = O + (size_t)(row0 + ai * HALF + m * 16) * 1024 + col0;
#pragma unroll
                for (int bj = 0; bj < 2; ++bj) *(u32x4*)(rowp + bj * HALF) = pack8(acc[ai][bj][m][0], acc[ai][bj][m][1]); }
    }
};
struct EpiR2 {
    float* R; const bf16_t* PP;
    DI void operator()(const Acc& acc, const Unit& u, int wr, int wc, int fr, int fq) const {
        const int row0 = u.pm * BM + wr * 64 + fr, col0 = u.pn * BM + wc * 32 + 8 * fq;
        const size_t base = (size_t)row0 * 1024 + col0;
#pragma unroll
        for (int hb = 0; hb < 4; ++hb) {
            const int ai = hb >> 1, m0 = (hb & 1) * 2;
            f32x4 rq[8]; u32x4 pq[4];
#pragma unroll
            for (int mm = 0; mm < 2; ++mm)
#pragma unroll
                for (int bj = 0; bj < 2; ++bj) { const size_t off = base + (size_t)(ai * HALF + (m0 + mm) * 16) * 1024 + bj * HALF;
                    pq[mm * 2 + bj] = *(const u32x4*)(PP + off); rq[(mm * 2 + bj) * 2] = *(const f32x4*)(R + off); rq[(mm * 2 + bj) * 2 + 1] = *(const f32x4*)(R + off + 4); }
            __builtin_amdgcn_sched_barrier(0);
#pragma unroll
            for (int mm = 0; mm < 2; ++mm)
#pragma unroll
                for (int bj = 0; bj < 2; ++bj) { const size_t off = base + (size_t)(ai * HALF + (m0 + mm) * 16) * 1024 + bj * HALF;
                    f32x4 p0, p1; unpack8(pq[mm * 2 + bj], p0, p1);
                    f32x4 r0 = rq[(mm * 2 + bj) * 2], r1 = rq[(mm * 2 + bj) * 2 + 1];
                    const f32x4 a0 = acc[ai][bj][m0 + mm][0], a1 = acc[ai][bj][m0 + mm][1];
#pragma unroll
                    for (int e = 0; e < 4; ++e) { r0[e] += sigm(a0[e]) * p0[e]; r1[e] += sigm(a1[e]) * p1[e]; }
                    *(f32x4*)(R + off) = r0; *(f32x4*)(R + off + 4) = r1; }
            __builtin_amdgcn_sched_barrier(0);
        }
    }
};
}

DI int crow(int r, int hi) { return (r & 3) + 8 * (r >> 2) + 4 * hi; }
DI s16x4 vtr(LAS const char* p) { typedef short v4i16_t __attribute__((ext_vector_type(4))); return __builtin_bit_cast(s16x4, __builtin_amdgcn_ds_read_tr16_b64_v4i16((LAS v4i16_t*)p)); }
constexpr int AT_SCR = 112 * 1024, AT_KM = 113 * 1024;
constexpr float NEGBIG = -1e30f;
DI float max3f(float a, float b, float c) { return fmaxf(fmaxf(a, b), c); }

template <int DQK, int KW, int DV, int NROWS, bool ALIBI, bool MOBA, bool PIPE, int NSET>
DI void attn_unit(LAS char* lds, const bf16_t* Qp, int ldq, const bf16_t* Kp, int ldk, const bf16_t* Vp, int ldv,
                  const bf16_t* Zp, int ldz, bf16_t* Yp, int ldy, int q0, float sl2, const float* kmp, float lam, const float* subg, float post) {
    constexpr int NTD = NROWS / 64, NS = DQK / 16, ND = DV / 32, PVG = (DV == 64) ? 2 : 1;
    constexpr int KPITCH = KW * 2 + 16, VPITCH = DV * 2 + 64;
    constexpr int KOFF0 = 0, VOFF0 = 3 * 64 * KPITCH;
    constexpr int KCH = KW / 8, VCH = DV / 8, NKC = 64 * KCH, NVC = 64 * VCH, KPT = (NKC + 511) / 512, VPT = (NVC + 511) / 512;
    static_assert(VOFF0 + 3 * 64 * VPITCH <= AT_SCR, "attention LDS map");
    const int tid = opaque_tid(), lane = tid & 63, r32 = lane & 31, hi = lane >> 5;
    const int wid = __builtin_amdgcn_readfirstlane(tid >> 6);
    const int ro = (NROWS == 256) ? 32 * wid : 32 * (wid & 3);
    const int map = (NROWS == 256) ? 0 : (wid >> 2);
    const int qpos = q0 + ro + r32;
    LAS float* scr = (LAS float*)(lds + AT_SCR) + wid * 32;

    bf16x8 qf[NS];
    { const bf16_t* qrow = Qp + (size_t)qpos * ldq + 64 * map + 8 * hi;
#pragma unroll
      for (int s = 0; s < NS; ++s) qf[s] = *(const bf16x8*)(qrow + 16 * s); }

    unsigned sel = 0xFFu;
    if (MOBA) {
        const int u = q0 >> 8;
        if (u > 3) {
            LAS float* km = (LAS float*)(lds + AT_KM);
            { const int j = tid >> 6, d = tid & 63; if (j < u) km[j * 64 + d] = (kmp[(size_t)(j * 2) * 512 + d] + kmp[(size_t)(j * 2 + 1) * 512 + d]) * (1.f / 256.f); }
            __syncthreads();
            float g[7];
#pragma unroll
            for (int j = 0; j < 7; ++j) { float a = 0.f;
                if (j < u) {
#pragma unroll
                    for (int s = 0; s < 4; ++s) { const f32x4 k0 = *(const LAS f32x4*)(km + j * 64 + 16 * s + 8 * hi), k1 = *(const LAS f32x4*)(km + j * 64 + 16 * s + 8 * hi + 4);
#pragma unroll
                        for (int e = 0; e < 4; ++e) { a += bf2f((bf16_t)qf[s][e]) * k0[e]; a += bf2f((bf16_t)qf[s][4 + e]) * k1[e]; } }
                }
                a += __shfl_xor(a, 32); g[j] = a; }
            sel = 0u;
#pragma unroll
            for (int k = 0; k < 3; ++k) { float best = -INFINITY; int bi = 0;
#pragma unroll
                for (int j = 0; j < 7; ++j) { const bool ok = (j < u) && !((sel >> j) & 1u) && (g[j] > best); best = ok ? g[j] : best; bi = ok ? j : bi; }
                sel |= 1u << bi; }
        }
    }

    f32x16 o[ND];
#pragma unroll
    for (int d0 = 0; d0 < ND; ++d0)
#pragma unroll
        for (int r = 0; r < 16; ++r) o[d0][r] = 0.f;
    f32x16 bias;
#pragma unroll
    for (int r = 0; r < 16; ++r) bias[r] = ALIBI ? sl2 * (float)((r & 3) + 8 * (r >> 2) + 4 * hi) : 0.f;
    const float d32 = ALIBI ? 32.f * sl2 : 0.f;
    float mrun = NEGBIG, lrun = 0.f;
    const int nt = NTD + (q0 >> 6);
    u32x4 kregA[KPT], vregA[VPT], kregB[KPT], vregB[VPT], kregC[KPT], vregC[VPT], kregD[KPT], vregD[VPT];
#define AT_TB(it) ((it) < NTD ? q0 + 64 * (it) : 64 * ((it) - NTD))
#define AT_LOAD(it, kreg, vreg) do { const int _ti = ((it) < nt) ? (it) : nt - 1; const int _kb = AT_TB(_ti); \
        _Pragma("unroll") for (int _i = 0; _i < KPT; ++_i) { const int _c = tid + 512 * _i; if (NKC % 512 == 0 || _i + 1 < KPT || _c < NKC) { const int _r = _c / KCH, _cc = _c % KCH; kreg[_i] = *(const u32x4*)(Kp + (size_t)(_kb + _r) * ldk + 8 * _cc); } } \
        _Pragma("unroll") for (int _i = 0; _i < VPT; ++_i) { const int _c = tid + 512 * _i; if (NVC % 512 == 0 || _i + 1 < VPT || _c < NVC) { const int _r = _c / VCH, _cc = _c % VCH; vreg[_i] = *(const u32x4*)(Vp + (size_t)(_kb + _r) * ldv + 8 * _cc); } } } while (0)
#define AT_STORE(buf, kreg, vreg) do { \
        _Pragma("unroll") for (int _i = 0; _i < KPT; ++_i) { const int _c = tid + 512 * _i; if (NKC % 512 == 0 || _i + 1 < KPT || _c < NKC) { const int _r = _c / KCH, _cc = _c % KCH; *(LAS u32x4*)(lds + KOFF0 + (buf) * 64 * KPITCH + _r * KPITCH + 16 * _cc) = kreg[_i]; } } \
        _Pragma("unroll") for (int _i = 0; _i < VPT; ++_i) { const int _c = tid + 512 * _i; if (NVC % 512 == 0 || _i + 1 < VPT || _c < NVC) { const int _r = _c / VCH, _cc = _c % VCH; *(LAS u32x4*)(lds + VOFF0 + (buf) * 64 * VPITCH + _r * VPITCH + 16 * _cc) = vreg[_i]; } } } while (0)
#define AT_ACTIVE(it) ((it) >= NTD || 64 * (it) <= ro + 31)
#define AT_QK(it, bufi, P0, P1) do { if (AT_ACTIVE(it)) { \
        LAS const char* _Kb = lds + KOFF0 + (bufi) * 64 * KPITCH + r32 * KPITCH + (64 * map + 8 * hi) * 2; \
        _Pragma("unroll") for (int _h = 0; _h < NS; _h += 4) { \
            bf16x8 _kf[8]; \
            _Pragma("unroll") for (int _s = 0; _s < 4; ++_s) if (_h + _s < NS) { _kf[2 * _s] = *(const LAS bf16x8*)(_Kb + 32 * (_h + _s)); _kf[2 * _s + 1] = *(const LAS bf16x8*)(_Kb + 32 * KPITCH + 32 * (_h + _s)); } \
            __builtin_amdgcn_sched_barrier(0); \
            _Pragma("unroll") for (int _s = 0; _s < 4; ++_s) if (_h + _s < NS) { \
                if (_h + _s == 0) { P0 = __builtin_amdgcn_mfma_f32_32x32x16_bf16(_kf[0], qf[0], bias, 0, 0, 0); P1 = __builtin_amdgcn_mfma_f32_32x32x16_bf16(_kf[1], qf[0], bias, 0, 0, 0); } \
                else { P0 = __builtin_amdgcn_mfma_f32_32x32x16_bf16(_kf[2 * _s], qf[_h + _s], P0, 0, 0, 0); P1 = __builtin_amdgcn_mfma_f32_32x32x16_bf16(_kf[2 * _s + 1], qf[_h + _s], P1, 0, 0, 0); } } \
            __builtin_amdgcn_sched_barrier(0); } } } while (0)
    if (NSET == 4) { AT_LOAD(0, kregA, vregA); AT_LOAD(1, kregB, vregB); AT_LOAD(2, kregC, vregC); AT_LOAD(3, kregD, vregD); AT_STORE(0, kregA, vregA); AT_STORE(1, kregB, vregB);
                     AT_LOAD(4, kregA, vregA); AT_LOAD(5, kregB, vregB); }
    else if (NSET == 2) { AT_LOAD(0, kregA, vregA); AT_LOAD(1, kregB, vregB); AT_STORE(0, kregA, vregA); AT_STORE(1, kregB, vregB); AT_LOAD(2, kregA, vregA); AT_LOAD(3, kregB, vregB); }
    else { AT_LOAD(0, kregA, vregA); AT_STORE(0, kregA, vregA); AT_LOAD(1, kregA, vregA); AT_STORE(1, kregA, vregA); AT_LOAD(2, kregA, vregA); }
    __syncthreads();
    const int i16 = lane & 15;
    const int vlane = (4 * hi + (i16 >> 2)) * VPITCH + (16 * ((lane >> 4) & 1) + 4 * (i16 & 3)) * 2;
    f32x16 pa0, pa1, pb0, pb1;
#pragma unroll
    for (int r = 0; r < 16; ++r) { pa0[r] = 0.f; pa1[r] = 0.f; pb0[r] = 0.f; pb1[r] = 0.f; }
    if (PIPE) AT_QK(0, 0, pa0, pa1);
    int bcur = 0;
#define AT_ITER(it, C0, C1, N0, N1, kreg, vreg) do { \
        const int _b1 = (bcur == 2) ? 0 : bcur + 1, _b2 = (_b1 == 2) ? 0 : _b1 + 1; \
        AT_STORE(_b2, kreg, vreg); \
        AT_LOAD((it) + 2 + NSET, kreg, vreg); \
        if (PIPE) { if ((it) + 1 < nt) AT_QK((it) + 1, _b1, N0, N1); } else AT_QK(it, bcur, C0, C1); \
        if (AT_ACTIVE(it)) { \
            LAS const char* _Vb = lds + VOFF0 + bcur * 64 * VPITCH + vlane; \
            bf16x8 _vf[4 * PVG];                      \
            _Pragma("unroll") for (int _e = 0; _e < PVG; ++_e) _Pragma("unroll") for (int _ks = 0; _ks < 4; ++_ks) { \
                const s16x4 _lo = vtr(_Vb + (16 * _ks) * VPITCH + 64 * _e), _hh = vtr(_Vb + (16 * _ks + 8) * VPITCH + 64 * _e); \
                _vf[4 * _e + _ks] = __builtin_shufflevector(_lo, _hh, 0, 1, 2, 3, 4, 5, 6, 7); } \
            __builtin_amdgcn_sched_barrier(0); \
            const int _kb = AT_TB(it); const bool _diag = (it) < NTD; \
            if (_diag) { const int _kq = _kb + 4 * hi - qpos; \
                _Pragma("unroll") for (int _r = 0; _r < 16; ++_r) { const int _dd = _kq + (_r & 3) + 8 * (_r >> 2); if (_dd > 0) C0[_r] = NEGBIG; if (_dd + 32 > 0) C1[_r] = NEGBIG; } } \
            float _m0 = max3f(C0[0], C0[1], C0[2]), _m1 = max3f(C1[0], C1[1], C1[2]); \
            _Pragma("unroll") for (int _r = 3; _r < 15; _r += 2) { _m0 = max3f(_m0, C0[_r], C0[_r + 1]); _m1 = max3f(_m1, C1[_r], C1[_r + 1]); } \
            _m0 = fmaxf(_m0, C0[15]); _m1 = fmaxf(_m1, C1[15]); \
            const float _c0 = ALIBI ? sl2 * (float)(_kb - qpos) : 0.f; \
            float _mx = fmaxf(_m0, _m1 + d32) + _c0; \
            bool _selok = true; if (MOBA && !_diag) _selok = ((sel >> (_kb >> 8)) & 1u) != 0u; \
            if (!_selok) _mx = NEGBIG; \
            { const auto _rr = __builtin_amdgcn_permlane32_swap(__float_as_uint(_mx), __float_as_uint(_mx), false, false); _mx = fmaxf(__uint_as_float(_rr[0]), __uint_as_float(_rr[1])); }     \
            const float _mn = fmaxf(mrun, _mx); \
            if (__any(_mn - mrun > 8.f)) { \
                const float _alpha = __builtin_amdgcn_exp2f(mrun - _mn); lrun *= _alpha; mrun = _mn; \
                scr[r32] = _alpha; \
                asm volatile("s_waitcnt lgkmcnt(0)" ::: "memory"); \
                f32x4 _a4[4]; \
                _Pragma("unroll") for (int _g = 0; _g < 4; ++_g) _a4[_g] = *(const LAS f32x4*)(scr + 8 * _g + 4 * hi); \
                asm volatile("s_waitcnt lgkmcnt(0)" ::: "memory"); \
                _Pragma("unroll") for (int _d0 = 0; _d0 < ND; ++_d0) _Pragma("unroll") for (int _r = 0; _r < 16; ++_r) o[_d0][_r] *= _a4[_r >> 2][_r & 3]; \
            } \
            const float _ms0 = _selok ? (mrun - _c0) : INFINITY, _ms1 = _ms0 - d32; \
            float _ls = 0.f; \
            _Pragma("unroll") for (int _r = 0; _r < 16; ++_r) { C0[_r] = __builtin_amdgcn_exp2f(C0[_r] - _ms0); C1[_r] = __builtin_amdgcn_exp2f(C1[_r] - _ms1); _ls += C0[_r] + C1[_r]; } \
            lrun += _ls; \
            bf16x8 _pa[4]; \
            _Pragma("unroll") for (int _ks = 0; _ks < 2; ++_ks) { u32x4 _w; \
                _w.x = pk2(C0[8 * _ks], C0[8 * _ks + 1]); _w.y = pk2(C0[8 * _ks + 2], C0[8 * _ks + 3]); _w.z = pk2(C0[8 * _ks + 4], C0[8 * _ks + 5]); _w.w = pk2(C0[8 * _ks + 6], C0[8 * _ks + 7]); \
                _pa[_ks] = __builtin_bit_cast(bf16x8, _w); \
                _w.x = pk2(C1[8 * _ks], C1[8 * _ks + 1]); _w.y = pk2(C1[8 * _ks + 2], C1[8 * _ks + 3]); _w.z = pk2(C1[8 * _ks + 4], C1[8 * _ks + 5]); _w.w = pk2(C1[8 * _ks + 6], C1[8 * _ks + 7]); \
                _pa[2 + _ks] = __builtin_bit_cast(bf16x8, _w); } \
            _Pragma("unroll") for (int _d0 = 0; _d0 < ND; _d0 += PVG) { \
                if (_d0 > 0) { \
                    _Pragma("unroll") for (int _e = 0; _e < PVG; ++_e) _Pragma("unroll") for (int _ks = 0; _ks < 4; ++_ks) { \
                        const s16x4 _lo = vtr(_Vb + (16 * _ks) * VPITCH + 64 * (_d0 + _e)), _hh = vtr(_Vb + (16 * _ks + 8) * VPITCH + 64 * (_d0 + _e)); \
                        _vf[4 * _e + _ks] = __builtin_shufflevector(_lo, _hh, 0, 1, 2, 3, 4, 5, 6, 7); } \
                    __builtin_amdgcn_sched_barrier(0); } \
                _Pragma("unroll") for (int _ks = 0; _ks < 4; ++_ks) _Pragma("unroll") for (int _e = 0; _e < PVG; ++_e) \
                    o[_d0 + _e] = __builtin_amdgcn_mfma_f32_32x32x16_bf16(_pa[_ks], _vf[4 * _e + _ks], o[_d0 + _e], 0, 0, 0); \
                __builtin_amdgcn_sched_barrier(0); } \
        } \
        bcur = _b1; \
        asm volatile("s_waitcnt lgkmcnt(0)\n\ts_barrier" ::: "memory"); } while (0)
    if (NSET == 4) {
        for (int it = 0; it < nt; it += 4) {
            AT_ITER(it, pa0, pa1, pb0, pb1, kregC, vregC);
            AT_ITER(it + 1, pb0, pb1, pa0, pa1, kregD, vregD);
            AT_ITER(it + 2, pa0, pa1, pb0, pb1, kregA, vregA);
            AT_ITER(it + 3, pb0, pb1, pa0, pa1, kregB, vregB);
        }
    } else {
        for (int it = 0; it < nt; it += 2) {
            AT_ITER(it, pa0, pa1, pb0, pb1, kregA, vregA);
            if (NSET == 2) AT_ITER(it + 1, pb0, pb1, pa0, pa1, kregB, vregB); else AT_ITER(it + 1, pb0, pb1, pa0, pa1, kregA, vregA);
        }
    }
#undef AT_TB
#undef AT_LOAD
#undef AT_STORE
#undef AT_ACTIVE
#undef AT_QK
#undef AT_ITER
    {
        const float lt = lrun + __shfl_xor(lrun, 32);
        scr[r32] = 1.f / lt;
        asm volatile("s_waitcnt lgkmcnt(0)" ::: "memory");
        f32x4 a4[4];
#pragma unroll
        for (int g = 0; g < 4; ++g) a4[g] = *(const LAS f32x4*)(scr + 8 * g + 4 * hi);
        asm volatile("s_waitcnt lgkmcnt(0)" ::: "memory");
#pragma unroll
        for (int d0 = 0; d0 < ND; ++d0)
#pragma unroll
            for (int r = 0; r < 16; ++r) o[d0][r] *= a4[r >> 2][r & 3];
    }
    if (NROWS == 256) {
#pragma unroll
        for (int d0 = 0; d0 < ND; ++d0)
#pragma unroll
            for (int r = 0; r < 16; ++r) { const size_t row = (size_t)(q0 + ro + crow(r, hi)); const int col = 32 * d0 + r32;
                const float z = bf2f(Zp[row * ldz + col]); Yp[row * ldy + col] = f2bf(o[d0][r] * silu(z)); }
    } else {
        LAS float* xch = (LAS float*)lds;
        if (map == 1) {
#pragma unroll
            for (int d0 = 0; d0 < ND; ++d0)
#pragma unroll
                for (int r = 0; r < 16; ++r) xch[(((wid & 3) * ND + d0) * 16 + r) * 64 + lane] = o[d0][r];
        }
        __syncthreads();
        if (map == 0) {
#pragma unroll
            for (int d0 = 0; d0 < ND; ++d0)
#pragma unroll
                for (int r = 0; r < 16; ++r) o[d0][r] -= lam * xch[(((wid & 3) * ND + d0) * 16 + r) * 64 + lane];
#pragma unroll
            for (int r = 0; r < 16; ++r) { float ss = 0.f;
#pragma unroll
                for (int d0 = 0; d0 < ND; ++d0) ss += o[d0][r] * o[d0][r];
                ss += __shfl_xor(ss, 1); ss += __shfl_xor(ss, 2); ss += __shfl_xor(ss, 4); ss += __shfl_xor(ss, 8); ss += __shfl_xor(ss, 16);
                const float rs = __builtin_amdgcn_rsqf(ss * (1.f / (float)DV) + 1e-5f) * post;
                const size_t row = (size_t)(q0 + ro + crow(r, hi));
#pragma unroll
                for (int d0 = 0; d0 < ND; ++d0) { const int col = 32 * d0 + r32; const float z = bf2f(Zp[row * ldz + col]);
                    Yp[row * ldy + col] = f2bf(o[d0][r] * rs * subg[col] * silu(z)); } }
        }
        __syncthreads();
    }
}

#define XB_TMO      128
#define XB_XCNT(j)  (256  + 64 * (j))
#define XB_XSUB(j)  (1280 + 64 * (j))
#define XB_XGEN(j)  (2304 + 64 * (j))
#define XB_TOP      3328
#define XB_TOPGEN   3392
#define XCD_BAR_WORDS 3456
#define XB_SPIN_CAP (1u << 22)
DI unsigned xb_ld(unsigned* p)              { return __hip_atomic_load(p, __ATOMIC_RELAXED, __HIP_MEMORY_SCOPE_AGENT); }
DI unsigned xb_add(unsigned* p, unsigned v) { return __hip_atomic_fetch_add(p, v, __ATOMIC_RELAXED, __HIP_MEMORY_SCOPE_AGENT); }
DI unsigned xb_xcc_id() { return (unsigned)__builtin_amdgcn_s_getreg((3 << 11) | 20) & 0xFu; }
#define XB_SPIN(cond, bar) do { unsigned _sp = 0; while (cond) { __builtin_amdgcn_s_sleep(1); \
    if ((++_sp & 255u) == 0u) { if (xb_ld(&(bar)[XB_TMO])) break; if (_sp > XB_SPIN_CAP) { atomicAdd(&(bar)[XB_TMO], 1u); break; } } } } while (0)
DI void xcd_barrier_complete(unsigned* bar, unsigned x, unsigned& nloc, unsigned& nx) {
    const unsigned Gn = gridDim.x;
    unsigned sum, cnt, mine, sp = 0u;
    for (;;) {
        sum = 0u; cnt = 0u; mine = 0u;
#pragma unroll
        for (unsigned j = 0; j < 16; ++j) { const unsigned c = xb_ld(&bar[XB_XCNT(j)]); sum += c; cnt += (c > 0u) ? 1u : 0u; mine = (j == x) ? c : mine; }
        if (sum == Gn) break;
        __builtin_amdgcn_s_sleep(1);
        if ((++sp & 255u) == 0u) { if (xb_ld(&bar[XB_TMO])) break; if (sp > XB_SPIN_CAP) { atomicAdd(&bar[XB_TMO], 1u); break; } }
    }
    nloc = mine > 0u ? mine : 1u; nx = cnt > 0u ? cnt : 1u;
}
DI void xcd_barrier(unsigned* bar, volatile LAS unsigned* st) {
    asm volatile("s_waitcnt vmcnt(0)" ::: "memory");
    __syncthreads();
    if (threadIdx.x == 0) {
        __builtin_amdgcn_s_waitcnt(0);
        const unsigned x = xb_xcc_id();
        unsigned nloc = st[0], nx = st[1];
        if (nloc == 0u) { xcd_barrier_complete(bar, x, nloc, nx); st[0] = nloc; st[1] = nx; }
        const unsigned old = xb_add(&bar[XB_XSUB(x)], 1u);
        const unsigned gen = old / nloc;
        if (old + 1u == (gen + 1u) * nloc) {
            __builtin_amdgcn_fence(__ATOMIC_RELEASE, "agent");
            asm volatile("s_waitcnt vmcnt(0)" ::: "memory");
            const unsigned og = xb_add(&bar[XB_TOP], 1u);
            const unsigned tg = og / nx;
            if (og + 1u == (tg + 1u) * nx) xb_add(&bar[XB_TOPGEN], 1u);
            else XB_SPIN(xb_ld(&bar[XB_TOPGEN]) == tg, bar);
            __builtin_amdgcn_fence(__ATOMIC_ACQUIRE, "agent");
            xb_add(&bar[XB_XGEN(x)], 1u);
            asm volatile("s_waitcnt vmcnt(0)" ::: "memory");
        } else {
            XB_SPIN(xb_ld(&bar[XB_XGEN(x)]) == gen, bar);
            __builtin_amdgcn_fence(__ATOMIC_ACQUIRE, "agent");
            asm volatile("s_waitcnt vmcnt(0)" ::: "memory");
        }
    }
    __syncthreads();
}

struct Params { const float* in[19]; float* out; unsigned char* ws; };

DI void colmap(int kind, int n, int& col, float& cs) {
    cs = 1.f;
    if (kind == 0) {
        if (n < 2048) { col = n; if (n < 512) cs = QS64; }
        else if (n < 2560) col = 2720 + (n - 2048);
        else if (n < 3072) { col = 3232 + (n - 2560); cs = QS64; }
        else if (n < 3584) col = 3744 + (n - 3072);
        else if (n < 4096) col = 4256 + (n - 3584);
        else if (n < 4608) col = 4768 + (n - 4096);
        else if (n < 4864) col = 2432 + (n - 4608);
        else if (n < 5248) col = 2048 + (n - 4864);
        else if (n < 5280) { const int j = n - 5248; col = 2688 + (j >> 1) + 16 * (j & 1); }
        else col = -1;
    } else if (kind == 1) col = n;
    else if (kind == 2) { const int h = n / 96, j = n % 96; if (j < 64) col = h * 96 + j; else { const int jj = j - 64; col = h * 96 + 64 + (jj >> 1) + 16 * (jj & 1); } }
    else { if (n < 512) col = (n >> 6) * 128 + (n & 63); else { const int m = n - 512; col = (m >> 6) * 128 + 64 + (m & 63); } }
}
DI void tr_tile(const float* src, int srcN, int K, bf16_t* dst, int kind, int n0, int k0, const float* kscale, LAS float* scr, int tid) {
    { const int nl = tid & 127, kl0 = tid >> 7; int col; float cs; colmap(kind, n0 + nl, col, cs);
      float v[16];
#pragma unroll
      for (int i = 0; i < 16; ++i) { const int kl = kl0 + 4 * i; v[i] = (col >= 0) ? src[(size_t)(k0 + kl) * srcN + col] : 0.f; }
#pragma unroll
      for (int i = 0; i < 16; ++i) { const int kl = kl0 + 4 * i; float w = v[i] * cs; if (kscale) w *= kscale[k0 + kl]; scr[kl * 129 + nl] = w; } }
    __syncthreads();
    { const int kp = tid & 31;
#pragma unroll
      for (int i = 0; i < 8; ++i) { const int nl = (tid >> 5) + 16 * i;
          *(unsigned*)(dst + (size_t)(n0 + nl) * K + k0 + 2 * kp) = pk2(scr[(2 * kp) * 129 + nl], scr[(2 * kp + 1) * 129 + nl]); } }
    __syncthreads();
}
typedef const __attribute__((address_space(4))) Params* KParams0;
DI void convert_weights(KParams0 Pk, int l, bf16_t* WT, LAS float* scr) {
    const int tid = opaque_tid();
    constexpr int T0 = 42 * 16, T1 = T0 + 24 * 16, T2 = T1 + 6 * 6, T3 = T2 + 8 * 4, T4 = T3 + 8 * 8, T5 = T4 + 8 * 8, T6 = T5 + 8 * 8, T7 = T6 + 8 * 16, T8 = T7 + 8 * 16, T9 = T8 + 8 * 4;
    for (int t = blockIdx.x; t < T9; t += gridDim.x) {
        const float* src; int srcN, K, kind, loc; bf16_t* dst; const float* ks = nullptr;
        if (t < T0) { src = Pk->in[2] + (size_t)l * 1024 * 5280; srcN = 5280; K = 1024; kind = 0; loc = t; dst = WT + OFF_WIN; }
        else if (t < T1) { src = Pk->in[12] + (size_t)l * 1024 * 3072; srcN = 3072; K = 1024; kind = 1; loc = t - T0; dst = WT + OFF_WIN + (size_t)5376 * 1024; }
        else if (t < T2) { src = Pk->in[5] + (size_t)l * 384 * 768; srcN = 768; K = 384; kind = 2; loc = t - T1; dst = WT + OFF_WUQ; ks = Pk->in[3] + l * 384; }
        else if (t < T3) { src = Pk->in[6] + (size_t)l * 256 * 1024; srcN = 1024; K = 256; kind = 3; loc = t - T2; dst = WT + OFF_WUKV; ks = Pk->in[4] + l * 256; }
        else if (t < T4) { src = Pk->in[9] + (size_t)l * 512 * 1024; srcN = 1024; K = 512; kind = 1; loc = t - T3; dst = WT + OFF_WABC; }
        else if (t < T5) { src = Pk->in[10] + (size_t)l * 512 * 1024; srcN = 1024; K = 512; kind = 1; loc = t - T4; dst = WT + OFF_WABC + (size_t)1024 * 512; }
        else if (t < T6) { src = Pk->in[11] + (size_t)l * 512 * 1024; srcN = 1024; K = 512; kind = 1; loc = t - T5; dst = WT + OFF_WABC + (size_t)2048 * 512; }
        else if (t < T7) { src = Pk->in[14] + (size_t)l * 1024 * 1024; srcN = 1024; K = 1024; kind = 1; loc = t - T6; dst = WT + OFF_WO; }
        else if (t < T8) { src = Pk->in[17] + (size_t)l * 1024 * 1024; srcN = 1024; K = 1024; kind = 1; loc = t - T7; dst = WT + OFF_WPG; }
        else { src = Pk->in[18] + (size_t)l * 256 * 1024; srcN = 1024; K = 256; kind = 1; loc = t - T8; dst = WT + OFF_WP; }
        const int kt = K / 64; const int n0 = (loc / kt) * 128, k0 = (loc % kt) * 64;
        tr_tile(src, srcN, K, dst, kind, n0, k0, ks, scr, tid);
    }
}
DI void convert_rows(const float* src, bf16_t* dst, size_t n) {
    const size_t stride = (size_t)gridDim.x * blockDim.x, ng = n / 8;
    for (size_t i = (size_t)blockIdx.x * blockDim.x + opaque_tid(); i < ng; i += 4 * stride) {
        f32x4 a[4], b[4];
#pragma unroll
        for (int j = 0; j < 4; ++j) { const size_t q = i + j * stride; if (q < ng) { a[j] = *(const f32x4*)(src + q * 8); b[j] = *(const f32x4*)(src + q * 8 + 4); } }
#pragma unroll
        for (int j = 0; j < 4; ++j) { const size_t q = i + j * stride; if (q < ng) *(u32x4*)(dst + q * 8) = pack8(a[j], b[j]); }
    }
}
typedef const __attribute__((address_space(4))) Params* KParams;
DI KParams kparams() { KParams p = (KParams)__builtin_amdgcn_kernarg_segment_ptr(); asm volatile("" : "+s"(p)); return p; }
DI unsigned char* wsbase() { unsigned char* w = kparams()->ws; asm volatile("" : "+s"(w)); return w; }

__global__ void __launch_bounds__(512, 2) fwd_megakernel(Params Punused) {
    extern __shared__ __attribute__((aligned(16))) unsigned char lds_raw[];
    cg::grid_group grid = cg::this_grid();
    LAS unsigned char* lds = (LAS unsigned char*)lds_raw;
#define G opaque_s((int)gridDim.x)
#define cu opaque_s((int)blockIdx.x)
#define XB_  ((bf16_t*)(ws + WS_XB))
#define WT_  ((bf16_t*)(ws + WS_WT))
#define PB_  ((bf16_t*)(ws + WS_PB))
#define Y_   ((bf16_t*)(ws + WS_Y))
#define H_   ((bf16_t*)(ws + WS_H))
#define QB_  ((bf16_t*)(ws + WS_MLA))
#define KB_  (QB_ + (size_t)HM * 768)
#define VB_  (KB_ + (size_t)HM * 768)
#define R_   ((float*)(ws + WS_H))
#define ROPE_ ((float*)(ws + CTL_ROPE))
#define KMP_ ((float*)(ws + CTL_KMP))
#define STQ_ ((float*)(ws + CTL_STQ))
#define STKV_ ((float*)(ws + CTL_STKV))

    if (threadIdx.x < 2) ((volatile LAS unsigned*)(lds + LDS_IDX + 64))[threadIdx.x] = 0u;
    {
        const int tid = opaque_tid();
        KParams P = kparams(); unsigned char* ws = P->ws;
        for (int rep = 0; rep < REP_P0; ++rep) {
        convert_weights(P, 0, WT_, (LAS float*)lds);
        convert_rows(P->in[0], XB_, (size_t)M * D);
        convert_rows(P->in[1], PB_, (size_t)M * 256); }
        float* rope = ROPE_;
        for (int i = cu * 512 + tid; i < SEQ * 16; i += G * 512) {
            const int pos = i >> 4, k = i & 15;
            const float freq = __builtin_amdgcn_exp2f(-(float)k * (13.287712379549449f / 16.f));
            const float ang = (float)pos * freq;
            double rev = (double)ang * 0.15915494309189535; rev -= __builtin_rint(rev);
            const float fr = (float)rev;
            rope[2 * i] = __builtin_amdgcn_cosf(fr); rope[2 * i + 1] = __builtin_amdgcn_sinf(fr);
        }
        if (cu == 0) {
            unsigned* ctl = (unsigned*)(ws + WS_CTL); float* lamv = (float*)(ws + CTL_LAM);
            if (tid < 64) {
#pragma unroll
                for (int l = 0; l < 2; ++l) { const float* dl = P->in[7] + l * 256; float a = dl[tid] * dl[64 + tid], b = dl[128 + tid] * dl[192 + tid];
#pragma unroll
                    for (int s = 1; s < 64; s <<= 1) { a += __shfl_xor(a, s); b += __shfl_xor(b, s); }
                    const float li = (l == 0) ? 0.2f : 0.35550906759096924f;
                    if (tid == 0) lamv[l] = __builtin_amdgcn_exp2f(a * LOG2E) - __builtin_amdgcn_exp2f(b * LOG2E) + li; }
            }
            if (tid < 64) ctl[tid] = 0u;
            if (tid < 128) ((unsigned*)(ws + CTL_DEP))[tid] = 0u;
            { unsigned* bw = (unsigned*)(ws + CTL_BAR); for (int i = tid; i < XCD_BAR_WORDS; i += 512) bw[i] = 0u; }
        }
    }
    grid.sync();
    if (threadIdx.x == 0) { unsigned char* ws = wsbase(); (void)xb_add(&((unsigned*)(ws + CTL_BAR))[XB_XCNT(xb_xcc_id())], 1u); }
#define GSYNC() do { unsigned char* _w = wsbase(); xcd_barrier((unsigned*)(_w + CTL_BAR), (volatile LAS unsigned*)(lds + LDS_IDX + 64)); } while (0)

    for (int l = 0; l < 2; ++l) {
        for (int hf = 0; hf < 2; ++hf) {
            for (int rep = 0; rep < REP_P1; ++rep)
            { unsigned char* ws = wsbase();
              pg8::Gemm g{XB_ + (size_t)hf * HM * D, WT_ + OFF_WIN, D, D}; pg8::P1Order S{G, cu};
              pg8::EpiH E{H_, KB_, KMP_ + (size_t)hf * 32 * 2 * 512, STQ_ + (size_t)hf * HM * 8, STKV_ + (size_t)hf * HM * 4, ROPE_, (unsigned*)(ws + CTL_DEP) + (l * 2 + hf) * 32};
              pg8::gemm_phase(lds, g, S, E); }
            {
                const int Gn = G, rem = 672 % Gn, NE = Gn - rem, e = cu - rem;
                pg8::ListOrder Sq{0, (e >= 0) ? 96 : 0, 3, (e >= 0) ? e : 0, NE}, Skv{96, (e >= 0) ? 224 : 96, 4, (e >= 0) ? e : 0, NE};
                if (opaque_tid() == 0) {
                    unsigned char* ws = wsbase(); unsigned* dep = (unsigned*)(ws + CTL_DEP) + (l * 2 + hf) * 32; pg8::Unit u;
                    for (int pass = 0; pass < 2; ++pass)
                        for (int i = 0; pass == 0 ? Sq.next(i, u) : Skv.next(i, u); ++i) {
                            unsigned sp = 0;
                            while (__hip_atomic_load(dep + u.pm, __ATOMIC_RELAXED, __HIP_MEMORY_SCOPE_AGENT) < 24u) { __builtin_amdgcn_s_sleep(2); if (++sp > (1u << 24)) break; }
                        }
                    __builtin_amdgcn_fence(__ATOMIC_ACQUIRE, "agent");
                    asm volatile("s_waitcnt vmcnt(0)" ::: "memory");
                }
                __syncthreads();
                { unsigned char* ws = wsbase();
                  pg8::Gemm g{H_ + C_CQL, WT_ + OFF_WUQ, HP, 384};
                  pg8::EpiUp<0> E{QB_, KB_, VB_, STQ_ + (size_t)hf * HM * 8, ROPE_}; pg8::gemm_phase(lds, g, Sq, E); }
                { unsigned char* ws = wsbase();
                  pg8::Gemm g{H_ + C_CKV, WT_ + OFF_WUKV, HP, 256};
                  pg8::EpiUp<1> E{QB_, KB_, VB_, STKV_ + (size_t)hf * HM * 4, ROPE_}; pg8::gemm_phase(lds, g, Skv, E); }
            }
            GSYNC();
            {
                for (int vcu = cu; vcu < 256; vcu += G)
                for (int step = 0; ; ++step) {
                    KParams P = kparams(); unsigned char* ws = P->ws;
                    const int x = vcu & 7, sl_ = vcu >> 3;
                    int type, u, bh;
                    if (step < 2) {
                        if (sl_ < 16) { type = 2; bh = 2 * x + (sl_ >> 3); const int j = sl_ & 7; u = (step == 0) ? 15 - j : j; }
                        else { const int t = sl_ - 16; bh = 4 * x + (t >> 2); type = step; u = 7 - (t & 3); }
                    } else {
                        if (opaque_tid() == 0) *(LAS int*)(lds + LDS_IDX) = (int)atomicAdd((unsigned*)(ws + WS_CTL) + 16 + (l * 2 + hf) * 8 + x, 1u);
                        __syncthreads();
                        const int k = *(LAS int*)(lds + LDS_IDX);
                        __syncthreads();
                        if (k >= 32) break;
                        u = 3 - (k >> 3); type = (k & 4) ? 0 : 1; bh = 4 * x + (k & 3);
                    }
                    if (type == 0) {
                        const int bl = bh >> 3, h = bh & 7, bg = 4 * hf + bl; const size_t ho = (size_t)bh * SEQ * 64;
                        const float sl = __builtin_amdgcn_exp2f(-(2.f / 3.f) * (float)(h + (h >> 1) + 2)) * LOG2E;
                        attn_unit<64, 64, 64, 256, true, true, true, 2>((LAS char*)lds, H_ + HM_AQ + ho, 64, H_ + HM_AK + ho, 64, H_ + HM_AV + ho, 64,
                            H_ + (size_t)bl * SEQ * HP + C_AZ + h * 64, HP,
                            Y_ + (size_t)bg * SEQ * 512 + h * 64, 512, u * 256, sl, KMP_ + (size_t)bg * 8 * 2 * 512 + h * 64, 0.f, nullptr, 1.f);
                    } else if (type == 1) {
                        const int bl = bh >> 3, h = bh & 7, bg = 4 * hf + bl;
                        attn_unit<96, 96, 64, 256, false, false, true, 2>((LAS char*)lds, QB_ + (size_t)bh * SEQ * 96, 96, KB_ + (size_t)bh * SEQ * 96, 96,
                            VB_ + (size_t)bh * SEQ * 64, 64, H_ + (size_t)bl * SEQ * HP + C_BZ + h * 64, HP,
                            Y_ + (size_t)M * 512 + (size_t)bg * SEQ * 512 + h * 64, 512, u * 256, 0.f, nullptr, 0.f, nullptr, 1.f);
                    } else {
                        const int bl = bh >> 2, h = bh & 3, bg = 4 * hf + bl; const size_t ho = (size_t)bh * SEQ * 128;
                        const float sl = __builtin_amdgcn_exp2f(-(2.f / 3.f) * (float)(3 * h + 1)) * LOG2E;
                        const float lam = ((const float*)(ws + CTL_LAM))[l];
                        const float post = (l == 0) ? 0.8f : (1.f - 0.35550906759096924f);
                        attn_unit<64, 128, 128, 128, true, false, false, 1>((LAS char*)lds, H_ + HM_CQ + ho, 128, H_ + HM_CK + ho, 128, H_ + HM_CV + ho, 128,
                            H_ + (size_t)bl * SEQ * HP + C_CZ + h * 128, HP,
                            Y_ + (size_t)2 * M * 512 + (size_t)bg * SEQ * 512 + h * 128, 512, u * 128, sl, nullptr, lam, P->in[8] + l * 128, post);
                    }
                }
            }
            GSYNC();
        }
        { KParams P = kparams(); unsigned char* ws = P->ws;
          pg8::Gemm g{XB_, WT_ + OFF_WIN + (size_t)5376 * 1024, D, D}; pg8::StaticOrder S; S.init(M, 3072, G, cu);
          pg8::EpiG E{H_, P->in[13] + l * 3072}; pg8::gemm_phase(lds, g, S, E); }
        GSYNC();
        { unsigned char* ws = wsbase();
          pg8::Gemm g{Y_, WT_ + OFF_WABC, 512, 512}; pg8::MergeOrder S{cu, G};
          pg8::EpiMerge E{H_, XB_}; pg8::gemm_phase(lds, g, S, E); }
        GSYNC();
        { KParams P = kparams(); unsigned char* ws = P->ws;
          pg8::Gemm g{XB_, WT_ + OFF_WO, D, D}; pg8::StaticOrder S; S.init(M, D, G, cu);
          pg8::EpiR E{(l == 0) ? P->in[0] : (const float*)P->out, R_, Y_}; pg8::gemm_phase(lds, g, S, E); }
        GSYNC();
        { unsigned char* ws = wsbase();
          pg8::Gemm g{PB_, WT_ + OFF_WP, 256, 256}; pg8::StaticOrder S; S.init(M, D, G, cu);
          pg8::EpiBf E{XB_}; pg8::gemm_phase(lds, g, S, E); }
        { unsigned char* ws = wsbase();
          pg8::Gemm g{Y_, WT_ + OFF_WPG, D, D}; pg8::StaticOrder S; S.init(M, D, G, cu);
          pg8::EpiR2 E{R_, XB_}; pg8::gemm_phase(lds, g, S, E); }
        GSYNC();
        {
            KParams P = kparams(); unsigned char* ws = P->ws;
            const int tid = opaque_tid(), lane = tid & 63, wid = tid >> 6;
            const float* lg = P->in[15] + l * 1024; const float* lb = P->in[16] + l * 1024;
            float* outp = P->out; const float* R = R_; bf16_t* XB = XB_;
            const int gstep = (int)gridDim.x * 8;
            for (int row = (int)blockIdx.x * 8 + wid; row < M; row += 2 * gstep) {
                const bool two = row + gstep < M;
                const float* rp0 = R + (size_t)row * 1024; const float* rp1 = R + (size_t)(two ? row + gstep : row) * 1024;
                f32x4 v[2][4]; float s0 = 0.f, s1 = 0.f;
#pragma unroll
                for (int j = 0; j < 4; ++j) { v[0][j] = *(const f32x4*)(rp0 + 4 * lane + 256 * j); v[1][j] = *(const f32x4*)(rp1 + 4 * lane + 256 * j); }
#pragma unroll
                for (int j = 0; j < 4; ++j) { s0 += (v[0][j][0] + v[0][j][1]) + (v[0][j][2] + v[0][j][3]); s1 += (v[1][j][0] + v[1][j][1]) + (v[1][j][2] + v[1][j][3]); }
#pragma unroll
                for (int k = 1; k < 64; k <<= 1) { s0 += __shfl_xor(s0, k); s1 += __shfl_xor(s1, k); }
                const float mu0 = s0 * (1.f / 1024.f), mu1 = s1 * (1.f / 1024.f); float q0 = 0.f, q1 = 0.f;
#pragma unroll
                for (int j = 0; j < 4; ++j) { v[0][j] -= mu0; v[1][j] -= mu1;
                    q0 += (v[0][j][0] * v[0][j][0] + v[0][j][1] * v[0][j][1]) + (v[0][j][2] * v[0][j][2] + v[0][j][3] * v[0][j][3]);
                    q1 += (v[1][j][0] * v[1][j][0] + v[1][j][1] * v[1][j][1]) + (v[1][j][2] * v[1][j][2] + v[1][j][3] * v[1][j][3]); }
#pragma unroll
                for (int k = 1; k < 64; k <<= 1) { q0 += __shfl_xor(q0, k); q1 += __shfl_xor(q1, k); }
                const float rs0 = __builtin_amdgcn_rsqf(q0 * (1.f / 1024.f) + 1e-5f), rs1 = __builtin_amdgcn_rsqf(q1 * (1.f / 1024.f) + 1e-5f);
#pragma unroll
                for (int j = 0; j < 4; ++j) { const f32x4 gv = *(const f32x4*)(lg + 4 * lane + 256 * j), bv = *(const f32x4*)(lb + 4 * lane + 256 * j);
#pragma unroll
                    for (int t = 0; t < 2; ++t) { if (t == 1 && !two) break;
                        const size_t rr = (size_t)(t == 0 ? row : row + gstep);
                        const f32x4 y = v[t][j] * (t == 0 ? rs0 : rs1) * gv + bv;
                        *(f32x4*)(outp + rr * 1024 + 4 * lane + 256 * j) = y;
                        if (l == 0) { u32x2 w; w.x = pk2(y[0], y[1]); w.y = pk2(y[2], y[3]); *(u32x2*)(XB + rr * 1024 + 4 * lane + 256 * j) = w; } } }
            }
            if (l == 0) {
                __syncthreads();
                convert_weights(P, 1, WT_, (LAS float*)lds);
                convert_rows(P->in[1] + (size_t)M * 256, PB_, (size_t)M * 256);
            }
        }
        if (l == 0) GSYNC();
    }
}

#undef G
#undef cu
extern "C" void kernel_launch(void* const* d_in, const int* in_sizes, int n_in, void* d_out, int out_size, void* d_ws, size_t ws_size, hipStream_t stream) {
    static int grid_blocks = 0;
    if (grid_blocks == 0) {
        if (n_in != 19 || out_size != M * D || ws_size < WS_END) { fprintf(stderr, "kernel_launch: unexpected problem (n_in %d out %d ws %zu)\n", n_in, out_size, ws_size); grid_blocks = -1; return; }
        int dev = 0, cus = 0, per_cu = 0;
        hipGetDevice(&dev);
        hipDeviceGetAttribute(&cus, hipDeviceAttributeMultiprocessorCount, dev);
        if (hipFuncSetAttribute((const void*)fwd_megakernel, hipFuncAttributeMaxDynamicSharedMemorySize, LDS_BYTES) != hipSuccess) { fprintf(stderr, "kernel_launch: hipFuncSetAttribute failed\n"); grid_blocks = -1; return; }
        if (hipOccupancyMaxActiveBlocksPerMultiprocessor(&per_cu, (const void*)fwd_megakernel, 512, LDS_BYTES) != hipSuccess || per_cu < 1) { fprintf(stderr, "kernel_launch: occupancy query failed (%d)\n", per_cu); grid_blocks = -1; return; }
        grid_blocks = cus * per_cu;
        if (grid_blocks > 256) grid_blocks = 256;
    }
    if (grid_blocks < 0) return;
    Params p{};
    for (int i = 0; i < 19; ++i) p.in[i] = (const float*)d_in[i];
    p.out = (float*)d_out; p.ws = (unsigned char*)d_ws;
    void* args[] = {&p};
    hipError_t e = hipLaunchCooperativeKernel((const void*)fwd_megakernel, dim3(grid_blocks), dim3(512), args, LDS_BYTES, stream);
    if (e != hipSuccess) fprintf(stderr, "cooperative launch failed: %s (grid %d)\n", hipGetErrorString(e), grid_blocks);
}
```

```cpp
#include <hip/hip_runtime.h>
#include <hip/hip_cooperative_groups.h>
#include <cstdio>
#include <cstdint>
namespace cg = cooperative_groups;
#ifndef REP_ATT
#define REP_ATT 1
#endif
#ifndef REP_P1
#define REP_P1 1
#endif
#ifndef REP_P0
#define REP_P0 1
#endif

#define LAS __attribute__((address_space(3)))
#define DI __device__ __forceinline__
typedef unsigned short bf16_t;
typedef short bf16x8 __attribute__((ext_vector_type(8)));
typedef short s16x4 __attribute__((ext_vector_type(4)));
typedef float f32x2 __attribute__((ext_vector_type(2)));
typedef float f32x4 __attribute__((ext_vector_type(4)));
typedef float f32x16 __attribute__((ext_vector_type(16)));
typedef unsigned u32x4 __attribute__((ext_vector_type(4)));
typedef unsigned u32x2 __attribute__((ext_vector_type(2)));
typedef __bf16 bf16x2_t __attribute__((ext_vector_type(2)));

constexpr int M = 16384, D = 1024, SEQ = 2048, HM = 8192;
constexpr int HP = 2304;
constexpr int NH1 = 5376;
constexpr int NWIN = 8448;
constexpr float LOG2E = 1.4426950408889634f;
constexpr float QS64 = 0.125f * LOG2E;
constexpr float QS96 = 0.10206207261596575f * LOG2E;
constexpr float ALPHA = 1.4142135623730951f;
constexpr int C_AZ = 0, C_BZ = 512, C_CZ = 1024, C_CKV = 1536, C_CQL = 1792;
constexpr size_t HM_AQ = (size_t)18 * 1048576, HM_AK = (size_t)22 * 1048576, HM_AV = (size_t)26 * 1048576, HM_CQ = (size_t)30 * 1048576, HM_CK = (size_t)34 * 1048576, HM_CV = (size_t)38 * 1048576;

constexpr size_t MiB = 1048576;
constexpr size_t WS_CTL = 0, WS_XB = 2 * MiB, WS_WT = 34 * MiB, WS_PB = 60 * MiB, WS_Y = 68 * MiB, WS_H = 116 * MiB, WS_MLA = 200 * MiB, WS_END = 232 * MiB;
constexpr size_t CTL_DEP = 8192, CTL_BAR = 16384, CTL_LAM = 4096, CTL_ROPE = 65536, CTL_KMP = 384 * 1024, CTL_STQ = 640 * 1024, CTL_STKV = 1152 * 1024;
constexpr size_t OFF_WIN = 0, OFF_WUQ = 8650752, OFF_WUKV = 8945664, OFF_WABC = 9207808, OFF_WO = 10780672, OFF_WPG = 11829248, OFF_WP = 12877824;
constexpr int LDS_BYTES = 132 * 1024, LDS_IDX = 131072;

DI int opaque_s(int v) { asm volatile("" : "+s"(v)); return v; }
DI int opaque_tid() { int t = threadIdx.x; asm volatile("" : "+v"(t)); return t; }
DI unsigned pk2(float lo, float hi) { f32x2 v = {lo, hi}; bf16x2_t b = __builtin_convertvector(v, bf16x2_t); return __builtin_bit_cast(unsigned, b); }
DI float bflo(unsigned w) { return __uint_as_float(w << 16); }
DI float bfhi(unsigned w) { return __uint_as_float(w & 0xffff0000u); }
DI float bf2f(bf16_t b) { return __uint_as_float((unsigned)b << 16); }
DI bf16_t f2bf(float f) { return (bf16_t)(pk2(f, 0.f) & 0xffffu); }
DI float sigm(float x) { return __builtin_amdgcn_rcpf(1.f + __builtin_amdgcn_exp2f(-x * LOG2E)); }
DI float silu(float x) { return x * sigm(x); }
DI u32x4 pack8(const f32x4 a, const f32x4 b) { u32x4 w; w.x = pk2(a[0], a[1]); w.y = pk2(a[2], a[3]); w.z = pk2(b[0], b[1]); w.w = pk2(b[2], b[3]); return w; }
DI void unpack8(const u32x4 w, f32x4& a, f32x4& b) { a = (f32x4){bflo(w.x), bfhi(w.x), bflo(w.y), bfhi(w.y)}; b = (f32x4){bflo(w.z), bfhi(w.z), bflo(w.w), bfhi(w.w)}; }

namespace pg8 {
constexpr int BM = 256, BK = 64, HALF = 128, HTB = HALF * BK * 2, NXCD = 8, WGM = 8;
__host__ __device__ __forceinline__ int lds_byte(int r, int c) { const int st = (r >> 4) * 2 + (c >> 5), rr = r & 15, cc = c & 31, ob = rr * 64 + cc * 2; return st * 1024 + (ob ^ (((ob >> 9) & 1) << 5)); }
__host__ __device__ __forceinline__ void stage_rc(int b, int& R, int& C) { const int st = b / 1024, sb = b % 1024, swz = sb ^ (((sb >> 9) & 1) << 5); R = (st >> 1) * 16 + swz / 64; C = (st & 1) * 32 + (swz % 64) / 2; }
__host__ __device__ __forceinline__ int perm32(int rho) { const int n = rho >> 4, i = rho & 15; return 8 * (i >> 2) + 4 * n + (i & 3); }

struct Unit { int pm, pn; };
struct Gemm { const bf16_t* A; const bf16_t* Bt; int lda, K; };

struct StaticOrder {
    int nM, nN, nwg, G, c;
    DI void init(int M_, int N_, int G_, int c_) { nM = M_ / BM; nN = N_ / BM; nwg = nM * nN; G = G_; c = c_; }
    DI bool next(int i, Unit& u) const {
        const long L = (long)i * G + c; if (L >= nwg) return false;
        int wgid = (int)L; { const int q = nwg / NXCD, r = nwg % NXCD, xcd = wgid % NXCD, off = wgid / NXCD; wgid = (xcd < r ? xcd * (q + 1) : r * (q + 1) + (xcd - r) * q) + off; }
        const int nig = WGM * nN, gid = wgid / nig, fm = gid * WGM, gsz = (nM - fm) < WGM ? (nM - fm) : WGM;
        u.pm = fm + ((wgid % nig) % gsz); u.pn = (wgid % nig) / gsz; return true;
    }
};
struct P1Order {
    int G, c;
    DI bool next(int i, Unit& u) const {
        const long L = (long)i * G + c; if (L >= 672) return false;
        if (L < 96) { u.pm = (int)L / 3; u.pn = 18 + (int)L % 3; return true; }
        const int nM = 32, nN = 18, nwg = 576;
        int wgid = (int)L - 96; { const int q = nwg / NXCD, r = nwg % NXCD, xcd = wgid % NXCD, off = wgid / NXCD; wgid = (xcd < r ? xcd * (q + 1) : r * (q + 1) + (xcd - r) * q) + off; }
        const int nig = WGM * nN, gid = wgid / nig, fm = gid * WGM, gsz = (nM - fm) < WGM ? (nM - fm) : WGM;
        u.pm = fm + ((wgid % nig) % gsz); u.pn = (wgid % nig) / gsz; return true;
    }
};
struct ListOrder {
    int lo, hi, nN, c, G;
    DI bool next(int i, Unit& u) const {
        int k0 = 0; if (c < lo) k0 = (lo - c + G - 1) / G;
        const int idx = c + (k0 + i) * G; if (idx >= hi) return false;
        const int loc = idx - lo; u.pm = loc / nN; u.pn = loc % nN; return true;
    }
};
struct MergeOrder {
    int c, G;
    DI bool next(int i, Unit& u) const {
        int tile = c + i * G; if (tile >= 256) return false;
        if (G == 256) tile = (c & 7) * 32 + (c >> 3);
        u.pm = tile >> 2; u.pn = tile & 3; return true;
    }
};

struct NoHook { static constexpr bool ACTIVE = false; template <class A> DI void operator()(A&, const Unit&, int, int, int, int, int) const {} };
template <class Epi, class Sched, class Hook = NoHook>
DI void gemm_phase(LAS unsigned char* lds, const Gemm g, const Sched& S, const Epi& E, const Hook& HK = Hook()) {
    const int tid = opaque_tid(), wid = __builtin_amdgcn_readfirstlane(tid >> 6), lane = tid & 63, wr = wid >> 2, wc = wid & 3, fr = lane & 15, fq = lane >> 4;
    const int K = g.K, nt = K / BK, lda = g.lda;
    unsigned voffA[2], voffB[2];
#pragma unroll
    for (int i = 0; i < 2; ++i) { int R, C; stage_rc(tid * 16 + i * 8192, R, C); const int Rb = (R & ~31) + perm32(R & 31);
        voffA[i] = (unsigned)(R * lda + C) * 2u; voffB[i] = (unsigned)(Rb * K + C) * 2u; }
    const size_t kstep = (size_t)(BK * 2);
    const size_t hstepA = (size_t)HALF * lda * 2, hstepB = (size_t)HALF * K * 2;
    const size_t tstepA = 2 * hstepA, tstepB = 2 * hstepB;
    const unsigned ldsw = (unsigned)wid * 1024u;
    const int aoff = lds_byte(wr * 64 + fr, fq * 8), boff = lds_byte(wc * 32 + fr, fq * 8);
#define PG8_SA(b, h) (((b) * 2 + (h)) * HTB)
#define PG8_SB(b, h) ((4 + (b) * 2 + (h)) * HTB)
#define PG8_STAGE(bufoff, gbase, voff) do { _Pragma("unroll") for (int _i = 0; _i < 2; ++_i) \
        __builtin_amdgcn_global_load_lds((const unsigned*)((const char*)(gbase) + (voff)[_i]), (LAS unsigned*)(lds + (bufoff) + ldsw + _i * 8192), 16, 0, 0); } while (0)
#define PG8_LDA(dst, b, h) do { _Pragma("unroll") for (int m = 0; m < 4; ++m) _Pragma("unroll") for (int k = 0; k < 2; ++k) dst[m][k] = *(const LAS bf16x8*)(lds + PG8_SA(b, h) + aoff + m * 2048 + k * 1024); } while (0)
#define PG8_LDB(dst, b, h) do { _Pragma("unroll") for (int n = 0; n < 2; ++n) _Pragma("unroll") for (int k = 0; k < 2; ++k) dst[n][k] = *(const LAS bf16x8*)(lds + PG8_SB(b, h) + boff + n * 2048 + k * 1024); } while (0)
#define PG8_MMA(ai, bj, At, Bt) do { __builtin_amdgcn_s_setprio(1); _Pragma("unroll") for (int m = 0; m < 4; ++m) _Pragma("unroll") for (int n = 0; n < 2; ++n) _Pragma("unroll") for (int k = 0; k < 2; ++k) \
        acc[ai][bj][m][n] = __builtin_amdgcn_mfma_f32_16x16x32_bf16(Bt[n][k], At[m][k], acc[ai][bj][m][n], 0, 0, 0); __builtin_amdgcn_s_setprio(0); } while (0)
#define PG8_WAIT_V(n) asm volatile("s_waitcnt vmcnt(" #n ")" ::: "memory")
#define PG8_WAIT_L(n) asm volatile("s_waitcnt lgkmcnt(" #n ")" ::: "memory")
#define PG8_BAR __builtin_amdgcn_s_barrier()
#define PG8_SCHED __builtin_amdgcn_sched_barrier(0)
    Unit cur, nxt; int ui = 0;
    if (!S.next(0, cur)) return;
    f32x4 acc[2][2][4][2];
#pragma unroll
    for (int a = 0; a < 2; ++a)
#pragma unroll
        for (int b = 0; b < 2; ++b)
#pragma unroll
            for (int m = 0; m < 4; ++m)
#pragma unroll
                for (int n = 0; n < 2; ++n) acc[a][b][m][n] = (f32x4){0.f, 0.f, 0.f, 0.f};
    bf16x8 At[4][2], B0[2][2], B1[2][2];
    const char* cA = (const char*)g.A + (size_t)cur.pm * tstepA; const char* cB = (const char*)g.Bt + (size_t)cur.pn * tstepB;
    PG8_STAGE(PG8_SB(0, 0), cB, voffB); PG8_STAGE(PG8_SB(0, 1), cB + hstepB, voffB); PG8_STAGE(PG8_SA(0, 0), cA, voffA); PG8_STAGE(PG8_SA(0, 1), cA + hstepA, voffA);
    if (wr == 1) PG8_BAR;
    PG8_WAIT_V(2); PG8_BAR;
    PG8_STAGE(PG8_SB(1, 0), cB + kstep, voffB); PG8_STAGE(PG8_SA(1, 0), cA + kstep, voffA); PG8_STAGE(PG8_SB(1, 1), cB + hstepB + kstep, voffB);
    PG8_WAIT_V(6); PG8_BAR;
    for (;;) {
        const bool has_next = S.next(ui + 1, nxt);
        const char* nA = has_next ? (const char*)g.A + (size_t)nxt.pm * tstepA : cA; const char* nB = has_next ? (const char*)g.Bt + (size_t)nxt.pn * tstepB : cB;
#pragma nounroll
        for (int t = 0; t < nt; t += 2) {
            if (Hook::ACTIVE) { if (t == 8 || t == 16) { HK(acc, cur, t, wr, wc, fr, fq); asm volatile("s_waitcnt vmcnt(0)" ::: "memory"); } }
            const bool last = (t == nt - 2);
            const char* a1 = cA + (size_t)(t + 1) * kstep;
            const char* a2 = last ? nA : cA + (size_t)(t + 2) * kstep; const char* b2 = last ? nB : cB + (size_t)(t + 2) * kstep;
            const char* a3 = a2 + kstep; const char* b3 = b2 + kstep;
            PG8_LDB(B0, 0, 0); PG8_LDB(B1, 0, 1); PG8_SCHED; PG8_LDA(At, 0, 0); PG8_STAGE(PG8_SA(1, 1), a1 + hstepA, voffA);
            PG8_WAIT_V(8); PG8_WAIT_L(0); PG8_BAR; PG8_MMA(0, 0, At, B0); PG8_MMA(0, 1, At, B1); PG8_BAR; PG8_SCHED;
            PG8_LDA(At, 0, 1); PG8_STAGE(PG8_SB(0, 0), b2, voffB); PG8_STAGE(PG8_SB(0, 1), b2 + hstepB, voffB); PG8_STAGE(PG8_SA(0, 0), a2, voffA);
            PG8_WAIT_V(8); PG8_WAIT_L(0); PG8_BAR; PG8_MMA(1, 0, At, B0); PG8_MMA(1, 1, At, B1); PG8_BAR; PG8_SCHED;
            PG8_LDB(B0, 1, 0); PG8_LDB(B1, 1, 1); PG8_SCHED; PG8_LDA(At, 1, 0); PG8_STAGE(PG8_SA(0, 1), a2 + hstepA, voffA);
            PG8_WAIT_V(8); PG8_WAIT_L(0); PG8_BAR; PG8_MMA(0, 0, At, B0); PG8_MMA(0, 1, At, B1); PG8_BAR; PG8_SCHED;
            PG8_LDA(At, 1, 1); PG8_STAGE(PG8_SB(1, 0), b3, voffB); PG8_STAGE(PG8_SB(1, 1), b3 + hstepB, voffB); PG8_STAGE(PG8_SA(1, 0), a3, voffA);
            PG8_WAIT_V(8); PG8_WAIT_L(0); PG8_BAR; PG8_MMA(1, 0, At, B0); PG8_MMA(1, 1, At, B1); PG8_BAR; PG8_SCHED;
        }
        if (wr == 0) PG8_BAR;
        E(acc, cur, wr, wc, fr, fq);
        if (!has_next) break;
#pragma unroll
        for (int a = 0; a < 2; ++a)
#pragma unroll
            for (int b = 0; b < 2; ++b)
#pragma unroll
                for (int m = 0; m < 4; ++m)
#pragma unroll
                    for (int n = 0; n < 2; ++n) acc[a][b][m][n] = (f32x4){0.f, 0.f, 0.f, 0.f};
        cur = nxt; cA = nA; cB = nB; ++ui;
        if (wr == 1) PG8_BAR;
    }
    PG8_WAIT_V(0);
    PG8_BAR;
#undef PG8_SA
#undef PG8_SB
#undef PG8_STAGE
#undef PG8_LDA
#undef PG8_LDB
#undef PG8_MMA
#undef PG8_WAIT_V
#undef PG8_WAIT_L
#undef PG8_BAR
#undef PG8_SCHED
}
typedef f32x4 Acc[2][2][4][2];

struct EpiH {
    bf16_t* H; bf16_t* KB; float* KMP; float* STQ; float* STKV; const float* rope; unsigned* dep;
    DI void operator()(const Acc& acc, const Unit& u, int wr, int wc, int fr, int fq) const {
        const int row0 = u.pm * BM + wr * 64 + fr;
        {
            const int pn = u.pn; bf16_t* base; int hw = 0, cseg;
            if (pn < 6) { base = H + (pn < 2 ? HM_AQ : pn < 4 ? HM_AK : HM_AV); hw = 64; cseg = (pn & 1) * 256; }
            else if (pn < 10) { base = H + (pn < 8 ? C_AZ : C_BZ); cseg = (pn & 1) * 256; }
            else if (pn < 16) { base = H + (pn < 12 ? HM_CQ : pn < 14 ? HM_CK : HM_CV); hw = 128; cseg = (pn & 1) * 256; }
            else if (pn < 18) { base = H + C_CZ; cseg = (pn & 1) * 256; }
            else { base = H + C_CKV; cseg = (pn - 18) * 256; }
            const int bl = u.pm >> 3, s0 = (u.pm & 7) * 256 + wr * 64 + fr;
#pragma unroll
            for (int bj = 0; bj < 2; ++bj) { const int cs = cseg + bj * HALF + wc * 32 + 8 * fq;
                bf16_t* colp; size_t pitch;
                if (hw == 64) { colp = base + ((size_t)(bl * 8 + (cs >> 6)) * SEQ) * 64 + (cs & 63); pitch = 64; }
                else if (hw == 128) { colp = base + ((size_t)(bl * 4 + (cs >> 7)) * SEQ) * 128 + (cs & 127); pitch = 128; }
                else { colp = base + (size_t)bl * SEQ * HP + cs; pitch = HP; }
#pragma unroll
                for (int ai = 0; ai < 2; ++ai)
#pragma unroll
                    for (int m = 0; m < 4; ++m) *(u32x4*)(colp + (size_t)(s0 + ai * HALF + m * 16) * pitch) = pack8(acc[ai][bj][m][0], acc[ai][bj][m][1]); }
        }
        if (u.pn == 2 || u.pn == 3) {
            float* dst = KMP + (size_t)(u.pm * 2 + wr) * 512 + (u.pn - 2) * 256 + wc * 32 + 8 * fq;
#pragma unroll
            for (int bj = 0; bj < 2; ++bj)
#pragma unroll
                for (int n = 0; n < 2; ++n) { f32x4 s = (f32x4){0.f, 0.f, 0.f, 0.f};
#pragma unroll
                    for (int ai = 0; ai < 2; ++ai)
#pragma unroll
                        for (int m = 0; m < 4; ++m) s += acc[ai][bj][m][n];
#pragma unroll
                    for (int e = 0; e < 4; ++e) { float v = s[e]; v += __shfl_xor(v, 1); v += __shfl_xor(v, 2); v += __shfl_xor(v, 4); v += __shfl_xor(v, 8); s[e] = v; }
                    if (fr == 0) *(f32x4*)(dst + bj * HALF + 4 * n) = s; }
        }
        if (u.pn >= 18) {
#pragma unroll
            for (int ai = 0; ai < 2; ++ai)
#pragma unroll
                for (int m = 0; m < 4; ++m) { const int row = row0 + ai * HALF + m * 16; float ss = 0.f;
#pragma unroll
                    for (int bj = 0; bj < 2; ++bj) { if (u.pn == 20 && bj == 1) continue;
#pragma unroll
                        for (int n = 0; n < 2; ++n) { const f32x4 x = acc[ai][bj][m][n]; ss += (x[0] * x[0] + x[1] * x[1]) + (x[2] * x[2] + x[3] * x[3]); } }
                    ss += __shfl_xor(ss, 16); ss += __shfl_xor(ss, 32);
                    if (fq == 0) { if (u.pn == 18) STKV[(size_t)row * 4 + wc] = ss; else STQ[(size_t)row * 8 + (u.pn - 19) * 4 + wc] = ss; }
                    if (u.pn == 20 && wc == 0) {
                        const int pos = row & (SEQ - 1); f32x4 o[2];
#pragma unroll
                        for (int n = 0; n < 2; ++n) { const f32x4 cs = *(const f32x4*)(rope + ((size_t)pos * 16 + 4 * fq + 2 * n) * 2); const f32x4 t = acc[ai][1][m][n];
                            o[n] = (f32x4){t[0] * cs[0] - t[1] * cs[1], t[0] * cs[1] + t[1] * cs[0], t[2] * cs[2] - t[3] * cs[3], t[2] * cs[3] + t[3] * cs[2]}; }
                        const u32x4 w = pack8(o[0], o[1]);
#pragma unroll
                        for (int h = 0; h < 8; ++h) *(u32x4*)(KB + ((size_t)((row >> 11) * 8 + h) * SEQ + pos) * 96 + 64 + 8 * fq) = w;
                    }
                }
        }
        if (u.pn >= 18) {
            asm volatile("s_waitcnt vmcnt(0)" ::: "memory");
            __syncthreads();
            if (threadIdx.x == 0) {
                __builtin_amdgcn_fence(__ATOMIC_RELEASE, "agent");
                asm volatile("s_waitcnt vmcnt(0)" ::: "memory");
                __hip_atomic_fetch_add(dep + u.pm, 8u, __ATOMIC_RELAXED, __HIP_MEMORY_SCOPE_AGENT);
            }
        }
    }
};
template <int MODE> struct EpiUp {
    bf16_t* QB; bf16_t* KB; bf16_t* VB; const float* ST; const float* rope;
    DI void operator()(const Acc& acc, const Unit& u, int wr, int wc, int fr, int fq) const {
        const int row0 = u.pm * BM + wr * 64 + fr;
#pragma unroll
        for (int ai = 0; ai < 2; ++ai)
#pragma unroll
            for (int m = 0; m < 4; ++m) { const int row = row0 + ai * HALF + m * 16; float sc;
                if (MODE == 0) { const f32x4 a = *(const f32x4*)(ST + (size_t)row * 8), b = *(const f32x4*)(ST + (size_t)row * 8 + 4);
                    sc = __builtin_amdgcn_rsqf(((a[0] + a[1]) + (a[2] + a[3]) + (b[0] + b[1]) + (b[2] + b[3])) * (1.f / 384.f) + 1e-6f) * QS96; }
                else { const f32x4 a = *(const f32x4*)(ST + (size_t)row * 4); sc = __builtin_amdgcn_rsqf(((a[0] + a[1]) + (a[2] + a[3])) * (1.f / 256.f) + 1e-6f); }
                const int pos = row & (SEQ - 1);
#pragma unroll
                for (int bj = 0; bj < 2; ++bj) { const int c0 = u.pn * BM + bj * HALF + wc * 32 + 8 * fq;
                    f32x4 v0 = acc[ai][bj][m][0] * sc, v1 = acc[ai][bj][m][1] * sc;
                    if (MODE == 0) { const int j = c0 % 96;
                        if (j >= 64) { const int i0 = (j - 64) >> 1; const f32x4 ca = *(const f32x4*)(rope + ((size_t)pos * 16 + i0) * 2), cb = *(const f32x4*)(rope + ((size_t)pos * 16 + i0 + 2) * 2);
                            v0 = (f32x4){v0[0] * ca[0] - v0[1] * ca[1], v0[0] * ca[1] + v0[1] * ca[0], v0[2] * ca[2] - v0[3] * ca[3], v0[2] * ca[3] + v0[3] * ca[2]};
                            v1 = (f32x4){v1[0] * cb[0] - v1[1] * cb[1], v1[0] * cb[1] + v1[1] * cb[0], v1[2] * cb[2] - v1[3] * cb[3], v1[2] * cb[3] + v1[3] * cb[2]}; }
                        *(u32x4*)(QB + ((size_t)((row >> 11) * 8 + c0 / 96) * SEQ + pos) * 96 + j) = pack8(v0, v1); }
                    else { if (c0 < 512) *(u32x4*)(KB + ((size_t)((row >> 11) * 8 + (c0 >> 6)) * SEQ + pos) * 96 + (c0 & 63)) = pack8(v0, v1);
                           else *(u32x4*)(VB + ((size_t)((row >> 11) * 8 + ((c0 - 512) >> 6)) * SEQ + pos) * 64 + (c0 & 63)) = pack8(v0, v1); }
                }
            }
    }
};
struct EpiG {
    bf16_t* G; const float* bias;
    DI void operator()(const Acc& acc, const Unit& u, int wr, int wc, int fr, int fq) const {
        const int row0 = u.pm * BM + wr * 64 + fr, col0 = u.pn * BM + wc * 32 + 8 * fq;
        f32x4 bv[2][2];
#pragma unroll
        for (int bj = 0; bj < 2; ++bj)
#pragma unroll
            for (int n = 0; n < 2; ++n) bv[bj][n] = *(const f32x4*)(bias + col0 + bj * HALF + 4 * n);
#pragma unroll
        for (int ai = 0; ai < 2; ++ai)
#pragma unroll
            for (int m = 0; m < 4; ++m) { bf16_t* rowp = G + (size_t)(row0 + ai * HALF + m * 16) * 3072 + col0;
#pragma unroll
                for (int bj = 0; bj < 2; ++bj) { f32x4 v0 = acc[ai][bj][m][0] + bv[bj][0], v1 = acc[ai][bj][m][1] + bv[bj][1];
#pragma unroll
                    for (int e = 0; e < 4; ++e) { v0[e] = fmaxf(sigm(v0[e]), 1e-12f); v1[e] = fmaxf(sigm(v1[e]), 1e-12f); }
                    *(u32x4*)(rowp + bj * HALF) = pack8(v0, v1); } }
    }
};
struct MergeHook {
    static constexpr bool ACTIVE = true;
    const bf16_t* G;
    DI void operator()(Acc& acc, const Unit& u, int t, int wr, int wc, int fr, int fq) const {
        const int seg = (t == 8) ? 0 : 1;
        const int row0 = u.pm * BM + wr * 64 + fr, col0 = u.pn * BM + wc * 32 + 8 * fq;
        const bf16_t* gp = G + (size_t)row0 * 3072 + seg * 1024 + col0;
#pragma unroll
        for (int ai = 0; ai < 2; ++ai) {
            u32x4 ga[8], gb[8];
#pragma unroll
            for (int m = 0; m < 4; ++m)
#pragma unroll
                for (int bj = 0; bj < 2; ++bj) { const bf16_t* p = gp + (size_t)(ai * HALF + m * 16) * 3072 + bj * HALF; ga[m * 2 + bj] = *(const u32x4*)p; gb[m * 2 + bj] = *(const u32x4*)(p + 1024); }
            __builtin_amdgcn_sched_barrier(0);
#pragma unroll
            for (int m = 0; m < 4; ++m)
#pragma unroll
                for (int bj = 0; bj < 2; ++bj) { f32x4 a0, a1, b0, b1; unpack8(ga[m * 2 + bj], a0, a1); unpack8(gb[m * 2 + bj], b0, b1);
#pragma unroll
                    for (int e = 0; e < 4; ++e) { acc[ai][bj][m][0][e] *= a0[e] * __builtin_amdgcn_rcpf(b0[e]); acc[ai][bj][m][1][e] *= a1[e] * __builtin_amdgcn_rcpf(b1[e]); } }
            __builtin_amdgcn_sched_barrier(0);
        }
    }
};
struct EpiMerge {
    const bf16_t* G; bf16_t* MG;
    DI void operator()(const Acc& acc, const Unit& u, int wr, int wc, int fr, int fq) const {
        const int row0 = u.pm * BM + wr * 64 + fr, col0 = u.pn * BM + wc * 32 + 8 * fq;
        const bf16_t* gp = G + (size_t)row0 * 3072 + 2048 + col0; bf16_t* mp = MG + (size_t)row0 * 1024 + col0;
#pragma unroll
        for (int ai = 0; ai < 2; ++ai) {
            u32x4 gq[8];
#pragma unroll
            for (int m = 0; m < 4; ++m)
#pragma unroll
                for (int bj = 0; bj < 2; ++bj) gq[m * 2 + bj] = *(const u32x4*)(gp + (size_t)(ai * HALF + m * 16) * 3072 + bj * HALF);
            __builtin_amdgcn_sched_barrier(0);
#pragma unroll
            for (int m = 0; m < 4; ++m)
#pragma unroll
                for (int bj = 0; bj < 2; ++bj) { f32x4 g0, g1; unpack8(gq[m * 2 + bj], g0, g1);
                    *(u32x4*)(mp + (size_t)(ai * HALF + m * 16) * 1024 + bj * HALF) = pack8(acc[ai][bj][m][0] * g0, acc[ai][bj][m][1] * g1); }
            __builtin_amdgcn_sched_barrier(0);
        }
    }
};
struct EpiR {
    const float* X; float* R; bf16_t* RB;
    DI void operator()(const Acc& acc, const Unit& u, int wr, int wc, int fr, int fq) const {
        const int row0 = u.pm * BM + wr * 64 + fr, col0 = u.pn * BM + wc * 32 + 8 * fq;
        const size_t base = (size_t)row0 * 1024 + col0;
#pragma unroll
        for (int hb = 0; hb < 4; ++hb) {
            const int ai = hb >> 1, m0 = (hb & 1) * 2;
            f32x4 xq[8];
#pragma unroll
            for (int mm = 0; mm < 2; ++mm)
#pragma unroll
                for (int bj = 0; bj < 2; ++bj) { const size_t off = base + (size_t)(ai * HALF + (m0 + mm) * 16) * 1024 + bj * HALF;
                    xq[(mm * 2 + bj) * 2] = *(const f32x4*)(X + off); xq[(mm * 2 + bj) * 2 + 1] = *(const f32x4*)(X + off + 4); }
            __builtin_amdgcn_sched_barrier(0);
#pragma unroll
            for (int mm = 0; mm < 2; ++mm)
#pragma unroll
                for (int bj = 0; bj < 2; ++bj) { const size_t off = base + (size_t)(ai * HALF + (m0 + mm) * 16) * 1024 + bj * HALF;
                    const f32x4 v0 = xq[(mm * 2 + bj) * 2] * ALPHA + acc[ai][bj][m0 + mm][0], v1 = xq[(mm * 2 + bj) * 2 + 1] * ALPHA + acc[ai][bj][m0 + mm][1];
                    *(f32x4*)(R + off) = v0; *(f32x4*)(R + off + 4) = v1;
                    *(u32x4*)(RB + off) = pack8(v0, v1); }
            __builtin_amdgcn_sched_barrier(0);
        }
    }
};
struct EpiBf {
    bf16_t* O;
    DI void operator()(const Acc& acc, const Unit& u, int wr, int wc, int fr, int fq) const {
        const int row0 = u.pm * BM + wr * 64 + fr, col0 = u.pn * BM + wc * 32 + 8 * fq;
#pragma unroll
        for (int ai = 0; ai < 2; ++ai)
#pragma unroll
            for (int m = 0; m < 4; ++m) { bf16_t* rowp = O + (size_t)(row0 + ai * HALF + m * 16) * 1024 + col0;
#pragma unroll
                for (int bj = 0; bj < 2; ++bj) *(u32x4*)(rowp + bj * HALF) = pack8(acc[ai][bj][m][0], acc[ai][bj][m][1]); }
    }
};
struct EpiR2 {
    float* R; const bf16_t* PP;
    DI void operator()(const Acc& acc, const Unit& u, int wr, int wc, int fr, int fq) const {
        const int row0 = u.pm * BM + wr * 64 + fr, col0 = u.pn * BM + wc * 32 + 8 * fq;
        const size_t base = (size_t)row0 * 1024 + col0;
#pragma unroll
        for (int hb = 0; hb < 4; ++hb) {
            const int ai = hb >> 1, m0 = (hb & 1) * 2;
            f32x4 rq[8]; u32x4 pq[4];
#pragma unroll
            for (int mm = 0; mm < 2; ++mm)
#pragma unroll
                for (int bj = 0; bj < 2; ++bj) { const size_t off = base + (size_t)(ai * HALF + (m0 + mm) * 16) * 1024 + bj * HALF;
                    pq[mm * 2 + bj] = *(const u32x4*)(PP + off); rq[(mm * 2 + bj) * 2] = *(const f32x4*)(R + off); rq[(mm * 2 + bj) * 2 + 1] = *(const f32x4*)(R + off + 4); }
            __builtin_amdgcn_sched_barrier(0);
#pragma unroll
            for (int mm = 0; mm < 2; ++mm)
#pragma unroll
                for (int bj = 0; bj < 2; ++bj) { const size_t off = base + (size_t)(ai * HALF + (m0 + mm) * 16) * 1024 + bj * HALF;
                    f32x4 p0, p1; unpack8(pq[mm * 2 + bj], p0, p1);
                    f32x4 r0 = rq[(mm * 2 + bj) * 2], r1 = rq[(mm * 2 + bj) * 2 + 1];
                    const f32x4 a0 = acc[ai][bj][m0 + mm][0], a1 = acc[ai][bj][m0 + mm][1];
#pragma unroll
                    for (int e = 0; e < 4; ++e) { r0[e] += sigm(a0[e]) * p0[e]; r1[e] += sigm(a1[e]) * p1[e]; }
                    *(f32x4*)(R + off) = r0; *(f32x4*)(R + off + 4) = r1; }
            __builtin_amdgcn_sched_barrier(0);
        }
    }
};
}

DI int crow(int r, int hi) { return (r & 3) + 8 * (r >> 2) + 4 * hi; }
DI s16x4 vtr(LAS const char* p) { typedef short v4i16_t __attribute__((ext_vector_type(4))); return __builtin_bit_cast(s16x4, __builtin_amdgcn_ds_read_tr16_b64_v4i16((LAS v4i16_t*)p)); }
constexpr int AT_SCR = 112 * 1024, AT_KM = 113 * 1024;
constexpr float NEGBIG = -1e30f;
DI float max3f(float a, float b, float c) { return fmaxf(fmaxf(a, b), c); }

template <int DQK, int KW, int DV, int NROWS, bool ALIBI, bool MOBA, bool PIPE, int NSET>
DI void attn_unit(LAS char* lds, const bf16_t* Qp, int ldq, const bf16_t* Kp, int ldk, const bf16_t* Vp, int ldv,
                  const bf16_t* Zp, int ldz, bf16_t* Yp, int ldy, int q0, float sl2, const float* kmp, float lam, const float* subg, float post) {
    constexpr int NTD = NROWS / 64, NS = DQK / 16, ND = DV / 32, PVG = (DV == 64) ? 2 : 1;
    constexpr int KPITCH = KW * 2 + 16, VPITCH = DV * 2 + 64;
    constexpr int KOFF0 = 0, VOFF0 = 3 * 64 * KPITCH;
    constexpr int KCH = KW / 8, VCH = DV / 8, NKC = 64 * KCH, NVC = 64 * VCH, KPT = (NKC + 511) / 512, VPT = (NVC + 511) / 512;
    static_assert(VOFF0 + 3 * 64 * VPITCH <= AT_SCR, "attention LDS map");
    const int tid = opaque_tid(), lane = tid & 63, r32 = lane & 31, hi = lane >> 5;
    const int wid = __builtin_amdgcn_readfirstlane(tid >> 6);
    const int ro = (NROWS == 256) ? 32 * wid : 32 * (wid & 3);
    const int map = (NROWS == 256) ? 0 : (wid >> 2);
    const int qpos = q0 + ro + r32;
    LAS float* scr = (LAS float*)(lds + AT_SCR) + wid * 32;

    bf16x8 qf[NS];
    { const bf16_t* qrow = Qp + (size_t)qpos * ldq + 64 * map + 8 * hi;
#pragma unroll
      for (int s = 0; s < NS; ++s) qf[s] = *(const bf16x8*)(qrow + 16 * s); }

    unsigned sel = 0xFFu;
    if (MOBA) {
        const int u = q0 >> 8;
        if (u > 3) {
            LAS float* km = (LAS float*)(lds + AT_KM);
            { const int j = tid >> 6, d = tid & 63; if (j < u) km[j * 64 + d] = (kmp[(size_t)(j * 2) * 512 + d] + kmp[(size_t)(j * 2 + 1) * 512 + d]) * (1.f / 256.f); }
            __syncthreads();
            float g[7];
#pragma unroll
            for (int j = 0; j < 7; ++j) { float a = 0.f;
                if (j < u) {
#pragma unroll
                    for (int s = 0; s < 4; ++s) { const f32x4 k0 = *(const LAS f32x4*)(km + j * 64 + 16 * s + 8 * hi), k1 = *(const LAS f32x4*)(km + j * 64 + 16 * s + 8 * hi + 4);
#pragma unroll
                        for (int e = 0; e < 4; ++e) { a += bf2f((bf16_t)qf[s][e]) * k0[e]; a += bf2f((bf16_t)qf[s][4 + e]) * k1[e]; } }
                }
                a += __shfl_xor(a, 32); g[j] = a; }
            sel = 0u;
#pragma unroll
            for (int k = 0; k < 3; ++k) { float best = -INFINITY; int bi = 0;
#pragma unroll
                for (int j = 0; j < 7; ++j) { const bool ok = (j < u) && !((sel >> j) & 1u) && (g[j] > best); best = ok ? g[j] : best; bi = ok ? j : bi; }
                sel |= 1u << bi; }
        }
    }

    f32x16 o[ND];
#pragma unroll
    for (int d0 = 0; d0 < ND; ++d0)
#pragma unroll
        for (int r = 0; r < 16; ++r) o[d0][r] = 0.f;
    f32x16 bias;
#pragma unroll
    for (int r = 0; r < 16; ++r) bias[r] = ALIBI ? sl2 * (float)((r & 3) + 8 * (r >> 2) + 4 * hi) : 0.f;
    const float d32 = ALIBI ? 32.f * sl2 : 0.f;
    float mrun = NEGBIG, lrun = 0.f;
    const int nt = NTD + (q0 >> 6);
    u32x4 kregA[KPT], vregA[VPT], kregB[KPT], vregB[VPT], kregC[KPT], vregC[VPT], kregD[KPT], vregD[VPT];
#define AT_TB(it) ((it) < NTD ? q0 + 64 * (it) : 64 * ((it) - NTD))
#define AT_LOAD(it, kreg, vreg) do { const int _ti = ((it) < nt) ? (it) : nt - 1; const int _kb = AT_TB(_ti); \
        _Pragma("unroll") for (int _i = 0; _i < KPT; ++_i) { const int _c = tid + 512 * _i; if (NKC % 512 == 0 || _i + 1 < KPT || _c < NKC) { const int _r = _c / KCH, _cc = _c % KCH; kreg[_i] = *(const u32x4*)(Kp + (size_t)(_kb + _r) * ldk + 8 * _cc); } } \
        _Pragma("unroll") for (int _i = 0; _i < VPT; ++_i) { const int _c = tid + 512 * _i; if (NVC % 512 == 0 || _i + 1 < VPT || _c < NVC) { const int _r = _c / VCH, _cc = _c % VCH; vreg[_i] = *(const u32x4*)(Vp + (size_t)(_kb + _r) * ldv + 8 * _cc); } } } while (0)
#define AT_STORE(buf, kreg, vreg) do { \
        _Pragma("unroll") for (int _i = 0; _i < KPT; ++_i) { const int _c = tid + 512 * _i; if (NKC % 512 == 0 || _i + 1 < KPT || _c < NKC) { const int _r = _c / KCH, _cc = _c % KCH; *(LAS u32x4*)(lds + KOFF0 + (buf) * 64 * KPITCH + _r * KPITCH + 16 * _cc) = kreg[_i]; } } \
        _Pragma("unroll") for (int _i = 0; _i < VPT; ++_i) { const int _c = tid + 512 * _i; if (NVC % 512 == 0 || _i + 1 < VPT || _c < NVC) { const int _r = _c / VCH, _cc = _c % VCH; *(LAS u32x4*)(lds + VOFF0 + (buf) * 64 * VPITCH + _r * VPITCH + 16 * _cc) = vreg[_i]; } } } while (0)
#define AT_ACTIVE(it) ((it) >= NTD || 64 * (it) <= ro + 31)
#define AT_QK(it, bufi, P0, P1) do { if (AT_ACTIVE(it)) { \
        LAS const char* _Kb = lds + KOFF0 + (bufi) * 64 * KPITCH + r32 * KPITCH + (64 * map + 8 * hi) * 2; \
        _Pragma("unroll") for (int _h = 0; _h < NS; _h += 4) { \
            bf16x8 _kf[8]; \
            _Pragma("unroll") for (int _s = 0; _s < 4; ++_s) if (_h + _s < NS) { _kf[2 * _s] = *(const LAS bf16x8*)(_Kb + 32 * (_h + _s)); _kf[2 * _s + 1] = *(const LAS bf16x8*)(_Kb + 32 * KPITCH + 32 * (_h + _s)); } \
            __builtin_amdgcn_sched_barrier(0); \
            _Pragma("unroll") for (int _s = 0; _s < 4; ++_s) if (_h + _s < NS) { \
                if (_h + _s == 0) { P0 = __builtin_amdgcn_mfma_f32_32x32x16_bf16(_kf[0], qf[0], bias, 0, 0, 0); P1 = __builtin_amdgcn_mfma_f32_32x32x16_bf16(_kf[1], qf[0], bias, 0, 0, 0); } \
                else { P0 = __builtin_amdgcn_mfma_f32_32x32x16_bf16(_kf[2 * _s], qf[_h + _s], P0, 0, 0, 0); P1 = __builtin_amdgcn_mfma_f32_32x32x16_bf16(_kf[2 * _s + 1], qf[_h + _s], P1, 0, 0, 0); } } \
            __builtin_amdgcn_sched_barrier(0); } } } while (0)
    if (NSET == 4) { AT_LOAD(0, kregA, vregA); AT_LOAD(1, kregB, vregB); AT_LOAD(2, kregC, vregC); AT_LOAD(3, kregD, vregD); AT_STORE(0, kregA, vregA); AT_STORE(1, kregB, vregB);
                     AT_LOAD(4, kregA, vregA); AT_LOAD(5, kregB, vregB); }
    else if (NSET == 2) { AT_LOAD(0, kregA, vregA); AT_LOAD(1, kregB, vregB); AT_STORE(0, kregA, vregA); AT_STORE(1, kregB, vregB); AT_LOAD(2, kregA, vregA); AT_LOAD(3, kregB, vregB); }
    else { AT_LOAD(0, kregA, vregA); AT_STORE(0, kregA, vregA); AT_LOAD(1, kregA, vregA); AT_STORE(1, kregA, vregA); AT_LOAD(2, kregA, vregA); }
    __syncthreads();
    const int i16 = lane & 15;
    const int vlane = (4 * hi + (i16 >> 2)) * VPITCH + (16 * ((lane >> 4) & 1) + 4 * (i16 & 3)) * 2;
    f32x16 pa0, pa1, pb0, pb1;
#pragma unroll
    for (int r = 0; r < 16; ++r) { pa0[r] = 0.f; pa1[r] = 0.f; pb0[r] = 0.f; pb1[r] = 0.f; }
    if (PIPE) AT_QK(0, 0, pa0, pa1);
    int bcur = 0;
#define AT_ITER(it, C0, C1, N0, N1, kreg, vreg) do { \
        const int _b1 = (bcur == 2) ? 0 : bcur + 1, _b2 = (_b1 == 2) ? 0 : _b1 + 1; \
        AT_STORE(_b2, kreg, vreg); \
        AT_LOAD((it) + 2 + NSET, kreg, vreg); \
        if (PIPE) { if ((it) + 1 < nt) AT_QK((it) + 1, _b1, N0, N1); } else AT_QK(it, bcur, C0, C1); \
        if (AT_ACTIVE(it)) { \
            LAS const char* _Vb = lds + VOFF0 + bcur * 64 * VPITCH + vlane; \
            bf16x8 _vf[4 * PVG];                      \
            _Pragma("unroll") for (int _e = 0; _e < PVG; ++_e) _Pragma("unroll") for (int _ks = 0; _ks < 4; ++_ks) { \
                const s16x4 _lo = vtr(_Vb + (16 * _ks) * VPITCH + 64 * _e), _hh = vtr(_Vb + (16 * _ks + 8) * VPITCH + 64 * _e); \
                _vf[4 * _e + _ks] = __builtin_shufflevector(_lo, _hh, 0, 1, 2, 3, 4, 5, 6, 7); } \
            __builtin_amdgcn_sched_barrier(0); \
            const int _kb = AT_TB(it); const bool _diag = (it) < NTD; \
            if (_diag) { const int _kq = _kb + 4 * hi - qpos; \
                _Pragma("unroll") for (int _r = 0; _r < 16; ++_r) { const int _dd = _kq + (_r & 3) + 8 * (_r >> 2); if (_dd > 0) C0[_r] = NEGBIG; if (_dd + 32 > 0) C1[_r] = NEGBIG; } } \
            float _m0 = max3f(C0[0], C0[1], C0[2]), _m1 = max3f(C1[0], C1[1], C1[2]); \
            _Pragma("unroll") for (int _r = 3; _r < 15; _r += 2) { _m0 = max3f(_m0, C0[_r], C0[_r + 1]); _m1 = max3f(_m1, C1[_r], C1[_r + 1]); } \
            _m0 = fmaxf(_m0, C0[15]); _m1 = fmaxf(_m1, C1[15]); \
            const float _c0 = ALIBI ? sl2 * (float)(_kb - qpos) : 0.f; \
            float _mx = fmaxf(_m0, _m1 + d32) + _c0; \
            bool _selok = true; if (MOBA && !_diag) _selok = ((sel >> (_kb >> 8)) & 1u) != 0u; \
            if (!_selok) _mx = NEGBIG; \
            { const auto _rr = __builtin_amdgcn_permlane32_swap(__float_as_uint(_mx), __float_as_uint(_mx), false, false); _mx = fmaxf(__uint_as_float(_rr[0]), __uint_as_float(_rr[1])); }     \
            const float _mn = fmaxf(mrun, _mx); \
            if (__any(_mn - mrun > 8.f)) { \
                const float _alpha = __builtin_amdgcn_exp2f(mrun - _mn); lrun *= _alpha; mrun = _mn; \
                scr[r32] = _alpha; \
                asm volatile("s_waitcnt lgkmcnt(0)" ::: "memory"); \
                f32x4 _a4[4]; \
                _Pragma("unroll") for (int _g = 0; _g < 4; ++_g) _a4[_g] = *(const LAS f32x4*)(scr + 8 * _g + 4 * hi); \
                asm volatile("s_waitcnt lgkmcnt(0)" ::: "memory"); \
                _Pragma("unroll") for (int _d0 = 0; _d0 < ND; ++_d0) _Pragma("unroll") for (int _r = 0; _r < 16; ++_r) o[_d0][_r] *= _a4[_r >> 2][_r & 3]; \
            } \
            const float _ms0 = _selok ? (mrun - _c0) : INFINITY, _ms1 = _ms0 - d32; \
            float _ls = 0.f; \
            _Pragma("unroll") for (int _r = 0; _r < 16; ++_r) { C0[_r] = __builtin_amdgcn_exp2f(C0[_r] - _ms0); C1[_r] = __builtin_amdgcn_exp2f(C1[_r] - _ms1); _ls += C0[_r] + C1[_r]; } \
            lrun += _ls; \
            bf16x8 _pa[4]; \
            _Pragma("unroll") for (int _ks = 0; _ks < 2; ++_ks) { u32x4 _w; \
                _w.x = pk2(C0[8 * _ks], C0[8 * _ks + 1]); _w.y = pk2(C0[8 * _ks + 2], C0[8 * _ks + 3]); _w.z = pk2(C0[8 * _ks + 4], C0[8 * _ks + 5]); _w.w = pk2(C0[8 * _ks + 6], C0[8 * _ks + 7]); \
                _pa[_ks] = __builtin_bit_cast(bf16x8, _w); \
                _w.x = pk2(C1[8 * _ks], C1[8 * _ks + 1]); _w.y = pk2(C1[8 * _ks + 2], C1[8 * _ks + 3]); _w.z = pk2(C1[8 * _ks + 4], C1[8 * _ks + 5]); _w.w = pk2(C1[8 * _ks + 6], C1[8 * _ks + 7]); \
                _pa[2 + _ks] = __builtin_bit_cast(bf16x8, _w); } \
            _Pragma("unroll") for (int _d0 = 0; _d0 < ND; _d0 += PVG) { \
                if (_d0 > 0) { \
                    _Pragma("unroll") for (int _e = 0; _e < PVG; ++_e) _Pragma("unroll") for (int _ks = 0; _ks < 4; ++_ks) { \
                        const s16x4 _lo = vtr(_Vb + (16 * _ks) * VPITCH + 64 * (_d0 + _e)), _hh = vtr(_Vb + (16 * _ks + 8) * VPITCH + 64 * (_d0 + _e)); \
                        _vf[4 * _e + _ks] = __builtin_shufflevector(_lo, _hh, 0, 1, 2, 3, 4, 5, 6, 7); } \
                    __builtin_amdgcn_sched_barrier(0); } \
                _Pragma("unroll") for (int _ks = 0; _ks < 4; ++_ks) _Pragma("unroll") for (int _e = 0; _e < PVG; ++_e) \
                    o[_d0 + _e] = __builtin_amdgcn_mfma_f32_32x32x16_bf16(_pa[_ks], _vf[4 * _e + _ks], o[_d0 + _e], 0, 0, 0); \
                __builtin_amdgcn_sched_barrier(0); } \
        } \
        bcur = _b1; \
        asm volatile("s_waitcnt lgkmcnt(0)\n\ts_barrier" ::: "memory"); } while (0)
    if (NSET == 4) {
        for (int it = 0; it < nt; it += 4) {
            AT_ITER(it, pa0, pa1, pb0, pb1, kregC, vregC);
            AT_ITER(it + 1, pb0, pb1, pa0, pa1, kregD, vregD);
            AT_ITER(it + 2, pa0, pa1, pb0, pb1, kregA, vregA);
            AT_ITER(it + 3, pb0, pb1, pa0, pa1, kregB, vregB);
        }
    } else {
        for (int it = 0; it < nt; it += 2) {
            AT_ITER(it, pa0, pa1, pb0, pb1, kregA, vregA);
            if (NSET == 2) AT_ITER(it + 1, pb0, pb1, pa0, pa1, kregB, vregB); else AT_ITER(it + 1, pb0, pb1, pa0, pa1, kregA, vregA);
        }
    }
#undef AT_TB
#undef AT_LOAD
#undef AT_STORE
#undef AT_ACTIVE
#undef AT_QK
#undef AT_ITER
    {
        const float lt = lrun + __shfl_xor(lrun, 32);
        scr[r32] = 1.f / lt;
        asm volatile("s_waitcnt lgkmcnt(0)" ::: "memory");
        f32x4 a4[4];
#pragma unroll
        for (int g = 0; g < 4; ++g) a4[g] = *(const LAS f32x4*)(scr + 8 * g + 4 * hi);
        asm volatile("s_waitcnt lgkmcnt(0)" ::: "memory");
#pragma unroll
        for (int d0 = 0; d0 < ND; ++d0)
#pragma unroll
            for (int r = 0; r < 16; ++r) o[d0][r] *= a4[r >> 2][r & 3];
    }
    if (NROWS == 256) {
#pragma unroll
        for (int d0 = 0; d0 < ND; ++d0)
#pragma unroll
            for (int r = 0; r < 16; ++r) { const size_t row = (size_t)(q0 + ro + crow(r, hi)); const int col = 32 * d0 + r32;
                const float z = bf2f(Zp[row * ldz + col]); Yp[row * ldy + col] = f2bf(o[d0][r] * silu(z)); }
    } else {
        LAS float* xch = (LAS float*)lds;
        if (map == 1) {
#pragma unroll
            for (int d0 = 0; d0 < ND; ++d0)
#pragma unroll
                for (int r = 0; r < 16; ++r) xch[(((wid & 3) * ND + d0) * 16 + r) * 64 + lane] = o[d0][r];
        }
        __syncthreads();
        if (map == 0) {
#pragma unroll
            for (int d0 = 0; d0 < ND; ++d0)
#pragma unroll
                for (int r = 0; r < 16; ++r) o[d0][r] -= lam * xch[(((wid & 3) * ND + d0) * 16 + r) * 64 + lane];
#pragma unroll
            for (int r = 0; r < 16; ++r) { float ss = 0.f;
#pragma unroll
                for (int d0 = 0; d0 < ND; ++d0) ss += o[d0][r] * o[d0][r];
                ss += __shfl_xor(ss, 1); ss += __shfl_xor(ss, 2); ss += __shfl_xor(ss, 4); ss += __shfl_xor(ss, 8); ss += __shfl_xor(ss, 16);
                const float rs = __builtin_amdgcn_rsqf(ss * (1.f / (float)DV) + 1e-5f) * post;
                const size_t row = (size_t)(q0 + ro + crow(r, hi));
#pragma unroll
                for (int d0 = 0; d0 < ND; ++d0) { const int col = 32 * d0 + r32; const float z = bf2f(Zp[row * ldz + col]);
                    Yp[row * ldy + col] = f2bf(o[d0][r] * rs * subg[col] * silu(z)); } }
        }
        __syncthreads();
    }
}

#define XB_TMO      128
#define XB_XCNT(j)  (256  + 64 * (j))
#define XB_XSUB(j)  (1280 + 64 * (j))
#define XB_XGEN(j)  (2304 + 64 * (j))
#define XB_TOP      3328
#define XB_TOPGEN   3392
#define XCD_BAR_WORDS 3456
#define XB_SPIN_CAP (1u << 22)
DI unsigned xb_ld(unsigned* p)              { return __hip_atomic_load(p, __ATOMIC_RELAXED, __HIP_MEMORY_SCOPE_AGENT); }
DI unsigned xb_add(unsigned* p, unsigned v) { return __hip_atomic_fetch_add(p, v, __ATOMIC_RELAXED, __HIP_MEMORY_SCOPE_AGENT); }
DI unsigned xb_xcc_id() { return (unsigned)__builtin_amdgcn_s_getreg((3 << 11) | 20) & 0xFu; }
#define XB_SPIN(cond, bar) do { unsigned _sp = 0; while (cond) { __builtin_amdgcn_s_sleep(1); \
    if ((++_sp & 255u) == 0u) { if (xb_ld(&(bar)[XB_TMO])) break; if (_sp > XB_SPIN_CAP) { atomicAdd(&(bar)[XB_TMO], 1u); break; } } } } while (0)
DI void xcd_barrier_complete(unsigned* bar, unsigned x, unsigned& nloc, unsigned& nx) {
    const unsigned Gn = gridDim.x;
    unsigned sum, cnt, mine, sp = 0u;
    for (;;) {
        sum = 0u; cnt = 0u; mine = 0u;
#pragma unroll
        for (unsigned j = 0; j < 16; ++j) { const unsigned c = xb_ld(&bar[XB_XCNT(j)]); sum += c; cnt += (c > 0u) ? 1u : 0u; mine = (j == x) ? c : mine; }
        if (sum == Gn) break;
        __builtin_amdgcn_s_sleep(1);
        if ((++sp & 255u) == 0u) { if (xb_ld(&bar[XB_TMO])) break; if (sp > XB_SPIN_CAP) { atomicAdd(&bar[XB_TMO], 1u); break; } }
    }
    nloc = mine > 0u ? mine : 1u; nx = cnt > 0u ? cnt : 1u;
}
DI void xcd_barrier(unsigned* bar, volatile LAS unsigned* st) {
    asm volatile("s_waitcnt vmcnt(0)" ::: "memory");
    __syncthreads();
    if (threadIdx.x == 0) {
        __builtin_amdgcn_s_waitcnt(0);
        const unsigned x = xb_xcc_id();
        unsigned nloc = st[0], nx = st[1];
        if (nloc == 0u) { xcd_barrier_complete(bar, x, nloc, nx); st[0] = nloc; st[1] = nx; }
        const unsigned old = xb_add(&bar[XB_XSUB(x)], 1u);
        const unsigned gen = old / nloc;
        if (old + 1u == (gen + 1u) * nloc) {
            __builtin_amdgcn_fence(__ATOMIC_RELEASE, "agent");
            asm volatile("s_waitcnt vmcnt(0)" ::: "memory");
            const unsigned og = xb_add(&bar[XB_TOP], 1u);
            const unsigned tg = og / nx;
            if (og + 1u == (tg + 1u) * nx) xb_add(&bar[XB_TOPGEN], 1u);
            else XB_SPIN(xb_ld(&bar[XB_TOPGEN]) == tg, bar);
            __builtin_amdgcn_fence(__ATOMIC_ACQUIRE, "agent");
            xb_add(&bar[XB_XGEN(x)], 1u);
            asm volatile("s_waitcnt vmcnt(0)" ::: "memory");
        } else {
            XB_SPIN(xb_ld(&bar[XB_XGEN(x)]) == gen, bar);
            __builtin_amdgcn_fence(__ATOMIC_ACQUIRE, "agent");
            asm volatile("s_waitcnt vmcnt(0)" ::: "memory");
        }
    }
    __syncthreads();
}

struct Params { const float* in[19]; float* out; unsigned char* ws; };

DI void colmap(int kind, int n, int& col, float& cs) {
    cs = 1.f;
    if (kind == 0) {
        if (n < 2048) { col = n; if (n < 512) cs = QS64; }
        else if (n < 2560) col = 2720 + (n - 2048);
        else if (n < 3072) { col = 3232 + (n - 2560); cs = QS64; }
        else if (n < 3584) col = 3744 + (n - 3072);
        else if (n < 4096) col = 4256 + (n - 3584);
        else if (n < 4608) col = 4768 + (n - 4096);
        else if (n < 4864) col = 2432 + (n - 4608);
        else if (n < 5248) col = 2048 + (n - 4864);
        else if (n < 5280) { const int j = n - 5248; col = 2688 + (j >> 1) + 16 * (j & 1); }
        else col = -1;
    } else if (kind == 1) col = n;
    else if (kind == 2) { const int h = n / 96, j = n % 96; if (j < 64) col = h * 96 + j; else { const int jj = j - 64; col = h * 96 + 64 + (jj >> 1) + 16 * (jj & 1); } }
    else { if (n < 512) col = (n >> 6) * 128 + (n & 63); else { const int m = n - 512; col = (m >> 6) * 128 + 64 + (m & 63); } }
}
DI void tr_tile(const float* src, int srcN, int ldd, bf16_t* dst, int kind, int n0, int k0, const float* kscale, LAS float* scr, int tid) {
    { const int nl = tid & 127, kl0 = tid >> 7; int col; float cs; colmap(kind, n0 + nl, col, cs);
      float v[16];
#pragma unroll
      for (int i = 0; i < 16; ++i) { const int kl = kl0 + 4 * i; v[i] = (col >= 0) ? src[(size_t)(k0 + kl) * srcN + col] : 0.f; }
#pragma unroll
      for (int i = 0; i < 16; ++i) { const int kl = kl0 + 4 * i; float w = v[i] * cs; if (kscale) w *= kscale[k0 + kl]; scr[kl * 129 + nl] = w; } }
    __syncthreads();
    { const int kp = tid & 31;
#pragma unroll
      for (int i = 0; i < 8; ++i) { const int nl = (tid >> 5) + 16 * i;
          *(unsigned*)(dst + (size_t)(n0 + nl) * ldd + k0 + 2 * kp) = pk2(scr[(2 * kp) * 129 + nl], scr[(2 * kp + 1) * 129 + nl]); } }
    __syncthreads();
}
typedef const __attribute__((address_space(4))) Params* KParams0;
DI void convert_weights(KParams0 Pk, int l, bf16_t* WT, LAS float* scr) {
    const int tid = opaque_tid();
    constexpr int T0 = 42 * 16, T1 = T0 + 24 * 16, T2 = T1 + 6 * 6, T3 = T2 + 8 * 4, T4 = T3 + 8 * 8, T5 = T4 + 8 * 8, T6 = T5 + 8 * 8, T7 = T6 + 8 * 16, T8 = T7 + 8 * 16, T9 = T8 + 8 * 4;
    for (int t = blockIdx.x; t < T9; t += gridDim.x) {
        const float* src; int srcN, K, kind, loc, ldd = 0; bf16_t* dst; const float* ks = nullptr;
        if (t < T0) { src = Pk->in[2] + (size_t)l * 1024 * 5280; srcN = 5280; K = 1024; kind = 0; loc = t; dst = WT + OFF_WIN; }
        else if (t < T1) { src = Pk->in[12] + (size_t)l * 1024 * 3072; srcN = 3072; K = 1024; kind = 1; loc = t - T0; dst = WT + OFF_WIN + (size_t)5376 * 1024; }
        else if (t < T2) { src = Pk->in[5] + (size_t)l * 384 * 768; srcN = 768; K = 384; kind = 2; loc = t - T1; dst = WT + OFF_WUQ; ks = Pk->in[3] + l * 384; }
        else if (t < T3) { src = Pk->in[6] + (size_t)l * 256 * 1024; srcN = 1024; K = 256; kind = 3; loc = t - T2; dst = WT + OFF_WUKV; ks = Pk->in[4] + l * 256; }
        else if (t < T4) { src = Pk->in[9] + (size_t)l * 512 * 1024; srcN = 1024; K = 512; kind = 1; loc = t - T3; dst = WT + OFF_WABC; ldd = 1536; }
        else if (t < T5) { src = Pk->in[10] + (size_t)l * 512 * 1024; srcN = 1024; K = 512; kind = 1; loc = t - T4; dst = WT + OFF_WABC + 512; ldd = 1536; }
        else if (t < T6) { src = Pk->in[11] + (size_t)l * 512 * 1024; srcN = 1024; K = 512; kind = 1; loc = t - T5; dst = WT + OFF_WABC + 1024; ldd = 1536; }
        else if (t < T7) { src = Pk->in[14] + (size_t)l * 1024 * 1024; srcN = 1024; K = 1024; kind = 1; loc = t - T6; dst = WT + OFF_WO; }
        else if (t < T8) { src = Pk->in[17] + (size_t)l * 1024 * 1024; srcN = 1024; K = 1024; kind = 1; loc = t - T7; dst = WT + OFF_WPG; }
        else { src = Pk->in[18] + (size_t)l * 256 * 1024; srcN = 1024; K = 256; kind = 1; loc = t - T8; dst = WT + OFF_WP; }
        const int kt = K / 64; const int n0 = (loc / kt) * 128, k0 = (loc % kt) * 64;
        tr_tile(src, srcN, ldd ? ldd : K, dst, kind, n0, k0, ks, scr, tid);
    }
}
DI void convert_rows(const float* src, bf16_t* dst, size_t n) {
    const size_t stride = (size_t)gridDim.x * blockDim.x, ng = n / 8;
    for (size_t i = (size_t)blockIdx.x * blockDim.x + opaque_tid(); i < ng; i += 4 * stride) {
        f32x4 a[4], b[4];
#pragma unroll
        for (int j = 0; j < 4; ++j) { const size_t q = i + j * stride; if (q < ng) { a[j] = *(const f32x4*)(src + q * 8); b[j] = *(const f32x4*)(src + q * 8 + 4); } }
#pragma unroll
        for (int j = 0; j < 4; ++j) { const size_t q = i + j * stride; if (q < ng) *(u32x4*)(dst + q * 8) = pack8(a[j], b[j]); }
    }
}
typedef const __attribute__((address_space(4))) Params* KParams;
DI KParams kparams() { KParams p = (KParams)__builtin_amdgcn_kernarg_segment_ptr(); asm volatile("" : "+s"(p)); return p; }
DI unsigned char* wsbase() { unsigned char* w = kparams()->ws; asm volatile("" : "+s"(w)); return w; }

__global__ void __launch_bounds__(512, 2) fwd_megakernel(Params Punused) {
    extern __shared__ __attribute__((aligned(16))) unsigned char lds_raw[];
    cg::grid_group grid = cg::this_grid();
    LAS unsigned char* lds = (LAS unsigned char*)lds_raw;
#define G opaque_s((int)gridDim.x)
#define cu opaque_s((int)blockIdx.x)
#define XB_  ((bf16_t*)(ws + WS_XB))
#define WT_  ((bf16_t*)(ws + WS_WT))
#define PB_  ((bf16_t*)(ws + WS_PB))
#define Y_   ((bf16_t*)(ws + WS_Y))
#define H_   ((bf16_t*)(ws + WS_H))
#define QB_  ((bf16_t*)(ws + WS_MLA))
#define KB_  (QB_ + (size_t)HM * 768)
#define VB_  (KB_ + (size_t)HM * 768)
#define R_   ((float*)(ws + WS_H))
#define ROPE_ ((float*)(ws + CTL_ROPE))
#define KMP_ ((float*)(ws + CTL_KMP))
#define STQ_ ((float*)(ws + CTL_STQ))
#define STKV_ ((float*)(ws + CTL_STKV))

    if (threadIdx.x < 2) ((volatile LAS unsigned*)(lds + LDS_IDX + 64))[threadIdx.x] = 0u;
    {
        const int tid = opaque_tid();
        KParams P = kparams(); unsigned char* ws = P->ws;
        for (int rep = 0; rep < REP_P0; ++rep) {
        convert_weights(P, 0, WT_, (LAS float*)lds);
        convert_rows(P->in[0], XB_, (size_t)M * D);
        convert_rows(P->in[1], PB_, (size_t)M * 256); }
        float* rope = ROPE_;
        for (int i = cu * 512 + tid; i < SEQ * 16; i += G * 512) {
            const int pos = i >> 4, k = i & 15;
            const float freq = __builtin_amdgcn_exp2f(-(float)k * (13.287712379549449f / 16.f));
            const float ang = (float)pos * freq;
            double rev = (double)ang * 0.15915494309189535; rev -= __builtin_rint(rev);
            const float fr = (float)rev;
            rope[2 * i] = __builtin_amdgcn_cosf(fr); rope[2 * i + 1] = __builtin_amdgcn_sinf(fr);
        }
        if (cu == 0) {
            unsigned* ctl = (unsigned*)(ws + WS_CTL); float* lamv = (float*)(ws + CTL_LAM);
            if (tid < 64) {
#pragma unroll
                for (int l = 0; l < 2; ++l) { const float* dl = P->in[7] + l * 256; float a = dl[tid] * dl[64 + tid], b = dl[128 + tid] * dl[192 + tid];
#pragma unroll
                    for (int s = 1; s < 64; s <<= 1) { a += __shfl_xor(a, s); b += __shfl_xor(b, s); }
                    const float li = (l == 0) ? 0.2f : 0.35550906759096924f;
                    if (tid == 0) lamv[l] = __builtin_amdgcn_exp2f(a * LOG2E) - __builtin_amdgcn_exp2f(b * LOG2E) + li; }
            }
            if (tid < 64) ctl[tid] = 0u;
            if (tid < 128) ((unsigned*)(ws + CTL_DEP))[tid] = 0u;
            { unsigned* bw = (unsigned*)(ws + CTL_BAR); for (int i = tid; i < XCD_BAR_WORDS; i += 512) bw[i] = 0u; }
        }
    }
    grid.sync();
    if (threadIdx.x == 0) { unsigned char* ws = wsbase(); (void)xb_add(&((unsigned*)(ws + CTL_BAR))[XB_XCNT(xb_xcc_id())], 1u); }
#define GSYNC() do { unsigned char* _w = wsbase(); xcd_barrier((unsigned*)(_w + CTL_BAR), (volatile LAS unsigned*)(lds + LDS_IDX + 64)); } while (0)

    for (int l = 0; l < 2; ++l) {
        for (int hf = 0; hf < 2; ++hf) {
            for (int rep = 0; rep < REP_P1; ++rep)
            { unsigned char* ws = wsbase();
              pg8::Gemm g{XB_ + (size_t)hf * HM * D, WT_ + OFF_WIN, D, D}; pg8::P1Order S{G, cu};
              pg8::EpiH E{H_, KB_, KMP_ + (size_t)hf * 32 * 2 * 512, STQ_ + (size_t)hf * HM * 8, STKV_ + (size_t)hf * HM * 4, ROPE_, (unsigned*)(ws + CTL_DEP) + (l * 2 + hf) * 32};
              pg8::gemm_phase(lds, g, S, E); }
            {
                const int Gn = G, rem = 672 % Gn, NE = Gn - rem, e = cu - rem;
                pg8::ListOrder Sq{0, (e >= 0) ? 96 : 0, 3, (e >= 0) ? e : 0, NE}, Skv{96, (e >= 0) ? 224 : 96, 4, (e >= 0) ? e : 0, NE};
                if (opaque_tid() == 0) {
                    unsigned char* ws = wsbase(); unsigned* dep = (unsigned*)(ws + CTL_DEP) + (l * 2 + hf) * 32; pg8::Unit u;
                    for (int pass = 0; pass < 2; ++pass)
                        for (int i = 0; pass == 0 ? Sq.next(i, u) : Skv.next(i, u); ++i) {
                            unsigned sp = 0;
                            while (__hip_atomic_load(dep + u.pm, __ATOMIC_RELAXED, __HIP_MEMORY_SCOPE_AGENT) < 24u) { __builtin_amdgcn_s_sleep(2); if (++sp > (1u << 24)) break; }
                        }
                    __builtin_amdgcn_fence(__ATOMIC_ACQUIRE, "agent");
                    asm volatile("s_waitcnt vmcnt(0)" ::: "memory");
                }
                __syncthreads();
                { unsigned char* ws = wsbase();
                  pg8::Gemm g{H_ + C_CQL, WT_ + OFF_WUQ, HP, 384};
                  pg8::EpiUp<0> E{QB_, KB_, VB_, STQ_ + (size_t)hf * HM * 8, ROPE_}; pg8::gemm_phase(lds, g, Sq, E); }
                { unsigned char* ws = wsbase();
                  pg8::Gemm g{H_ + C_CKV, WT_ + OFF_WUKV, HP, 256};
                  pg8::EpiUp<1> E{QB_, KB_, VB_, STKV_ + (size_t)hf * HM * 4, ROPE_}; pg8::gemm_phase(lds, g, Skv, E); }
            }
            GSYNC();
            {
                for (int vcu = cu; vcu < 256; vcu += G)
                for (int step = 0; ; ++step) {
                    KParams P = kparams(); unsigned char* ws = P->ws;
                    const int x = vcu & 7, sl_ = vcu >> 3;
                    int type, u, bh;
                    if (step < 2) {
                        if (sl_ < 16) { type = 2; bh = 2 * x + (sl_ >> 3); const int j = sl_ & 7; u = (step == 0) ? 15 - j : j; }
                        else { const int t = sl_ - 16; bh = 4 * x + (t >> 2); type = step; u = 7 - (t & 3); }
                    } else {
                        if (opaque_tid() == 0) *(LAS int*)(lds + LDS_IDX) = (int)atomicAdd((unsigned*)(ws + WS_CTL) + 16 + (l * 2 + hf) * 8 + x, 1u);
                        __syncthreads();
                        const int k = *(LAS int*)(lds + LDS_IDX);
                        __syncthreads();
                        if (k >= 32) break;
                        u = 3 - (k >> 3); type = (k & 4) ? 0 : 1; bh = 4 * x + (k & 3);
                    }
                    if (type == 0) {
                        const int bl = bh >> 3, h = bh & 7, bg = 4 * hf + bl; const size_t ho = (size_t)bh * SEQ * 64;
                        const float sl = __builtin_amdgcn_exp2f(-(2.f / 3.f) * (float)(h + (h >> 1) + 2)) * LOG2E;
                        attn_unit<64, 64, 64, 256, true, true, true, 2>((LAS char*)lds, H_ + HM_AQ + ho, 64, H_ + HM_AK + ho, 64, H_ + HM_AV + ho, 64,
                            H_ + (size_t)bl * SEQ * HP + C_AZ + h * 64, HP,
                            Y_ + (size_t)bg * SEQ * 1536 + h * 64, 1536, u * 256, sl, KMP_ + (size_t)bg * 8 * 2 * 512 + h * 64, 0.f, nullptr, 1.f);
                    } else if (type == 1) {
                        const int bl = bh >> 3, h = bh & 7, bg = 4 * hf + bl;
                        attn_unit<96, 96, 64, 256, false, false, true, 2>((LAS char*)lds, QB_ + (size_t)bh * SEQ * 96, 96, KB_ + (size_t)bh * SEQ * 96, 96,
                            VB_ + (size_t)bh * SEQ * 64, 64, H_ + (size_t)bl * SEQ * HP + C_BZ + h * 64, HP,
                            Y_ + 512 + (size_t)bg * SEQ * 1536 + h * 64, 1536, u * 256, 0.f, nullptr, 0.f, nullptr, 1.f);
                    } else {
                        const int bl = bh >> 2, h = bh & 3, bg = 4 * hf + bl; const size_t ho = (size_t)bh * SEQ * 128;
                        const float sl = __builtin_amdgcn_exp2f(-(2.f / 3.f) * (float)(3 * h + 1)) * LOG2E;
                        const float lam = ((const float*)(ws + CTL_LAM))[l];
                        const float post = (l == 0) ? 0.8f : (1.f - 0.35550906759096924f);
                        attn_unit<64, 128, 128, 128, true, false, false, 1>((LAS char*)lds, H_ + HM_CQ + ho, 128, H_ + HM_CK + ho, 128, H_ + HM_CV + ho, 128,
                            H_ + (size_t)bl * SEQ * HP + C_CZ + h * 128, HP,
                            Y_ + 1024 + (size_t)bg * SEQ * 1536 + h * 128, 1536, u * 128, sl, nullptr, lam, P->in[8] + l * 128, post);
                    }
                }
            }
            GSYNC();
        }
        { KParams P = kparams(); unsigned char* ws = P->ws;
          pg8::Gemm g{XB_, WT_ + OFF_WIN + (size_t)5376 * 1024, D, D}; pg8::StaticOrder S; S.init(M, 3072, G, cu);
          pg8::EpiG E{H_, P->in[13] + l * 3072}; pg8::gemm_phase(lds, g, S, E); }
        GSYNC();
        { unsigned char* ws = wsbase();
          pg8::Gemm g{Y_, WT_ + OFF_WABC, 1536, 1536}; pg8::MergeOrder S{cu, G};
          pg8::EpiMerge E{H_, XB_}; pg8::MergeHook HK{H_}; pg8::gemm_phase(lds, g, S, E, HK); }
        GSYNC();
        { KParams P = kparams(); unsigned char* ws = P->ws;
          pg8::Gemm g{XB_, WT_ + OFF_WO, D, D}; pg8::StaticOrder S; S.init(M, D, G, cu);
          pg8::EpiR E{(l == 0) ? P->in[0] : (const float*)P->out, R_, Y_}; pg8::gemm_phase(lds, g, S, E); }
        GSYNC();
        { unsigned char* ws = wsbase();
          pg8::Gemm g{PB_, WT_ + OFF_WP, 256, 256}; pg8::StaticOrder S; S.init(M, D, G, cu);
          pg8::EpiBf E{XB_}; pg8::gemm_phase(lds, g, S, E); }
        { unsigned char* ws = wsbase();
          pg8::Gemm g{Y_, WT_ + OFF_WPG, D, D}; pg8::StaticOrder S; S.init(M, D, G, cu);
          pg8::EpiR2 E{R_, XB_}; pg8::gemm_phase(lds, g, S, E); }
        GSYNC();
        {
            KParams P = kparams(); unsigned char* ws = P->ws;
            const int tid = opaque_tid(), lane = tid & 63, wid = tid >> 6;
            const float* lg = P->in[15] + l * 1024; const float* lb = P->in[16] + l * 1024;
            float* outp = P->out; const float* R = R_; bf16_t* XB = XB_;
            const int gstep = (int)gridDim.x * 8;
            for (int row = (int)blockIdx.x * 8 + wid; row < M; row += 2 * gstep) {
                const bool two = row + gstep < M;
                const float* rp0 = R + (size_t)row * 1024; const float* rp1 = R + (size_t)(two ? row + gstep : row) * 1024;
                f32x4 v[2][4]; float s0 = 0.f, s1 = 0.f;
#pragma unroll
                for (int j = 0; j < 4; ++j) { v[0][j] = *(const f32x4*)(rp0 + 4 * lane + 256 * j); v[1][j] = *(const f32x4*)(rp1 + 4 * lane + 256 * j); }
#pragma unroll
                for (int j = 0; j < 4; ++j) { s0 += (v[0][j][0] + v[0][j][1]) + (v[0][j][2] + v[0][j][3]); s1 += (v[1][j][0] + v[1][j][1]) + (v[1][j][2] + v[1][j][3]); }
#pragma unroll
                for (int k = 1; k < 64; k <<= 1) { s0 += __shfl_xor(s0, k); s1 += __shfl_xor(s1, k); }
                const float mu0 = s0 * (1.f / 1024.f), mu1 = s1 * (1.f / 1024.f); float q0 = 0.f, q1 = 0.f;
#pragma unroll
                for (int j = 0; j < 4; ++j) { v[0][j] -= mu0; v[1][j] -= mu1;
                    q0 += (v[0][j][0] * v[0][j][0] + v[0][j][1] * v[0][j][1]) + (v[0][j][2] * v[0][j][2] + v[0][j][3] * v[0][j][3]);
                    q1 += (v[1][j][0] * v[1][j][0] + v[1][j][1] * v[1][j][1]) + (v[1][j][2] * v[1][j][2] + v[1][j][3] * v[1][j][3]); }
#pragma unroll
                for (int k = 1; k < 64; k <<= 1) { q0 += __shfl_xor(q0, k); q1 += __shfl_xor(q1, k); }
                const float rs0 = __builtin_amdgcn_rsqf(q0 * (1.f / 1024.f) + 1e-5f), rs1 = __builtin_amdgcn_rsqf(q1 * (1.f / 1024.f) + 1e-5f);
#pragma unroll
                for (int j = 0; j < 4; ++j) { const f32x4 gv = *(const f32x4*)(lg + 4 * lane + 256 * j), bv = *(const f32x4*)(lb + 4 * lane + 256 * j);
#pragma unroll
                    for (int t = 0; t < 2; ++t) { if (t == 1 && !two) break;
                        const size_t rr = (size_t)(t == 0 ? row : row + gstep);
                        const f32x4 y = v[t][j] * (t == 0 ? rs0 : rs1) * gv + bv;
                        *(f32x4*)(outp + rr * 1024 + 4 * lane + 256 * j) = y;
                        if (l == 0) { u32x2 w; w.x = pk2(y[0], y[1]); w.y = pk2(y[2], y[3]); *(u32x2*)(XB + rr * 1024 + 4 * lane + 256 * j) = w; } } }
            }
            if (l == 0) {
                __syncthreads();
                convert_weights(P, 1, WT_, (LAS float*)lds);
                convert_rows(P->in[1] + (size_t)M * 256, PB_, (size_t)M * 256);
            }
        }
        if (l == 0) GSYNC();
    }
}

#undef G
#undef cu
extern "C" void kernel_launch(void* const* d_in, const int* in_sizes, int n_in, void* d_out, int out_size, void* d_ws, size_t ws_size, hipStream_t stream) {
    static int grid_blocks = 0;
    if (grid_blocks == 0) {
        if (n_in != 19 || out_size != M * D || ws_size < WS_END) { fprintf(stderr, "kernel_launch: unexpected problem (n_in %d out %d ws %zu)\n", n_in, out_size, ws_size); grid_blocks = -1; return; }
        int dev = 0, cus = 0, per_cu = 0;
        hipGetDevice(&dev);
        hipDeviceGetAttribute(&cus, hipDeviceAttributeMultiprocessorCount, dev);
        if (hipFuncSetAttribute((const void*)fwd_megakernel, hipFuncAttributeMaxDynamicSharedMemorySize, LDS_BYTES) != hipSuccess) { fprintf(stderr, "kernel_launch: hipFuncSetAttribute failed\n"); grid_blocks = -1; return; }
        if (hipOccupancyMaxActiveBlocksPerMultiprocessor(&per_cu, (const void*)fwd_megakernel, 512, LDS_BYTES) != hipSuccess || per_cu < 1) { fprintf(stderr, "kernel_launch: occupancy query failed (%d)\n", per_cu); grid_blocks = -1; return; }
        grid_blocks = cus * per_cu;
        if (grid_blocks > 256) grid_blocks = 256;
    }
    if (grid_blocks < 0) return;
    Params p{};
    for (int i = 0; i < 19; ++i) p.in[i] = (const float*)d_in[i];
    p.out = (float*)d_out; p.ws = (unsigned char*)d_ws;
    void* args[] = {&p};
    hipError_t e = hipLaunchCooperativeKernel((const void*)fwd_megakernel, dim3(grid_blocks), dim3(512), args, LDS_BYTES, stream);
    if (e != hipSuccess) fprintf(stderr, "cooperative launch failed: %s (grid %d)\n", hipGetErrorString(e), grid_blocks);
}
```

```cpp
#include <hip/hip_runtime.h>
#include <hip/hip_cooperative_groups.h>
#include <cstdio>
#include <cstdint>
namespace cg = cooperative_groups;
#ifndef REP_ATT
#define REP_ATT 1
#endif
#ifndef REP_P1
#define REP_P1 1
#endif
#ifndef REP_P0
#define REP_P0 1
#endif

#define LAS __attribute__((address_space(3)))
#define DI __device__ __forceinline__
typedef unsigned short bf16_t;
typedef short bf16x8 __attribute__((ext_vector_type(8)));
typedef short s16x4 __attribute__((ext_vector_type(4)));
typedef float f32x2 __attribute__((ext_vector_type(2)));
typedef float f32x4 __attribute__((ext_vector_type(4)));
typedef float f32x16 __attribute__((ext_vector_type(16)));
typedef unsigned u32x4 __attribute__((ext_vector_type(4)));
typedef unsigned u32x2 __attribute__((ext_vector_type(2)));
typedef __bf16 bf16x2_t __attribute__((ext_vector_type(2)));

constexpr int M = 16384, D = 1024, SEQ = 2048, HM = 8192;
constexpr int HP = 2304;
constexpr int NH1 = 5376;
constexpr int NWIN = 8448;
constexpr float LOG2E = 1.4426950408889634f;
constexpr float QS64 = 0.125f * LOG2E;
constexpr float QS96 = 0.10206207261596575f * LOG2E;
constexpr float ALPHA = 1.4142135623730951f;
constexpr int C_AZ = 0, C_BZ = 512, C_CZ = 1024, C_CKV = 1536, C_CQL = 1792;
constexpr size_t HM_AQ = (size_t)18 * 1048576, HM_AK = (size_t)22 * 1048576, HM_AV = (size_t)26 * 1048576, HM_CQ = (size_t)30 * 1048576, HM_CK = (size_t)34 * 1048576, HM_CV = (size_t)38 * 1048576;

constexpr size_t MiB = 1048576;
constexpr size_t WS_CTL = 0, WS_XB = 2 * MiB, WS_WT = 34 * MiB, WS_PB = 60 * MiB, WS_Y = 68 * MiB, WS_H = 116 * MiB, WS_MLA = 200 * MiB, WS_END = 232 * MiB;
constexpr size_t CTL_DEP = 8192, CTL_BAR = 16384, CTL_LAM = 4096, CTL_ROPE = 65536, CTL_KMP = 384 * 1024, CTL_STQ = 640 * 1024, CTL_STKV = 1152 * 1024;
constexpr size_t OFF_WIN = 0, OFF_WUQ = 8650752, OFF_WUKV = 8945664, OFF_WABC = 9207808, OFF_WO = 10780672, OFF_WPG = 11829248, OFF_WP = 12877824;
constexpr int LDS_BYTES = 132 * 1024, LDS_IDX = 131072;

DI int opaque_s(int v) { asm volatile("" : "+s"(v)); return v; }
DI int opaque_tid() { int t = threadIdx.x; asm volatile("" : "+v"(t)); return t; }
DI unsigned pk2(float lo, float hi) { f32x2 v = {lo, hi}; bf16x2_t b = __builtin_convertvector(v, bf16x2_t); return __builtin_bit_cast(unsigned, b); }
DI float bflo(unsigned w) { return __uint_as_float(w << 16); }
DI float bfhi(unsigned w) { return __uint_as_float(w & 0xffff0000u); }
DI float bf2f(bf16_t b) { return __uint_as_float((unsigned)b << 16); }
DI bf16_t f2bf(float f) { return (bf16_t)(pk2(f, 0.f) & 0xffffu); }
DI float sigm(float x) { return __builtin_amdgcn_rcpf(1.f + __builtin_amdgcn_exp2f(-x * LOG2E)); }
DI float silu(float x) { return x * sigm(x); }
DI u32x4 pack8(const f32x4 a, const f32x4 b) { u32x4 w; w.x = pk2(a[0], a[1]); w.y = pk2(a[2], a[3]); w.z = pk2(b[0], b[1]); w.w = pk2(b[2], b[3]); return w; }
DI void unpack8(const u32x4 w, f32x4& a, f32x4& b) { a = (f32x4){bflo(w.x), bfhi(w.x), bflo(w.y), bfhi(w.y)}; b = (f32x4){bflo(w.z), bfhi(w.z), bflo(w.w), bfhi(w.w)}; }

namespace pg8 {
constexpr int BM = 256, BK = 64, HALF = 128, HTB = HALF * BK * 2, NXCD = 8, WGM = 8;
__host__ __device__ __forceinline__ int lds_byte(int r, int c) { const int st = (r >> 4) * 2 + (c >> 5), rr = r & 15, cc = c & 31, ob = rr * 64 + cc * 2; return st * 1024 + (ob ^ (((ob >> 9) & 1) << 5)); }
__host__ __device__ __forceinline__ void stage_rc(int b, int& R, int& C) { const int st = b / 1024, sb = b % 1024, swz = sb ^ (((sb >> 9) & 1) << 5); R = (st >> 1) * 16 + swz / 64; C = (st & 1) * 32 + (swz % 64) / 2; }
__host__ __device__ __forceinline__ int perm32(int rho) { const int n = rho >> 4, i = rho & 15; return 8 * (i >> 2) + 4 * n + (i & 3); }

struct Unit { int pm, pn; };
struct Gemm { const bf16_t* A; const bf16_t* Bt; int lda, K; };

struct StaticOrder {
    int nM, nN, nwg, G, c;
    DI void init(int M_, int N_, int G_, int c_) { nM = M_ / BM; nN = N_ / BM; nwg = nM * nN; G = G_; c = c_; }
    DI bool next(int i, Unit& u) const {
        const long L = (long)i * G + c; if (L >= nwg) return false;
        int wgid = (int)L; { const int q = nwg / NXCD, r = nwg % NXCD, xcd = wgid % NXCD, off = wgid / NXCD; wgid = (xcd < r ? xcd * (q + 1) : r * (q + 1) + (xcd - r) * q) + off; }
        const int nig = WGM * nN, gid = wgid / nig, fm = gid * WGM, gsz = (nM - fm) < WGM ? (nM - fm) : WGM;
        u.pm = fm + ((wgid % nig) % gsz); u.pn = (wgid % nig) / gsz; return true;
    }
};
struct P1Order {
    int G, c;
    DI bool next(int i, Unit& u) const {
        const long L = (long)i * G + c; if (L >= 672) return false;
        if (L < 96) { u.pm = (int)L / 3; u.pn = 18 + (int)L % 3; return true; }
        const int nM = 32, nN = 18, nwg = 576;
        int wgid = (int)L - 96; { const int q = nwg / NXCD, r = nwg % NXCD, xcd = wgid % NXCD, off = wgid / NXCD; wgid = (xcd < r ? xcd * (q + 1) : r * (q + 1) + (xcd - r) * q) + off; }
        const int nig = WGM * nN, gid = wgid / nig, fm = gid * WGM, gsz = (nM - fm) < WGM ? (nM - fm) : WGM;
        u.pm = fm + ((wgid % nig) % gsz); u.pn = (wgid % nig) / gsz; return true;
    }
};
struct ListOrder {
    int lo, hi, nN, c, G;
    DI bool next(int i, Unit& u) const {
        int k0 = 0; if (c < lo) k0 = (lo - c + G - 1) / G;
        const int idx = c + (k0 + i) * G; if (idx >= hi) return false;
        const int loc = idx - lo; u.pm = loc / nN; u.pn = loc % nN; return true;
    }
};
struct MergeOrder {
    int c, G;
    DI bool next(int i, Unit& u) const {
        int tile = c + i * G; if (tile >= 256) return false;
        if (G == 256) tile = (c & 7) * 32 + (c >> 3);
        u.pm = tile >> 2; u.pn = tile & 3; return true;
    }
};

struct NoHook { static constexpr bool ACTIVE = false; template <class A> DI void operator()(A&, const Unit&, int, int, int, int, int) const {} };
template <class Epi, class Sched, class Hook = NoHook>
DI void gemm_phase(LAS unsigned char* lds, const Gemm g, const Sched& S, const Epi& E, const Hook& HK = Hook()) {
    const int tid = opaque_tid(), wid = __builtin_amdgcn_readfirstlane(tid >> 6), lane = tid & 63, wr = wid >> 2, wc = wid & 3, fr = lane & 15, fq = lane >> 4;
    const int K = g.K, nt = K / BK, lda = g.lda;
    unsigned voffA[2], voffB[2];
#pragma unroll
    for (int i = 0; i < 2; ++i) { int R, C; stage_rc(tid * 16 + i * 8192, R, C); const int Rb = (R & ~31) + perm32(R & 31);
        voffA[i] = (unsigned)(R * lda + C) * 2u; voffB[i] = (unsigned)(Rb * K + C) * 2u; }
    const size_t kstep = (size_t)(BK * 2);
    const size_t hstepA = (size_t)HALF * lda * 2, hstepB = (size_t)HALF * K * 2;
    const size_t tstepA = 2 * hstepA, tstepB = 2 * hstepB;
    const unsigned ldsw = (unsigned)wid * 1024u;
    const int aoff = lds_byte(wr * 64 + fr, fq * 8), boff = lds_byte(wc * 32 + fr, fq * 8);
#define PG8_SA(b, h) (((b) * 2 + (h)) * HTB)
#define PG8_SB(b, h) ((4 + (b) * 2 + (h)) * HTB)
#define PG8_STAGE(bufoff, gbase, voff) do { _Pragma("unroll") for (int _i = 0; _i < 2; ++_i) \
        __builtin_amdgcn_global_load_lds((const unsigned*)((const char*)(gbase) + (voff)[_i]), (LAS unsigned*)(lds + (bufoff) + ldsw + _i * 8192), 16, 0, 0); } while (0)
#define PG8_LDA(dst, b, h) do { _Pragma("unroll") for (int m = 0; m < 4; ++m) _Pragma("unroll") for (int k = 0; k < 2; ++k) dst[m][k] = *(const LAS bf16x8*)(lds + PG8_SA(b, h) + aoff + m * 2048 + k * 1024); } while (0)
#define PG8_LDB(dst, b, h) do { _Pragma("unroll") for (int n = 0; n < 2; ++n) _Pragma("unroll") for (int k = 0; k < 2; ++k) dst[n][k] = *(const LAS bf16x8*)(lds + PG8_SB(b, h) + boff + n * 2048 + k * 1024); } while (0)
#define PG8_MMA(ai, bj, At, Bt) do { __builtin_amdgcn_s_setprio(1); _Pragma("unroll") for (int m = 0; m < 4; ++m) _Pragma("unroll") for (int n = 0; n < 2; ++n) _Pragma("unroll") for (int k = 0; k < 2; ++k) \
        acc[ai][bj][m][n] = __builtin_amdgcn_mfma_f32_16x16x32_bf16(Bt[n][k], At[m][k], acc[ai][bj][m][n], 0, 0, 0); __builtin_amdgcn_s_setprio(0); } while (0)
#define PG8_WAIT_V(n) asm volatile("s_waitcnt vmcnt(" #n ")" ::: "memory")
#define PG8_WAIT_L(n) asm volatile("s_waitcnt lgkmcnt(" #n ")" ::: "memory")
#define PG8_BAR __builtin_amdgcn_s_barrier()
#define PG8_SCHED __builtin_amdgcn_sched_barrier(0)
    Unit cur, nxt; int ui = 0;
    if (!S.next(0, cur)) return;
    f32x4 acc[2][2][4][2];
#pragma unroll
    for (int a = 0; a < 2; ++a)
#pragma unroll
        for (int b = 0; b < 2; ++b)
#pragma unroll
            for (int m = 0; m < 4; ++m)
#pragma unroll
                for (int n = 0; n < 2; ++n) acc[a][b][m][n] = (f32x4){0.f, 0.f, 0.f, 0.f};
    bf16x8 At[4][2], B0[2][2], B1[2][2];
    const char* cA = (const char*)g.A + (size_t)cur.pm * tstepA; const char* cB = (const char*)g.Bt + (size_t)cur.pn * tstepB;
    PG8_STAGE(PG8_SB(0, 0), cB, voffB); PG8_STAGE(PG8_SB(0, 1), cB + hstepB, voffB); PG8_STAGE(PG8_SA(0, 0), cA, voffA); PG8_STAGE(PG8_SA(0, 1), cA + hstepA, voffA);
    if (wr == 1) PG8_BAR;
    PG8_WAIT_V(2); PG8_BAR;
    PG8_STAGE(PG8_SB(1, 0), cB + kstep, voffB); PG8_STAGE(PG8_SA(1, 0), cA + kstep, voffA); PG8_STAGE(PG8_SB(1, 1), cB + hstepB + kstep, voffB);
    PG8_WAIT_V(6); PG8_BAR;
    for (;;) {
        const bool has_next = S.next(ui + 1, nxt);
        const char* nA = has_next ? (const char*)g.A + (size_t)nxt.pm * tstepA : cA; const char* nB = has_next ? (const char*)g.Bt + (size_t)nxt.pn * tstepB : cB;
#pragma nounroll
        for (int t = 0; t < nt; t += 2) {
            if (Hook::ACTIVE) { if (t == 8 || t == 16) { HK(acc, cur, t, wr, wc, fr, fq); asm volatile("s_waitcnt vmcnt(0)" ::: "memory"); } }
            const bool last = (t == nt - 2);
            const char* a1 = cA + (size_t)(t + 1) * kstep;
            const char* a2 = last ? nA : cA + (size_t)(t + 2) * kstep; const char* b2 = last ? nB : cB + (size_t)(t + 2) * kstep;
            const char* a3 = a2 + kstep; const char* b3 = b2 + kstep;
            PG8_LDB(B0, 0, 0); PG8_LDB(B1, 0, 1); PG8_SCHED; PG8_LDA(At, 0, 0); PG8_STAGE(PG8_SA(1, 1), a1 + hstepA, voffA);
            PG8_WAIT_V(8); PG8_WAIT_L(0); PG8_BAR; PG8_MMA(0, 0, At, B0); PG8_MMA(0, 1, At, B1); PG8_BAR; PG8_SCHED;
            PG8_LDA(At, 0, 1); PG8_STAGE(PG8_SB(0, 0), b2, voffB); PG8_STAGE(PG8_SB(0, 1), b2 + hstepB, voffB); PG8_STAGE(PG8_SA(0, 0), a2, voffA);
            PG8_WAIT_V(8); PG8_WAIT_L(0); PG8_BAR; PG8_MMA(1, 0, At, B0); PG8_MMA(1, 1, At, B1); PG8_BAR; PG8_SCHED;
            PG8_LDB(B0, 1, 0); PG8_LDB(B1, 1, 1); PG8_SCHED; PG8_LDA(At, 1, 0); PG8_STAGE(PG8_SA(0, 1), a2 + hstepA, voffA);
            PG8_WAIT_V(8); PG8_WAIT_L(0); PG8_BAR; PG8_MMA(0, 0, At, B0); PG8_MMA(0, 1, At, B1); PG8_BAR; PG8_SCHED;
            PG8_LDA(At, 1, 1); PG8_STAGE(PG8_SB(1, 0), b3, voffB); PG8_STAGE(PG8_SB(1, 1), b3 + hstepB, voffB); PG8_STAGE(PG8_SA(1, 0), a3, voffA);
            PG8_WAIT_V(8); PG8_WAIT_L(0); PG8_BAR; PG8_MMA(1, 0, At, B0); PG8_MMA(1, 1, At, B1); PG8_BAR; PG8_SCHED;
        }
        if (wr == 0) PG8_BAR;
        E(acc, cur, wr, wc, fr, fq);
        if (!has_next) break;
#pragma unroll
        for (int a = 0; a < 2; ++a)
#pragma unroll
            for (int b = 0; b < 2; ++b)
#pragma unroll
                for (int m = 0; m < 4; ++m)
#pragma unroll
                    for (int n = 0; n < 2; ++n) acc[a][b][m][n] = (f32x4){0.f, 0.f, 0.f, 0.f};
        cur = nxt; cA = nA; cB = nB; ++ui;
        if (wr == 1) PG8_BAR;
    }
    PG8_WAIT_V(0);
    PG8_BAR;
#undef PG8_SA
#undef PG8_SB
#undef PG8_STAGE
#undef PG8_LDA
#undef PG8_LDB
#undef PG8_MMA
#undef PG8_WAIT_V
#undef PG8_WAIT_L
#undef PG8_BAR
#undef PG8_SCHED
}
typedef f32x4 Acc[2][2][4][2];

struct EpiH {
    bf16_t* H; bf16_t* KB; float* KMP; float* STQ; float* STKV; const float* rope; unsigned* dep;
    DI void operator()(const Acc& acc, const Unit& u, int wr, int wc, int fr, int fq) const {
        const int row0 = u.pm * BM + wr * 64 + fr;
        {
            const int pn = u.pn; bf16_t* base; int hw = 0, cseg;
            if (pn < 6) { base = H + (pn < 2 ? HM_AQ : pn < 4 ? HM_AK : HM_AV); hw = 64; cseg = (pn & 1) * 256; }
            else if (pn < 10) { base = H + (pn < 8 ? C_AZ : C_BZ); cseg = (pn & 1) * 256; }
            else if (pn < 16) { base = H + (pn < 12 ? HM_CQ : pn < 14 ? HM_CK : HM_CV); hw = 128; cseg = (pn & 1) * 256; }
            else if (pn < 18) { base = H + C_CZ; cseg = (pn & 1) * 256; }
            else { base = H + C_CKV; cseg = (pn - 18) * 256; }
            const int bl = u.pm >> 3, s0 = (u.pm & 7) * 256 + wr * 64 + fr;
#pragma unroll
            for (int bj = 0; bj < 2; ++bj) { const int cs = cseg + bj * HALF + wc * 32 + 8 * fq;
                bf16_t* colp; size_t pitch;
                if (hw == 64) { colp = base + ((size_t)(bl * 8 + (cs >> 6)) * SEQ) * 64 + (cs & 63); pitch = 64; }
                else if (hw == 128) { colp = base + ((size_t)(bl * 4 + (cs >> 7)) * SEQ) * 128 + (cs & 127); pitch = 128; }
                else { colp = base + (size_t)bl * SEQ * HP + cs; pitch = HP; }
#pragma unroll
                for (int ai = 0; ai < 2; ++ai)
#pragma unroll
                    for (int m = 0; m < 4; ++m) *(u32x4*)(colp + (size_t)(s0 + ai * HALF + m * 16) * pitch) = pack8(acc[ai][bj][m][0], acc[ai][bj][m][1]); }
        }
        if (u.pn == 2 || u.pn == 3) {
            float* dst = KMP + (size_t)(u.pm * 2 + wr) * 512 + (u.pn - 2) * 256 + wc * 32 + 8 * fq;
#pragma unroll
            for (int bj = 0; bj < 2; ++bj)
#pragma unroll
                for (int n = 0; n < 2; ++n) { f32x4 s = (f32x4){0.f, 0.f, 0.f, 0.f};
#pragma unroll
                    for (int ai = 0; ai < 2; ++ai)
#pragma unroll
                        for (int m = 0; m < 4; ++m) s += acc[ai][bj][m][n];
#pragma unroll
                    for (int e = 0; e < 4; ++e) { float v = s[e]; v += __shfl_xor(v, 1); v += __shfl_xor(v, 2); v += __shfl_xor(v, 4); v += __shfl_xor(v, 8); s[e] = v; }
                    if (fr == 0) *(f32x4*)(dst + bj * HALF + 4 * n) = s; }
        }
        if (u.pn >= 18) {
#pragma unroll
            for (int ai = 0; ai < 2; ++ai)
#pragma unroll
                for (int m = 0; m < 4; ++m) { const int row = row0 + ai * HALF + m * 16; float ss = 0.f;
#pragma unroll
                    for (int bj = 0; bj < 2; ++bj) { if (u.pn == 20 && bj == 1) continue;
#pragma unroll
                        for (int n = 0; n < 2; ++n) { const f32x4 x = acc[ai][bj][m][n]; ss += (x[0] * x[0] + x[1] * x[1]) + (x[2] * x[2] + x[3] * x[3]); } }
                    ss += __shfl_xor(ss, 16); ss += __shfl_xor(ss, 32);
                    if (fq == 0) { if (u.pn == 18) STKV[(size_t)row * 4 + wc] = ss; else STQ[(size_t)row * 8 + (u.pn - 19) * 4 + wc] = ss; }
                    if (u.pn == 20 && wc == 0) {
                        const int pos = row & (SEQ - 1); f32x4 o[2];
#pragma unroll
                        for (int n = 0; n < 2; ++n) { const f32x4 cs = *(const f32x4*)(rope + ((size_t)pos * 16 + 4 * fq + 2 * n) * 2); const f32x4 t = acc[ai][1][m][n];
                            o[n] = (f32x4){t[0] * cs[0] - t[1] * cs[1], t[0] * cs[1] + t[1] * cs[0], t[2] * cs[2] - t[3] * cs[3], t[2] * cs[3] + t[3] * cs[2]}; }
                        const u32x4 w = pack8(o[0], o[1]);
#pragma unroll
                        for (int h = 0; h < 8; ++h) *(u32x4*)(KB + ((size_t)((row >> 11) * 8 + h) * SEQ + pos) * 96 + 64 + 8 * fq) = w;
                    }
                }
        }
        if (u.pn >= 18) {
            asm volatile("s_waitcnt vmcnt(0)" ::: "memory");
            __syncthreads();
            if (threadIdx.x == 0) {
                __builtin_amdgcn_fence(__ATOMIC_RELEASE, "agent");
                asm volatile("s_waitcnt vmcnt(0)" ::: "memory");
                __hip_atomic_fetch_add(dep + u.pm, 8u, __ATOMIC_RELAXED, __HIP_MEMORY_SCOPE_AGENT);
            }
        }
    }
};
template <int MODE> struct EpiUp {
    bf16_t* QB; bf16_t* KB; bf16_t* VB; const float* ST; const float* rope;
    DI void operator()(const Acc& acc, const Unit& u, int wr, int wc, int fr, int fq) const {
        const int row0 = u.pm * BM + wr * 64 + fr;
#pragma unroll
        for (int ai = 0; ai < 2; ++ai)
#pragma unroll
            for (int m = 0; m < 4; ++m) { const int row = row0 + ai * HALF + m * 16; float sc;
                if (MODE == 0) { const f32x4 a = *(const f32x4*)(ST + (size_t)row * 8), b = *(const f32x4*)(ST + (size_t)row * 8 + 4);
                    sc = __builtin_amdgcn_rsqf(((a[0] + a[1]) + (a[2] + a[3]) + (b[0] + b[1]) + (b[2] + b[3])) * (1.f / 384.f) + 1e-6f) * QS96; }
                else { const f32x4 a = *(const f32x4*)(ST + (size_t)row * 4); sc = __builtin_amdgcn_rsqf(((a[0] + a[1]) + (a[2] + a[3])) * (1.f / 256.f) + 1e-6f); }
                const int pos = row & (SEQ - 1);
#pragma unroll
                for (int bj = 0; bj < 2; ++bj) { const int c0 = u.pn * BM + bj * HALF + wc * 32 + 8 * fq;
                    f32x4 v0 = acc[ai][bj][m][0] * sc, v1 = acc[ai][bj][m][1] * sc;
                    if (MODE == 0) { const int j = c0 % 96;
                        if (j >= 64) { const int i0 = (j - 64) >> 1; const f32x4 ca = *(const f32x4*)(rope + ((size_t)pos * 16 + i0) * 2), cb = *(const f32x4*)(rope + ((size_t)pos * 16 + i0 + 2) * 2);
                            v0 = (f32x4){v0[0] * ca[0] - v0[1] * ca[1], v0[0] * ca[1] + v0[1] * ca[0], v0[2] * ca[2] - v0[3] * ca[3], v0[2] * ca[3] + v0[3] * ca[2]};
                            v1 = (f32x4){v1[0] * cb[0] - v1[1] * cb[1], v1[0] * cb[1] + v1[1] * cb[0], v1[2] * cb[2] - v1[3] * cb[3], v1[2] * cb[3] + v1[3] * cb[2]}; }
                        *(u32x4*)(QB + ((size_t)((row >> 11) * 8 + c0 / 96) * SEQ + pos) * 96 + j) = pack8(v0, v1); }
                    else { if (c0 < 512) *(u32x4*)(KB + ((size_t)((row >> 11) * 8 + (c0 >> 6)) * SEQ + pos) * 96 + (c0 & 63)) = pack8(v0, v1);
                           else *(u32x4*)(VB + ((size_t)((row >> 11) * 8 + ((c0 - 512) >> 6)) * SEQ + pos) * 64 + (c0 & 63)) = pack8(v0, v1); }
                }
            }
    }
};
DI size_t gfrag(int pm, int pnn, int wr, int wc, int fr, int fq) { return ((size_t)(pm * 12 + pnn) * 65536) + (size_t)(((wr * 4 + wc) * 64 + fq * 16 + fr) * 8); }
struct EpiG {
    bf16_t* G; const float* bias;
    DI void operator()(const Acc& acc, const Unit& u, int wr, int wc, int fr, int fq) const {
        const int row0 = u.pm * BM + wr * 64 + fr, col0 = u.pn * BM + wc * 32 + 8 * fq;
        f32x4 bv[2][2];
#pragma unroll
        for (int bj = 0; bj < 2; ++bj)
#pragma unroll
            for (int n = 0; n < 2; ++n) bv[bj][n] = *(const f32x4*)(bias + col0 + bj * HALF + 4 * n);
#pragma unroll
        for (int ai = 0; ai < 2; ++ai)
#pragma unroll
            for (int m = 0; m < 4; ++m) { bf16_t* rowp = G + gfrag(u.pm, u.pn, wr, wc, fr, fq) + (size_t)((ai * 4 + m) * 2) * 4096;
#pragma unroll
                for (int bj = 0; bj < 2; ++bj) { f32x4 v0 = acc[ai][bj][m][0] + bv[bj][0], v1 = acc[ai][bj][m][1] + bv[bj][1];
#pragma unroll
                    for (int e = 0; e < 4; ++e) { v0[e] = fmaxf(sigm(v0[e]), 1e-12f); v1[e] = fmaxf(sigm(v1[e]), 1e-12f); }
                    *(u32x4*)(rowp + bj * 4096) = pack8(v0, v1); } }
    }
};
struct MergeHook {
    static constexpr bool ACTIVE = true;
    const bf16_t* G;
    DI void operator()(Acc& acc, const Unit& u, int t, int wr, int wc, int fr, int fq) const {
        const int seg = (t == 8) ? 0 : 1;
        const int row0 = u.pm * BM + wr * 64 + fr, col0 = u.pn * BM + wc * 32 + 8 * fq;
        const bf16_t* gp = G + gfrag(u.pm, seg * 4 + u.pn, wr, wc, fr, fq);
#pragma unroll
        for (int ai = 0; ai < 2; ++ai) {
            u32x4 ga[8], gb[8];
#pragma unroll
            for (int m = 0; m < 4; ++m)
#pragma unroll
                for (int bj = 0; bj < 2; ++bj) { const bf16_t* p = gp + (size_t)((ai * 4 + m) * 2 + bj) * 4096; ga[m * 2 + bj] = *(const u32x4*)p; gb[m * 2 + bj] = *(const u32x4*)(p + 4 * 65536); }
            __builtin_amdgcn_sched_barrier(0);
#pragma unroll
            for (int m = 0; m < 4; ++m)
#pragma unroll
                for (int bj = 0; bj < 2; ++bj) { f32x4 a0, a1, b0, b1; unpack8(ga[m * 2 + bj], a0, a1); unpack8(gb[m * 2 + bj], b0, b1);
#pragma unroll
                    for (int e = 0; e < 4; ++e) { acc[ai][bj][m][0][e] *= a0[e] * __builtin_amdgcn_rcpf(b0[e]); acc[ai][bj][m][1][e] *= a1[e] * __builtin_amdgcn_rcpf(b1[e]); } }
            __builtin_amdgcn_sched_barrier(0);
        }
    }
};
struct EpiMerge {
    const bf16_t* G; bf16_t* MG;
    DI void operator()(const Acc& acc, const Unit& u, int wr, int wc, int fr, int fq) const {
        const int row0 = u.pm * BM + wr * 64 + fr, col0 = u.pn * BM + wc * 32 + 8 * fq;
        const bf16_t* gp = G + gfrag(u.pm, 8 + u.pn, wr, wc, fr, fq); bf16_t* mp = MG + (size_t)row0 * 1024 + col0;
#pragma unroll
        for (int ai = 0; ai < 2; ++ai) {
            u32x4 gq[8];
#pragma unroll
            for (int m = 0; m < 4; ++m)
#pragma unroll
                for (int bj = 0; bj < 2; ++bj) gq[m * 2 + bj] = *(const u32x4*)(gp + (size_t)((ai * 4 + m) * 2 + bj) * 4096);
            __builtin_amdgcn_sched_barrier(0);
#pragma unroll
            for (int m = 0; m < 4; ++m)
#pragma unroll
                for (int bj = 0; bj < 2; ++bj) { f32x4 g0, g1; unpack8(gq[m * 2 + bj], g0, g1);
                    *(u32x4*)(mp + (size_t)(ai * HALF + m * 16) * 1024 + bj * HALF) = pack8(acc[ai][bj][m][0] * g0, acc[ai][bj][m][1] * g1); }
            __builtin_amdgcn_sched_barrier(0);
        }
    }
};
struct EpiR {
    const float* X; float* R; bf16_t* RB;
    DI void operator()(const Acc& acc, const Unit& u, int wr, int wc, int fr, int fq) const {
        const int row0 = u.pm * BM + wr * 64 + fr, col0 = u.pn * BM + wc * 32 + 8 * fq;
        const size_t base = (size_t)row0 * 1024 + col0;
#pragma unroll
        for (int hb = 0; hb < 4; ++hb) {
            const int ai = hb >> 1, m0 = (hb & 1) * 2;
            f32x4 xq[8];
#pragma unroll
            for (int mm = 0; mm < 2; ++mm)
#pragma unroll
                for (int bj = 0; bj < 2; ++bj) { const size_t off = base + (size_t)(ai * HALF + (m0 + mm) * 16) * 1024 + bj * HALF;
                    xq[(mm * 2 + bj) * 2] = *(const f32x4*)(X + off); xq[(mm * 2 + bj) * 2 + 1] = *(const f32x4*)(X + off + 4); }
            __builtin_amdgcn_sched_barrier(0);
#pragma unroll
            for (int mm = 0; mm < 2; ++mm)
#pragma unroll
                for (int bj = 0; bj < 2; ++bj) { const size_t off = base + (size_t)(ai * HALF + (m0 + mm) * 16) * 1024 + bj * HALF;
                    const f32x4 v0 = xq[(mm * 2 + bj) * 2] * ALPHA + acc[ai][bj][m0 + mm][0], v1 = xq[(mm * 2 + bj) * 2 + 1] * ALPHA + acc[ai][bj][m0 + mm][1];
                    *(f32x4*)(R + off) = v0; *(f32x4*)(R + off + 4) = v1;
                    *(u32x4*)(RB + off) = pack8(v0, v1); }
            __builtin_amdgcn_sched_barrier(0);
        }
    }
};
struct EpiBf {
    bf16_t* O;
    DI void operator()(const Acc& acc, const Unit& u, int wr, int wc, int fr, int fq) const {
        const int row0 = u.pm * BM + wr * 64 + fr, col0 = u.pn * BM + wc * 32 + 8 * fq;
#pragma unroll
        for (int ai = 0; ai < 2; ++ai)
#pragma unroll
            for (int m = 0; m < 4; ++m) { bf16_t* rowp = O + (size_t)(row0 + ai * HALF + m * 16) * 1024 + col0;
#pragma unroll
                for (int bj = 0; bj < 2; ++bj) *(u32x4*)(rowp + bj * HALF) = pack8(acc[ai][bj][m][0], acc[ai][bj][m][1]); }
    }
};
struct EpiR2 {
    float* R; const bf16_t* PP;
    DI void operator()(const Acc& acc, const Unit& u, int wr, int wc, int fr, int fq) const {
        const int row0 = u.pm * BM + wr * 64 + fr, col0 = u.pn * BM + wc * 32 + 8 * fq;
        const size_t base = (size_t)row0 * 1024 + col0;
#pragma unroll
        for (int hb = 0; hb < 4; ++hb) {
            const int ai = hb >> 1, m0 = (hb & 1) * 2;
            f32x4 rq[8]; u32x4 pq[4];
#pragma unroll
            for (int mm = 0; mm < 2; ++mm)
#pragma unroll
                for (int bj = 0; bj < 2; ++bj) { const size_t off = base + (size_t)(ai * HALF + (m0 + mm) * 16) * 1024 + bj * HALF;
                    pq[mm * 2 + bj] = *(const u32x4*)(PP + off); rq[(mm * 2 + bj) * 2] = *(const f32x4*)(R + off); rq[(mm * 2 + bj) * 2 + 1] = *(const f32x4*)(R + off + 4); }
            __builtin_amdgcn_sched_barrier(0);
#pragma unroll
            for (int mm = 0; mm < 2; ++mm)
#pragma unroll
                for (int bj = 0; bj < 2; ++bj) { const size_t off = base + (size_t)(ai * HALF + (m0 + mm) * 16) * 1024 + bj * HALF;
                    f32x4 p0, p1; unpack8(pq[mm * 2 + bj], p0, p1);
                    f32x4 r0 = rq[(mm * 2 + bj) * 2], r1 = rq[(mm * 2 + bj) * 2 + 1];
                    const f32x4 a0 = acc[ai][bj][m0 + mm][0], a1 = acc[ai][bj][m0 + mm][1];
#pragma unroll
                    for (int e = 0; e < 4; ++e) { r0[e] += sigm(a0[e]) * p0[e]; r1[e] += sigm(a1[e]) * p1[e]; }
                    *(f32x4*)(R + off) = r0; *(f32x4*)(R + off + 4) = r1; }
            __builtin_amdgcn_sched_barrier(0);
        }
    }
};
}

DI int crow(int r, int hi) { return (r & 3) + 8 * (r >> 2) + 4 * hi; }
DI s16x4 vtr(LAS const char* p) { typedef short v4i16_t __attribute__((ext_vector_type(4))); return __builtin_bit_cast(s16x4, __builtin_amdgcn_ds_read_tr16_b64_v4i16((LAS v4i16_t*)p)); }
constexpr int AT_SCR = 112 * 1024, AT_KM = 113 * 1024;
constexpr float NEGBIG = -1e30f;
DI float max3f(float a, float b, float c) { return fmaxf(fmaxf(a, b), c); }

template <int DQK, int KW, int DV, int NROWS, bool ALIBI, bool MOBA, bool PIPE, int NSET>
DI void attn_unit(LAS char* lds, const bf16_t* Qp, int ldq, const bf16_t* Kp, int ldk, const bf16_t* Vp, int ldv,
                  const bf16_t* Zp, int ldz, bf16_t* Yp, int ldy, int q0, float sl2, const float* kmp, float lam, const float* subg, float post) {
    constexpr int NTD = NROWS / 64, NS = DQK / 16, ND = DV / 32, PVG = (DV == 64) ? 2 : 1;
    constexpr int KPITCH = KW * 2 + 16, VPITCH = DV * 2 + 64;
    constexpr int KOFF0 = 0, VOFF0 = 3 * 64 * KPITCH;
    constexpr int KCH = KW / 8, VCH = DV / 8, NKC = 64 * KCH, NVC = 64 * VCH, KPT = (NKC + 511) / 512, VPT = (NVC + 511) / 512;
    static_assert(VOFF0 + 3 * 64 * VPITCH <= AT_SCR, "attention LDS map");
    const int tid = opaque_tid(), lane = tid & 63, r32 = lane & 31, hi = lane >> 5;
    const int wid = __builtin_amdgcn_readfirstlane(tid >> 6);
    const int ro = (NROWS == 256) ? 32 * wid : 32 * (wid & 3);
    const int map = (NROWS == 256) ? 0 : (wid >> 2);
    const int qpos = q0 + ro + r32;
    LAS float* scr = (LAS float*)(lds + AT_SCR) + wid * 32;

    bf16x8 qf[NS];
    { const bf16_t* qrow = Qp + (size_t)qpos * ldq + 64 * map + 8 * hi;
#pragma unroll
      for (int s = 0; s < NS; ++s) qf[s] = *(const bf16x8*)(qrow + 16 * s); }

    unsigned sel = 0xFFu;
    if (MOBA) {
        const int u = q0 >> 8;
        if (u > 3) {
            LAS float* km = (LAS float*)(lds + AT_KM);
            { const int j = tid >> 6, d = tid & 63; if (j < u) km[j * 64 + d] = (kmp[(size_t)(j * 2) * 512 + d] + kmp[(size_t)(j * 2 + 1) * 512 + d]) * (1.f / 256.f); }
            __syncthreads();
            float g[7];
#pragma unroll
            for (int j = 0; j < 7; ++j) { float a = 0.f;
                if (j < u) {
#pragma unroll
                    for (int s = 0; s < 4; ++s) { const f32x4 k0 = *(const LAS f32x4*)(km + j * 64 + 16 * s + 8 * hi), k1 = *(const LAS f32x4*)(km + j * 64 + 16 * s + 8 * hi + 4);
#pragma unroll
                        for (int e = 0; e < 4; ++e) { a += bf2f((bf16_t)qf[s][e]) * k0[e]; a += bf2f((bf16_t)qf[s][4 + e]) * k1[e]; } }
                }
                a += __shfl_xor(a, 32); g[j] = a; }
            sel = 0u;
#pragma unroll
            for (int k = 0; k < 3; ++k) { float best = -INFINITY; int bi = 0;
#pragma unroll
                for (int j = 0; j < 7; ++j) { const bool ok = (j < u) && !((sel >> j) & 1u) && (g[j] > best); best = ok ? g[j] : best; bi = ok ? j : bi; }
                sel |= 1u << bi; }
        }
    }

    f32x16 o[ND];
#pragma unroll
    for (int d0 = 0; d0 < ND; ++d0)
#pragma unroll
        for (int r = 0; r < 16; ++r) o[d0][r] = 0.f;
    f32x16 bias;
#pragma unroll
    for (int r = 0; r < 16; ++r) bias[r] = ALIBI ? sl2 * (float)((r & 3) + 8 * (r >> 2) + 4 * hi) : 0.f;
    const float d32 = ALIBI ? 32.f * sl2 : 0.f;
    float mrun = NEGBIG, lrun = 0.f;
    const int nt = NTD + (q0 >> 6);
    u32x4 kregA[KPT], vregA[VPT], kregB[KPT], vregB[VPT], kregC[KPT], vregC[VPT], kregD[KPT], vregD[VPT];
#define AT_TB(it) ((it) < NTD ? q0 + 64 * (it) : 64 * ((it) - NTD))
#define AT_LOAD(it, kreg, vreg) do { const int _ti = ((it) < nt) ? (it) : nt - 1; const int _kb = AT_TB(_ti); \
        _Pragma("unroll") for (int _i = 0; _i < KPT; ++_i) { const int _c = tid + 512 * _i; if (NKC % 512 == 0 || _i + 1 < KPT || _c < NKC) { const int _r = _c / KCH, _cc = _c % KCH; kreg[_i] = *(const u32x4*)(Kp + (size_t)(_kb + _r) * ldk + 8 * _cc); } } \
        _Pragma("unroll") for (int _i = 0; _i < VPT; ++_i) { const int _c = tid + 512 * _i; if (NVC % 512 == 0 || _i + 1 < VPT || _c < NVC) { const int _r = _c / VCH, _cc = _c % VCH; vreg[_i] = *(const u32x4*)(Vp + (size_t)(_kb + _r) * ldv + 8 * _cc); } } } while (0)
#define AT_STORE(buf, kreg, vreg) do { \
        _Pragma("unroll") for (int _i = 0; _i < KPT; ++_i) { const int _c = tid + 512 * _i; if (NKC % 512 == 0 || _i + 1 < KPT || _c < NKC) { const int _r = _c / KCH, _cc = _c % KCH; *(LAS u32x4*)(lds + KOFF0 + (buf) * 64 * KPITCH + _r * KPITCH + 16 * _cc) = kreg[_i]; } } \
        _Pragma("unroll") for (int _i = 0; _i < VPT; ++_i) { const int _c = tid + 512 * _i; if (NVC % 512 == 0 || _i + 1 < VPT || _c < NVC) { const int _r = _c / VCH, _cc = _c % VCH; *(LAS u32x4*)(lds + VOFF0 + (buf) * 64 * VPITCH + _r * VPITCH + 16 * _cc) = vreg[_i]; } } } while (0)
#define AT_ACTIVE(it) ((it) >= NTD || 64 * (it) <= ro + 31)
#define AT_QK(it, bufi, P0, P1) do { if (AT_ACTIVE(it)) { \
        LAS const char* _Kb = lds + KOFF0 + (bufi) * 64 * KPITCH + r32 * KPITCH + (64 * map + 8 * hi) * 2; \
        _Pragma("unroll") for (int _h = 0; _h < NS; _h += 4) { \
            bf16x8 _kf[8]; \
            _Pragma("unroll") for (int _s = 0; _s < 4; ++_s) if (_h + _s < NS) { _kf[2 * _s] = *(const LAS bf16x8*)(_Kb + 32 * (_h + _s)); _kf[2 * _s + 1] = *(const LAS bf16x8*)(_Kb + 32 * KPITCH + 32 * (_h + _s)); } \
            __builtin_amdgcn_sched_barrier(0); \
            _Pragma("unroll") for (int _s = 0; _s < 4; ++_s) if (_h + _s < NS) { \
                if (_h + _s == 0) { P0 = __builtin_amdgcn_mfma_f32_32x32x16_bf16(_kf[0], qf[0], bias, 0, 0, 0); P1 = __builtin_amdgcn_mfma_f32_32x32x16_bf16(_kf[1], qf[0], bias, 0, 0, 0); } \
                else { P0 = __builtin_amdgcn_mfma_f32_32x32x16_bf16(_kf[2 * _s], qf[_h + _s], P0, 0, 0, 0); P1 = __builtin_amdgcn_mfma_f32_32x32x16_bf16(_kf[2 * _s + 1], qf[_h + _s], P1, 0, 0, 0); } } \
            __builtin_amdgcn_sched_barrier(0); } } } while (0)
    if (NSET == 4) { AT_LOAD(0, kregA, vregA); AT_LOAD(1, kregB, vregB); AT_LOAD(2, kregC, vregC); AT_LOAD(3, kregD, vregD); AT_STORE(0, kregA, vregA); AT_STORE(1, kregB, vregB);
                     AT_LOAD(4, kregA, vregA); AT_LOAD(5, kregB, vregB); }
    else if (NSET == 2) { AT_LOAD(0, kregA, vregA); AT_LOAD(1, kregB, vregB); AT_STORE(0, kregA, vregA); AT_STORE(1, kregB, vregB); AT_LOAD(2, kregA, vregA); AT_LOAD(3, kregB, vregB); }
    else { AT_LOAD(0, kregA, vregA); AT_STORE(0, kregA, vregA); AT_LOAD(1, kregA, vregA); AT_STORE(1, kregA, vregA); AT_LOAD(2, kregA, vregA); }
    __syncthreads();
    const int i16 = lane & 15;
    const int vlane = (4 * hi + (i16 >> 2)) * VPITCH + (16 * ((lane >> 4) & 1) + 4 * (i16 & 3)) * 2;
    f32x16 pa0, pa1, pb0, pb1;
#pragma unroll
    for (int r = 0; r < 16; ++r) { pa0[r] = 0.f; pa1[r] = 0.f; pb0[r] = 0.f; pb1[r] = 0.f; }
    if (PIPE) AT_QK(0, 0, pa0, pa1);
    int bcur = 0;
#define AT_ITER(it, C0, C1, N0, N1, kreg, vreg) do { \
        const int _b1 = (bcur == 2) ? 0 : bcur + 1, _b2 = (_b1 == 2) ? 0 : _b1 + 1; \
        AT_STORE(_b2, kreg, vreg); \
        AT_LOAD((it) + 2 + NSET, kreg, vreg); \
        if (PIPE) { if ((it) + 1 < nt) AT_QK((it) + 1, _b1, N0, N1); } else AT_QK(it, bcur, C0, C1); \
        if (AT_ACTIVE(it)) { \
            LAS const char* _Vb = lds + VOFF0 + bcur * 64 * VPITCH + vlane; \
            bf16x8 _vf[4 * PVG];                      \
            _Pragma("unroll") for (int _e = 0; _e < PVG; ++_e) _Pragma("unroll") for (int _ks = 0; _ks < 4; ++_ks) { \
                const s16x4 _lo = vtr(_Vb + (16 * _ks) * VPITCH + 64 * _e), _hh = vtr(_Vb + (16 * _ks + 8) * VPITCH + 64 * _e); \
                _vf[4 * _e + _ks] = __builtin_shufflevector(_lo, _hh, 0, 1, 2, 3, 4, 5, 6, 7); } \
            __builtin_amdgcn_sched_barrier(0); \
            const int _kb = AT_TB(it); const bool _diag = (it) < NTD; \
            if (_diag) { const int _kq = _kb + 4 * hi - qpos; \
                _Pragma("unroll") for (int _r = 0; _r < 16; ++_r) { const int _dd = _kq + (_r & 3) + 8 * (_r >> 2); if (_dd > 0) C0[_r] = NEGBIG; if (_dd + 32 > 0) C1[_r] = NEGBIG; } } \
            float _m0 = max3f(C0[0], C0[1], C0[2]), _m1 = max3f(C1[0], C1[1], C1[2]); \
            _Pragma("unroll") for (int _r = 3; _r < 15; _r += 2) { _m0 = max3f(_m0, C0[_r], C0[_r + 1]); _m1 = max3f(_m1, C1[_r], C1[_r + 1]); } \
            _m0 = fmaxf(_m0, C0[15]); _m1 = fmaxf(_m1, C1[15]); \
            const float _c0 = ALIBI ? sl2 * (float)(_kb - qpos) : 0.f; \
            float _mx = fmaxf(_m0, _m1 + d32) + _c0; \
            bool _selok = true; if (MOBA && !_diag) _selok = ((sel >> (_kb >> 8)) & 1u) != 0u; \
            if (!_selok) _mx = NEGBIG; \
            { const auto _rr = __builtin_amdgcn_permlane32_swap(__float_as_uint(_mx), __float_as_uint(_mx), false, false); _mx = fmaxf(__uint_as_float(_rr[0]), __uint_as_float(_rr[1])); }     \
            const float _mn = fmaxf(mrun, _mx); \
            if (__any(_mn - mrun > 8.f)) { \
                const float _alpha = __builtin_amdgcn_exp2f(mrun - _mn); lrun *= _alpha; mrun = _mn; \
                scr[r32] = _alpha; \
                asm volatile("s_waitcnt lgkmcnt(0)" ::: "memory"); \
                f32x4 _a4[4]; \
                _Pragma("unroll") for (int _g = 0; _g < 4; ++_g) _a4[_g] = *(const LAS f32x4*)(scr + 8 * _g + 4 * hi); \
                asm volatile("s_waitcnt lgkmcnt(0)" ::: "memory"); \
                _Pragma("unroll") for (int _d0 = 0; _d0 < ND; ++_d0) _Pragma("unroll") for (int _r = 0; _r < 16; ++_r) o[_d0][_r] *= _a4[_r >> 2][_r & 3]; \
            } \
            const float _ms0 = _selok ? (mrun - _c0) : INFINITY, _ms1 = _ms0 - d32; \
            float _ls = 0.f; \
            _Pragma("unroll") for (int _r = 0; _r < 16; ++_r) { C0[_r] = __builtin_amdgcn_exp2f(C0[_r] - _ms0); C1[_r] = __builtin_amdgcn_exp2f(C1[_r] - _ms1); _ls += C0[_r] + C1[_r]; } \
            lrun += _ls; \
            bf16x8 _pa[4]; \
            _Pragma("unroll") for (int _ks = 0; _ks < 2; ++_ks) { u32x4 _w; \
                _w.x = pk2(C0[8 * _ks], C0[8 * _ks + 1]); _w.y = pk2(C0[8 * _ks + 2], C0[8 * _ks + 3]); _w.z = pk2(C0[8 * _ks + 4], C0[8 * _ks + 5]); _w.w = pk2(C0[8 * _ks + 6], C0[8 * _ks + 7]); \
                _pa[_ks] = __builtin_bit_cast(bf16x8, _w); \
                _w.x = pk2(C1[8 * _ks], C1[8 * _ks + 1]); _w.y = pk2(C1[8 * _ks + 2], C1[8 * _ks + 3]); _w.z = pk2(C1[8 * _ks + 4], C1[8 * _ks + 5]); _w.w = pk2(C1[8 * _ks + 6], C1[8 * _ks + 7]); \
                _pa[2 + _ks] = __builtin_bit_cast(bf16x8, _w); } \
            _Pragma("unroll") for (int _d0 = 0; _d0 < ND; _d0 += PVG) { \
                if (_d0 > 0) { \
                    _Pragma("unroll") for (int _e = 0; _e < PVG; ++_e) _Pragma("unroll") for (int _ks = 0; _ks < 4; ++_ks) { \
                        const s16x4 _lo = vtr(_Vb + (16 * _ks) * VPITCH + 64 * (_d0 + _e)), _hh = vtr(_Vb + (16 * _ks + 8) * VPITCH + 64 * (_d0 + _e)); \
                        _vf[4 * _e + _ks] = __builtin_shufflevector(_lo, _hh, 0, 1, 2, 3, 4, 5, 6, 7); } \
                    __builtin_amdgcn_sched_barrier(0); } \
                _Pragma("unroll") for (int _ks = 0; _ks < 4; ++_ks) _Pragma("unroll") for (int _e = 0; _e < PVG; ++_e) \
                    o[_d0 + _e] = __builtin_amdgcn_mfma_f32_32x32x16_bf16(_pa[_ks], _vf[4 * _e + _ks], o[_d0 + _e], 0, 0, 0); \
                __builtin_amdgcn_sched_barrier(0); } \
        } \
        bcur = _b1; \
        asm volatile("s_waitcnt lgkmcnt(0)\n\ts_barrier" ::: "memory"); } while (0)
    if (NSET == 4) {
        for (int it = 0; it < nt; it += 4) {
            AT_ITER(it, pa0, pa1, pb0, pb1, kregC, vregC);
            AT_ITER(it + 1, pb0, pb1, pa0, pa1, kregD, vregD);
            AT_ITER(it + 2, pa0, pa1, pb0, pb1, kregA, vregA);
            AT_ITER(it + 3, pb0, pb1, pa0, pa1, kregB, vregB);
        }
    } else {
        for (int it = 0; it < nt; it += 2) {
            AT_ITER(it, pa0, pa1, pb0, pb1, kregA, vregA);
            if (NSET == 2) AT_ITER(it + 1, pb0, pb1, pa0, pa1, kregB, vregB); else AT_ITER(it + 1, pb0, pb1, pa0, pa1, kregA, vregA);
        }
    }
#undef AT_TB
#undef AT_LOAD
#undef AT_STORE
#undef AT_ACTIVE
#undef AT_QK
#undef AT_ITER
    {
        const float lt = lrun + __shfl_xor(lrun, 32);
        scr[r32] = 1.f / lt;
        asm volatile("s_waitcnt lgkmcnt(0)" ::: "memory");
        f32x4 a4[4];
#pragma unroll
        for (int g = 0; g < 4; ++g) a4[g] = *(const LAS f32x4*)(scr + 8 * g + 4 * hi);
        asm volatile("s_waitcnt lgkmcnt(0)" ::: "memory");
#pragma unroll
        for (int d0 = 0; d0 < ND; ++d0)
#pragma unroll
            for (int r = 0; r < 16; ++r) o[d0][r] *= a4[r >> 2][r & 3];
    }
    if (NROWS == 256) {
#pragma unroll
        for (int d0 = 0; d0 < ND; ++d0)
#pragma unroll
            for (int r = 0; r < 16; ++r) { const size_t row = (size_t)(q0 + ro + crow(r, hi)); const int col = 32 * d0 + r32;
                const float z = bf2f(Zp[row * ldz + col]); Yp[row * ldy + col] = f2bf(o[d0][r] * silu(z)); }
    } else {
        LAS float* xch = (LAS float*)lds;
        if (map == 1) {
#pragma unroll
            for (int d0 = 0; d0 < ND; ++d0)
#pragma unroll
                for (int r = 0; r < 16; ++r) xch[(((wid & 3) * ND + d0) * 16 + r) * 64 + lane] = o[d0][r];
        }
        __syncthreads();
        if (map == 0) {
#pragma unroll
            for (int d0 = 0; d0 < ND; ++d0)
#pragma unroll
                for (int r = 0; r < 16; ++r) o[d0][r] -= lam * xch[(((wid & 3) * ND + d0) * 16 + r) * 64 + lane];
#pragma unroll
            for (int r = 0; r < 16; ++r) { float ss = 0.f;
#pragma unroll
                for (int d0 = 0; d0 < ND; ++d0) ss += o[d0][r] * o[d0][r];
                ss += __shfl_xor(ss, 1); ss += __shfl_xor(ss, 2); ss += __shfl_xor(ss, 4); ss += __shfl_xor(ss, 8); ss += __shfl_xor(ss, 16);
                const float rs = __builtin_amdgcn_rsqf(ss * (1.f / (float)DV) + 1e-5f) * post;
                const size_t row = (size_t)(q0 + ro + crow(r, hi));
#pragma unroll
                for (int d0 = 0; d0 < ND; ++d0) { const int col = 32 * d0 + r32; const float z = bf2f(Zp[row * ldz + col]);
                    Yp[row * ldy + col] = f2bf(o[d0][r] * rs * subg[col] * silu(z)); } }
        }
        __syncthreads();
    }
}

#define XB_TMO      128
#define XB_XCNT(j)  (256  + 64 * (j))
#define XB_XSUB(j)  (1280 + 64 * (j))
#define XB_XGEN(j)  (2304 + 64 * (j))
#define XB_TOP      3328
#define XB_TOPGEN   3392
#define XCD_BAR_WORDS 3456
#define XB_SPIN_CAP (1u << 22)
DI unsigned xb_ld(unsigned* p)              { return __hip_atomic_load(p, __ATOMIC_RELAXED, __HIP_MEMORY_SCOPE_AGENT); }
DI unsigned xb_add(unsigned* p, unsigned v) { return __hip_atomic_fetch_add(p, v, __ATOMIC_RELAXED, __HIP_MEMORY_SCOPE_AGENT); }
DI unsigned xb_xcc_id() { return (unsigned)__builtin_amdgcn_s_getreg((3 << 11) | 20) & 0xFu; }
#define XB_SPIN(cond, bar) do { unsigned _sp = 0; while (cond) { __builtin_amdgcn_s_sleep(1); \
    if ((++_sp & 255u) == 0u) { if (xb_ld(&(bar)[XB_TMO])) break; if (_sp > XB_SPIN_CAP) { atomicAdd(&(bar)[XB_TMO], 1u); break; } } } } while (0)
DI void xcd_barrier_complete(unsigned* bar, unsigned x, unsigned& nloc, unsigned& nx) {
    const unsigned Gn = gridDim.x;
    unsigned sum, cnt, mine, sp = 0u;
    for (;;) {
        sum = 0u; cnt = 0u; mine = 0u;
#pragma unroll
        for (unsigned j = 0; j < 16; ++j) { const unsigned c = xb_ld(&bar[XB_XCNT(j)]); sum += c; cnt += (c > 0u) ? 1u : 0u; mine = (j == x) ? c : mine; }
        if (sum == Gn) break;
        __builtin_amdgcn_s_sleep(1);
        if ((++sp & 255u) == 0u) { if (xb_ld(&bar[XB_TMO])) break; if (sp > XB_SPIN_CAP) { atomicAdd(&bar[XB_TMO], 1u); break; } }
    }
    nloc = mine > 0u ? mine : 1u; nx = cnt > 0u ? cnt : 1u;
}
DI void xcd_barrier(unsigned* bar, volatile LAS unsigned* st) {
    asm volatile("s_waitcnt vmcnt(0)" ::: "memory");
    __syncthreads();
    if (threadIdx.x == 0) {
        __builtin_amdgcn_s_waitcnt(0);
        const unsigned x = xb_xcc_id();
        unsigned nloc = st[0], nx = st[1];
        if (nloc == 0u) { xcd_barrier_complete(bar, x, nloc, nx); st[0] = nloc; st[1] = nx; }
        const unsigned old = xb_add(&bar[XB_XSUB(x)], 1u);
        const unsigned gen = old / nloc;
        if (old + 1u == (gen + 1u) * nloc) {
            __builtin_amdgcn_fence(__ATOMIC_RELEASE, "agent");
            asm volatile("s_waitcnt vmcnt(0)" ::: "memory");
            const unsigned og = xb_add(&bar[XB_TOP], 1u);
            const unsigned tg = og / nx;
            if (og + 1u == (tg + 1u) * nx) xb_add(&bar[XB_TOPGEN], 1u);
            else XB_SPIN(xb_ld(&bar[XB_TOPGEN]) == tg, bar);
            __builtin_amdgcn_fence(__ATOMIC_ACQUIRE, "agent");
            xb_add(&bar[XB_XGEN(x)], 1u);
            asm volatile("s_waitcnt vmcnt(0)" ::: "memory");
        } else {
            XB_SPIN(xb_ld(&bar[XB_XGEN(x)]) == gen, bar);
            __builtin_amdgcn_fence(__ATOMIC_ACQUIRE, "agent");
            asm volatile("s_waitcnt vmcnt(0)" ::: "memory");
        }
    }
    __syncthreads();
}

struct Params { const float* in[19]; float* out; unsigned char* ws; };

DI void colmap(int kind, int n, int& col, float& cs) {
    cs = 1.f;
    if (kind == 0) {
        if (n < 2048) { col = n; if (n < 512) cs = QS64; }
        else if (n < 2560) col = 2720 + (n - 2048);
        else if (n < 3072) { col = 3232 + (n - 2560); cs = QS64; }
        else if (n < 3584) col = 3744 + (n - 3072);
        else if (n < 4096) col = 4256 + (n - 3584);
        else if (n < 4608) col = 4768 + (n - 4096);
        else if (n < 4864) col = 2432 + (n - 4608);
        else if (n < 5248) col = 2048 + (n - 4864);
        else if (n < 5280) { const int j = n - 5248; col = 2688 + (j >> 1) + 16 * (j & 1); }
        else col = -1;
    } else if (kind == 1) col = n;
    else if (kind == 2) { const int h = n / 96, j = n % 96; if (j < 64) col = h * 96 + j; else { const int jj = j - 64; col = h * 96 + 64 + (jj >> 1) + 16 * (jj & 1); } }
    else { if (n < 512) col = (n >> 6) * 128 + (n & 63); else { const int m = n - 512; col = (m >> 6) * 128 + 64 + (m & 63); } }
}
DI void tr_tile(const float* src, int srcN, int ldd, bf16_t* dst, int kind, int n0, int k0, const float* kscale, LAS float* scr, int tid) {
    { const int nl = tid & 127, kl0 = tid >> 7; int col; float cs; colmap(kind, n0 + nl, col, cs);
      float v[16];
#pragma unroll
      for (int i = 0; i < 16; ++i) { const int kl = kl0 + 4 * i; v[i] = (col >= 0) ? src[(size_t)(k0 + kl) * srcN + col] : 0.f; }
#pragma unroll
      for (int i = 0; i < 16; ++i) { const int kl = kl0 + 4 * i; float w = v[i] * cs; if (kscale) w *= kscale[k0 + kl]; scr[kl * 129 + nl] = w; } }
    __syncthreads();
    { const int kp = tid & 31;
#pragma unroll
      for (int i = 0; i < 8; ++i) { const int nl = (tid >> 5) + 16 * i;
          *(unsigned*)(dst + (size_t)(n0 + nl) * ldd + k0 + 2 * kp) = pk2(scr[(2 * kp) * 129 + nl], scr[(2 * kp + 1) * 129 + nl]); } }
    __syncthreads();
}
typedef const __attribute__((address_space(4))) Params* KParams0;
DI void convert_weights(KParams0 Pk, int l, bf16_t* WT, LAS float* scr) {
    const int tid = opaque_tid();
    constexpr int T0 = 42 * 16, T1 = T0 + 24 * 16, T2 = T1 + 6 * 6, T3 = T2 + 8 * 4, T4 = T3 + 8 * 8, T5 = T4 + 8 * 8, T6 = T5 + 8 * 8, T7 = T6 + 8 * 16, T8 = T7 + 8 * 16, T9 = T8 + 8 * 4;
    for (int t = blockIdx.x; t < T9; t += gridDim.x) {
        const float* src; int srcN, K, kind, loc, ldd = 0; bf16_t* dst; const float* ks = nullptr;
        if (t < T0) { src = Pk->in[2] + (size_t)l * 1024 * 5280; srcN = 5280; K = 1024; kind = 0; loc = t; dst = WT + OFF_WIN; }
        else if (t < T1) { src = Pk->in[12] + (size_t)l * 1024 * 3072; srcN = 3072; K = 1024; kind = 1; loc = t - T0; dst = WT + OFF_WIN + (size_t)5376 * 1024; }
        else if (t < T2) { src = Pk->in[5] + (size_t)l * 384 * 768; srcN = 768; K = 384; kind = 2; loc = t - T1; dst = WT + OFF_WUQ; ks = Pk->in[3] + l * 384; }
        else if (t < T3) { src = Pk->in[6] + (size_t)l * 256 * 1024; srcN = 1024; K = 256; kind = 3; loc = t - T2; dst = WT + OFF_WUKV; ks = Pk->in[4] + l * 256; }
        else if (t < T4) { src = Pk->in[9] + (size_t)l * 512 * 1024; srcN = 1024; K = 512; kind = 1; loc = t - T3; dst = WT + OFF_WABC; ldd = 1536; }
        else if (t < T5) { src = Pk->in[10] + (size_t)l * 512 * 1024; srcN = 1024; K = 512; kind = 1; loc = t - T4; dst = WT + OFF_WABC + 512; ldd = 1536; }
        else if (t < T6) { src = Pk->in[11] + (size_t)l * 512 * 1024; srcN = 1024; K = 512; kind = 1; loc = t - T5; dst = WT + OFF_WABC + 1024; ldd = 1536; }
        else if (t < T7) { src = Pk->in[14] + (size_t)l * 1024 * 1024; srcN = 1024; K = 1024; kind = 1; loc = t - T6; dst = WT + OFF_WO; }
        else if (t < T8) { src = Pk->in[17] + (size_t)l * 1024 * 1024; srcN = 1024; K = 1024; kind = 1; loc = t - T7; dst = WT + OFF_WPG; }
        else { src = Pk->in[18] + (size_t)l * 256 * 1024; srcN = 1024; K = 256; kind = 1; loc = t - T8; dst = WT + OFF_WP; }
        const int kt = K / 64; const int n0 = (loc / kt) * 128, k0 = (loc % kt) * 64;
        tr_tile(src, srcN, ldd ? ldd : K, dst, kind, n0, k0, ks, scr, tid);
    }
}
DI void convert_rows(const float* src, bf16_t* dst, size_t n) {
    const size_t stride = (size_t)gridDim.x * blockDim.x, ng = n / 8;
    for (size_t i = (size_t)blockIdx.x * blockDim.x + opaque_tid(); i < ng; i += 4 * stride) {
        f32x4 a[4], b[4];
#pragma unroll
        for (int j = 0; j < 4; ++j) { const size_t q = i + j * stride; if (q < ng) { a[j] = *(const f32x4*)(src + q * 8); b[j] = *(const f32x4*)(src + q * 8 + 4); } }
#pragma unroll
        for (int j = 0; j < 4; ++j) { const size_t q = i + j * stride; if (q < ng) *(u32x4*)(dst + q * 8) = pack8(a[j], b[j]); }
    }
}
typedef const __attribute__((address_space(4))) Params* KParams;
DI KParams kparams() { KParams p = (KParams)__builtin_amdgcn_kernarg_segment_ptr(); asm volatile("" : "+s"(p)); return p; }
DI unsigned char* wsbase() { unsigned char* w = kparams()->ws; asm volatile("" : "+s"(w)); return w; }

__global__ void __launch_bounds__(512, 2) fwd_megakernel(Params Punused) {
    extern __shared__ __attribute__((aligned(16))) unsigned char lds_raw[];
    cg::grid_group grid = cg::this_grid();
    LAS unsigned char* lds = (LAS unsigned char*)lds_raw;
#define G opaque_s((int)gridDim.x)
#define cu opaque_s((int)blockIdx.x)
#define XB_  ((bf16_t*)(ws + WS_XB))
#define WT_  ((bf16_t*)(ws + WS_WT))
#define PB_  ((bf16_t*)(ws + WS_PB))
#define Y_   ((bf16_t*)(ws + WS_Y))
#define H_   ((bf16_t*)(ws + WS_H))
#define QB_  ((bf16_t*)(ws + WS_MLA))
#define KB_  (QB_ + (size_t)HM * 768)
#define VB_  (KB_ + (size_t)HM * 768)
#define R_   ((float*)(ws + WS_H))
#define ROPE_ ((float*)(ws + CTL_ROPE))
#define KMP_ ((float*)(ws + CTL_KMP))
#define STQ_ ((float*)(ws + CTL_STQ))
#define STKV_ ((float*)(ws + CTL_STKV))

    if (threadIdx.x < 2) ((volatile LAS unsigned*)(lds + LDS_IDX + 64))[threadIdx.x] = 0u;
    {
        const int tid = opaque_tid();
        KParams P = kparams(); unsigned char* ws = P->ws;
        for (int rep = 0; rep < REP_P0; ++rep) {
        convert_weights(P, 0, WT_, (LAS float*)lds);
        convert_rows(P->in[0], XB_, (size_t)M * D);
        convert_rows(P->in[1], PB_, (size_t)M * 256); }
        float* rope = ROPE_;
        for (int i = cu * 512 + tid; i < SEQ * 16; i += G * 512) {
            const int pos = i >> 4, k = i & 15;
            const float freq = __builtin_amdgcn_exp2f(-(float)k * (13.287712379549449f / 16.f));
            const float ang = (float)pos * freq;
            double rev = (double)ang * 0.15915494309189535; rev -= __builtin_rint(rev);
            const float fr = (float)rev;
            rope[2 * i] = __builtin_amdgcn_cosf(fr); rope[2 * i + 1] = __builtin_amdgcn_sinf(fr);
        }
        if (cu == 0) {
            unsigned* ctl = (unsigned*)(ws + WS_CTL); float* lamv = (float*)(ws + CTL_LAM);
            if (tid < 64) {
#pragma unroll
                for (int l = 0; l < 2; ++l) { const float* dl = P->in[7] + l * 256; float a = dl[tid] * dl[64 + tid], b = dl[128 + tid] * dl[192 + tid];
#pragma unroll
                    for (int s = 1; s < 64; s <<= 1) { a += __shfl_xor(a, s); b += __shfl_xor(b, s); }
                    const float li = (l == 0) ? 0.2f : 0.35550906759096924f;
                    if (tid == 0) lamv[l] = __builtin_amdgcn_exp2f(a * LOG2E) - __builtin_amdgcn_exp2f(b * LOG2E) + li; }
            }
            if (tid < 64) ctl[tid] = 0u;
            if (tid < 128) ((unsigned*)(ws + CTL_DEP))[tid] = 0u;
            { unsigned* bw = (unsigned*)(ws + CTL_BAR); for (int i = tid; i < XCD_BAR_WORDS; i += 512) bw[i] = 0u; }
        }
    }
    grid.sync();
    if (threadIdx.x == 0) { unsigned char* ws = wsbase(); (void)xb_add(&((unsigned*)(ws + CTL_BAR))[XB_XCNT(xb_xcc_id())], 1u); }
#define GSYNC() do { unsigned char* _w = wsbase(); xcd_barrier((unsigned*)(_w + CTL_BAR), (volatile LAS unsigned*)(lds + LDS_IDX + 64)); } while (0)

    for (int l = 0; l < 2; ++l) {
        for (int hf = 0; hf < 2; ++hf) {
            for (int rep = 0; rep < REP_P1; ++rep)
            { unsigned char* ws = wsbase();
              pg8::Gemm g{XB_ + (size_t)hf * HM * D, WT_ + OFF_WIN, D, D}; pg8::P1Order S{G, cu};
              pg8::EpiH E{H_, KB_, KMP_ + (size_t)hf * 32 * 2 * 512, STQ_ + (size_t)hf * HM * 8, STKV_ + (size_t)hf * HM * 4, ROPE_, (unsigned*)(ws + CTL_DEP) + (l * 2 + hf) * 32};
              pg8::gemm_phase(lds, g, S, E); }
            {
                const int Gn = G, rem = 672 % Gn, NE = Gn - rem, e = cu - rem;
                pg8::ListOrder Sq{0, (e >= 0) ? 96 : 0, 3, (e >= 0) ? e : 0, NE}, Skv{96, (e >= 0) ? 224 : 96, 4, (e >= 0) ? e : 0, NE};
                if (opaque_tid() == 0) {
                    unsigned char* ws = wsbase(); unsigned* dep = (unsigned*)(ws + CTL_DEP) + (l * 2 + hf) * 32; pg8::Unit u;
                    for (int pass = 0; pass < 2; ++pass)
                        for (int i = 0; pass == 0 ? Sq.next(i, u) : Skv.next(i, u); ++i) {
                            unsigned sp = 0;
                            while (__hip_atomic_load(dep + u.pm, __ATOMIC_RELAXED, __HIP_MEMORY_SCOPE_AGENT) < 24u) { __builtin_amdgcn_s_sleep(2); if (++sp > (1u << 24)) break; }
                        }
                    __builtin_amdgcn_fence(__ATOMIC_ACQUIRE, "agent");
                    asm volatile("s_waitcnt vmcnt(0)" ::: "memory");
                }
                __syncthreads();
                { unsigned char* ws = wsbase();
                  pg8::Gemm g{H_ + C_CQL, WT_ + OFF_WUQ, HP, 384};
                  pg8::EpiUp<0> E{QB_, KB_, VB_, STQ_ + (size_t)hf * HM * 8, ROPE_}; pg8::gemm_phase(lds, g, Sq, E); }
                { unsigned char* ws = wsbase();
                  pg8::Gemm g{H_ + C_CKV, WT_ + OFF_WUKV, HP, 256};
                  pg8::EpiUp<1> E{QB_, KB_, VB_, STKV_ + (size_t)hf * HM * 4, ROPE_}; pg8::gemm_phase(lds, g, Skv, E); }
            }
            GSYNC();
            {
                for (int vcu = cu; vcu < 256; vcu += G)
                for (int step = 0; ; ++step) {
                    KParams P = kparams(); unsigned char* ws = P->ws;
                    const int x = vcu & 7, sl_ = vcu >> 3;
                    int type, u, bh;
                    if (step < 2) {
                        if (sl_ < 16) { type = 2; bh = 2 * x + (sl_ >> 3); const int j = sl_ & 7; u = (step == 0) ? 15 - j : j; }
                        else { const int t = sl_ - 16; bh = 4 * x + (t >> 2); type = step; u = 7 - (t & 3); }
                    } else {
                        if (opaque_tid() == 0) *(LAS int*)(lds + LDS_IDX) = (int)atomicAdd((unsigned*)(ws + WS_CTL) + 16 + (l * 2 + hf) * 8 + x, 1u);
                        __syncthreads();
                        const int k = *(LAS int*)(lds + LDS_IDX);
                        __syncthreads();
                        if (k >= 32) break;
                        u = 3 - (k >> 3); type = (k & 4) ? 0 : 1; bh = 4 * x + (k & 3);
                    }
                    if (type == 0) {
                        const int bl = bh >> 3, h = bh & 7, bg = 4 * hf + bl; const size_t ho = (size_t)bh * SEQ * 64;
                        const float sl = __builtin_amdgcn_exp2f(-(2.f / 3.f) * (float)(h + (h >> 1) + 2)) * LOG2E;
                        attn_unit<64, 64, 64, 256, true, true, true, 2>((LAS char*)lds, H_ + HM_AQ + ho, 64, H_ + HM_AK + ho, 64, H_ + HM_AV + ho, 64,
                            H_ + (size_t)bl * SEQ * HP + C_AZ + h * 64, HP,
                            Y_ + (size_t)bg * SEQ * 1536 + h * 64, 1536, u * 256, sl, KMP_ + (size_t)bg * 8 * 2 * 512 + h * 64, 0.f, nullptr, 1.f);
                    } else if (type == 1) {
                        const int bl = bh >> 3, h = bh & 7, bg = 4 * hf + bl;
                        attn_unit<96, 96, 64, 256, false, false, true, 2>((LAS char*)lds, QB_ + (size_t)bh * SEQ * 96, 96, KB_ + (size_t)bh * SEQ * 96, 96,
                            VB_ + (size_t)bh * SEQ * 64, 64, H_ + (size_t)bl * SEQ * HP + C_BZ + h * 64, HP,
                            Y_ + 512 + (size_t)bg * SEQ * 1536 + h * 64, 1536, u * 256, 0.f, nullptr, 0.f, nullptr, 1.f);
                    } else {
                        const int bl = bh >> 2, h = bh & 3, bg = 4 * hf + bl; const size_t ho = (size_t)bh * SEQ * 128;
                        const float sl = __builtin_amdgcn_exp2f(-(2.f / 3.f) * (float)(3 * h + 1)) * LOG2E;
                        const float lam = ((const float*)(ws + CTL_LAM))[l];
                        const float post = (l == 0) ? 0.8f : (1.f - 0.35550906759096924f);
                        attn_unit<64, 128, 128, 128, true, false, false, 1>((LAS char*)lds, H_ + HM_CQ + ho, 128, H_ + HM_CK + ho, 128, H_ + HM_CV + ho, 128,
                            H_ + (size_t)bl * SEQ * HP + C_CZ + h * 128, HP,
                            Y_ + 1024 + (size_t)bg * SEQ * 1536 + h * 128, 1536, u * 128, sl, nullptr, lam, P->in[8] + l * 128, post);
                    }
                }
            }
            GSYNC();
        }
        { KParams P = kparams(); unsigned char* ws = P->ws;
          pg8::Gemm g{XB_, WT_ + OFF_WIN + (size_t)5376 * 1024, D, D}; pg8::StaticOrder S; S.init(M, 3072, G, cu);
          pg8::EpiG E{H_, P->in[13] + l * 3072}; pg8::gemm_phase(lds, g, S, E); }
        GSYNC();
        { unsigned char* ws = wsbase();
          pg8::Gemm g{Y_, WT_ + OFF_WABC, 1536, 1536}; pg8::MergeOrder S{cu, G};
          pg8::EpiMerge E{H_, XB_}; pg8::MergeHook HK{H_}; pg8::gemm_phase(lds, g, S, E, HK); }
        GSYNC();
        { KParams P = kparams(); unsigned char* ws = P->ws;
          pg8::Gemm g{XB_, WT_ + OFF_WO, D, D}; pg8::StaticOrder S; S.init(M, D, G, cu);
          pg8::EpiR E{(l == 0) ? P->in[0] : (const float*)P->out, R_, Y_}; pg8::gemm_phase(lds, g, S, E); }
        GSYNC();
        { unsigned char* ws = wsbase();
          pg8::Gemm g{PB_, WT_ + OFF_WP, 256, 256}; pg8::StaticOrder S; S.init(M, D, G, cu);
          pg8::EpiBf E{XB_}; pg8::gemm_phase(lds, g, S, E); }
        { unsigned char* ws = wsbase();
          pg8::Gemm g{Y_, WT_ + OFF_WPG, D, D}; pg8::StaticOrder S; S.init(M, D, G, cu);
          pg8::EpiR2 E{R_, XB_}; pg8::gemm_phase(lds, g, S, E); }
        GSYNC();
        {
            KParams P = kparams(); unsigned char* ws = P->ws;
            const int tid = opaque_tid(), lane = tid & 63, wid = tid >> 6;
            const float* lg = P->in[15] + l * 1024; const float* lb = P->in[16] + l * 1024;
            float* outp = P->out; const float* R = R_; bf16_t* XB = XB_;
            const int gstep = (int)gridDim.x * 8;
            for (int row = (int)blockIdx.x * 8 + wid; row < M; row += 2 * gstep) {
                const bool two = row + gstep < M;
                const float* rp0 = R + (size_t)row * 1024; const float* rp1 = R + (size_t)(two ? row + gstep : row) * 1024;
                f32x4 v[2][4]; float s0 = 0.f, s1 = 0.f;
#pragma unroll
                for (int j = 0; j < 4; ++j) { v[0][j] = *(const f32x4*)(rp0 + 4 * lane + 256 * j); v[1][j] = *(const f32x4*)(rp1 + 4 * lane + 256 * j); }
#pragma unroll
                for (int j = 0; j < 4; ++j) { s0 += (v[0][j][0] + v[0][j][1]) + (v[0][j][2] + v[0][j][3]); s1 += (v[1][j][0] + v[1][j][1]) + (v[1][j][2] + v[1][j][3]); }
#pragma unroll
                for (int k = 1; k < 64; k <<= 1) { s0 += __shfl_xor(s0, k); s1 += __shfl_xor(s1, k); }
                const float mu0 = s0 * (1.f / 1024.f), mu1 = s1 * (1.f / 1024.f); float q0 = 0.f, q1 = 0.f;
#pragma unroll
                for (int j = 0; j < 4; ++j) { v[0][j] -= mu0; v[1][j] -= mu1;
                    q0 += (v[0][j][0] * v[0][j][0] + v[0][j][1] * v[0][j][1]) + (v[0][j][2] * v[0][j][2] + v[0][j][3] * v[0][j][3]);
                    q1 += (v[1][j][0] * v[1][j][0] + v[1][j][1] * v[1][j][1]) + (v[1][j][2] * v[1][j][2] + v[1][j][3] * v[1][j][3]); }
#pragma unroll
                for (int k = 1; k < 64; k <<= 1) { q0 += __shfl_xor(q0, k); q1 += __shfl_xor(q1, k); }
                const float rs0 = __builtin_amdgcn_rsqf(q0 * (1.f / 1024.f) + 1e-5f), rs1 = __builtin_amdgcn_rsqf(q1 * (1.f / 1024.f) + 1e-5f);
#pragma unroll
                for (int j = 0; j < 4; ++j) { const f32x4 gv = *(const f32x4*)(lg + 4 * lane + 256 * j), bv = *(const f32x4*)(lb + 4 * lane + 256 * j);
#pragma unroll
                    for (int t = 0; t < 2; ++t) { if (t == 1 && !two) break;
                        const size_t rr = (size_t)(t == 0 ? row : row + gstep);
                        const f32x4 y = v[t][j] * (t == 0 ? rs0 : rs1) * gv + bv;
                        *(f32x4*)(outp + rr * 1024 + 4 * lane + 256 * j) = y;
                        if (l == 0) { u32x2 w; w.x = pk2(y[0], y[1]); w.y = pk2(y[2], y[3]); *(u32x2*)(XB + rr * 1024 + 4 * lane + 256 * j) = w; } } }
            }
            if (l == 0) {
                __syncthreads();
                convert_weights(P, 1, WT_, (LAS float*)lds);
                convert_rows(P->in[1] + (size_t)M * 256, PB_, (size_t)M * 256);
            }
        }
        if (l == 0) GSYNC();
    }
}

#undef G
#undef cu
extern "C" void kernel_launch(void* const* d_in, const int* in_sizes, int n_in, void* d_out, int out_size, void* d_ws, size_t ws_size, hipStream_t stream) {
    static int grid_blocks = 0;
    if (grid_blocks == 0) {
        if (n_in != 19 || out_size != M * D || ws_size < WS_END) { fprintf(stderr, "kernel_launch: unexpected problem (n_in %d out %d ws %zu)\n", n_in, out_size, ws_size); grid_blocks = -1; return; }
        int dev = 0, cus = 0, per_cu = 0;
        hipGetDevice(&dev);
        hipDeviceGetAttribute(&cus, hipDeviceAttributeMultiprocessorCount, dev);
        if (hipFuncSetAttribute((const void*)fwd_megakernel, hipFuncAttributeMaxDynamicSharedMemorySize, LDS_BYTES) != hipSuccess) { fprintf(stderr, "kernel_launch: hipFuncSetAttribute failed\n"); grid_blocks = -1; return; }
        if (hipOccupancyMaxActiveBlocksPerMultiprocessor(&per_cu, (const void*)fwd_megakernel, 512, LDS_BYTES) != hipSuccess || per_cu < 1) { fprintf(stderr, "kernel_launch: occupancy query failed (%d)\n", per_cu); grid_blocks = -1; return; }
        grid_blocks = cus * per_cu;
        if (grid_blocks > 256) grid_blocks = 256;
    }
    if (grid_blocks < 0) return;
    Params p{};
    for (int i = 0; i < 19; ++i) p.in[i] = (const float*)d_in[i];
    p.out = (float*)d_out; p.ws = (unsigned char*)d_ws;
    void* args[] = {&p};
    hipError_t e = hipLaunchCooperativeKernel((const void*)fwd_megakernel, dim3(grid_blocks), dim3(512), args, LDS_BYTES, stream);
    if (e != hipSuccess) fprintf(stderr, "cooperative launch failed: %s (grid %d)\n", hipGetErrorString(e), grid_blocks);
}
```

```cpp
#include <hip/hip_runtime.h>
#include <hip/hip_cooperative_groups.h>
#include <cstdio>
#include <cstdint>
namespace cg = cooperative_groups;
#ifndef REP_ATT
#define REP_ATT 1
#endif
#ifndef REP_P1
#define REP_P1 1
#endif
#ifndef REP_P0
#define REP_P0 1
#endif

#define LAS __attribute__((address_space(3)))
#define DI __device__ __forceinline__
typedef unsigned short bf16_t;
typedef short bf16x8 __attribute__((ext_vector_type(8)));
typedef short s16x4 __attribute__((ext_vector_type(4)));
typedef float f32x2 __attribute__((ext_vector_type(2)));
typedef float f32x4 __attribute__((ext_vector_type(4)));
typedef float f32x16 __attribute__((ext_vector_type(16)));
typedef unsigned u32x4 __attribute__((ext_vector_type(4)));
typedef unsigned u32x2 __attribute__((ext_vector_type(2)));
typedef __bf16 bf16x2_t __attribute__((ext_vector_type(2)));

constexpr int M = 16384, D = 1024, SEQ = 2048, HM = 8192;
constexpr int HP = 2304;
constexpr int NH1 = 5376;
constexpr int NWIN = 8448;
constexpr float LOG2E = 1.4426950408889634f;
constexpr float QS64 = 0.125f * LOG2E;
constexpr float QS96 = 0.10206207261596575f * LOG2E;
constexpr float ALPHA = 1.4142135623730951f;
constexpr int C_AZ = 0, C_BZ = 512, C_CZ = 1024, C_CKV = 1536, C_CQL = 1792;
constexpr size_t HM_AQ = (size_t)18 * 1048576, HM_AK = (size_t)22 * 1048576, HM_AV = (size_t)26 * 1048576, HM_CQ = (size_t)30 * 1048576, HM_CK = (size_t)34 * 1048576, HM_CV = (size_t)38 * 1048576;

constexpr size_t MiB = 1048576;
constexpr size_t WS_CTL = 0, WS_XB = 2 * MiB, WS_WT = 34 * MiB, WS_PB = 60 * MiB, WS_Y = 68 * MiB, WS_H = 116 * MiB, WS_MLA = 200 * MiB, WS_END = 232 * MiB;
constexpr size_t CTL_DEP = 8192, CTL_BAR = 16384, CTL_LAM = 4096, CTL_ROPE = 65536, CTL_KMP = 384 * 1024, CTL_STQ = 640 * 1024, CTL_STKV = 1152 * 1024;
constexpr size_t OFF_WIN = 0, OFF_WUQ = 8650752, OFF_WUKV = 8945664, OFF_WABC = 9207808, OFF_WO = 10780672, OFF_WPG = 11829248, OFF_WP = 12877824;
constexpr int LDS_BYTES = 132 * 1024, LDS_IDX = 131072;

DI int opaque_s(int v) { asm volatile("" : "+s"(v)); return v; }
DI int opaque_tid() { int t = threadIdx.x; asm volatile("" : "+v"(t)); return t; }
DI unsigned pk2(float lo, float hi) { f32x2 v = {lo, hi}; bf16x2_t b = __builtin_convertvector(v, bf16x2_t); return __builtin_bit_cast(unsigned, b); }
DI float bflo(unsigned w) { return __uint_as_float(w << 16); }
DI float bfhi(unsigned w) { return __uint_as_float(w & 0xffff0000u); }
DI float bf2f(bf16_t b) { return __uint_as_float((unsigned)b << 16); }
DI bf16_t f2bf(float f) { return (bf16_t)(pk2(f, 0.f) & 0xffffu); }
DI float sigm(float x) { return __builtin_amdgcn_rcpf(1.f + __builtin_amdgcn_exp2f(-x * LOG2E)); }
DI float silu(float x) { return x * sigm(x); }
DI u32x4 pack8(const f32x4 a, const f32x4 b) { u32x4 w; w.x = pk2(a[0], a[1]); w.y = pk2(a[2], a[3]); w.z = pk2(b[0], b[1]); w.w = pk2(b[2], b[3]); return w; }
DI void unpack8(const u32x4 w, f32x4& a, f32x4& b) { a = (f32x4){bflo(w.x), bfhi(w.x), bflo(w.y), bfhi(w.y)}; b = (f32x4){bflo(w.z), bfhi(w.z), bflo(w.w), bfhi(w.w)}; }

namespace pg8 {
constexpr int BM = 256, BK = 64, HALF = 128, HTB = HALF * BK * 2, NXCD = 8, WGM = 8;
__host__ __device__ __forceinline__ int lds_byte(int r, int c) { const int st = (r >> 4) * 2 + (c >> 5), rr = r & 15, cc = c & 31, ob = rr * 64 + cc * 2; return st * 1024 + (ob ^ (((ob >> 9) & 1) << 5)); }
__host__ __device__ __forceinline__ void stage_rc(int b, int& R, int& C) { const int st = b / 1024, sb = b % 1024, swz = sb ^ (((sb >> 9) & 1) << 5); R = (st >> 1) * 16 + swz / 64; C = (st & 1) * 32 + (swz % 64) / 2; }
__host__ __device__ __forceinline__ int perm32(int rho) { const int n = rho >> 4, i = rho & 15; return 8 * (i >> 2) + 4 * n + (i & 3); }

struct Unit { int pm, pn; };
struct Gemm { const bf16_t* A; const bf16_t* Bt; int lda, K; };

struct StaticOrder {
    int nM, nN, nwg, G, c;
    DI void init(int M_, int N_, int G_, int c_) { nM = M_ / BM; nN = N_ / BM; nwg = nM * nN; G = G_; c = c_; }
    DI bool next(int i, Unit& u) const {
        const long L = (long)i * G + c; if (L >= nwg) return false;
        int wgid = (int)L; { const int q = nwg / NXCD, r = nwg % NXCD, xcd = wgid % NXCD, off = wgid / NXCD; wgid = (xcd < r ? xcd * (q + 1) : r * (q + 1) + (xcd - r) * q) + off; }
        const int nig = WGM * nN, gid = wgid / nig, fm = gid * WGM, gsz = (nM - fm) < WGM ? (nM - fm) : WGM;
        u.pm = fm + ((wgid % nig) % gsz); u.pn = (wgid % nig) / gsz; return true;
    }
};
struct P1Order {
    int G, c;
    DI bool next(int i, Unit& u) const {
        const long L = (long)i * G + c; if (L >= 672) return false;
        if (L < 96) { u.pm = (int)L / 3; u.pn = 18 + (int)L % 3; return true; }
        const int nM = 32, nN = 18, nwg = 576;
        int wgid = (int)L - 96; { const int q = nwg / NXCD, r = nwg % NXCD, xcd = wgid % NXCD, off = wgid / NXCD; wgid = (xcd < r ? xcd * (q + 1) : r * (q + 1) + (xcd - r) * q) + off; }
        const int nig = WGM * nN, gid = wgid / nig, fm = gid * WGM, gsz = (nM - fm) < WGM ? (nM - fm) : WGM;
        u.pm = fm + ((wgid % nig) % gsz); u.pn = (wgid % nig) / gsz; return true;
    }
};
struct ListOrder {
    int lo, hi, nN, c, G;
    DI bool next(int i, Unit& u) const {
        int k0 = 0; if (c < lo) k0 = (lo - c + G - 1) / G;
        const int idx = c + (k0 + i) * G; if (idx >= hi) return false;
        const int loc = idx - lo; u.pm = loc / nN; u.pn = loc % nN; return true;
    }
};
struct MergeOrder {
    int c, G;
    DI bool next(int i, Unit& u) const {
        int tile = c + i * G; if (tile >= 256) return false;
        if (G == 256) tile = (c & 7) * 32 + (c >> 3);
        u.pm = tile >> 2; u.pn = tile & 3; return true;
    }
};

struct NoHook { static constexpr bool ACTIVE = false; template <class A> DI void operator()(A&, const Unit&, int, int, int, int, int) const {} };
template <class Epi, class Sched, class Hook = NoHook>
DI void gemm_phase(LAS unsigned char* lds, const Gemm g, const Sched& S, const Epi& E, const Hook& HK = Hook()) {
    const int tid = opaque_tid(), wid = __builtin_amdgcn_readfirstlane(tid >> 6), lane = tid & 63, wr = wid >> 2, wc = wid & 3, fr = lane & 15, fq = lane >> 4;
    const int K = g.K, nt = K / BK, lda = g.lda;
    unsigned voffA[2], voffB[2];
#pragma unroll
    for (int i = 0; i < 2; ++i) { int R, C; stage_rc(tid * 16 + i * 8192, R, C); const int Rb = (R & ~31) + perm32(R & 31);
        voffA[i] = (unsigned)(R * lda + C) * 2u; voffB[i] = (unsigned)(Rb * K + C) * 2u; }
    const size_t kstep = (size_t)(BK * 2);
    const size_t hstepA = (size_t)HALF * lda * 2, hstepB = (size_t)HALF * K * 2;
    const size_t tstepA = 2 * hstepA, tstepB = 2 * hstepB;
    const unsigned ldsw = (unsigned)wid * 1024u;
    const int aoff = lds_byte(wr * 64 + fr, fq * 8), boff = lds_byte(wc * 32 + fr, fq * 8);
#define PG8_SA(b, h) (((b) * 2 + (h)) * HTB)
#define PG8_SB(b, h) ((4 + (b) * 2 + (h)) * HTB)
#define PG8_STAGE(bufoff, gbase, voff) do { _Pragma("unroll") for (int _i = 0; _i < 2; ++_i) \
        __builtin_amdgcn_global_load_lds((const unsigned*)((const char*)(gbase) + (voff)[_i]), (LAS unsigned*)(lds + (bufoff) + ldsw + _i * 8192), 16, 0, 0); } while (0)
#define PG8_LDA(dst, b, h) do { _Pragma("unroll") for (int m = 0; m < 4; ++m) _Pragma("unroll") for (int k = 0; k < 2; ++k) dst[m][k] = *(const LAS bf16x8*)(lds + PG8_SA(b, h) + aoff + m * 2048 + k * 1024); } while (0)
#define PG8_LDB(dst, b, h) do { _Pragma("unroll") for (int n = 0; n < 2; ++n) _Pragma("unroll") for (int k = 0; k < 2; ++k) dst[n][k] = *(const LAS bf16x8*)(lds + PG8_SB(b, h) + boff + n * 2048 + k * 1024); } while (0)
#define PG8_MMA(ai, bj, At, Bt) do { __builtin_amdgcn_s_setprio(1); _Pragma("unroll") for (int m = 0; m < 4; ++m) _Pragma("unroll") for (int n = 0; n < 2; ++n) _Pragma("unroll") for (int k = 0; k < 2; ++k) \
        acc[ai][bj][m][n] = __builtin_amdgcn_mfma_f32_16x16x32_bf16(Bt[n][k], At[m][k], acc[ai][bj][m][n], 0, 0, 0); __builtin_amdgcn_s_setprio(0); } while (0)
#define PG8_WAIT_V(n) asm volatile("s_waitcnt vmcnt(" #n ")" ::: "memory")
#define PG8_WAIT_L(n) asm volatile("s_waitcnt lgkmcnt(" #n ")" ::: "memory")
#define PG8_BAR __builtin_amdgcn_s_barrier()
#define PG8_SCHED __builtin_amdgcn_sched_barrier(0)
    Unit cur, nxt; int ui = 0;
    if (!S.next(0, cur)) return;
    f32x4 acc[2][2][4][2];
#pragma unroll
    for (int a = 0; a < 2; ++a)
#pragma unroll
        for (int b = 0; b < 2; ++b)
#pragma unroll
            for (int m = 0; m < 4; ++m)
#pragma unroll
                for (int n = 0; n < 2; ++n) acc[a][b][m][n] = (f32x4){0.f, 0.f, 0.f, 0.f};
    bf16x8 At[4][2], B0[2][2], B1[2][2];
    const char* cA = (const char*)g.A + (size_t)cur.pm * tstepA; const char* cB = (const char*)g.Bt + (size_t)cur.pn * tstepB;
    PG8_STAGE(PG8_SB(0, 0), cB, voffB); PG8_STAGE(PG8_SB(0, 1), cB + hstepB, voffB); PG8_STAGE(PG8_SA(0, 0), cA, voffA); PG8_STAGE(PG8_SA(0, 1), cA + hstepA, voffA);
    if (wr == 1) PG8_BAR;
    PG8_WAIT_V(2); PG8_BAR;
    PG8_STAGE(PG8_SB(1, 0), cB + kstep, voffB); PG8_STAGE(PG8_SA(1, 0), cA + kstep, voffA); PG8_STAGE(PG8_SB(1, 1), cB + hstepB + kstep, voffB);
    PG8_WAIT_V(6); PG8_BAR;
    for (;;) {
        const bool has_next = S.next(ui + 1, nxt);
        const char* nA = has_next ? (const char*)g.A + (size_t)nxt.pm * tstepA : cA; const char* nB = has_next ? (const char*)g.Bt + (size_t)nxt.pn * tstepB : cB;
#pragma nounroll
        for (int t = 0; t < nt; t += 2) {
            if (Hook::ACTIVE) { if (t == 8 || t == 16) { HK(acc, cur, t, wr, wc, fr, fq); asm volatile("s_waitcnt vmcnt(0)" ::: "memory"); } }
            const bool last = (t == nt - 2);
            const char* a1 = cA + (size_t)(t + 1) * kstep;
            const char* a2 = last ? nA : cA + (size_t)(t + 2) * kstep; const char* b2 = last ? nB : cB + (size_t)(t + 2) * kstep;
            const char* a3 = a2 + kstep; const char* b3 = b2 + kstep;
            PG8_LDB(B0, 0, 0); PG8_LDB(B1, 0, 1); PG8_SCHED; PG8_LDA(At, 0, 0); PG8_STAGE(PG8_SA(1, 1), a1 + hstepA, voffA);
            PG8_WAIT_V(8); PG8_WAIT_L(0); PG8_BAR; PG8_MMA(0, 0, At, B0); PG8_MMA(0, 1, At, B1); PG8_BAR; PG8_SCHED;
            PG8_LDA(At, 0, 1); PG8_STAGE(PG8_SB(0, 0), b2, voffB); PG8_STAGE(PG8_SB(0, 1), b2 + hstepB, voffB); PG8_STAGE(PG8_SA(0, 0), a2, voffA);
            PG8_WAIT_V(8); PG8_WAIT_L(0); PG8_BAR; PG8_MMA(1, 0, At, B0); PG8_MMA(1, 1, At, B1); PG8_BAR; PG8_SCHED;
            PG8_LDB(B0, 1, 0); PG8_LDB(B1, 1, 1); PG8_SCHED; PG8_LDA(At, 1, 0); PG8_STAGE(PG8_SA(0, 1), a2 + hstepA, voffA);
            PG8_WAIT_V(8); PG8_WAIT_L(0); PG8_BAR; PG8_MMA(0, 0, At, B0); PG8_MMA(0, 1, At, B1); PG8_BAR; PG8_SCHED;
            PG8_LDA(At, 1, 1); PG8_STAGE(PG8_SB(1, 0), b3, voffB); PG8_STAGE(PG8_SB(1, 1), b3 + hstepB, voffB); PG8_STAGE(PG8_SA(1, 0), a3, voffA);
            PG8_WAIT_V(8); PG8_WAIT_L(0); PG8_BAR; PG8_MMA(1, 0, At, B0); PG8_MMA(1, 1, At, B1); PG8_BAR; PG8_SCHED;
        }
        if (wr == 0) PG8_BAR;
        E(acc, cur, wr, wc, fr, fq);
        if (!has_next) break;
#pragma unroll
        for (int a = 0; a < 2; ++a)
#pragma unroll
            for (int b = 0; b < 2; ++b)
#pragma unroll
                for (int m = 0; m < 4; ++m)
#pragma unroll
                    for (int n = 0; n < 2; ++n) acc[a][b][m][n] = (f32x4){0.f, 0.f, 0.f, 0.f};
        cur = nxt; cA = nA; cB = nB; ++ui;
        if (wr == 1) PG8_BAR;
    }
    PG8_WAIT_V(0);
    PG8_BAR;
#undef PG8_SA
#undef PG8_SB
#undef PG8_STAGE
#undef PG8_LDA
#undef PG8_LDB
#undef PG8_MMA
#undef PG8_WAIT_V
#undef PG8_WAIT_L
#undef PG8_BAR
#undef PG8_SCHED
}
typedef f32x4 Acc[2][2][4][2];

struct EpiH {
    bf16_t* H; bf16_t* KB; float* KMP; float* STQ; float* STKV; const float* rope; unsigned* dep;
    DI void operator()(const Acc& acc, const Unit& u, int wr, int wc, int fr, int fq) const {
        const int row0 = u.pm * BM + wr * 64 + fr;
        {
            const int pn = u.pn; bf16_t* base; int hw = 0, cseg;
            if (pn < 6) { base = H + (pn < 2 ? HM_AQ : pn < 4 ? HM_AK : HM_AV); hw = 64; cseg = (pn & 1) * 256; }
            else if (pn < 10) { base = H + (pn < 8 ? C_AZ : C_BZ); cseg = (pn & 1) * 256; }
            else if (pn < 16) { base = H + (pn < 12 ? HM_CQ : pn < 14 ? HM_CK : HM_CV); hw = 128; cseg = (pn & 1) * 256; }
            else if (pn < 18) { base = H + C_CZ; cseg = (pn & 1) * 256; }
            else { base = H + C_CKV; cseg = (pn - 18) * 256; }
            const int bl = u.pm >> 3, s0 = (u.pm & 7) * 256 + wr * 64 + fr;
#pragma unroll
            for (int bj = 0; bj < 2; ++bj) { const int cs = cseg + bj * HALF + wc * 32 + 8 * fq;
                bf16_t* colp; size_t pitch;
                if (hw == 64) { colp = base + ((size_t)(bl * 8 + (cs >> 6)) * SEQ) * 64 + (cs & 63); pitch = 64; }
                else if (hw == 128) { colp = base + ((size_t)(bl * 4 + (cs >> 7)) * SEQ) * 128 + (cs & 127); pitch = 128; }
                else { colp = base + (size_t)bl * SEQ * HP + cs; pitch = HP; }
#pragma unroll
                for (int ai = 0; ai < 2; ++ai)
#pragma unroll
                    for (int m = 0; m < 4; ++m) *(u32x4*)(colp + (size_t)(s0 + ai * HALF + m * 16) * pitch) = pack8(acc[ai][bj][m][0], acc[ai][bj][m][1]); }
        }
        if (u.pn == 2 || u.pn == 3) {
            float* dst = KMP + (size_t)(u.pm * 2 + wr) * 512 + (u.pn - 2) * 256 + wc * 32 + 8 * fq;
#pragma unroll
            for (int bj = 0; bj < 2; ++bj)
#pragma unroll
                for (int n = 0; n < 2; ++n) { f32x4 s = (f32x4){0.f, 0.f, 0.f, 0.f};
#pragma unroll
                    for (int ai = 0; ai < 2; ++ai)
#pragma unroll
                        for (int m = 0; m < 4; ++m) s += acc[ai][bj][m][n];
#pragma unroll
                    for (int e = 0; e < 4; ++e) { float v = s[e]; v += __shfl_xor(v, 1); v += __shfl_xor(v, 2); v += __shfl_xor(v, 4); v += __shfl_xor(v, 8); s[e] = v; }
                    if (fr == 0) *(f32x4*)(dst + bj * HALF + 4 * n) = s; }
        }
        if (u.pn >= 18) {
#pragma unroll
            for (int ai = 0; ai < 2; ++ai)
#pragma unroll
                for (int m = 0; m < 4; ++m) { const int row = row0 + ai * HALF + m * 16; float ss = 0.f;
#pragma unroll
                    for (int bj = 0; bj < 2; ++bj) { if (u.pn == 20 && bj == 1) continue;
#pragma unroll
                        for (int n = 0; n < 2; ++n) { const f32x4 x = acc[ai][bj][m][n]; ss += (x[0] * x[0] + x[1] * x[1]) + (x[2] * x[2] + x[3] * x[3]); } }
                    ss += __shfl_xor(ss, 16); ss += __shfl_xor(ss, 32);
                    if (fq == 0) { if (u.pn == 18) STKV[(size_t)row * 4 + wc] = ss; else STQ[(size_t)row * 8 + (u.pn - 19) * 4 + wc] = ss; }
                    if (u.pn == 20 && wc == 0) {
                        const int pos = row & (SEQ - 1); f32x4 o[2];
#pragma unroll
                        for (int n = 0; n < 2; ++n) { const f32x4 cs = *(const f32x4*)(rope + ((size_t)pos * 16 + 4 * fq + 2 * n) * 2); const f32x4 t = acc[ai][1][m][n];
                            o[n] = (f32x4){t[0] * cs[0] - t[1] * cs[1], t[0] * cs[1] + t[1] * cs[0], t[2] * cs[2] - t[3] * cs[3], t[2] * cs[3] + t[3] * cs[2]}; }
                        const u32x4 w = pack8(o[0], o[1]);
#pragma unroll
                        for (int h = 0; h < 8; ++h) *(u32x4*)(KB + ((size_t)((row >> 11) * 8 + h) * SEQ + pos) * 96 + 64 + 8 * fq) = w;
                    }
                }
        }
        if (u.pn >= 18) {
            asm volatile("s_waitcnt vmcnt(0)" ::: "memory");
            __syncthreads();
            if (threadIdx.x == 0) {
                __builtin_amdgcn_fence(__ATOMIC_RELEASE, "agent");
                asm volatile("s_waitcnt vmcnt(0)" ::: "memory");
                __hip_atomic_fetch_add(dep + u.pm, 8u, __ATOMIC_RELAXED, __HIP_MEMORY_SCOPE_AGENT);
            }
        }
    }
};
template <int MODE> struct EpiUp {
    bf16_t* QB; bf16_t* KB; bf16_t* VB; const float* ST; const float* rope;
    DI void operator()(const Acc& acc, const Unit& u, int wr, int wc, int fr, int fq) const {
        const int row0 = u.pm * BM + wr * 64 + fr;
#pragma unroll
        for (int ai = 0; ai < 2; ++ai)
#pragma unroll
            for (int m = 0; m < 4; ++m) { const int row = row0 + ai * HALF + m * 16; float sc;
                if (MODE == 0) { const f32x4 a = *(const f32x4*)(ST + (size_t)row * 8), b = *(const f32x4*)(ST + (size_t)row * 8 + 4);
                    sc = __builtin_amdgcn_rsqf(((a[0] + a[1]) + (a[2] + a[3]) + (b[0] + b[1]) + (b[2] + b[3])) * (1.f / 384.f) + 1e-6f) * QS96; }
                else { const f32x4 a = *(const f32x4*)(ST + (size_t)row * 4); sc = __builtin_amdgcn_rsqf(((a[0] + a[1]) + (a[2] + a[3])) * (1.f / 256.f) + 1e-6f); }
                const int pos = row & (SEQ - 1);
#pragma unroll
                for (int bj = 0; bj < 2; ++bj) { const int c0 = u.pn * BM + bj * HALF + wc * 32 + 8 * fq;
                    f32x4 v0 = acc[ai][bj][m][0] * sc, v1 = acc[ai][bj][m][1] * sc;
                    if (MODE == 0) { const int j = c0 % 96;
                        if (j >= 64) { const int i0 = (j - 64) >> 1; const f32x4 ca = *(const f32x4*)(rope + ((size_t)pos * 16 + i0) * 2), cb = *(const f32x4*)(rope + ((size_t)pos * 16 + i0 + 2) * 2);
                            v0 = (f32x4){v0[0] * ca[0] - v0[1] * ca[1], v0[0] * ca[1] + v0[1] * ca[0], v0[2] * ca[2] - v0[3] * ca[3], v0[2] * ca[3] + v0[3] * ca[2]};
                            v1 = (f32x4){v1[0] * cb[0] - v1[1] * cb[1], v1[0] * cb[1] + v1[1] * cb[0], v1[2] * cb[2] - v1[3] * cb[3], v1[2] * cb[3] + v1[3] * cb[2]}; }
                        *(u32x4*)(QB + ((size_t)((row >> 11) * 8 + c0 / 96) * SEQ + pos) * 96 + j) = pack8(v0, v1); }
                    else { if (c0 < 512) *(u32x4*)(KB + ((size_t)((row >> 11) * 8 + (c0 >> 6)) * SEQ + pos) * 96 + (c0 & 63)) = pack8(v0, v1);
                           else *(u32x4*)(VB + ((size_t)((row >> 11) * 8 + ((c0 - 512) >> 6)) * SEQ + pos) * 64 + (c0 & 63)) = pack8(v0, v1); }
                }
            }
    }
};
DI size_t gfrag(int pm, int pnn, int wr, int wc, int fr, int fq) { return ((size_t)(pm * 12 + pnn) * 65536) + (size_t)(((wr * 4 + wc) * 64 + fq * 16 + fr) * 8); }
struct EpiG {
    bf16_t* G; const float* bias;
    DI void operator()(const Acc& acc, const Unit& u, int wr, int wc, int fr, int fq) const {
        const int row0 = u.pm * BM + wr * 64 + fr, col0 = u.pn * BM + wc * 32 + 8 * fq;
        f32x4 bv[2][2];
#pragma unroll
        for (int bj = 0; bj < 2; ++bj)
#pragma unroll
            for (int n = 0; n < 2; ++n) bv[bj][n] = *(const f32x4*)(bias + col0 + bj * HALF + 4 * n);
#pragma unroll
        for (int ai = 0; ai < 2; ++ai)
#pragma unroll
            for (int m = 0; m < 4; ++m) { bf16_t* rowp = G + gfrag(u.pm, u.pn, wr, wc, fr, fq) + (size_t)((ai * 4 + m) * 2) * 4096;
#pragma unroll
                for (int bj = 0; bj < 2; ++bj) { f32x4 v0 = acc[ai][bj][m][0] + bv[bj][0], v1 = acc[ai][bj][m][1] + bv[bj][1];
#pragma unroll
                    for (int e = 0; e < 4; ++e) { v0[e] = fmaxf(sigm(v0[e]), 1e-12f); v1[e] = fmaxf(sigm(v1[e]), 1e-12f); }
                    *(u32x4*)(rowp + bj * 4096) = pack8(v0, v1); } }
    }
};
struct MergeHook {
    static constexpr bool ACTIVE = true;
    const bf16_t* G;
    DI void operator()(Acc& acc, const Unit& u, int t, int wr, int wc, int fr, int fq) const {
        const int seg = (t == 8) ? 0 : 1;
        const int row0 = u.pm * BM + wr * 64 + fr, col0 = u.pn * BM + wc * 32 + 8 * fq;
        const bf16_t* gp = G + gfrag(u.pm, seg * 4 + u.pn, wr, wc, fr, fq);
#pragma unroll
        for (int ai = 0; ai < 2; ++ai) {
            u32x4 ga[8], gb[8];
#pragma unroll
            for (int m = 0; m < 4; ++m)
#pragma unroll
                for (int bj = 0; bj < 2; ++bj) { const bf16_t* p = gp + (size_t)((ai * 4 + m) * 2 + bj) * 4096; ga[m * 2 + bj] = *(const u32x4*)p; gb[m * 2 + bj] = *(const u32x4*)(p + 4 * 65536); }
            __builtin_amdgcn_sched_barrier(0);
#pragma unroll
            for (int m = 0; m < 4; ++m)
#pragma unroll
                for (int bj = 0; bj < 2; ++bj) { f32x4 a0, a1, b0, b1; unpack8(ga[m * 2 + bj], a0, a1); unpack8(gb[m * 2 + bj], b0, b1);
#pragma unroll
                    for (int e = 0; e < 4; ++e) { acc[ai][bj][m][0][e] *= a0[e] * __builtin_amdgcn_rcpf(b0[e]); acc[ai][bj][m][1][e] *= a1[e] * __builtin_amdgcn_rcpf(b1[e]); } }
            __builtin_amdgcn_sched_barrier(0);
        }
    }
};
struct EpiMerge {
    const bf16_t* G; bf16_t* MG;
    DI void operator()(const Acc& acc, const Unit& u, int wr, int wc, int fr, int fq) const {
        const int row0 = u.pm * BM + wr * 64 + fr, col0 = u.pn * BM + wc * 32 + 8 * fq;
        const bf16_t* gp = G + gfrag(u.pm, 8 + u.pn, wr, wc, fr, fq); bf16_t* mp = MG + (size_t)row0 * 1024 + col0;
#pragma unroll
        for (int ai = 0; ai < 2; ++ai) {
            u32x4 gq[8];
#pragma unroll
            for (int m = 0; m < 4; ++m)
#pragma unroll
                for (int bj = 0; bj < 2; ++bj) gq[m * 2 + bj] = *(const u32x4*)(gp + (size_t)((ai * 4 + m) * 2 + bj) * 4096);
            __builtin_amdgcn_sched_barrier(0);
#pragma unroll
            for (int m = 0; m < 4; ++m)
#pragma unroll
                for (int bj = 0; bj < 2; ++bj) { f32x4 g0, g1; unpack8(gq[m * 2 + bj], g0, g1);
                    *(u32x4*)(mp + (size_t)(ai * HALF + m * 16) * 1024 + bj * HALF) = pack8(acc[ai][bj][m][0] * g0, acc[ai][bj][m][1] * g1); }
            __builtin_amdgcn_sched_barrier(0);
        }
    }
};
struct EpiR {
    const float* X; float* R; bf16_t* RB;
    DI void operator()(const Acc& acc, const Unit& u, int wr, int wc, int fr, int fq) const {
        const int row0 = u.pm * BM + wr * 64 + fr, col0 = u.pn * BM + wc * 32 + 8 * fq;
        const size_t base = (size_t)row0 * 1024 + col0;
#pragma unroll
        for (int hb = 0; hb < 4; ++hb) {
            const int ai = hb >> 1, m0 = (hb & 1) * 2;
            f32x4 xq[8];
#pragma unroll
            for (int mm = 0; mm < 2; ++mm)
#pragma unroll
                for (int bj = 0; bj < 2; ++bj) { const size_t off = base + (size_t)(ai * HALF + (m0 + mm) * 16) * 1024 + bj * HALF;
                    xq[(mm * 2 + bj) * 2] = *(const f32x4*)(X + off); xq[(mm * 2 + bj) * 2 + 1] = *(const f32x4*)(X + off + 4); }
            __builtin_amdgcn_sched_barrier(0);
#pragma unroll
            for (int mm = 0; mm < 2; ++mm)
#pragma unroll
                for (int bj = 0; bj < 2; ++bj) { const size_t off = base + (size_t)(ai * HALF + (m0 + mm) * 16) * 1024 + bj * HALF;
                    const f32x4 v0 = xq[(mm * 2 + bj) * 2] * ALPHA + acc[ai][bj][m0 + mm][0], v1 = xq[(mm * 2 + bj) * 2 + 1] * ALPHA + acc[ai][bj][m0 + mm][1];
                    *(f32x4*)(R + off) = v0; *(f32x4*)(R + off + 4) = v1;
                    *(u32x4*)(RB + off) = pack8(v0, v1); }
            __builtin_amdgcn_sched_barrier(0);
        }
    }
};
struct EpiBf {
    bf16_t* O;
    DI void operator()(const Acc& acc, const Unit& u, int wr, int wc, int fr, int fq) const {
        const int row0 = u.pm * BM + wr * 64 + fr, col0 = u.pn * BM + wc * 32 + 8 * fq;
#pragma unroll
        for (int ai = 0; ai < 2; ++ai)
#pragma unroll
            for (int m = 0; m < 4; ++m) { bf16_t* rowp = O + (size_t)(row0 + ai * HALF + m * 16) * 1024 + col0;
#pragma unroll
                for (int bj = 0; bj < 2; ++bj) *(u32x4*)(rowp + bj * HALF) = pack8(acc[ai][bj][m][0], acc[ai][bj][m][1]); }
    }
};
struct EpiR2 {
    float* R; const bf16_t* PP;
    DI void operator()(const Acc& acc, const Unit& u, int wr, int wc, int fr, int fq) const {
        const int row0 = u.pm * BM + wr * 64 + fr, col0 = u.pn * BM + wc * 32 + 8 * fq;
        const size_t base = (size_t)row0 * 1024 + col0;
#pragma unroll
        for (int hb = 0; hb < 4; ++hb) {
            const int ai = hb >> 1, m0 = (hb & 1) * 2;
            f32x4 rq[8]; u32x4 pq[4];
#pragma unroll
            for (int mm = 0; mm < 2; ++mm)
#pragma unroll
                for (int bj = 0; bj < 2; ++bj) { const size_t off = base + (size_t)(ai * HALF + (m0 + mm) * 16) * 1024 + bj * HALF;
                    pq[mm * 2 + bj] = *(const u32x4*)(PP + off); rq[(mm * 2 + bj) * 2] = *(const f32x4*)(R + off); rq[(mm * 2 + bj) * 2 + 1] = *(const f32x4*)(R + off + 4); }
            __builtin_amdgcn_sched_barrier(0);
#pragma unroll
            for (int mm = 0; mm < 2; ++mm)
#pragma unroll
                for (int bj = 0; bj < 2; ++bj) { const size_t off = base + (size_t)(ai * HALF + (m0 + mm) * 16) * 1024 + bj * HALF;
                    f32x4 p0, p1; unpack8(pq[mm * 2 + bj], p0, p1);
                    f32x4 r0 = rq[(mm * 2 + bj) * 2], r1 = rq[(mm * 2 + bj) * 2 + 1];
                    const f32x4 a0 = acc[ai][bj][m0 + mm][0], a1 = acc[ai][bj][m0 + mm][1];
#pragma unroll
                    for (int e = 0; e < 4; ++e) { r0[e] += sigm(a0[e]) * p0[e]; r1[e] += sigm(a1[e]) * p1[e]; }
                    *(f32x4*)(R + off) = r0; *(f32x4*)(R + off + 4) = r1; }
            __builtin_amdgcn_sched_barrier(0);
        }
    }
};
}

DI float row16_sum(float v) {
    v += __builtin_bit_cast(float, __builtin_amdgcn_update_dpp(0, __builtin_bit_cast(int, v), 0xB1, 0xF, 0xF, true));
    v += __builtin_bit_cast(float, __builtin_amdgcn_update_dpp(0, __builtin_bit_cast(int, v), 0x4E, 0xF, 0xF, true));
    v += __builtin_bit_cast(float, __builtin_amdgcn_update_dpp(0, __builtin_bit_cast(int, v), 0x124, 0xF, 0xF, true));
    v += __builtin_bit_cast(float, __builtin_amdgcn_update_dpp(0, __builtin_bit_cast(int, v), 0x128, 0xF, 0xF, true));
    return v;
}
DI int crow(int r, int hi) { return (r & 3) + 8 * (r >> 2) + 4 * hi; }
DI s16x4 vtr(LAS const char* p) { typedef short v4i16_t __attribute__((ext_vector_type(4))); return __builtin_bit_cast(s16x4, __builtin_amdgcn_ds_read_tr16_b64_v4i16((LAS v4i16_t*)p)); }
constexpr int AT_SCR = 112 * 1024, AT_KM = 113 * 1024;
constexpr float NEGBIG = -1e30f;
DI float max3f(float a, float b, float c) { return fmaxf(fmaxf(a, b), c); }

template <int DQK, int KW, int DV, int NROWS, bool ALIBI, bool MOBA, bool PIPE, int NSET>
DI void attn_unit(LAS char* lds, const bf16_t* Qp, int ldq, const bf16_t* Kp, int ldk, const bf16_t* Vp, int ldv,
                  const bf16_t* Zp, int ldz, bf16_t* Yp, int ldy, int q0, float sl2, const float* kmp, float lam, const float* subg, float post) {
    constexpr int NTD = NROWS / 64, NS = DQK / 16, ND = DV / 32, PVG = (DV == 64) ? 2 : 1;
    constexpr int KPITCH = KW * 2 + 16, VPITCH = DV * 2 + 64;
    constexpr int KOFF0 = 0, VOFF0 = 3 * 64 * KPITCH;
    constexpr int KCH = KW / 8, VCH = DV / 8, NKC = 64 * KCH, NVC = 64 * VCH, KPT = (NKC + 511) / 512, VPT = (NVC + 511) / 512;
    static_assert(VOFF0 + 3 * 64 * VPITCH <= AT_SCR, "attention LDS map");
    const int tid = opaque_tid(), lane = tid & 63, r32 = lane & 31, hi = lane >> 5;
    const int wid = __builtin_amdgcn_readfirstlane(tid >> 6);
    const int ro = (NROWS == 256) ? 32 * wid : 32 * (wid & 3);
    const int map = (NROWS == 256) ? 0 : (wid >> 2);
    const int qpos = q0 + ro + r32;
    LAS float* scr = (LAS float*)(lds + AT_SCR) + wid * 32;

    bf16x8 qf[NS];
    { const bf16_t* qrow = Qp + (size_t)qpos * ldq + 64 * map + 8 * hi;
#pragma unroll
      for (int s = 0; s < NS; ++s) qf[s] = *(const bf16x8*)(qrow + 16 * s); }

    unsigned sel = 0xFFu;
    if (MOBA) {
        const int u = q0 >> 8;
        if (u > 3) {
            LAS float* km = (LAS float*)(lds + AT_KM);
            { const int j = tid >> 6, d = tid & 63; if (j < u) km[j * 64 + d] = (kmp[(size_t)(j * 2) * 512 + d] + kmp[(size_t)(j * 2 + 1) * 512 + d]) * (1.f / 256.f); }
            __syncthreads();
            float g[7];
#pragma unroll
            for (int j = 0; j < 7; ++j) { float a = 0.f;
                if (j < u) {
#pragma unroll
                    for (int s = 0; s < 4; ++s) { const f32x4 k0 = *(const LAS f32x4*)(km + j * 64 + 16 * s + 8 * hi), k1 = *(const LAS f32x4*)(km + j * 64 + 16 * s + 8 * hi + 4);
#pragma unroll
                        for (int e = 0; e < 4; ++e) { a += bf2f((bf16_t)qf[s][e]) * k0[e]; a += bf2f((bf16_t)qf[s][4 + e]) * k1[e]; } }
                }
                a += __shfl_xor(a, 32); g[j] = a; }
            sel = 0u;
#pragma unroll
            for (int k = 0; k < 3; ++k) { float best = -INFINITY; int bi = 0;
#pragma unroll
                for (int j = 0; j < 7; ++j) { const bool ok = (j < u) && !((sel >> j) & 1u) && (g[j] > best); best = ok ? g[j] : best; bi = ok ? j : bi; }
                sel |= 1u << bi; }
        }
    }

    f32x16 o[ND];
#pragma unroll
    for (int d0 = 0; d0 < ND; ++d0)
#pragma unroll
        for (int r = 0; r < 16; ++r) o[d0][r] = 0.f;
    f32x16 bias;
#pragma unroll
    for (int r = 0; r < 16; ++r) bias[r] = ALIBI ? sl2 * (float)((r & 3) + 8 * (r >> 2) + 4 * hi) : 0.f;
    const float d32 = ALIBI ? 32.f * sl2 : 0.f;
    float mrun = NEGBIG, lrun = 0.f;
    const int nt = NTD + (q0 >> 6);
    u32x4 kregA[KPT], vregA[VPT], kregB[KPT], vregB[VPT], kregC[KPT], vregC[VPT], kregD[KPT], vregD[VPT];
#define AT_TB(it) ((it) < NTD ? q0 + 64 * (it) : 64 * ((it) - NTD))
#define AT_LOAD(it, kreg, vreg) do { const int _ti = ((it) < nt) ? (it) : nt - 1; const int _kb = AT_TB(_ti); \
        _Pragma("unroll") for (int _i = 0; _i < KPT; ++_i) { const int _c = tid + 512 * _i; if (NKC % 512 == 0 || _i + 1 < KPT || _c < NKC) { const int _r = _c / KCH, _cc = _c % KCH; kreg[_i] = *(const u32x4*)(Kp + (size_t)(_kb + _r) * ldk + 8 * _cc); } } \
        _Pragma("unroll") for (int _i = 0; _i < VPT; ++_i) { const int _c = tid + 512 * _i; if (NVC % 512 == 0 || _i + 1 < VPT || _c < NVC) { const int _r = _c / VCH, _cc = _c % VCH; vreg[_i] = *(const u32x4*)(Vp + (size_t)(_kb + _r) * ldv + 8 * _cc); } } } while (0)
#define AT_STORE(buf, kreg, vreg) do { \
        _Pragma("unroll") for (int _i = 0; _i < KPT; ++_i) { const int _c = tid + 512 * _i; if (NKC % 512 == 0 || _i + 1 < KPT || _c < NKC) { const int _r = _c / KCH, _cc = _c % KCH; *(LAS u32x4*)(lds + KOFF0 + (buf) * 64 * KPITCH + _r * KPITCH + 16 * _cc) = kreg[_i]; } } \
        _Pragma("unroll") for (int _i = 0; _i < VPT; ++_i) { const int _c = tid + 512 * _i; if (NVC % 512 == 0 || _i + 1 < VPT || _c < NVC) { const int _r = _c / VCH, _cc = _c % VCH; *(LAS u32x4*)(lds + VOFF0 + (buf) * 64 * VPITCH + _r * VPITCH + 16 * _cc) = vreg[_i]; } } } while (0)
#define AT_ACTIVE(it) ((it) >= NTD || 64 * (it) <= ro + 31)
#define AT_QK(it, bufi, P0, P1) do { if (AT_ACTIVE(it)) { \
        LAS const char* _Kb = lds + KOFF0 + (bufi) * 64 * KPITCH + r32 * KPITCH + (64 * map + 8 * hi) * 2; \
        _Pragma("unroll") for (int _h = 0; _h < NS; _h += 4) { \
            bf16x8 _kf[8]; \
            _Pragma("unroll") for (int _s = 0; _s < 4; ++_s) if (_h + _s < NS) { _kf[2 * _s] = *(const LAS bf16x8*)(_Kb + 32 * (_h + _s)); _kf[2 * _s + 1] = *(const LAS bf16x8*)(_Kb + 32 * KPITCH + 32 * (_h + _s)); } \
            __builtin_amdgcn_sched_barrier(0); \
            _Pragma("unroll") for (int _s = 0; _s < 4; ++_s) if (_h + _s < NS) { \
                if (_h + _s == 0) { P0 = __builtin_amdgcn_mfma_f32_32x32x16_bf16(_kf[0], qf[0], bias, 0, 0, 0); P1 = __builtin_amdgcn_mfma_f32_32x32x16_bf16(_kf[1], qf[0], bias, 0, 0, 0); } \
                else { P0 = __builtin_amdgcn_mfma_f32_32x32x16_bf16(_kf[2 * _s], qf[_h + _s], P0, 0, 0, 0); P1 = __builtin_amdgcn_mfma_f32_32x32x16_bf16(_kf[2 * _s + 1], qf[_h + _s], P1, 0, 0, 0); } } \
            __builtin_amdgcn_sched_barrier(0); } } } while (0)
    if (NSET == 4) { AT_LOAD(0, kregA, vregA); AT_LOAD(1, kregB, vregB); AT_LOAD(2, kregC, vregC); AT_LOAD(3, kregD, vregD); AT_STORE(0, kregA, vregA); AT_STORE(1, kregB, vregB);
                     AT_LOAD(4, kregA, vregA); AT_LOAD(5, kregB, vregB); }
    else if (NSET == 2) { AT_LOAD(0, kregA, vregA); AT_LOAD(1, kregB, vregB); AT_STORE(0, kregA, vregA); AT_STORE(1, kregB, vregB); AT_LOAD(2, kregA, vregA); AT_LOAD(3, kregB, vregB); }
    else { AT_LOAD(0, kregA, vregA); AT_STORE(0, kregA, vregA); AT_LOAD(1, kregA, vregA); AT_STORE(1, kregA, vregA); AT_LOAD(2, kregA, vregA); }
    __syncthreads();
    const int i16 = lane & 15;
    const int vlane = (4 * hi + (i16 >> 2)) * VPITCH + (16 * ((lane >> 4) & 1) + 4 * (i16 & 3)) * 2;
    f32x16 pa0, pa1, pb0, pb1;
#pragma unroll
    for (int r = 0; r < 16; ++r) { pa0[r] = 0.f; pa1[r] = 0.f; pb0[r] = 0.f; pb1[r] = 0.f; }
    if (PIPE) AT_QK(0, 0, pa0, pa1);
    int bcur = 0;
#define AT_ITER(it, C0, C1, N0, N1, kreg, vreg) do { \
        const int _b1 = (bcur == 2) ? 0 : bcur + 1, _b2 = (_b1 == 2) ? 0 : _b1 + 1; \
        AT_STORE(_b2, kreg, vreg); \
        AT_LOAD((it) + 2 + NSET, kreg, vreg); \
        if (PIPE) { if ((it) + 1 < nt) AT_QK((it) + 1, _b1, N0, N1); } else AT_QK(it, bcur, C0, C1); \
        if (AT_ACTIVE(it)) { \
            LAS const char* _Vb = lds + VOFF0 + bcur * 64 * VPITCH + vlane; \
            bf16x8 _vf[4 * PVG];                      \
            _Pragma("unroll") for (int _e = 0; _e < PVG; ++_e) _Pragma("unroll") for (int _ks = 0; _ks < 4; ++_ks) { \
                const s16x4 _lo = vtr(_Vb + (16 * _ks) * VPITCH + 64 * _e), _hh = vtr(_Vb + (16 * _ks + 8) * VPITCH + 64 * _e); \
                _vf[4 * _e + _ks] = __builtin_shufflevector(_lo, _hh, 0, 1, 2, 3, 4, 5, 6, 7); } \
            __builtin_amdgcn_sched_barrier(0); \
            const int _kb = AT_TB(it); const bool _diag = (it) < NTD; \
            if (_diag) { const int _kq = _kb + 4 * hi - qpos; \
                _Pragma("unroll") for (int _r = 0; _r < 16; ++_r) { const int _dd = _kq + (_r & 3) + 8 * (_r >> 2); if (_dd > 0) C0[_r] = NEGBIG; if (_dd + 32 > 0) C1[_r] = NEGBIG; } } \
            float _m0 = max3f(C0[0], C0[1], C0[2]), _m1 = max3f(C1[0], C1[1], C1[2]); \
            _Pragma("unroll") for (int _r = 3; _r < 15; _r += 2) { _m0 = max3f(_m0, C0[_r], C0[_r + 1]); _m1 = max3f(_m1, C1[_r], C1[_r + 1]); } \
            _m0 = fmaxf(_m0, C0[15]); _m1 = fmaxf(_m1, C1[15]); \
            const float _c0 = ALIBI ? sl2 * (float)(_kb - qpos) : 0.f; \
            float _mx = fmaxf(_m0, _m1 + d32) + _c0; \
            bool _selok = true; if (MOBA && !_diag) _selok = ((sel >> (_kb >> 8)) & 1u) != 0u; \
            if (!_selok) _mx = NEGBIG; \
            { const auto _rr = __builtin_amdgcn_permlane32_swap(__float_as_uint(_mx), __float_as_uint(_mx), false, false); _mx = fmaxf(__uint_as_float(_rr[0]), __uint_as_float(_rr[1])); }     \
            const float _mn = fmaxf(mrun, _mx); \
            if (__any(_mn - mrun > 8.f)) { \
                const float _alpha = __builtin_amdgcn_exp2f(mrun - _mn); lrun *= _alpha; mrun = _mn; \
                scr[r32] = _alpha; \
                asm volatile("s_waitcnt lgkmcnt(0)" ::: "memory"); \
                f32x4 _a4[4]; \
                _Pragma("unroll") for (int _g = 0; _g < 4; ++_g) _a4[_g] = *(const LAS f32x4*)(scr + 8 * _g + 4 * hi); \
                asm volatile("s_waitcnt lgkmcnt(0)" ::: "memory"); \
                _Pragma("unroll") for (int _d0 = 0; _d0 < ND; ++_d0) _Pragma("unroll") for (int _r = 0; _r < 16; ++_r) o[_d0][_r] *= _a4[_r >> 2][_r & 3]; \
            } \
            const float _ms0 = _selok ? (mrun - _c0) : INFINITY, _ms1 = _ms0 - d32; \
            float _ls = 0.f; \
            _Pragma("unroll") for (int _r = 0; _r < 16; ++_r) { C0[_r] = __builtin_amdgcn_exp2f(C0[_r] - _ms0); C1[_r] = __builtin_amdgcn_exp2f(C1[_r] - _ms1); _ls += C0[_r] + C1[_r]; } \
            lrun += _ls; \
            bf16x8 _pa[4]; \
            _Pragma("unroll") for (int _ks = 0; _ks < 2; ++_ks) { u32x4 _w; \
                _w.x = pk2(C0[8 * _ks], C0[8 * _ks + 1]); _w.y = pk2(C0[8 * _ks + 2], C0[8 * _ks + 3]); _w.z = pk2(C0[8 * _ks + 4], C0[8 * _ks + 5]); _w.w = pk2(C0[8 * _ks + 6], C0[8 * _ks + 7]); \
                _pa[_ks] = __builtin_bit_cast(bf16x8, _w); \
                _w.x = pk2(C1[8 * _ks], C1[8 * _ks + 1]); _w.y = pk2(C1[8 * _ks + 2], C1[8 * _ks + 3]); _w.z = pk2(C1[8 * _ks + 4], C1[8 * _ks + 5]); _w.w = pk2(C1[8 * _ks + 6], C1[8 * _ks + 7]); \
                _pa[2 + _ks] = __builtin_bit_cast(bf16x8, _w); } \
            _Pragma("unroll") for (int _d0 = 0; _d0 < ND; _d0 += PVG) { \
                if (_d0 > 0) { \
                    _Pragma("unroll") for (int _e = 0; _e < PVG; ++_e) _Pragma("unroll") for (int _ks = 0; _ks < 4; ++_ks) { \
                        const s16x4 _lo = vtr(_Vb + (16 * _ks) * VPITCH + 64 * (_d0 + _e)), _hh = vtr(_Vb + (16 * _ks + 8) * VPITCH + 64 * (_d0 + _e)); \
                        _vf[4 * _e + _ks] = __builtin_shufflevector(_lo, _hh, 0, 1, 2, 3, 4, 5, 6, 7); } \
                    __builtin_amdgcn_sched_barrier(0); } \
                _Pragma("unroll") for (int _ks = 0; _ks < 4; ++_ks) _Pragma("unroll") for (int _e = 0; _e < PVG; ++_e) \
                    o[_d0 + _e] = __builtin_amdgcn_mfma_f32_32x32x16_bf16(_pa[_ks], _vf[4 * _e + _ks], o[_d0 + _e], 0, 0, 0); \
                __builtin_amdgcn_sched_barrier(0); } \
        } \
        bcur = _b1; \
        asm volatile("s_waitcnt lgkmcnt(0)\n\ts_barrier" ::: "memory"); } while (0)
    if (NSET == 4) {
        for (int it = 0; it < nt; it += 4) {
            AT_ITER(it, pa0, pa1, pb0, pb1, kregC, vregC);
            AT_ITER(it + 1, pb0, pb1, pa0, pa1, kregD, vregD);
            AT_ITER(it + 2, pa0, pa1, pb0, pb1, kregA, vregA);
            AT_ITER(it + 3, pb0, pb1, pa0, pa1, kregB, vregB);
        }
    } else {
        for (int it = 0; it < nt; it += 2) {
            AT_ITER(it, pa0, pa1, pb0, pb1, kregA, vregA);
            if (NSET == 2) AT_ITER(it + 1, pb0, pb1, pa0, pa1, kregB, vregB); else AT_ITER(it + 1, pb0, pb1, pa0, pa1, kregA, vregA);
        }
    }
#undef AT_TB
#undef AT_LOAD
#undef AT_STORE
#undef AT_ACTIVE
#undef AT_QK
#undef AT_ITER
    {
        const float lt = lrun + __shfl_xor(lrun, 32);
        scr[r32] = 1.f / lt;
        asm volatile("s_waitcnt lgkmcnt(0)" ::: "memory");
        f32x4 a4[4];
#pragma unroll
        for (int g = 0; g < 4; ++g) a4[g] = *(const LAS f32x4*)(scr + 8 * g + 4 * hi);
        asm volatile("s_waitcnt lgkmcnt(0)" ::: "memory");
#pragma unroll
        for (int d0 = 0; d0 < ND; ++d0)
#pragma unroll
            for (int r = 0; r < 16; ++r) o[d0][r] *= a4[r >> 2][r & 3];
    }
    if (NROWS == 256) {
#pragma unroll
        for (int d0 = 0; d0 < ND; ++d0)
#pragma unroll
            for (int r = 0; r < 16; ++r) { const size_t row = (size_t)(q0 + ro + crow(r, hi)); const int col = 32 * d0 + r32;
                const float z = bf2f(Zp[row * ldz + col]); Yp[row * ldy + col] = f2bf(o[d0][r] * silu(z)); }
    } else {
        LAS float* xch = (LAS float*)lds;
        if (map == 1) {
#pragma unroll
            for (int d0 = 0; d0 < ND; ++d0)
#pragma unroll
                for (int r = 0; r < 16; ++r) xch[(((wid & 3) * ND + d0) * 16 + r) * 64 + lane] = o[d0][r];
        }
        __syncthreads();
        if (map == 0) {
#pragma unroll
            for (int d0 = 0; d0 < ND; ++d0)
#pragma unroll
                for (int r = 0; r < 16; ++r) o[d0][r] -= lam * xch[(((wid & 3) * ND + d0) * 16 + r) * 64 + lane];
#pragma unroll
            for (int r = 0; r < 16; ++r) { float ss = 0.f;
#pragma unroll
                for (int d0 = 0; d0 < ND; ++d0) ss += o[d0][r] * o[d0][r];
                ss = row16_sum(ss); ss += __shfl_xor(ss, 16);
                const float rs = __builtin_amdgcn_rsqf(ss * (1.f / (float)DV) + 1e-5f) * post;
                const size_t row = (size_t)(q0 + ro + crow(r, hi));
#pragma unroll
                for (int d0 = 0; d0 < ND; ++d0) { const int col = 32 * d0 + r32; const float z = bf2f(Zp[row * ldz + col]);
                    Yp[row * ldy + col] = f2bf(o[d0][r] * rs * subg[col] * silu(z)); } }
        }
        __syncthreads();
    }
}

#define XB_TMO      128
#define XB_XCNT(j)  (256  + 64 * (j))
#define XB_XSUB(j)  (1280 + 64 * (j))
#define XB_XGEN(j)  (2304 + 64 * (j))
#define XB_TOP      3328
#define XB_TOPGEN   3392
#define XCD_BAR_WORDS 3456
#define XB_SPIN_CAP (1u << 22)
DI unsigned xb_ld(unsigned* p)              { return __hip_atomic_load(p, __ATOMIC_RELAXED, __HIP_MEMORY_SCOPE_AGENT); }
DI unsigned xb_add(unsigned* p, unsigned v) { return __hip_atomic_fetch_add(p, v, __ATOMIC_RELAXED, __HIP_MEMORY_SCOPE_AGENT); }
DI unsigned xb_xcc_id() { return (unsigned)__builtin_amdgcn_s_getreg((3 << 11) | 20) & 0xFu; }
#define XB_SPIN(cond, bar) do { unsigned _sp = 0; while (cond) { __builtin_amdgcn_s_sleep(1); \
    if ((++_sp & 255u) == 0u) { if (xb_ld(&(bar)[XB_TMO])) break; if (_sp > XB_SPIN_CAP) { atomicAdd(&(bar)[XB_TMO], 1u); break; } } } } while (0)
DI void xcd_barrier_complete(unsigned* bar, unsigned x, unsigned& nloc, unsigned& nx) {
    const unsigned Gn = gridDim.x;
    unsigned sum, cnt, mine, sp = 0u;
    for (;;) {
        sum = 0u; cnt = 0u; mine = 0u;
#pragma unroll
        for (unsigned j = 0; j < 16; ++j) { const unsigned c = xb_ld(&bar[XB_XCNT(j)]); sum += c; cnt += (c > 0u) ? 1u : 0u; mine = (j == x) ? c : mine; }
        if (sum == Gn) break;
        __builtin_amdgcn_s_sleep(1);
        if ((++sp & 255u) == 0u) { if (xb_ld(&bar[XB_TMO])) break; if (sp > XB_SPIN_CAP) { atomicAdd(&bar[XB_TMO], 1u); break; } }
    }
    nloc = mine > 0u ? mine : 1u; nx = cnt > 0u ? cnt : 1u;
}
DI void xcd_barrier(unsigned* bar, volatile LAS unsigned* st) {
    asm volatile("s_waitcnt vmcnt(0)" ::: "memory");
    __syncthreads();
    if (threadIdx.x == 0) {
        __builtin_amdgcn_s_waitcnt(0);
        const unsigned x = xb_xcc_id();
        unsigned nloc = st[0], nx = st[1];
        if (nloc == 0u) { xcd_barrier_complete(bar, x, nloc, nx); st[0] = nloc; st[1] = nx; }
        const unsigned old = xb_add(&bar[XB_XSUB(x)], 1u);
        const unsigned gen = old / nloc;
        if (old + 1u == (gen + 1u) * nloc) {
            __builtin_amdgcn_fence(__ATOMIC_RELEASE, "agent");
            asm volatile("s_waitcnt vmcnt(0)" ::: "memory");
            const unsigned og = xb_add(&bar[XB_TOP], 1u);
            const unsigned tg = og / nx;
            if (og + 1u == (tg + 1u) * nx) xb_add(&bar[XB_TOPGEN], 1u);
            else XB_SPIN(xb_ld(&bar[XB_TOPGEN]) == tg, bar);
            __builtin_amdgcn_fence(__ATOMIC_ACQUIRE, "agent");
            xb_add(&bar[XB_XGEN(x)], 1u);
            asm volatile("s_waitcnt vmcnt(0)" ::: "memory");
        } else {
            XB_SPIN(xb_ld(&bar[XB_XGEN(x)]) == gen, bar);
            __builtin_amdgcn_fence(__ATOMIC_ACQUIRE, "agent");
            asm volatile("s_waitcnt vmcnt(0)" ::: "memory");
        }
    }
    __syncthreads();
}

struct Params { const float* in[19]; float* out; unsigned char* ws; };

DI void colmap(int kind, int n, int& col, float& cs) {
    cs = 1.f;
    if (kind == 0) {
        if (n < 2048) { col = n; if (n < 512) cs = QS64; }
        else if (n < 2560) col = 2720 + (n - 2048);
        else if (n < 3072) { col = 3232 + (n - 2560); cs = QS64; }
        else if (n < 3584) col = 3744 + (n - 3072);
        else if (n < 4096) col = 4256 + (n - 3584);
        else if (n < 4608) col = 4768 + (n - 4096);
        else if (n < 4864) col = 2432 + (n - 4608);
        else if (n < 5248) col = 2048 + (n - 4864);
        else if (n < 5280) { const int j = n - 5248; col = 2688 + (j >> 1) + 16 * (j & 1); }
        else col = -1;
    } else if (kind == 1) col = n;
    else if (kind == 2) { const int h = n / 96, j = n % 96; if (j < 64) col = h * 96 + j; else { const int jj = j - 64; col = h * 96 + 64 + (jj >> 1) + 16 * (jj & 1); } }
    else { if (n < 512) col = (n >> 6) * 128 + (n & 63); else { const int m = n - 512; col = (m >> 6) * 128 + 64 + (m & 63); } }
}
DI void tr_tile(const float* src, int srcN, int ldd, bf16_t* dst, int kind, int n0, int k0, const float* kscale, LAS float* scr, int tid) {
    { const int nl = tid & 127, kl0 = tid >> 7; int col; float cs; colmap(kind, n0 + nl, col, cs);
      float v[16];
#pragma unroll
      for (int i = 0; i < 16; ++i) { const int kl = kl0 + 4 * i; v[i] = (col >= 0) ? src[(size_t)(k0 + kl) * srcN + col] : 0.f; }
#pragma unroll
      for (int i = 0; i < 16; ++i) { const int kl = kl0 + 4 * i; float w = v[i] * cs; if (kscale) w *= kscale[k0 + kl]; scr[kl * 129 + nl] = w; } }
    __syncthreads();
    { const int kp = tid & 31;
#pragma unroll
      for (int i = 0; i < 8; ++i) { const int nl = (tid >> 5) + 16 * i;
          *(unsigned*)(dst + (size_t)(n0 + nl) * ldd + k0 + 2 * kp) = pk2(scr[(2 * kp) * 129 + nl], scr[(2 * kp + 1) * 129 + nl]); } }
    __syncthreads();
}
typedef const __attribute__((address_space(4))) Params* KParams0;
DI void convert_weights(KParams0 Pk, int l, bf16_t* WT, LAS float* scr) {
    const int tid = opaque_tid();
    constexpr int T0 = 42 * 16, T1 = T0 + 24 * 16, T2 = T1 + 6 * 6, T3 = T2 + 8 * 4, T4 = T3 + 8 * 8, T5 = T4 + 8 * 8, T6 = T5 + 8 * 8, T7 = T6 + 8 * 16, T8 = T7 + 8 * 16, T9 = T8 + 8 * 4;
    for (int t = blockIdx.x; t < T9; t += gridDim.x) {
        const float* src; int srcN, K, kind, loc, ldd = 0; bf16_t* dst; const float* ks = nullptr;
        if (t < T0) { src = Pk->in[2] + (size_t)l * 1024 * 5280; srcN = 5280; K = 1024; kind = 0; loc = t; dst = WT + OFF_WIN; }
        else if (t < T1) { src = Pk->in[12] + (size_t)l * 1024 * 3072; srcN = 3072; K = 1024; kind = 1; loc = t - T0; dst = WT + OFF_WIN + (size_t)5376 * 1024; }
        else if (t < T2) { src = Pk->in[5] + (size_t)l * 384 * 768; srcN = 768; K = 384; kind = 2; loc = t - T1; dst = WT + OFF_WUQ; ks = Pk->in[3] + l * 384; }
        else if (t < T3) { src = Pk->in[6] + (size_t)l * 256 * 1024; srcN = 1024; K = 256; kind = 3; loc = t - T2; dst = WT + OFF_WUKV; ks = Pk->in[4] + l * 256; }
        else if (t < T4) { src = Pk->in[9] + (size_t)l * 512 * 1024; srcN = 1024; K = 512; kind = 1; loc = t - T3; dst = WT + OFF_WABC; ldd = 1536; }
        else if (t < T5) { src = Pk->in[10] + (size_t)l * 512 * 1024; srcN = 1024; K = 512; kind = 1; loc = t - T4; dst = WT + OFF_WABC + 512; ldd = 1536; }
        else if (t < T6) { src = Pk->in[11] + (size_t)l * 512 * 1024; srcN = 1024; K = 512; kind = 1; loc = t - T5; dst = WT + OFF_WABC + 1024; ldd = 1536; }
        else if (t < T7) { src = Pk->in[14] + (size_t)l * 1024 * 1024; srcN = 1024; K = 1024; kind = 1; loc = t - T6; dst = WT + OFF_WO; }
        else if (t < T8) { src = Pk->in[17] + (size_t)l * 1024 * 1024; srcN = 1024; K = 1024; kind = 1; loc = t - T7; dst = WT + OFF_WPG; }
        else { src = Pk->in[18] + (size_t)l * 256 * 1024; srcN = 1024; K = 256; kind = 1; loc = t - T8; dst = WT + OFF_WP; }
        const int kt = K / 64; const int n0 = (loc / kt) * 128, k0 = (loc % kt) * 64;
        tr_tile(src, srcN, ldd ? ldd : K, dst, kind, n0, k0, ks, scr, tid);
    }
}
DI void convert_rows(const float* src, bf16_t* dst, size_t n) {
    const size_t stride = (size_t)gridDim.x * blockDim.x, ng = n / 8;
    for (size_t i = (size_t)blockIdx.x * blockDim.x + opaque_tid(); i < ng; i += 4 * stride) {
        f32x4 a[4], b[4];
#pragma unroll
        for (int j = 0; j < 4; ++j) { const size_t q = i + j * stride; if (q < ng) { a[j] = *(const f32x4*)(src + q * 8); b[j] = *(const f32x4*)(src + q * 8 + 4); } }
#pragma unroll
        for (int j = 0; j < 4; ++j) { const size_t q = i + j * stride; if (q < ng) *(u32x4*)(dst + q * 8) = pack8(a[j], b[j]); }
    }
}
typedef const __attribute__((address_space(4))) Params* KParams;
DI KParams kparams() { KParams p = (KParams)__builtin_amdgcn_kernarg_segment_ptr(); asm volatile("" : "+s"(p)); return p; }
DI unsigned char* wsbase() { unsigned char* w = kparams()->ws; asm volatile("" : "+s"(w)); return w; }

__global__ void __launch_bounds__(512, 2) fwd_megakernel(Params Punused) {
    extern __shared__ __attribute__((aligned(16))) unsigned char lds_raw[];
    cg::grid_group grid = cg::this_grid();
    LAS unsigned char* lds = (LAS unsigned char*)lds_raw;
#define G opaque_s((int)gridDim.x)
#define cu opaque_s((int)blockIdx.x)
#define XB_  ((bf16_t*)(ws + WS_XB))
#define WT_  ((bf16_t*)(ws + WS_WT))
#define PB_  ((bf16_t*)(ws + WS_PB))
#define Y_   ((bf16_t*)(ws + WS_Y))
#define H_   ((bf16_t*)(ws + WS_H))
#define QB_  ((bf16_t*)(ws + WS_MLA))
#define KB_  (QB_ + (size_t)HM * 768)
#define VB_  (KB_ + (size_t)HM * 768)
#define R_   ((float*)(ws + WS_H))
#define ROPE_ ((float*)(ws + CTL_ROPE))
#define KMP_ ((float*)(ws + CTL_KMP))
#define STQ_ ((float*)(ws + CTL_STQ))
#define STKV_ ((float*)(ws + CTL_STKV))

    if (threadIdx.x < 2) ((volatile LAS unsigned*)(lds + LDS_IDX + 64))[threadIdx.x] = 0u;
    {
        const int tid = opaque_tid();
        KParams P = kparams(); unsigned char* ws = P->ws;
        for (int rep = 0; rep < REP_P0; ++rep) {
        convert_weights(P, 0, WT_, (LAS float*)lds);
        convert_rows(P->in[0], XB_, (size_t)M * D);
        convert_rows(P->in[1], PB_, (size_t)M * 256); }
        float* rope = ROPE_;
        for (int i = cu * 512 + tid; i < SEQ * 16; i += G * 512) {
            const int pos = i >> 4, k = i & 15;
            const float freq = __builtin_amdgcn_exp2f(-(float)k * (13.287712379549449f / 16.f));
            const float ang = (float)pos * freq;
            double rev = (double)ang * 0.15915494309189535; rev -= __builtin_rint(rev);
            const float fr = (float)rev;
            rope[2 * i] = __builtin_amdgcn_cosf(fr); rope[2 * i + 1] = __builtin_amdgcn_sinf(fr);
        }
        if (cu == 0) {
            unsigned* ctl = (unsigned*)(ws + WS_CTL); float* lamv = (float*)(ws + CTL_LAM);
            if (tid < 64) {
#pragma unroll
                for (int l = 0; l < 2; ++l) { const float* dl = P->in[7] + l * 256; float a = dl[tid] * dl[64 + tid], b = dl[128 + tid] * dl[192 + tid];
#pragma unroll
                    for (int s = 1; s < 64; s <<= 1) { a += __shfl_xor(a, s); b += __shfl_xor(b, s); }
                    const float li = (l == 0) ? 0.2f : 0.35550906759096924f;
                    if (tid == 0) lamv[l] = __builtin_amdgcn_exp2f(a * LOG2E) - __builtin_amdgcn_exp2f(b * LOG2E) + li; }
            }
            if (tid < 64) ctl[tid] = 0u;
            if (tid < 128) ((unsigned*)(ws + CTL_DEP))[tid] = 0u;
            { unsigned* bw = (unsigned*)(ws + CTL_BAR); for (int i = tid; i < XCD_BAR_WORDS; i += 512) bw[i] = 0u; }
        }
    }
    grid.sync();
    if (threadIdx.x == 0) { unsigned char* ws = wsbase(); (void)xb_add(&((unsigned*)(ws + CTL_BAR))[XB_XCNT(xb_xcc_id())], 1u); }
#define GSYNC() do { unsigned char* _w = wsbase(); xcd_barrier((unsigned*)(_w + CTL_BAR), (volatile LAS unsigned*)(lds + LDS_IDX + 64)); } while (0)

    for (int l = 0; l < 2; ++l) {
        for (int hf = 0; hf < 2; ++hf) {
            for (int rep = 0; rep < REP_P1; ++rep)
            { unsigned char* ws = wsbase();
              pg8::Gemm g{XB_ + (size_t)hf * HM * D, WT_ + OFF_WIN, D, D}; pg8::P1Order S{G, cu};
              pg8::EpiH E{H_, KB_, KMP_ + (size_t)hf * 32 * 2 * 512, STQ_ + (size_t)hf * HM * 8, STKV_ + (size_t)hf * HM * 4, ROPE_, (unsigned*)(ws + CTL_DEP) + (l * 2 + hf) * 32};
              pg8::gemm_phase(lds, g, S, E); }
            {
                const int Gn = G, rem = 672 % Gn, NE = Gn - rem, e = cu - rem;
                pg8::ListOrder Sq{0, (e >= 0) ? 96 : 0, 3, (e >= 0) ? e : 0, NE}, Skv{96, (e >= 0) ? 224 : 96, 4, (e >= 0) ? e : 0, NE};
                if (opaque_tid() == 0) {
                    unsigned char* ws = wsbase(); unsigned* dep = (unsigned*)(ws + CTL_DEP) + (l * 2 + hf) * 32; pg8::Unit u;
                    for (int pass = 0; pass < 2; ++pass)
                        for (int i = 0; pass == 0 ? Sq.next(i, u) : Skv.next(i, u); ++i) {
                            unsigned sp = 0;
                            while (__hip_atomic_load(dep + u.pm, __ATOMIC_RELAXED, __HIP_MEMORY_SCOPE_AGENT) < 24u) { __builtin_amdgcn_s_sleep(2); if (++sp > (1u << 24)) break; }
                        }
                    __builtin_amdgcn_fence(__ATOMIC_ACQUIRE, "agent");
                    asm volatile("s_waitcnt vmcnt(0)" ::: "memory");
                }
                __syncthreads();
                { unsigned char* ws = wsbase();
                  pg8::Gemm g{H_ + C_CQL, WT_ + OFF_WUQ, HP, 384};
                  pg8::EpiUp<0> E{QB_, KB_, VB_, STQ_ + (size_t)hf * HM * 8, ROPE_}; pg8::gemm_phase(lds, g, Sq, E); }
                { unsigned char* ws = wsbase();
                  pg8::Gemm g{H_ + C_CKV, WT_ + OFF_WUKV, HP, 256};
                  pg8::EpiUp<1> E{QB_, KB_, VB_, STKV_ + (size_t)hf * HM * 4, ROPE_}; pg8::gemm_phase(lds, g, Skv, E); }
            }
            GSYNC();
            {
                for (int vcu = cu; vcu < 256; vcu += G)
                for (int step = 0; ; ++step) {
                    KParams P = kparams(); unsigned char* ws = P->ws;
                    const int x = vcu & 7, sl_ = vcu >> 3;
                    int type, u, bh;
                    if (step < 2) {
                        if (sl_ < 16) { type = 2; bh = 2 * x + (sl_ >> 3); const int j = sl_ & 7; u = (step == 0) ? 15 - j : j; }
                        else { const int t = sl_ - 16; bh = 4 * x + (t >> 2); type = step; u = 7 - (t & 3); }
                    } else {
                        if (opaque_tid() == 0) *(LAS int*)(lds + LDS_IDX) = (int)atomicAdd((unsigned*)(ws + WS_CTL) + 16 + (l * 2 + hf) * 8 + x, 1u);
                        __syncthreads();
                        const int k = *(LAS int*)(lds + LDS_IDX);
                        __syncthreads();
                        if (k >= 32) break;
                        u = 3 - (k >> 3); type = (k & 4) ? 0 : 1; bh = 4 * x + (k & 3);
                    }
                    if (type == 0) {
                        const int bl = bh >> 3, h = bh & 7, bg = 4 * hf + bl; const size_t ho = (size_t)bh * SEQ * 64;
                        const float sl = __builtin_amdgcn_exp2f(-(2.f / 3.f) * (float)(h + (h >> 1) + 2)) * LOG2E;
                        attn_unit<64, 64, 64, 256, true, true, true, 2>((LAS char*)lds, H_ + HM_AQ + ho, 64, H_ + HM_AK + ho, 64, H_ + HM_AV + ho, 64,
                            H_ + (size_t)bl * SEQ * HP + C_AZ + h * 64, HP,
                            Y_ + (size_t)bg * SEQ * 1536 + h * 64, 1536, u * 256, sl, KMP_ + (size_t)bg * 8 * 2 * 512 + h * 64, 0.f, nullptr, 1.f);
                    } else if (type == 1) {
                        const int bl = bh >> 3, h = bh & 7, bg = 4 * hf + bl;
                        attn_unit<96, 96, 64, 256, false, false, true, 2>((LAS char*)lds, QB_ + (size_t)bh * SEQ * 96, 96, KB_ + (size_t)bh * SEQ * 96, 96,
                            VB_ + (size_t)bh * SEQ * 64, 64, H_ + (size_t)bl * SEQ * HP + C_BZ + h * 64, HP,
                            Y_ + 512 + (size_t)bg * SEQ * 1536 + h * 64, 1536, u * 256, 0.f, nullptr, 0.f, nullptr, 1.f);
                    } else {
                        const int bl = bh >> 2, h = bh & 3, bg = 4 * hf + bl; const size_t ho = (size_t)bh * SEQ * 128;
                        const float sl = __builtin_amdgcn_exp2f(-(2.f / 3.f) * (float)(3 * h + 1)) * LOG2E;
                        const float lam = ((const float*)(ws + CTL_LAM))[l];
                        const float post = (l == 0) ? 0.8f : (1.f - 0.35550906759096924f);
                        attn_unit<64, 128, 128, 128, true, false, false, 1>((LAS char*)lds, H_ + HM_CQ + ho, 128, H_ + HM_CK + ho, 128, H_ + HM_CV + ho, 128,
                            H_ + (size_t)bl * SEQ * HP + C_CZ + h * 128, HP,
                            Y_ + 1024 + (size_t)bg * SEQ * 1536 + h * 128, 1536, u * 128, sl, nullptr, lam, P->in[8] + l * 128, post);
                    }
                }
            }
            GSYNC();
        }
        { KParams P = kparams(); unsigned char* ws = P->ws;
          pg8::Gemm g{XB_, WT_ + OFF_WIN + (size_t)5376 * 1024, D, D}; pg8::StaticOrder S; S.init(M, 3072, G, cu);
          pg8::EpiG E{H_, P->in[13] + l * 3072}; pg8::gemm_phase(lds, g, S, E); }
        GSYNC();
        { unsigned char* ws = wsbase();
          pg8::Gemm g{Y_, WT_ + OFF_WABC, 1536, 1536}; pg8::MergeOrder S{cu, G};
          pg8::EpiMerge E{H_, XB_}; pg8::MergeHook HK{H_}; pg8::gemm_phase(lds, g, S, E, HK); }
        GSYNC();
        { KParams P = kparams(); unsigned char* ws = P->ws;
          pg8::Gemm g{XB_, WT_ + OFF_WO, D, D}; pg8::StaticOrder S; S.init(M, D, G, cu);
          pg8::EpiR E{(l == 0) ? P->in[0] : (const float*)P->out, R_, Y_}; pg8::gemm_phase(lds, g, S, E); }
        GSYNC();
        { unsigned char* ws = wsbase();
          pg8::Gemm g{PB_, WT_ + OFF_WP, 256, 256}; pg8::StaticOrder S; S.init(M, D, G, cu);
          pg8::EpiBf E{XB_}; pg8::gemm_phase(lds, g, S, E); }
        { unsigned char* ws = wsbase();
          pg8::Gemm g{Y_, WT_ + OFF_WPG, D, D}; pg8::StaticOrder S; S.init(M, D, G, cu);
          pg8::EpiR2 E{R_, XB_}; pg8::gemm_phase(lds, g, S, E); }
        GSYNC();
        {
            KParams P = kparams(); unsigned char* ws = P->ws;
            const int tid = opaque_tid(), lane = tid & 63, wid = tid >> 6;
            const float* lg = P->in[15] + l * 1024; const float* lb = P->in[16] + l * 1024;
            float* outp = P->out; const float* R = R_; bf16_t* XB = XB_;
            const int gstep = (int)gridDim.x * 8;
            for (int row = (int)blockIdx.x * 8 + wid; row < M; row += 2 * gstep) {
                const bool two = row + gstep < M;
                const float* rp0 = R + (size_t)row * 1024; const float* rp1 = R + (size_t)(two ? row + gstep : row) * 1024;
                f32x4 v[2][4]; float s0 = 0.f, s1 = 0.f;
#pragma unroll
                for (int j = 0; j < 4; ++j) { v[0][j] = *(const f32x4*)(rp0 + 4 * lane + 256 * j); v[1][j] = *(const f32x4*)(rp1 + 4 * lane + 256 * j); }
#pragma unroll
                for (int j = 0; j < 4; ++j) { s0 += (v[0][j][0] + v[0][j][1]) + (v[0][j][2] + v[0][j][3]); s1 += (v[1][j][0] + v[1][j][1]) + (v[1][j][2] + v[1][j][3]); }
#pragma unroll
                for (int k = 1; k < 64; k <<= 1) { s0 += __shfl_xor(s0, k); s1 += __shfl_xor(s1, k); }
                const float mu0 = s0 * (1.f / 1024.f), mu1 = s1 * (1.f / 1024.f); float q0 = 0.f, q1 = 0.f;
#pragma unroll
                for (int j = 0; j < 4; ++j) { v[0][j] -= mu0; v[1][j] -= mu1;
                    q0 += (v[0][j][0] * v[0][j][0] + v[0][j][1] * v[0][j][1]) + (v[0][j][2] * v[0][j][2] + v[0][j][3] * v[0][j][3]);
                    q1 += (v[1][j][0] * v[1][j][0] + v[1][j][1] * v[1][j][1]) + (v[1][j][2] * v[1][j][2] + v[1][j][3] * v[1][j][3]); }
#pragma unroll
                for (int k = 1; k < 64; k <<= 1) { q0 += __shfl_xor(q0, k); q1 += __shfl_xor(q1, k); }
                const float rs0 = __builtin_amdgcn_rsqf(q0 * (1.f / 1024.f) + 1e-5f), rs1 = __builtin_amdgcn_rsqf(q1 * (1.f / 1024.f) + 1e-5f);
#pragma unroll
                for (int j = 0; j < 4; ++j) { const f32x4 gv = *(const f32x4*)(lg + 4 * lane + 256 * j), bv = *(const f32x4*)(lb + 4 * lane + 256 * j);
#pragma unroll
                    for (int t = 0; t < 2; ++t) { if (t == 1 && !two) break;
                        const size_t rr = (size_t)(t == 0 ? row : row + gstep);
                        const f32x4 y = v[t][j] * (t == 0 ? rs0 : rs1) * gv + bv;
                        *(f32x4*)(outp + rr * 1024 + 4 * lane + 256 * j) = y;
                        if (l == 0) { u32x2 w; w.x = pk2(y[0], y[1]); w.y = pk2(y[2], y[3]); *(u32x2*)(XB + rr * 1024 + 4 * lane + 256 * j) = w; } } }
            }
            if (l == 0) {
                __syncthreads();
                convert_weights(P, 1, WT_, (LAS float*)lds);
                convert_rows(P->in[1] + (size_t)M * 256, PB_, (size_t)M * 256);
            }
        }
        if (l == 0) GSYNC();
    }
}

#undef G
#undef cu
extern "C" void kernel_launch(void* const* d_in, const int* in_sizes, int n_in, void* d_out, int out_size, void* d_ws, size_t ws_size, hipStream_t stream) {
    static int grid_blocks = 0;
    if (grid_blocks == 0) {
        if (n_in != 19 || out_size != M * D || ws_size < WS_END) { fprintf(stderr, "kernel_launch: unexpected problem (n_in %d out %d ws %zu)\n", n_in, out_size, ws_size); grid_blocks = -1; return; }
        int dev = 0, cus = 0, per_cu = 0;
        hipGetDevice(&dev);
        hipDeviceGetAttribute(&cus, hipDeviceAttributeMultiprocessorCount, dev);
        if (hipFuncSetAttribute((const void*)fwd_megakernel, hipFuncAttributeMaxDynamicSharedMemorySize, LDS_BYTES) != hipSuccess) { fprintf(stderr, "kernel_launch: hipFuncSetAttribute failed\n"); grid_blocks = -1; return; }
        if (hipOccupancyMaxActiveBlocksPerMultiprocessor(&per_cu, (const void*)fwd_megakernel, 512, LDS_BYTES) != hipSuccess || per_cu < 1) { fprintf(stderr, "kernel_launch: occupancy query failed (%d)\n", per_cu); grid_blocks = -1; return; }
        grid_blocks = cus * per_cu;
        if (grid_blocks > 256) grid_blocks = 256;
    }
    if (grid_blocks < 0) return;
    Params p{};
    for (int i = 0; i < 19; ++i) p.in[i] = (const float*)d_in[i];
    p.out = (float*)d_out; p.ws = (unsigned char*)d_ws;
    void* args[] = {&p};
    hipError_t e = hipLaunchCooperativeKernel((const void*)fwd_megakernel, dim3(grid_blocks), dim3(512), args, LDS_BYTES, stream);
    if (e != hipSuccess) fprintf(stderr, "cooperative launch failed: %s (grid %d)\n", hipGetErrorString(e), grid_blocks);
}
```

```cpp
#include <hip/hip_runtime.h>
#include <hip/hip_cooperative_groups.h>
#include <cstdio>
#include <cstdint>
namespace cg = cooperative_groups;
#ifndef REP_ATT
#define REP_ATT 1
#endif
#ifndef REP_P1
#define REP_P1 1
#endif
#ifndef REP_P0
#define REP_P0 1
#endif

#define LAS __attribute__((address_space(3)))
#define DI __device__ __forceinline__
typedef unsigned short bf16_t;
typedef short bf16x8 __attribute__((ext_vector_type(8)));
typedef short s16x4 __attribute__((ext_vector_type(4)));
typedef float f32x2 __attribute__((ext_vector_type(2)));
typedef float f32x4 __attribute__((ext_vector_type(4)));
typedef float f32x16 __attribute__((ext_vector_type(16)));
typedef unsigned u32x4 __attribute__((ext_vector_type(4)));
typedef unsigned u32x2 __attribute__((ext_vector_type(2)));
typedef __bf16 bf16x2_t __attribute__((ext_vector_type(2)));

constexpr int M = 16384, D = 1024, SEQ = 2048, HM = 8192;
constexpr int HP = 2304;
constexpr int NH1 = 5376;
constexpr int NWIN = 8448;
constexpr float LOG2E = 1.4426950408889634f;
constexpr float QS64 = 0.125f * LOG2E;
constexpr float QS96 = 0.10206207261596575f * LOG2E;
constexpr float ALPHA = 1.4142135623730951f;
constexpr int C_AZ = 0, C_BZ = 512, C_CZ = 1024, C_CKV = 1536, C_CQL = 1792;
constexpr size_t HM_AQ = (size_t)18 * 1048576, HM_AK = (size_t)22 * 1048576, HM_AV = (size_t)26 * 1048576, HM_CQ = (size_t)30 * 1048576, HM_CK = (size_t)34 * 1048576, HM_CV = (size_t)38 * 1048576;

constexpr size_t MiB = 1048576;
constexpr size_t WS_CTL = 0, WS_XB = 2 * MiB, WS_WT = 34 * MiB, WS_PB = 60 * MiB, WS_Y = 68 * MiB, WS_H = 116 * MiB, WS_MLA = 200 * MiB, WS_END = 232 * MiB;
constexpr size_t CTL_DEP = 8192, CTL_BAR = 16384, CTL_LAM = 4096, CTL_ROPE = 65536, CTL_KMP = 384 * 1024, CTL_STQ = 640 * 1024, CTL_STKV = 1152 * 1024;
constexpr size_t OFF_WIN = 0, OFF_WUQ = 8650752, OFF_WUKV = 8945664, OFF_WABC = 9207808, OFF_WO = 10780672, OFF_WPG = 11829248, OFF_WP = 12877824;
constexpr int LDS_BYTES = 132 * 1024, LDS_IDX = 131072;

DI int opaque_s(int v) { asm volatile("" : "+s"(v)); return v; }
DI int opaque_tid() { int t = threadIdx.x; asm volatile("" : "+v"(t)); return t; }
DI unsigned pk2(float lo, float hi) { f32x2 v = {lo, hi}; bf16x2_t b = __builtin_convertvector(v, bf16x2_t); return __builtin_bit_cast(unsigned, b); }
DI float bflo(unsigned w) { return __uint_as_float(w << 16); }
DI float bfhi(unsigned w) { return __uint_as_float(w & 0xffff0000u); }
DI float bf2f(bf16_t b) { return __uint_as_float((unsigned)b << 16); }
DI bf16_t f2bf(float f) { return (bf16_t)(pk2(f, 0.f) & 0xffffu); }
DI float sigm(float x) { return __builtin_amdgcn_rcpf(1.f + __builtin_amdgcn_exp2f(-x * LOG2E)); }
DI float silu(float x) { return x * sigm(x); }
DI u32x4 pack8(const f32x4 a, const f32x4 b) { u32x4 w; w.x = pk2(a[0], a[1]); w.y = pk2(a[2], a[3]); w.z = pk2(b[0], b[1]); w.w = pk2(b[2], b[3]); return w; }
DI void unpack8(const u32x4 w, f32x4& a, f32x4& b) { a = (f32x4){bflo(w.x), bfhi(w.x), bflo(w.y), bfhi(w.y)}; b = (f32x4){bflo(w.z), bfhi(w.z), bflo(w.w), bfhi(w.w)}; }

namespace pg8 {
constexpr int BM = 256, BK = 64, HALF = 128, HTB = HALF * BK * 2, NXCD = 8, WGM = 8;
__host__ __device__ __forceinline__ int lds_byte(int r, int c) { const int st = (r >> 4) * 2 + (c >> 5), rr = r & 15, cc = c & 31, ob = rr * 64 + cc * 2; return st * 1024 + (ob ^ (((ob >> 9) & 1) << 5)); }
__host__ __device__ __forceinline__ void stage_rc(int b, int& R, int& C) { const int st = b / 1024, sb = b % 1024, swz = sb ^ (((sb >> 9) & 1) << 5); R = (st >> 1) * 16 + swz / 64; C = (st & 1) * 32 + (swz % 64) / 2; }
__host__ __device__ __forceinline__ int perm32(int rho) { const int n = rho >> 4, i = rho & 15; return 8 * (i >> 2) + 4 * n + (i & 3); }

struct Unit { int pm, pn; };
struct Gemm { const bf16_t* A; const bf16_t* Bt; int lda, K; };

struct StaticOrder {
    int nM, nN, nwg, G, c;
    DI void init(int M_, int N_, int G_, int c_) { nM = M_ / BM; nN = N_ / BM; nwg = nM * nN; G = G_; c = c_; }
    DI bool next(int i, Unit& u) const {
        const long L = (long)i * G + c; if (L >= nwg) return false;
        int wgid = (int)L; { const int q = nwg / NXCD, r = nwg % NXCD, xcd = wgid % NXCD, off = wgid / NXCD; wgid = (xcd < r ? xcd * (q + 1) : r * (q + 1) + (xcd - r) * q) + off; }
        const int nig = WGM * nN, gid = wgid / nig, fm = gid * WGM, gsz = (nM - fm) < WGM ? (nM - fm) : WGM;
        u.pm = fm + ((wgid % nig) % gsz); u.pn = (wgid % nig) / gsz; return true;
    }
};
struct P1Order {
    int G, c;
    DI bool next(int i, Unit& u) const {
        const long L = (long)i * G + c; if (L >= 672) return false;
        if (L < 96) { u.pm = (int)L / 3; u.pn = 18 + (int)L % 3; return true; }
        const int nM = 32, nN = 18, nwg = 576;
        int wgid = (int)L - 96; { const int q = nwg / NXCD, r = nwg % NXCD, xcd = wgid % NXCD, off = wgid / NXCD; wgid = (xcd < r ? xcd * (q + 1) : r * (q + 1) + (xcd - r) * q) + off; }
        const int nig = WGM * nN, gid = wgid / nig, fm = gid * WGM, gsz = (nM - fm) < WGM ? (nM - fm) : WGM;
        u.pm = fm + ((wgid % nig) % gsz); u.pn = (wgid % nig) / gsz; return true;
    }
};
struct ListOrder {
    int lo, hi, nN, c, G;
    DI bool next(int i, Unit& u) const {
        int k0 = 0; if (c < lo) k0 = (lo - c + G - 1) / G;
        const int idx = c + (k0 + i) * G; if (idx >= hi) return false;
        const int loc = idx - lo; u.pm = loc / nN; u.pn = loc % nN; return true;
    }
};
struct MergeOrder {
    int c, G;
    DI bool next(int i, Unit& u) const {
        int tile = c + i * G; if (tile >= 256) return false;
        if (G == 256) tile = (c & 7) * 32 + (c >> 3);
        u.pm = tile >> 2; u.pn = tile & 3; return true;
    }
};

struct NoHook { static constexpr bool ACTIVE = false; template <class A> DI void operator()(A&, const Unit&, int, int, int, int, int) const {} };
template <class Epi, class Sched, class Hook = NoHook>
DI void gemm_phase(LAS unsigned char* lds, const Gemm g, const Sched& S, const Epi& E, const Hook& HK = Hook()) {
    const int tid = opaque_tid(), wid = __builtin_amdgcn_readfirstlane(tid >> 6), lane = tid & 63, wr = wid >> 2, wc = wid & 3, fr = lane & 15, fq = lane >> 4;
    const int K = g.K, nt = K / BK, lda = g.lda;
    unsigned voffA[2], voffB[2];
#pragma unroll
    for (int i = 0; i < 2; ++i) { int R, C; stage_rc(tid * 16 + i * 8192, R, C); const int Rb = (R & ~31) + perm32(R & 31);
        voffA[i] = (unsigned)(R * lda + C) * 2u; voffB[i] = (unsigned)(Rb * K + C) * 2u; }
    const size_t kstep = (size_t)(BK * 2);
    const size_t hstepA = (size_t)HALF * lda * 2, hstepB = (size_t)HALF * K * 2;
    const size_t tstepA = 2 * hstepA, tstepB = 2 * hstepB;
    const unsigned ldsw = (unsigned)wid * 1024u;
    const int aoff = lds_byte(wr * 64 + fr, fq * 8), boff = lds_byte(wc * 32 + fr, fq * 8);
#define PG8_SA(b, h) (((b) * 2 + (h)) * HTB)
#define PG8_SB(b, h) ((4 + (b) * 2 + (h)) * HTB)
#define PG8_STAGE(bufoff, gbase, voff) do { _Pragma("unroll") for (int _i = 0; _i < 2; ++_i) \
        __builtin_amdgcn_global_load_lds((const unsigned*)((const char*)(gbase) + (voff)[_i]), (LAS unsigned*)(lds + (bufoff) + ldsw + _i * 8192), 16, 0, 0); } while (0)
#define PG8_LDA(dst, b, h) do { _Pragma("unroll") for (int m = 0; m < 4; ++m) _Pragma("unroll") for (int k = 0; k < 2; ++k) dst[m][k] = *(const LAS bf16x8*)(lds + PG8_SA(b, h) + aoff + m * 2048 + k * 1024); } while (0)
#define PG8_LDB(dst, b, h) do { _Pragma("unroll") for (int n = 0; n < 2; ++n) _Pragma("unroll") for (int k = 0; k < 2; ++k) dst[n][k] = *(const LAS bf16x8*)(lds + PG8_SB(b, h) + boff + n * 2048 + k * 1024); } while (0)
#define PG8_MMA(ai, bj, At, Bt) do { __builtin_amdgcn_s_setprio(1); _Pragma("unroll") for (int m = 0; m < 4; ++m) _Pragma("unroll") for (int n = 0; n < 2; ++n) _Pragma("unroll") for (int k = 0; k < 2; ++k) \
        acc[ai][bj][m][n] = __builtin_amdgcn_mfma_f32_16x16x32_bf16(Bt[n][k], At[m][k], acc[ai][bj][m][n], 0, 0, 0); __builtin_amdgcn_s_setprio(0); } while (0)
#define PG8_WAIT_V(n) asm volatile("s_waitcnt vmcnt(" #n ")" ::: "memory")
#define PG8_WAIT_L(n) asm volatile("s_waitcnt lgkmcnt(" #n ")" ::: "memory")
#define PG8_BAR __builtin_amdgcn_s_barrier()
#define PG8_SCHED __builtin_amdgcn_sched_barrier(0)
    Unit cur, nxt; int ui = 0;
    if (!S.next(0, cur)) return;
    f32x4 acc[2][2][4][2];
#pragma unroll
    for (int a = 0; a < 2; ++a)
#pragma unroll
        for (int b = 0; b < 2; ++b)
#pragma unroll
            for (int m = 0; m < 4; ++m)
#pragma unroll
                for (int n = 0; n < 2; ++n) acc[a][b][m][n] = (f32x4){0.f, 0.f, 0.f, 0.f};
    bf16x8 At[4][2], B0[2][2], B1[2][2];
    const char* cA = (const char*)g.A + (size_t)cur.pm * tstepA; const char* cB = (const char*)g.Bt + (size_t)cur.pn * tstepB;
    PG8_STAGE(PG8_SB(0, 0), cB, voffB); PG8_STAGE(PG8_SB(0, 1), cB + hstepB, voffB); PG8_STAGE(PG8_SA(0, 0), cA, voffA); PG8_STAGE(PG8_SA(0, 1), cA + hstepA, voffA);
    if (wr == 1) PG8_BAR;
    PG8_WAIT_V(2); PG8_BAR;
    PG8_STAGE(PG8_SB(1, 0), cB + kstep, voffB); PG8_STAGE(PG8_SA(1, 0), cA + kstep, voffA); PG8_STAGE(PG8_SB(1, 1), cB + hstepB + kstep, voffB);
    PG8_WAIT_V(6); PG8_BAR;
    for (;;) {
        const bool has_next = S.next(ui + 1, nxt);
        const char* nA = has_next ? (const char*)g.A + (size_t)nxt.pm * tstepA : cA; const char* nB = has_next ? (const char*)g.Bt + (size_t)nxt.pn * tstepB : cB;
#pragma nounroll
        for (int t = 0; t < nt; t += 2) {
            if (Hook::ACTIVE) { if (t == 8 || t == 16) { HK(acc, cur, t, wr, wc, fr, fq); asm volatile("s_waitcnt vmcnt(0)" ::: "memory"); } }
            const bool last = (t == nt - 2);
            const char* a1 = cA + (size_t)(t + 1) * kstep;
            const char* a2 = last ? nA : cA + (size_t)(t + 2) * kstep; const char* b2 = last ? nB : cB + (size_t)(t + 2) * kstep;
            const char* a3 = a2 + kstep; const char* b3 = b2 + kstep;
            PG8_LDB(B0, 0, 0); PG8_LDB(B1, 0, 1); PG8_SCHED; PG8_LDA(At, 0, 0); PG8_STAGE(PG8_SA(1, 1), a1 + hstepA, voffA);
            PG8_WAIT_V(8); PG8_WAIT_L(0); PG8_BAR; PG8_MMA(0, 0, At, B0); PG8_MMA(0, 1, At, B1); PG8_BAR; PG8_SCHED;
            PG8_LDA(At, 0, 1); PG8_STAGE(PG8_SB(0, 0), b2, voffB); PG8_STAGE(PG8_SB(0, 1), b2 + hstepB, voffB); PG8_STAGE(PG8_SA(0, 0), a2, voffA);
            PG8_WAIT_V(8); PG8_WAIT_L(0); PG8_BAR; PG8_MMA(1, 0, At, B0); PG8_MMA(1, 1, At, B1); PG8_BAR; PG8_SCHED;
            PG8_LDB(B0, 1, 0); PG8_LDB(B1, 1, 1); PG8_SCHED; PG8_LDA(At, 1, 0); PG8_STAGE(PG8_SA(0, 1), a2 + hstepA, voffA);
            PG8_WAIT_V(8); PG8_WAIT_L(0); PG8_BAR; PG8_MMA(0, 0, At, B0); PG8_MMA(0, 1, At, B1); PG8_BAR; PG8_SCHED;
            PG8_LDA(At, 1, 1); PG8_STAGE(PG8_SB(1, 0), b3, voffB); PG8_STAGE(PG8_SB(1, 1), b3 + hstepB, voffB); PG8_STAGE(PG8_SA(1, 0), a3, voffA);
            PG8_WAIT_V(8); PG8_WAIT_L(0); PG8_BAR; PG8_MMA(1, 0, At, B0); PG8_MMA(1, 1, At, B1); PG8_BAR; PG8_SCHED;
        }
        if (wr == 0) PG8_BAR;
        E(acc, cur, wr, wc, fr, fq);
        if (!has_next) break;
#pragma unroll
        for (int a = 0; a < 2; ++a)
#pragma unroll
            for (int b = 0; b < 2; ++b)
#pragma unroll
                for (int m = 0; m < 4; ++m)
#pragma unroll
                    for (int n = 0; n < 2; ++n) acc[a][b][m][n] = (f32x4){0.f, 0.f, 0.f, 0.f};
        cur = nxt; cA = nA; cB = nB; ++ui;
        if (wr == 1) PG8_BAR;
    }
    PG8_WAIT_V(0);
    PG8_BAR;
#undef PG8_SA
#undef PG8_SB
#undef PG8_STAGE
#undef PG8_LDA
#undef PG8_LDB
#undef PG8_MMA
#undef PG8_WAIT_V
#undef PG8_WAIT_L
#undef PG8_BAR
#undef PG8_SCHED
}
typedef f32x4 Acc[2][2][4][2];

struct EpiH {
    bf16_t* H; bf16_t* KB; float* KMP; float* STQ; float* STKV; const float* rope; unsigned* dep;
    DI void operator()(const Acc& acc, const Unit& u, int wr, int wc, int fr, int fq) const {
        const int row0 = u.pm * BM + wr * 64 + fr;
        {
            const int pn = u.pn; bf16_t* base; int hw = 0, cseg;
            if (pn < 6) { base = H + (pn < 2 ? HM_AQ : pn < 4 ? HM_AK : HM_AV); hw = 64; cseg = (pn & 1) * 256; }
            else if (pn < 10) { base = H + (pn < 8 ? C_AZ : C_BZ); cseg = (pn & 1) * 256; }
            else if (pn < 16) { base = H + (pn < 12 ? HM_CQ : pn < 14 ? HM_CK : HM_CV); hw = 128; cseg = (pn & 1) * 256; }
            else if (pn < 18) { base = H + C_CZ; cseg = (pn & 1) * 256; }
            else { base = H + C_CKV; cseg = (pn - 18) * 256; }
            const int bl = u.pm >> 3, s0 = (u.pm & 7) * 256 + wr * 64 + fr;
#pragma unroll
            for (int bj = 0; bj < 2; ++bj) { const int cs = cseg + bj * HALF + wc * 32 + 8 * fq;
                bf16_t* colp; size_t pitch;
                if (hw == 64) { colp = base + ((size_t)(bl * 8 + (cs >> 6)) * SEQ) * 64 + (cs & 63); pitch = 64; }
                else if (hw == 128) { colp = base + ((size_t)(bl * 4 + (cs >> 7)) * SEQ) * 128 + (cs & 127); pitch = 128; }
                else { colp = base + (size_t)bl * SEQ * HP + cs; pitch = HP; }
#pragma unroll
                for (int ai = 0; ai < 2; ++ai)
#pragma unroll
                    for (int m = 0; m < 4; ++m) *(u32x4*)(colp + (size_t)(s0 + ai * HALF + m * 16) * pitch) = pack8(acc[ai][bj][m][0], acc[ai][bj][m][1]); }
        }
        if (u.pn == 2 || u.pn == 3) {
            float* dst = KMP + (size_t)(u.pm * 2 + wr) * 512 + (u.pn - 2) * 256 + wc * 32 + 8 * fq;
#pragma unroll
            for (int bj = 0; bj < 2; ++bj)
#pragma unroll
                for (int n = 0; n < 2; ++n) { f32x4 s = (f32x4){0.f, 0.f, 0.f, 0.f};
#pragma unroll
                    for (int ai = 0; ai < 2; ++ai)
#pragma unroll
                        for (int m = 0; m < 4; ++m) s += acc[ai][bj][m][n];
#pragma unroll
                    for (int e = 0; e < 4; ++e) { float v = s[e]; v += __shfl_xor(v, 1); v += __shfl_xor(v, 2); v += __shfl_xor(v, 4); v += __shfl_xor(v, 8); s[e] = v; }
                    if (fr == 0) *(f32x4*)(dst + bj * HALF + 4 * n) = s; }
        }
        if (u.pn >= 18) {
#pragma unroll
            for (int ai = 0; ai < 2; ++ai)
#pragma unroll
                for (int m = 0; m < 4; ++m) { const int row = row0 + ai * HALF + m * 16; float ss = 0.f;
#pragma unroll
                    for (int bj = 0; bj < 2; ++bj) { if (u.pn == 20 && bj == 1) continue;
#pragma unroll
                        for (int n = 0; n < 2; ++n) { const f32x4 x = acc[ai][bj][m][n]; ss += (x[0] * x[0] + x[1] * x[1]) + (x[2] * x[2] + x[3] * x[3]); } }
                    ss += __shfl_xor(ss, 16); ss += __shfl_xor(ss, 32);
                    if (fq == 0) { if (u.pn == 18) STKV[(size_t)row * 4 + wc] = ss; else STQ[(size_t)row * 8 + (u.pn - 19) * 4 + wc] = ss; }
                    if (u.pn == 20 && wc == 0) {
                        const int pos = row & (SEQ - 1); f32x4 o[2];
#pragma unroll
                        for (int n = 0; n < 2; ++n) { const f32x4 cs = *(const f32x4*)(rope + ((size_t)pos * 16 + 4 * fq + 2 * n) * 2); const f32x4 t = acc[ai][1][m][n];
                            o[n] = (f32x4){t[0] * cs[0] - t[1] * cs[1], t[0] * cs[1] + t[1] * cs[0], t[2] * cs[2] - t[3] * cs[3], t[2] * cs[3] + t[3] * cs[2]}; }
                        const u32x4 w = pack8(o[0], o[1]);
#pragma unroll
                        for (int h = 0; h < 8; ++h) *(u32x4*)(KB + ((size_t)((row >> 11) * 8 + h) * SEQ + pos) * 96 + 64 + 8 * fq) = w;
                    }
                }
        }
        if (u.pn >= 18) {
            asm volatile("s_waitcnt vmcnt(0)" ::: "memory");
            __syncthreads();
            if (threadIdx.x == 0) {
                __builtin_amdgcn_fence(__ATOMIC_RELEASE, "agent");
                asm volatile("s_waitcnt vmcnt(0)" ::: "memory");
                __hip_atomic_fetch_add(dep + u.pm, 8u, __ATOMIC_RELAXED, __HIP_MEMORY_SCOPE_AGENT);
            }
        }
    }
};
template <int MODE> struct EpiUp {
    bf16_t* QB; bf16_t* KB; bf16_t* VB; const float* ST; const float* rope;
    DI void operator()(const Acc& acc, const Unit& u, int wr, int wc, int fr, int fq) const {
        const int row0 = u.pm * BM + wr * 64 + fr;
#pragma unroll
        for (int ai = 0; ai < 2; ++ai)
#pragma unroll
            for (int m = 0; m < 4; ++m) { const int row = row0 + ai * HALF + m * 16; float sc;
                if (MODE == 0) { const f32x4 a = *(const f32x4*)(ST + (size_t)row * 8), b = *(const f32x4*)(ST + (size_t)row * 8 + 4);
                    sc = __builtin_amdgcn_rsqf(((a[0] + a[1]) + (a[2] + a[3]) + (b[0] + b[1]) + (b[2] + b[3])) * (1.f / 384.f) + 1e-6f) * QS96; }
                else { const f32x4 a = *(const f32x4*)(ST + (size_t)row * 4); sc = __builtin_amdgcn_rsqf(((a[0] + a[1]) + (a[2] + a[3])) * (1.f / 256.f) + 1e-6f); }
                const int pos = row & (SEQ - 1);
#pragma unroll
                for (int bj = 0; bj < 2; ++bj) { const int c0 = u.pn * BM + bj * HALF + wc * 32 + 8 * fq;
                    f32x4 v0 = acc[ai][bj][m][0] * sc, v1 = acc[ai][bj][m][1] * sc;
                    if (MODE == 0) { const int j = c0 % 96;
                        if (j >= 64) { const int i0 = (j - 64) >> 1; const f32x4 ca = *(const f32x4*)(rope + ((size_t)pos * 16 + i0) * 2), cb = *(const f32x4*)(rope + ((size_t)pos * 16 + i0 + 2) * 2);
                            v0 = (f32x4){v0[0] * ca[0] - v0[1] * ca[1], v0[0] * ca[1] + v0[1] * ca[0], v0[2] * ca[2] - v0[3] * ca[3], v0[2] * ca[3] + v0[3] * ca[2]};
                            v1 = (f32x4){v1[0] * cb[0] - v1[1] * cb[1], v1[0] * cb[1] + v1[1] * cb[0], v1[2] * cb[2] - v1[3] * cb[3], v1[2] * cb[3] + v1[3] * cb[2]}; }
                        *(u32x4*)(QB + ((size_t)((row >> 11) * 8 + c0 / 96) * SEQ + pos) * 96 + j) = pack8(v0, v1); }
                    else { if (c0 < 512) *(u32x4*)(KB + ((size_t)((row >> 11) * 8 + (c0 >> 6)) * SEQ + pos) * 96 + (c0 & 63)) = pack8(v0, v1);
                           else *(u32x4*)(VB + ((size_t)((row >> 11) * 8 + ((c0 - 512) >> 6)) * SEQ + pos) * 64 + (c0 & 63)) = pack8(v0, v1); }
                }
            }
    }
};
DI size_t gfrag(int pm, int pnn, int wr, int wc, int fr, int fq) { return ((size_t)(pm * 12 + pnn) * 65536) + (size_t)(((wr * 4 + wc) * 64 + fq * 16 + fr) * 8); }
struct EpiG {
    bf16_t* G; const float* bias;
    DI void operator()(const Acc& acc, const Unit& u, int wr, int wc, int fr, int fq) const {
        const int row0 = u.pm * BM + wr * 64 + fr, col0 = u.pn * BM + wc * 32 + 8 * fq;
        f32x4 bv[2][2];
#pragma unroll
        for (int bj = 0; bj < 2; ++bj)
#pragma unroll
            for (int n = 0; n < 2; ++n) bv[bj][n] = *(const f32x4*)(bias + col0 + bj * HALF + 4 * n);
#pragma unroll
        for (int ai = 0; ai < 2; ++ai)
#pragma unroll
            for (int m = 0; m < 4; ++m) { bf16_t* rowp = G + gfrag(u.pm, u.pn, wr, wc, fr, fq) + (size_t)((ai * 4 + m) * 2) * 4096;
#pragma unroll
                for (int bj = 0; bj < 2; ++bj) { f32x4 v0 = acc[ai][bj][m][0] + bv[bj][0], v1 = acc[ai][bj][m][1] + bv[bj][1];
#pragma unroll
                    for (int e = 0; e < 4; ++e) { v0[e] = fmaxf(sigm(v0[e]), 1e-12f); v1[e] = fmaxf(sigm(v1[e]), 1e-12f); }
                    *(u32x4*)(rowp + bj * 4096) = pack8(v0, v1); } }
    }
};
struct MergeHook {
    static constexpr bool ACTIVE = true;
    const bf16_t* G;
    DI void operator()(Acc& acc, const Unit& u, int t, int wr, int wc, int fr, int fq) const {
        const int seg = (t == 8) ? 0 : 1;
        const int row0 = u.pm * BM + wr * 64 + fr, col0 = u.pn * BM + wc * 32 + 8 * fq;
        const bf16_t* gp = G + gfrag(u.pm, seg * 4 + u.pn, wr, wc, fr, fq);
#pragma unroll
        for (int ai = 0; ai < 2; ++ai) {
            u32x4 ga[8], gb[8];
#pragma unroll
            for (int m = 0; m < 4; ++m)
#pragma unroll
                for (int bj = 0; bj < 2; ++bj) { const bf16_t* p = gp + (size_t)((ai * 4 + m) * 2 + bj) * 4096; ga[m * 2 + bj] = *(const u32x4*)p; gb[m * 2 + bj] = *(const u32x4*)(p + 4 * 65536); }
            __builtin_amdgcn_sched_barrier(0);
#pragma unroll
            for (int m = 0; m < 4; ++m)
#pragma unroll
                for (int bj = 0; bj < 2; ++bj) { f32x4 a0, a1, b0, b1; unpack8(ga[m * 2 + bj], a0, a1); unpack8(gb[m * 2 + bj], b0, b1);
#pragma unroll
                    for (int e = 0; e < 4; ++e) { acc[ai][bj][m][0][e] *= a0[e] * __builtin_amdgcn_rcpf(b0[e]); acc[ai][bj][m][1][e] *= a1[e] * __builtin_amdgcn_rcpf(b1[e]); } }
            __builtin_amdgcn_sched_barrier(0);
        }
    }
};
struct EpiMerge {
    const bf16_t* G; bf16_t* MG;
    DI void operator()(const Acc& acc, const Unit& u, int wr, int wc, int fr, int fq) const {
        const int row0 = u.pm * BM + wr * 64 + fr, col0 = u.pn * BM + wc * 32 + 8 * fq;
        const bf16_t* gp = G + gfrag(u.pm, 8 + u.pn, wr, wc, fr, fq); bf16_t* mp = MG + (size_t)row0 * 1024 + col0;
#pragma unroll
        for (int ai = 0; ai < 2; ++ai) {
            u32x4 gq[8];
#pragma unroll
            for (int m = 0; m < 4; ++m)
#pragma unroll
                for (int bj = 0; bj < 2; ++bj) gq[m * 2 + bj] = *(const u32x4*)(gp + (size_t)((ai * 4 + m) * 2 + bj) * 4096);
            __builtin_amdgcn_sched_barrier(0);
#pragma unroll
            for (int m = 0; m < 4; ++m)
#pragma unroll
                for (int bj = 0; bj < 2; ++bj) { f32x4 g0, g1; unpack8(gq[m * 2 + bj], g0, g1);
                    *(u32x4*)(mp + (size_t)(ai * HALF + m * 16) * 1024 + bj * HALF) = pack8(acc[ai][bj][m][0] * g0, acc[ai][bj][m][1] * g1); }
            __builtin_amdgcn_sched_barrier(0);
        }
    }
};
struct EpiR {
    const float* X; float* R; bf16_t* RB;
    DI void operator()(const Acc& acc, const Unit& u, int wr, int wc, int fr, int fq) const {
        const int row0 = u.pm * BM + wr * 64 + fr, col0 = u.pn * BM + wc * 32 + 8 * fq;
        const size_t base = (size_t)row0 * 1024 + col0;
#pragma unroll
        for (int hb = 0; hb < 4; ++hb) {
            const int ai = hb >> 1, m0 = (hb & 1) * 2;
            f32x4 xq[8];
#pragma unroll
            for (int mm = 0; mm < 2; ++mm)
#pragma unroll
                for (int bj = 0; bj < 2; ++bj) { const size_t off = base + (size_t)(ai * HALF + (m0 + mm) * 16) * 1024 + bj * HALF;
                    xq[(mm * 2 + bj) * 2] = *(const f32x4*)(X + off); xq[(mm * 2 + bj) * 2 + 1] = *(const f32x4*)(X + off + 4); }
            __builtin_amdgcn_sched_barrier(0);
#pragma unroll
            for (int mm = 0; mm < 2; ++mm)
#pragma unroll
                for (int bj = 0; bj < 2; ++bj) { const size_t off = base + (size_t)(ai * HALF + (m0 + mm) * 16) * 1024 + bj * HALF;
                    const f32x4 v0 = xq[(mm * 2 + bj) * 2] * ALPHA + acc[ai][bj][m0 + mm][0], v1 = xq[(mm * 2 + bj) * 2 + 1] * ALPHA + acc[ai][bj][m0 + mm][1];
                    *(f32x4*)(R + off) = v0; *(f32x4*)(R + off + 4) = v1;
                    *(u32x4*)(RB + off) = pack8(v0, v1); }
            __builtin_amdgcn_sched_barrier(0);
        }
    }
};
struct EpiBf {
    bf16_t* O;
    DI void operator()(const Acc& acc, const Unit& u, int wr, int wc, int fr, int fq) const {
        const int row0 = u.pm * BM + wr * 64 + fr, col0 = u.pn * BM + wc * 32 + 8 * fq;
#pragma unroll
        for (int ai = 0; ai < 2; ++ai)
#pragma unroll
            for (int m = 0; m < 4; ++m) { bf16_t* rowp = O + (size_t)(row0 + ai * HALF + m * 16) * 1024 + col0;
#pragma unroll
                for (int bj = 0; bj < 2; ++bj) *(u32x4*)(rowp + bj * HALF) = pack8(acc[ai][bj][m][0], acc[ai][bj][m][1]); }
    }
};
struct EpiR2 {
    float* R; const bf16_t* PP;
    DI void operator()(const Acc& acc, const Unit& u, int wr, int wc, int fr, int fq) const {
        const int row0 = u.pm * BM + wr * 64 + fr, col0 = u.pn * BM + wc * 32 + 8 * fq;
        const size_t base = (size_t)row0 * 1024 + col0;
#pragma unroll
        for (int hb = 0; hb < 4; ++hb) {
            const int ai = hb >> 1, m0 = (hb & 1) * 2;
            f32x4 rq[8]; u32x4 pq[4];
#pragma unroll
            for (int mm = 0; mm < 2; ++mm)
#pragma unroll
                for (int bj = 0; bj < 2; ++bj) { const size_t off = base + (size_t)(ai * HALF + (m0 + mm) * 16) * 1024 + bj * HALF;
                    pq[mm * 2 + bj] = *(const u32x4*)(PP + off); rq[(mm * 2 + bj) * 2] = *(const f32x4*)(R + off); rq[(mm * 2 + bj) * 2 + 1] = *(const f32x4*)(R + off + 4); }
            __builtin_amdgcn_sched_barrier(0);
#pragma unroll
            for (int mm = 0; mm < 2; ++mm)
#pragma unroll
                for (int bj = 0; bj < 2; ++bj) { const size_t off = base + (size_t)(ai * HALF + (m0 + mm) * 16) * 1024 + bj * HALF;
                    f32x4 p0, p1; unpack8(pq[mm * 2 + bj], p0, p1);
                    f32x4 r0 = rq[(mm * 2 + bj) * 2], r1 = rq[(mm * 2 + bj) * 2 + 1];
                    const f32x4 a0 = acc[ai][bj][m0 + mm][0], a1 = acc[ai][bj][m0 + mm][1];
#pragma unroll
                    for (int e = 0; e < 4; ++e) { r0[e] += sigm(a0[e]) * p0[e]; r1[e] += sigm(a1[e]) * p1[e]; }
                    *(f32x4*)(R + off) = r0; *(f32x4*)(R + off + 4) = r1; }
            __builtin_amdgcn_sched_barrier(0);
        }
    }
};
}

DI float row16_sum(float v) {
    v += __builtin_bit_cast(float, __builtin_amdgcn_update_dpp(0, __builtin_bit_cast(int, v), 0xB1, 0xF, 0xF, true));
    v += __builtin_bit_cast(float, __builtin_amdgcn_update_dpp(0, __builtin_bit_cast(int, v), 0x4E, 0xF, 0xF, true));
    v += __builtin_bit_cast(float, __builtin_amdgcn_update_dpp(0, __builtin_bit_cast(int, v), 0x124, 0xF, 0xF, true));
    v += __builtin_bit_cast(float, __builtin_amdgcn_update_dpp(0, __builtin_bit_cast(int, v), 0x128, 0xF, 0xF, true));
    return v;
}
DI int crow(int r, int hi) { return (r & 3) + 8 * (r >> 2) + 4 * hi; }
DI s16x4 vtr(LAS const char* p) { typedef short v4i16_t __attribute__((ext_vector_type(4))); return __builtin_bit_cast(s16x4, __builtin_amdgcn_ds_read_tr16_b64_v4i16((LAS v4i16_t*)p)); }
constexpr int AT_SCR = 112 * 1024, AT_KM = 113 * 1024;
constexpr float NEGBIG = -1e30f;
DI float max3f(float a, float b, float c) { return fmaxf(fmaxf(a, b), c); }

template <int DQK, int KW, int DV, int NROWS, bool ALIBI, bool MOBA, bool PIPE, int NSET>
DI void attn_unit(LAS char* lds, const bf16_t* Qp, int ldq, const bf16_t* Kp, int ldk, const bf16_t* Vp, int ldv,
                  const bf16_t* Zp, int ldz, bf16_t* Yp, int ldy, int q0, float sl2, const float* kmp, float lam, const float* subg, float post) {
    constexpr int NTD = NROWS / 64, NS = DQK / 16, ND = DV / 32, PVG = (DV == 64) ? 2 : 1;
    constexpr int KPITCH = KW * 2 + 16, VPITCH = DV * 2 + 64;
    constexpr int KOFF0 = 0, VOFF0 = 3 * 64 * KPITCH;
    constexpr int KCH = KW / 8, VCH = DV / 8, NKC = 64 * KCH, NVC = 64 * VCH, KPT = (NKC + 511) / 512, VPT = (NVC + 511) / 512;
    static_assert(VOFF0 + 3 * 64 * VPITCH <= AT_SCR, "attention LDS map");
    const int tid = opaque_tid(), lane = tid & 63, r32 = lane & 31, hi = lane >> 5;
    const int wid = __builtin_amdgcn_readfirstlane(tid >> 6);
    const int ro = (NROWS == 256) ? 32 * wid : 32 * (wid & 3);
    const int map = (NROWS == 256) ? 0 : (wid >> 2);
    const int qpos = q0 + ro + r32;
    LAS float* scr = (LAS float*)(lds + AT_SCR) + wid * 32;

    bf16x8 qf[NS];
    { const bf16_t* qrow = Qp + (size_t)qpos * ldq + 64 * map + 8 * hi;
#pragma unroll
      for (int s = 0; s < NS; ++s) qf[s] = *(const bf16x8*)(qrow + 16 * s); }

    unsigned sel = 0xFFu;
    if (MOBA) {
        const int u = q0 >> 8;
        if (u > 3) {
            LAS float* km = (LAS float*)(lds + AT_KM);
            { const int j = tid >> 6, d = tid & 63; if (j < u) km[j * 64 + d] = (kmp[(size_t)(j * 2) * 512 + d] + kmp[(size_t)(j * 2 + 1) * 512 + d]) * (1.f / 256.f); }
            __syncthreads();
            float g[7];
#pragma unroll
            for (int j = 0; j < 7; ++j) { float a = 0.f;
                if (j < u) {
#pragma unroll
                    for (int s = 0; s < 4; ++s) { const f32x4 k0 = *(const LAS f32x4*)(km + j * 64 + 16 * s + 8 * hi), k1 = *(const LAS f32x4*)(km + j * 64 + 16 * s + 8 * hi + 4);
#pragma unroll
                        for (int e = 0; e < 4; ++e) { a += bf2f((bf16_t)qf[s][e]) * k0[e]; a += bf2f((bf16_t)qf[s][4 + e]) * k1[e]; } }
                }
                a += __shfl_xor(a, 32); g[j] = a; }
            sel = 0u;
#pragma unroll
            for (int k = 0; k < 3; ++k) { float best = -INFINITY; int bi = 0;
#pragma unroll
                for (int j = 0; j < 7; ++j) { const bool ok = (j < u) && !((sel >> j) & 1u) && (g[j] > best); best = ok ? g[j] : best; bi = ok ? j : bi; }
                sel |= 1u << bi; }
        }
    }

    f32x16 o[ND];
#pragma unroll
    for (int d0 = 0; d0 < ND; ++d0)
#pragma unroll
        for (int r = 0; r < 16; ++r) o[d0][r] = 0.f;
    f32x16 bias;
#pragma unroll
    for (int r = 0; r < 16; ++r) bias[r] = ALIBI ? sl2 * (float)((r & 3) + 8 * (r >> 2) + 4 * hi) : 0.f;
    const float d32 = ALIBI ? 32.f * sl2 : 0.f;
    float mrun = NEGBIG, lrun = 0.f;
    const int nt = NTD + (q0 >> 6);
    u32x4 kregA[KPT], vregA[VPT], kregB[KPT], vregB[VPT], kregC[KPT], vregC[VPT], kregD[KPT], vregD[VPT];
#define AT_TB(it) ((it) < NTD ? q0 + 64 * (it) : 64 * ((it) - NTD))
#define AT_LOAD(it, kreg, vreg) do { const int _ti = ((it) < nt) ? (it) : nt - 1; const int _kb = AT_TB(_ti); \
        _Pragma("unroll") for (int _i = 0; _i < KPT; ++_i) { const int _c = tid + 512 * _i; if (NKC % 512 == 0 || _i + 1 < KPT || _c < NKC) { const int _r = _c / KCH, _cc = _c % KCH; kreg[_i] = *(const u32x4*)(Kp + (size_t)(_kb + _r) * ldk + 8 * _cc); } } \
        _Pragma("unroll") for (int _i = 0; _i < VPT; ++_i) { const int _c = tid + 512 * _i; if (NVC % 512 == 0 || _i + 1 < VPT || _c < NVC) { const int _r = _c / VCH, _cc = _c % VCH; vreg[_i] = *(const u32x4*)(Vp + (size_t)(_kb + _r) * ldv + 8 * _cc); } } } while (0)
#define AT_STORE(buf, kreg, vreg) do { \
        _Pragma("unroll") for (int _i = 0; _i < KPT; ++_i) { const int _c = tid + 512 * _i; if (NKC % 512 == 0 || _i + 1 < KPT || _c < NKC) { const int _r = _c / KCH, _cc = _c % KCH; *(LAS u32x4*)(lds + KOFF0 + (buf) * 64 * KPITCH + _r * KPITCH + 16 * _cc) = kreg[_i]; } } \
        _Pragma("unroll") for (int _i = 0; _i < VPT; ++_i) { const int _c = tid + 512 * _i; if (NVC % 512 == 0 || _i + 1 < VPT || _c < NVC) { const int _r = _c / VCH, _cc = _c % VCH; *(LAS u32x4*)(lds + VOFF0 + (buf) * 64 * VPITCH + _r * VPITCH + 16 * _cc) = vreg[_i]; } } } while (0)
#define AT_ACTIVE(it) ((it) >= NTD || 64 * (it) <= ro + 31)
#define AT_QK(it, bufi, P0, P1) do { if (AT_ACTIVE(it)) { \
        LAS const char* _Kb = lds + KOFF0 + (bufi) * 64 * KPITCH + r32 * KPITCH + (64 * map + 8 * hi) * 2; \
        _Pragma("unroll") for (int _h = 0; _h < NS; _h += 4) { \
            bf16x8 _kf[8]; \
            _Pragma("unroll") for (int _s = 0; _s < 4; ++_s) if (_h + _s < NS) { _kf[2 * _s] = *(const LAS bf16x8*)(_Kb + 32 * (_h + _s)); _kf[2 * _s + 1] = *(const LAS bf16x8*)(_Kb + 32 * KPITCH + 32 * (_h + _s)); } \
            __builtin_amdgcn_sched_barrier(0); \
            _Pragma("unroll") for (int _s = 0; _s < 4; ++_s) if (_h + _s < NS) { \
                if (_h + _s == 0) { P0 = __builtin_amdgcn_mfma_f32_32x32x16_bf16(_kf[0], qf[0], bias, 0, 0, 0); P1 = __builtin_amdgcn_mfma_f32_32x32x16_bf16(_kf[1], qf[0], bias, 0, 0, 0); } \
                else { P0 = __builtin_amdgcn_mfma_f32_32x32x16_bf16(_kf[2 * _s], qf[_h + _s], P0, 0, 0, 0); P1 = __builtin_amdgcn_mfma_f32_32x32x16_bf16(_kf[2 * _s + 1], qf[_h + _s], P1, 0, 0, 0); } } \
            __builtin_amdgcn_sched_barrier(0); } } } while (0)
    if (NSET == 4) { AT_LOAD(0, kregA, vregA); AT_LOAD(1, kregB, vregB); AT_LOAD(2, kregC, vregC); AT_LOAD(3, kregD, vregD); AT_STORE(0, kregA, vregA); AT_STORE(1, kregB, vregB);
                     AT_LOAD(4, kregA, vregA); AT_LOAD(5, kregB, vregB); }
    else if (NSET == 2) { AT_LOAD(0, kregA, vregA); AT_LOAD(1, kregB, vregB); AT_STORE(0, kregA, vregA); AT_STORE(1, kregB, vregB); AT_LOAD(2, kregA, vregA); AT_LOAD(3, kregB, vregB); }
    else { AT_LOAD(0, kregA, vregA); AT_STORE(0, kregA, vregA); AT_LOAD(1, kregA, vregA); AT_STORE(1, kregA, vregA); AT_LOAD(2, kregA, vregA); }
    __syncthreads();
    const int i16 = lane & 15;
    const int vlane = (4 * hi + (i16 >> 2)) * VPITCH + (16 * ((lane >> 4) & 1) + 4 * (i16 & 3)) * 2;
    f32x16 pa0, pa1, pb0, pb1;
#pragma unroll
    for (int r = 0; r < 16; ++r) { pa0[r] = 0.f; pa1[r] = 0.f; pb0[r] = 0.f; pb1[r] = 0.f; }
    if (PIPE) AT_QK(0, 0, pa0, pa1);
    int bcur = 0;
#define AT_ITER(it, C0, C1, N0, N1, kreg, vreg) do { \
        const int _b1 = (bcur == 2) ? 0 : bcur + 1, _b2 = (_b1 == 2) ? 0 : _b1 + 1; \
        AT_STORE(_b2, kreg, vreg); \
        AT_LOAD((it) + 2 + NSET, kreg, vreg); \
        if (PIPE) { if ((it) + 1 < nt) AT_QK((it) + 1, _b1, N0, N1); } else AT_QK(it, bcur, C0, C1); \
        if (AT_ACTIVE(it)) { \
            LAS const char* _Vb = lds + VOFF0 + bcur * 64 * VPITCH + vlane; \
            bf16x8 _vf[4 * PVG];                      \
            _Pragma("unroll") for (int _e = 0; _e < PVG; ++_e) _Pragma("unroll") for (int _ks = 0; _ks < 4; ++_ks) { \
                const s16x4 _lo = vtr(_Vb + (16 * _ks) * VPITCH + 64 * _e), _hh = vtr(_Vb + (16 * _ks + 8) * VPITCH + 64 * _e); \
                _vf[4 * _e + _ks] = __builtin_shufflevector(_lo, _hh, 0, 1, 2, 3, 4, 5, 6, 7); } \
            __builtin_amdgcn_sched_barrier(0); \
            const int _kb = AT_TB(it); const bool _diag = (it) < NTD; \
            if (_diag) { const int _kq = _kb + 4 * hi - qpos; \
                _Pragma("unroll") for (int _r = 0; _r < 16; ++_r) { const int _dd = _kq + (_r & 3) + 8 * (_r >> 2); if (_dd > 0) C0[_r] = NEGBIG; if (_dd + 32 > 0) C1[_r] = NEGBIG; } } \
            float _m0 = max3f(C0[0], C0[1], C0[2]), _m1 = max3f(C1[0], C1[1], C1[2]); \
            _Pragma("unroll") for (int _r = 3; _r < 15; _r += 2) { _m0 = max3f(_m0, C0[_r], C0[_r + 1]); _m1 = max3f(_m1, C1[_r], C1[_r + 1]); } \
            _m0 = fmaxf(_m0, C0[15]); _m1 = fmaxf(_m1, C1[15]); \
            const float _c0 = ALIBI ? sl2 * (float)(_kb - qpos) : 0.f; \
            float _mx = fmaxf(_m0, _m1 + d32) + _c0; \
            bool _selok = true; if (MOBA && !_diag) _selok = ((sel >> (_kb >> 8)) & 1u) != 0u; \
            if (!_selok) _mx = NEGBIG; \
            { const auto _rr = __builtin_amdgcn_permlane32_swap(__float_as_uint(_mx), __float_as_uint(_mx), false, false); _mx = fmaxf(__uint_as_float(_rr[0]), __uint_as_float(_rr[1])); }     \
            const float _mn = fmaxf(mrun, _mx); \
            if (__any(_mn - mrun > 8.f)) { \
                const float _alpha = __builtin_amdgcn_exp2f(mrun - _mn); lrun *= _alpha; mrun = _mn; \
                scr[r32] = _alpha; \
                asm volatile("s_waitcnt lgkmcnt(0)" ::: "memory"); \
                f32x4 _a4[4]; \
                _Pragma("unroll") for (int _g = 0; _g < 4; ++_g) _a4[_g] = *(const LAS f32x4*)(scr + 8 * _g + 4 * hi); \
                asm volatile("s_waitcnt lgkmcnt(0)" ::: "memory"); \
                _Pragma("unroll") for (int _d0 = 0; _d0 < ND; ++_d0) _Pragma("unroll") for (int _r = 0; _r < 16; ++_r) o[_d0][_r] *= _a4[_r >> 2][_r & 3]; \
            } \
            const float _ms0 = _selok ? (mrun - _c0) : INFINITY, _ms1 = _ms0 - d32; \
            float _ls = 0.f; \
            _Pragma("unroll") for (int _r = 0; _r < 16; ++_r) { C0[_r] = __builtin_amdgcn_exp2f(C0[_r] - _ms0); C1[_r] = __builtin_amdgcn_exp2f(C1[_r] - _ms1); _ls += C0[_r] + C1[_r]; } \
            lrun += _ls; \
            bf16x8 _pa[4]; \
            _Pragma("unroll") for (int _ks = 0; _ks < 2; ++_ks) { u32x4 _w; \
                _w.x = pk2(C0[8 * _ks], C0[8 * _ks + 1]); _w.y = pk2(C0[8 * _ks + 2], C0[8 * _ks + 3]); _w.z = pk2(C0[8 * _ks + 4], C0[8 * _ks + 5]); _w.w = pk2(C0[8 * _ks + 6], C0[8 * _ks + 7]); \
                _pa[_ks] = __builtin_bit_cast(bf16x8, _w); \
                _w.x = pk2(C1[8 * _ks], C1[8 * _ks + 1]); _w.y = pk2(C1[8 * _ks + 2], C1[8 * _ks + 3]); _w.z = pk2(C1[8 * _ks + 4], C1[8 * _ks + 5]); _w.w = pk2(C1[8 * _ks + 6], C1[8 * _ks + 7]); \
                _pa[2 + _ks] = __builtin_bit_cast(bf16x8, _w); } \
            _Pragma("unroll") for (int _d0 = 0; _d0 < ND; _d0 += PVG) { \
                if (_d0 > 0) { \
                    _Pragma("unroll") for (int _e = 0; _e < PVG; ++_e) _Pragma("unroll") for (int _ks = 0; _ks < 4; ++_ks) { \
                        const s16x4 _lo = vtr(_Vb + (16 * _ks) * VPITCH + 64 * (_d0 + _e)), _hh = vtr(_Vb + (16 * _ks + 8) * VPITCH + 64 * (_d0 + _e)); \
                        _vf[4 * _e + _ks] = __builtin_shufflevector(_lo, _hh, 0, 1, 2, 3, 4, 5, 6, 7); } \
                    __builtin_amdgcn_sched_barrier(0); } \
                _Pragma("unroll") for (int _ks = 0; _ks < 4; ++_ks) _Pragma("unroll") for (int _e = 0; _e < PVG; ++_e) \
                    o[_d0 + _e] = __builtin_amdgcn_mfma_f32_32x32x16_bf16(_pa[_ks], _vf[4 * _e + _ks], o[_d0 + _e], 0, 0, 0); \
                __builtin_amdgcn_sched_barrier(0); } \
        } \
        bcur = _b1; \
        asm volatile("s_waitcnt lgkmcnt(0)\n\ts_barrier" ::: "memory"); } while (0)
    if (NSET == 4) {
        for (int it = 0; it < nt; it += 4) {
            AT_ITER(it, pa0, pa1, pb0, pb1, kregC, vregC);
            AT_ITER(it + 1, pb0, pb1, pa0, pa1, kregD, vregD);
            AT_ITER(it + 2, pa0, pa1, pb0, pb1, kregA, vregA);
            AT_ITER(it + 3, pb0, pb1, pa0, pa1, kregB, vregB);
        }
    } else {
        for (int it = 0; it < nt; it += 2) {
            AT_ITER(it, pa0, pa1, pb0, pb1, kregA, vregA);
            if (NSET == 2) AT_ITER(it + 1, pb0, pb1, pa0, pa1, kregB, vregB); else AT_ITER(it + 1, pb0, pb1, pa0, pa1, kregA, vregA);
        }
    }
#undef AT_TB
#undef AT_LOAD
#undef AT_STORE
#undef AT_ACTIVE
#undef AT_QK
#undef AT_ITER
    {
        const float lt = lrun + __shfl_xor(lrun, 32);
        scr[r32] = 1.f / lt;
        asm volatile("s_waitcnt lgkmcnt(0)" ::: "memory");
        f32x4 a4[4];
#pragma unroll
        for (int g = 0; g < 4; ++g) a4[g] = *(const LAS f32x4*)(scr + 8 * g + 4 * hi);
        asm volatile("s_waitcnt lgkmcnt(0)" ::: "memory");
#pragma unroll
        for (int d0 = 0; d0 < ND; ++d0)
#pragma unroll
            for (int r = 0; r < 16; ++r) o[d0][r] *= a4[r >> 2][r & 3];
    }
    if (NROWS == 256) {
#pragma unroll
        for (int d0 = 0; d0 < ND; ++d0)
#pragma unroll
            for (int r = 0; r < 16; ++r) { const size_t row = (size_t)(q0 + ro + crow(r, hi)); const int col = 32 * d0 + r32;
                const float z = bf2f(Zp[row * ldz + col]); Yp[row * ldy + col] = f2bf(o[d0][r] * silu(z)); }
    } else {
        LAS float* xch = (LAS float*)lds;
        if (map == 1) {
#pragma unroll
            for (int d0 = 0; d0 < ND; ++d0)
#pragma unroll
                for (int r = 0; r < 16; ++r) xch[(((wid & 3) * ND + d0) * 16 + r) * 64 + lane] = o[d0][r];
        }
        __syncthreads();
        if (map == 0) {
#pragma unroll
            for (int d0 = 0; d0 < ND; ++d0)
#pragma unroll
                for (int r = 0; r < 16; ++r) o[d0][r] -= lam * xch[(((wid & 3) * ND + d0) * 16 + r) * 64 + lane];
#pragma unroll
            for (int r = 0; r < 16; ++r) { float ss = 0.f;
#pragma unroll
                for (int d0 = 0; d0 < ND; ++d0) ss += o[d0][r] * o[d0][r];
                ss = row16_sum(ss); ss += __shfl_xor(ss, 16);
                const float rs = __builtin_amdgcn_rsqf(ss * (1.f / (float)DV) + 1e-5f) * post;
                const size_t row = (size_t)(q0 + ro + crow(r, hi));
#pragma unroll
                for (int d0 = 0; d0 < ND; ++d0) { const int col = 32 * d0 + r32; const float z = bf2f(Zp[row * ldz + col]);
                    Yp[row * ldy + col] = f2bf(o[d0][r] * rs * subg[col] * silu(z)); } }
        }
        __syncthreads();
    }
}

#define XB_TMO      128
#define XB_XCNT(j)  (256  + 64 * (j))
#define XB_XSUB(j)  (1280 + 64 * (j))
#define XB_XGEN(j)  (2304 + 64 * (j))
#define XB_TOP      3328
#define XB_TOPGEN   3392
#define XCD_BAR_WORDS 3456
#define XB_SPIN_CAP (1u << 22)
DI unsigned xb_ld(unsigned* p)              { return __hip_atomic_load(p, __ATOMIC_RELAXED, __HIP_MEMORY_SCOPE_AGENT); }
DI unsigned xb_add(unsigned* p, unsigned v) { return __hip_atomic_fetch_add(p, v, __ATOMIC_RELAXED, __HIP_MEMORY_SCOPE_AGENT); }
DI unsigned xb_xcc_id() { return (unsigned)__builtin_amdgcn_s_getreg((3 << 11) | 20) & 0xFu; }
#define XB_SPIN(cond, bar) do { unsigned _sp = 0; while (cond) { __builtin_amdgcn_s_sleep(1); \
    if ((++_sp & 255u) == 0u) { if (xb_ld(&(bar)[XB_TMO])) break; if (_sp > XB_SPIN_CAP) { atomicAdd(&(bar)[XB_TMO], 1u); break; } } } } while (0)
DI void xcd_barrier_complete(unsigned* bar, unsigned x, unsigned& nloc, unsigned& nx) {
    const unsigned Gn = gridDim.x;
    unsigned sum, cnt, mine, sp = 0u;
    for (;;) {
        sum = 0u; cnt = 0u; mine = 0u;
#pragma unroll
        for (unsigned j = 0; j < 16; ++j) { const unsigned c = xb_ld(&bar[XB_XCNT(j)]); sum += c; cnt += (c > 0u) ? 1u : 0u; mine = (j == x) ? c : mine; }
        if (sum == Gn) break;
        __builtin_amdgcn_s_sleep(1);
        if ((++sp & 255u) == 0u) { if (xb_ld(&bar[XB_TMO])) break; if (sp > XB_SPIN_CAP) { atomicAdd(&bar[XB_TMO], 1u); break; } }
    }
    nloc = mine > 0u ? mine : 1u; nx = cnt > 0u ? cnt : 1u;
}
DI void xcd_barrier(unsigned* bar, volatile LAS unsigned* st) {
    asm volatile("s_waitcnt vmcnt(0)" ::: "memory");
    __syncthreads();
    if (threadIdx.x == 0) {
        __builtin_amdgcn_s_waitcnt(0);
        const unsigned x = xb_xcc_id();
        unsigned nloc = st[0], nx = st[1];
        if (nloc == 0u) { xcd_barrier_complete(bar, x, nloc, nx); st[0] = nloc; st[1] = nx; }
        const unsigned old = xb_add(&bar[XB_XSUB(x)], 1u);
        const unsigned gen = old / nloc;
        if (old + 1u == (gen + 1u) * nloc) {
            __builtin_amdgcn_fence(__ATOMIC_RELEASE, "agent");
            asm volatile("s_waitcnt vmcnt(0)" ::: "memory");
            const unsigned og = xb_add(&bar[XB_TOP], 1u);
            const unsigned tg = og / nx;
            if (og + 1u == (tg + 1u) * nx) xb_add(&bar[XB_TOPGEN], 1u);
            else XB_SPIN(xb_ld(&bar[XB_TOPGEN]) == tg, bar);
            __builtin_amdgcn_fence(__ATOMIC_ACQUIRE, "agent");
            xb_add(&bar[XB_XGEN(x)], 1u);
            asm volatile("s_waitcnt vmcnt(0)" ::: "memory");
        } else {
            XB_SPIN(xb_ld(&bar[XB_XGEN(x)]) == gen, bar);
            __builtin_amdgcn_fence(__ATOMIC_ACQUIRE, "agent");
            asm volatile("s_waitcnt vmcnt(0)" ::: "memory");
        }
    }
    __syncthreads();
}

struct Params { const float* in[19]; float* out; unsigned char* ws; };

DI void colmap(int kind, int n, int& col, float& cs) {
    cs = 1.f;
    if (kind == 0) {
        if (n < 2048) { col = n; if (n < 512) cs = QS64; }
        else if (n < 2560) col = 2720 + (n - 2048);
        else if (n < 3072) { col = 3232 + (n - 2560); cs = QS64; }
        else if (n < 3584) col = 3744 + (n - 3072);
        else if (n < 4096) col = 4256 + (n - 3584);
        else if (n < 4608) col = 4768 + (n - 4096);
        else if (n < 4864) col = 2432 + (n - 4608);
        else if (n < 5248) col = 2048 + (n - 4864);
        else if (n < 5280) { const int j = n - 5248; col = 2688 + (j >> 1) + 16 * (j & 1); }
        else col = -1;
    } else if (kind == 1) col = n;
    else if (kind == 2) { const int h = n / 96, j = n % 96; if (j < 64) col = h * 96 + j; else { const int jj = j - 64; col = h * 96 + 64 + (jj >> 1) + 16 * (jj & 1); } }
    else { if (n < 512) col = (n >> 6) * 128 + (n & 63); else { const int m = n - 512; col = (m >> 6) * 128 + 64 + (m & 63); } }
}
DI void tr_tile(const float* src, int srcN, int ldd, bf16_t* dst, int kind, int n0, int k0, const float* kscale, LAS float* scr, int tid) {
    { const int nl = tid & 127, kl0 = tid >> 7; int col; float cs; colmap(kind, n0 + nl, col, cs);
      float v[16];
#pragma unroll
      for (int i = 0; i < 16; ++i) { const int kl = kl0 + 4 * i; v[i] = (col >= 0) ? __builtin_nontemporal_load(src + (size_t)(k0 + kl) * srcN + col) : 0.f; }
#pragma unroll
      for (int i = 0; i < 16; ++i) { const int kl = kl0 + 4 * i; float w = v[i] * cs; if (kscale) w *= kscale[k0 + kl]; scr[kl * 129 + nl] = w; } }
    __syncthreads();
    { const int kp = tid & 31;
#pragma unroll
      for (int i = 0; i < 8; ++i) { const int nl = (tid >> 5) + 16 * i;
          *(unsigned*)(dst + (size_t)(n0 + nl) * ldd + k0 + 2 * kp) = pk2(scr[(2 * kp) * 129 + nl], scr[(2 * kp + 1) * 129 + nl]); } }
    __syncthreads();
}
typedef const __attribute__((address_space(4))) Params* KParams0;
DI void convert_weights(KParams0 Pk, int l, bf16_t* WT, LAS float* scr) {
    const int tid = opaque_tid();
    constexpr int T0 = 42 * 16, T1 = T0 + 24 * 16, T2 = T1 + 6 * 6, T3 = T2 + 8 * 4, T4 = T3 + 8 * 8, T5 = T4 + 8 * 8, T6 = T5 + 8 * 8, T7 = T6 + 8 * 16, T8 = T7 + 8 * 16, T9 = T8 + 8 * 4;
    for (int t = blockIdx.x; t < T9; t += gridDim.x) {
        const float* src; int srcN, K, kind, loc, ldd = 0; bf16_t* dst; const float* ks = nullptr;
        if (t < T0) { src = Pk->in[2] + (size_t)l * 1024 * 5280; srcN = 5280; K = 1024; kind = 0; loc = t; dst = WT + OFF_WIN; }
        else if (t < T1) { src = Pk->in[12] + (size_t)l * 1024 * 3072; srcN = 3072; K = 1024; kind = 1; loc = t - T0; dst = WT + OFF_WIN + (size_t)5376 * 1024; }
        else if (t < T2) { src = Pk->in[5] + (size_t)l * 384 * 768; srcN = 768; K = 384; kind = 2; loc = t - T1; dst = WT + OFF_WUQ; ks = Pk->in[3] + l * 384; }
        else if (t < T3) { src = Pk->in[6] + (size_t)l * 256 * 1024; srcN = 1024; K = 256; kind = 3; loc = t - T2; dst = WT + OFF_WUKV; ks = Pk->in[4] + l * 256; }
        else if (t < T4) { src = Pk->in[9] + (size_t)l * 512 * 1024; srcN = 1024; K = 512; kind = 1; loc = t - T3; dst = WT + OFF_WABC; ldd = 1536; }
        else if (t < T5) { src = Pk->in[10] + (size_t)l * 512 * 1024; srcN = 1024; K = 512; kind = 1; loc = t - T4; dst = WT + OFF_WABC + 512; ldd = 1536; }
        else if (t < T6) { src = Pk->in[11] + (size_t)l * 512 * 1024; srcN = 1024; K = 512; kind = 1; loc = t - T5; dst = WT + OFF_WABC + 1024; ldd = 1536; }
        else if (t < T7) { src = Pk->in[14] + (size_t)l * 1024 * 1024; srcN = 1024; K = 1024; kind = 1; loc = t - T6; dst = WT + OFF_WO; }
        else if (t < T8) { src = Pk->in[17] + (size_t)l * 1024 * 1024; srcN = 1024; K = 1024; kind = 1; loc = t - T7; dst = WT + OFF_WPG; }
        else { src = Pk->in[18] + (size_t)l * 256 * 1024; srcN = 1024; K = 256; kind = 1; loc = t - T8; dst = WT + OFF_WP; }
        const int kt = K / 64; const int n0 = (loc / kt) * 128, k0 = (loc % kt) * 64;
        tr_tile(src, srcN, ldd ? ldd : K, dst, kind, n0, k0, ks, scr, tid);
    }
}
DI void convert_rows(const float* src, bf16_t* dst, size_t n) {
    const size_t stride = (size_t)gridDim.x * blockDim.x, ng = n / 8;
    for (size_t i = (size_t)blockIdx.x * blockDim.x + opaque_tid(); i < ng; i += 4 * stride) {
        f32x4 a[4], b[4];
#pragma unroll
        for (int j = 0; j < 4; ++j) { const size_t q = i + j * stride; if (q < ng) { a[j] = __builtin_nontemporal_load((const f32x4*)(src + q * 8)); b[j] = __builtin_nontemporal_load((const f32x4*)(src + q * 8 + 4)); } }
#pragma unroll
        for (int j = 0; j < 4; ++j) { const size_t q = i + j * stride; if (q < ng) *(u32x4*)(dst + q * 8) = pack8(a[j], b[j]); }
    }
}
typedef const __attribute__((address_space(4))) Params* KParams;
DI KParams kparams() { KParams p = (KParams)__builtin_amdgcn_kernarg_segment_ptr(); asm volatile("" : "+s"(p)); return p; }
DI unsigned char* wsbase() { unsigned char* w = kparams()->ws; asm volatile("" : "+s"(w)); return w; }

__global__ void __launch_bounds__(512, 2) fwd_megakernel(Params Punused) {
    extern __shared__ __attribute__((aligned(16))) unsigned char lds_raw[];
    cg::grid_group grid = cg::this_grid();
    LAS unsigned char* lds = (LAS unsigned char*)lds_raw;
#define G opaque_s((int)gridDim.x)
#define cu opaque_s((int)blockIdx.x)
#define XB_  ((bf16_t*)(ws + WS_XB))
#define WT_  ((bf16_t*)(ws + WS_WT))
#define PB_  ((bf16_t*)(ws + WS_PB))
#define Y_   ((bf16_t*)(ws + WS_Y))
#define H_   ((bf16_t*)(ws + WS_H))
#define QB_  ((bf16_t*)(ws + WS_MLA))
#define KB_  (QB_ + (size_t)HM * 768)
#define VB_  (KB_ + (size_t)HM * 768)
#define R_   ((float*)(ws + WS_H))
#define ROPE_ ((float*)(ws + CTL_ROPE))
#define KMP_ ((float*)(ws + CTL_KMP))
#define STQ_ ((float*)(ws + CTL_STQ))
#define STKV_ ((float*)(ws + CTL_STKV))

    if (threadIdx.x < 2) ((volatile LAS unsigned*)(lds + LDS_IDX + 64))[threadIdx.x] = 0u;
    {
        const int tid = opaque_tid();
        KParams P = kparams(); unsigned char* ws = P->ws;
        for (int rep = 0; rep < REP_P0; ++rep) {
        convert_weights(P, 0, WT_, (LAS float*)lds);
        convert_rows(P->in[0], XB_, (size_t)M * D);
        convert_rows(P->in[1], PB_, (size_t)M * 256); }
        float* rope = ROPE_;
        for (int i = cu * 512 + tid; i < SEQ * 16; i += G * 512) {
            const int pos = i >> 4, k = i & 15;
            const float freq = __builtin_amdgcn_exp2f(-(float)k * (13.287712379549449f / 16.f));
            const float ang = (float)pos * freq;
            double rev = (double)ang * 0.15915494309189535; rev -= __builtin_rint(rev);
            const float fr = (float)rev;
            rope[2 * i] = __builtin_amdgcn_cosf(fr); rope[2 * i + 1] = __builtin_amdgcn_sinf(fr);
        }
        if (cu == 0) {
            unsigned* ctl = (unsigned*)(ws + WS_CTL); float* lamv = (float*)(ws + CTL_LAM);
            if (tid < 64) {
#pragma unroll
                for (int l = 0; l < 2; ++l) { const float* dl = P->in[7] + l * 256; float a = dl[tid] * dl[64 + tid], b = dl[128 + tid] * dl[192 + tid];
#pragma unroll
                    for (int s = 1; s < 64; s <<= 1) { a += __shfl_xor(a, s); b += __shfl_xor(b, s); }
                    const float li = (l == 0) ? 0.2f : 0.35550906759096924f;
                    if (tid == 0) lamv[l] = __builtin_amdgcn_exp2f(a * LOG2E) - __builtin_amdgcn_exp2f(b * LOG2E) + li; }
            }
            if (tid < 64) ctl[tid] = 0u;
            if (tid < 128) ((unsigned*)(ws + CTL_DEP))[tid] = 0u;
            { unsigned* bw = (unsigned*)(ws + CTL_BAR); for (int i = tid; i < XCD_BAR_WORDS; i += 512) bw[i] = 0u; }
        }
    }
    grid.sync();
    if (threadIdx.x == 0) { unsigned char* ws = wsbase(); (void)xb_add(&((unsigned*)(ws + CTL_BAR))[XB_XCNT(xb_xcc_id())], 1u); }
#define GSYNC() do { unsigned char* _w = wsbase(); xcd_barrier((unsigned*)(_w + CTL_BAR), (volatile LAS unsigned*)(lds + LDS_IDX + 64)); } while (0)

    for (int l = 0; l < 2; ++l) {
        for (int hf = 0; hf < 2; ++hf) {
            for (int rep = 0; rep < REP_P1; ++rep)
            { unsigned char* ws = wsbase();
              pg8::Gemm g{XB_ + (size_t)hf * HM * D, WT_ + OFF_WIN, D, D}; pg8::P1Order S{G, cu};
              pg8::EpiH E{H_, KB_, KMP_ + (size_t)hf * 32 * 2 * 512, STQ_ + (size_t)hf * HM * 8, STKV_ + (size_t)hf * HM * 4, ROPE_, (unsigned*)(ws + CTL_DEP) + (l * 2 + hf) * 32};
              pg8::gemm_phase(lds, g, S, E); }
            {
                const int Gn = G, rem = 672 % Gn, NE = Gn - rem, e = cu - rem;
                pg8::ListOrder Sq{0, (e >= 0) ? 96 : 0, 3, (e >= 0) ? e : 0, NE}, Skv{96, (e >= 0) ? 224 : 96, 4, (e >= 0) ? e : 0, NE};
                if (opaque_tid() == 0) {
                    unsigned char* ws = wsbase(); unsigned* dep = (unsigned*)(ws + CTL_DEP) + (l * 2 + hf) * 32; pg8::Unit u;
                    for (int pass = 0; pass < 2; ++pass)
                        for (int i = 0; pass == 0 ? Sq.next(i, u) : Skv.next(i, u); ++i) {
                            unsigned sp = 0;
                            while (__hip_atomic_load(dep + u.pm, __ATOMIC_RELAXED, __HIP_MEMORY_SCOPE_AGENT) < 24u) { __builtin_amdgcn_s_sleep(2); if (++sp > (1u << 24)) break; }
                        }
                    __builtin_amdgcn_fence(__ATOMIC_ACQUIRE, "agent");
                    asm volatile("s_waitcnt vmcnt(0)" ::: "memory");
                }
                __syncthreads();
                { unsigned char* ws = wsbase();
                  pg8::Gemm g{H_ + C_CQL, WT_ + OFF_WUQ, HP, 384};
                  pg8::EpiUp<0> E{QB_, KB_, VB_, STQ_ + (size_t)hf * HM * 8, ROPE_}; pg8::gemm_phase(lds, g, Sq, E); }
                { unsigned char* ws = wsbase();
                  pg8::Gemm g{H_ + C_CKV, WT_ + OFF_WUKV, HP, 256};
                  pg8::EpiUp<1> E{QB_, KB_, VB_, STKV_ + (size_t)hf * HM * 4, ROPE_}; pg8::gemm_phase(lds, g, Skv, E); }
            }
            GSYNC();
            {
                for (int vcu = cu; vcu < 256; vcu += G)
                for (int step = 0; ; ++step) {
                    KParams P = kparams(); unsigned char* ws = P->ws;
                    const int x = vcu & 7, sl_ = vcu >> 3;
                    int type, u, bh;
                    if (step < 2) {
                        if (sl_ < 16) { type = 2; bh = 2 * x + (sl_ >> 3); const int j = sl_ & 7; u = (step == 0) ? 15 - j : j; }
                        else { const int t = sl_ - 16; bh = 4 * x + (t >> 2); type = step; u = 7 - (t & 3); }
                    } else {
                        if (opaque_tid() == 0) *(LAS int*)(lds + LDS_IDX) = (int)atomicAdd((unsigned*)(ws + WS_CTL) + 16 + (l * 2 + hf) * 8 + x, 1u);
                        __syncthreads();
                        const int k = *(LAS int*)(lds + LDS_IDX);
                        __syncthreads();
                        if (k >= 32) break;
                        u = 3 - (k >> 3); type = (k & 4) ? 0 : 1; bh = 4 * x + (k & 3);
                    }
                    if (type == 0) {
                        const int bl = bh >> 3, h = bh & 7, bg = 4 * hf + bl; const size_t ho = (size_t)bh * SEQ * 64;
                        const float sl = __builtin_amdgcn_exp2f(-(2.f / 3.f) * (float)(h + (h >> 1) + 2)) * LOG2E;
                        attn_unit<64, 64, 64, 256, true, true, true, 2>((LAS char*)lds, H_ + HM_AQ + ho, 64, H_ + HM_AK + ho, 64, H_ + HM_AV + ho, 64,
                            H_ + (size_t)bl * SEQ * HP + C_AZ + h * 64, HP,
                            Y_ + (size_t)bg * SEQ * 1536 + h * 64, 1536, u * 256, sl, KMP_ + (size_t)bg * 8 * 2 * 512 + h * 64, 0.f, nullptr, 1.f);
                    } else if (type == 1) {
                        const int bl = bh >> 3, h = bh & 7, bg = 4 * hf + bl;
                        attn_unit<96, 96, 64, 256, false, false, true, 2>((LAS char*)lds, QB_ + (size_t)bh * SEQ * 96, 96, KB_ + (size_t)bh * SEQ * 96, 96,
                            VB_ + (size_t)bh * SEQ * 64, 64, H_ + (size_t)bl * SEQ * HP + C_BZ + h * 64, HP,
                            Y_ + 512 + (size_t)bg * SEQ * 1536 + h * 64, 1536, u * 256, 0.f, nullptr, 0.f, nullptr, 1.f);
                    } else {
                        const int bl = bh >> 2, h = bh & 3, bg = 4 * hf + bl; const size_t ho = (size_t)bh * SEQ * 128;
                        const float sl = __builtin_amdgcn_exp2f(-(2.f / 3.f) * (float)(3 * h + 1)) * LOG2E;
                        const float lam = ((const float*)(ws + CTL_LAM))[l];
                        const float post = (l == 0) ? 0.8f : (1.f - 0.35550906759096924f);
                        attn_unit<64, 128, 128, 128, true, false, false, 1>((LAS char*)lds, H_ + HM_CQ + ho, 128, H_ + HM_CK + ho, 128, H_ + HM_CV + ho, 128,
                            H_ + (size_t)bl * SEQ * HP + C_CZ + h * 128, HP,
                            Y_ + 1024 + (size_t)bg * SEQ * 1536 + h * 128, 1536, u * 128, sl, nullptr, lam, P->in[8] + l * 128, post);
                    }
                }
            }
            GSYNC();
        }
        { KParams P = kparams(); unsigned char* ws = P->ws;
          pg8::Gemm g{XB_, WT_ + OFF_WIN + (size_t)5376 * 1024, D, D}; pg8::StaticOrder S; S.init(M, 3072, G, cu);
          pg8::EpiG E{H_, P->in[13] + l * 3072}; pg8::gemm_phase(lds, g, S, E); }
        GSYNC();
        { unsigned char* ws = wsbase();
          pg8::Gemm g{Y_, WT_ + OFF_WABC, 1536, 1536}; pg8::MergeOrder S{cu, G};
          pg8::EpiMerge E{H_, XB_}; pg8::MergeHook HK{H_}; pg8::gemm_phase(lds, g, S, E, HK); }
        GSYNC();
        { KParams P = kparams(); unsigned char* ws = P->ws;
          pg8::Gemm g{XB_, WT_ + OFF_WO, D, D}; pg8::StaticOrder S; S.init(M, D, G, cu);
          pg8::EpiR E{(l == 0) ? P->in[0] : (const float*)P->out, R_, Y_}; pg8::gemm_phase(lds, g, S, E); }
        GSYNC();
        { unsigned char* ws = wsbase();
          pg8::Gemm g{PB_, WT_ + OFF_WP, 256, 256}; pg8::StaticOrder S; S.init(M, D, G, cu);
          pg8::EpiBf E{XB_}; pg8::gemm_phase(lds, g, S, E); }
        { unsigned char* ws = wsbase();
          pg8::Gemm g{Y_, WT_ + OFF_WPG, D, D}; pg8::StaticOrder S; S.init(M, D, G, cu);
          pg8::EpiR2 E{R_, XB_}; pg8::gemm_phase(lds, g, S, E); }
        GSYNC();
        {
            KParams P = kparams(); unsigned char* ws = P->ws;
            const int tid = opaque_tid(), lane = tid & 63, wid = tid >> 6;
            const float* lg = P->in[15] + l * 1024; const float* lb = P->in[16] + l * 1024;
            float* outp = P->out; const float* R = R_; bf16_t* XB = XB_;
            const int gstep = (int)gridDim.x * 8;
            for (int row = (int)blockIdx.x * 8 + wid; row < M; row += 2 * gstep) {
                const bool two = row + gstep < M;
                const float* rp0 = R + (size_t)row * 1024; const float* rp1 = R + (size_t)(two ? row + gstep : row) * 1024;
                f32x4 v[2][4]; float s0 = 0.f, s1 = 0.f;
#pragma unroll
                for (int j = 0; j < 4; ++j) { v[0][j] = __builtin_nontemporal_load((const f32x4*)(rp0 + 4 * lane + 256 * j)); v[1][j] = __builtin_nontemporal_load((const f32x4*)(rp1 + 4 * lane + 256 * j)); }
#pragma unroll
                for (int j = 0; j < 4; ++j) { s0 += (v[0][j][0] + v[0][j][1]) + (v[0][j][2] + v[0][j][3]); s1 += (v[1][j][0] + v[1][j][1]) + (v[1][j][2] + v[1][j][3]); }
#pragma unroll
                for (int k = 1; k < 64; k <<= 1) { s0 += __shfl_xor(s0, k); s1 += __shfl_xor(s1, k); }
                const float mu0 = s0 * (1.f / 1024.f), mu1 = s1 * (1.f / 1024.f); float q0 = 0.f, q1 = 0.f;
#pragma unroll
                for (int j = 0; j < 4; ++j) { v[0][j] -= mu0; v[1][j] -= mu1;
                    q0 += (v[0][j][0] * v[0][j][0] + v[0][j][1] * v[0][j][1]) + (v[0][j][2] * v[0][j][2] + v[0][j][3] * v[0][j][3]);
                    q1 += (v[1][j][0] * v[1][j][0] + v[1][j][1] * v[1][j][1]) + (v[1][j][2] * v[1][j][2] + v[1][j][3] * v[1][j][3]); }
#pragma unroll
                for (int k = 1; k < 64; k <<= 1) { q0 += __shfl_xor(q0, k); q1 += __shfl_xor(q1, k); }
                const float rs0 = __builtin_amdgcn_rsqf(q0 * (1.f / 1024.f) + 1e-5f), rs1 = __builtin_amdgcn_rsqf(q1 * (1.f / 1024.f) + 1e-5f);
#pragma unroll
                for (int j = 0; j < 4; ++j) { const f32x4 gv = *(const f32x4*)(lg + 4 * lane + 256 * j), bv = *(const f32x4*)(lb + 4 * lane + 256 * j);
#pragma unroll
                    for (int t = 0; t < 2; ++t) { if (t == 1 && !two) break;
                        const size_t rr = (size_t)(t == 0 ? row : row + gstep);
                        const f32x4 y = v[t][j] * (t == 0 ? rs0 : rs1) * gv + bv;
                        __builtin_nontemporal_store(y, (f32x4*)(outp + rr * 1024 + 4 * lane + 256 * j));
                        if (l == 0) { u32x2 w; w.x = pk2(y[0], y[1]); w.y = pk2(y[2], y[3]); *(u32x2*)(XB + rr * 1024 + 4 * lane + 256 * j) = w; } } }
            }
            if (l == 0) {
                __syncthreads();
                convert_weights(P, 1, WT_, (LAS float*)lds);
                convert_rows(P->in[1] + (size_t)M * 256, PB_, (size_t)M * 256);
            }
        }
        if (l == 0) GSYNC();
    }
}

#undef G
#undef cu
extern "C" void kernel_launch(void* const* d_in, const int* in_sizes, int n_in, void* d_out, int out_size, void* d_ws, size_t ws_size, hipStream_t stream) {
    static int grid_blocks = 0;
    if (grid_blocks == 0) {
        if (n_in != 19 || out_size != M * D || ws_size < WS_END) { fprintf(stderr, "kernel_launch: unexpected problem (n_in %d out %d ws %zu)\n", n_in, out_size, ws_size); grid_blocks = -1; return; }
        int dev = 0, cus = 0, per_cu = 0;
        hipGetDevice(&dev);
        hipDeviceGetAttribute(&cus, hipDeviceAttributeMultiprocessorCount, dev);
        if (hipFuncSetAttribute((const void*)fwd_megakernel, hipFuncAttributeMaxDynamicSharedMemorySize, LDS_BYTES) != hipSuccess) { fprintf(stderr, "kernel_launch: hipFuncSetAttribute failed\n"); grid_blocks = -1; return; }
        if (hipOccupancyMaxActiveBlocksPerMultiprocessor(&per_cu, (const void*)fwd_megakernel, 512, LDS_BYTES) != hipSuccess || per_cu < 1) { fprintf(stderr, "kernel_launch: occupancy query failed (%d)\n", per_cu); grid_blocks = -1; return; }
        grid_blocks = cus * per_cu;
        if (grid_blocks > 256) grid_blocks = 256;
    }
    if (grid_blocks < 0) return;
    Params p{};
    for (int i = 0; i < 19; ++i) p.in[i] = (const float*)d_in[i];
    p.out = (float*)d_out; p.ws = (unsigned char*)d_ws;
    void* args[] = {&p};
    hipError_t e = hipLaunchCooperativeKernel((const void*)fwd_megakernel, dim3(grid_blocks), dim3(512), args, LDS_BYTES, stream);
    if (e != hipSuccess) fprintf(stderr, "cooperative launch failed: %s (grid %d)\n", hipGetErrorString(e), grid_blocks);
}
```

```cpp
#include <hip/hip_runtime.h>
#include <hip/hip_cooperative_groups.h>
#include <cstdio>
#include <cstdint>
namespace cg = cooperative_groups;
#ifndef REP_ATT
#define REP_ATT 1
#endif
#ifndef REP_P1
#define REP_P1 1
#endif
#ifndef REP_P0
#define REP_P0 1
#endif

#define LAS __attribute__((address_space(3)))
#define DI __device__ __forceinline__
typedef unsigned short bf16_t;
typedef short bf16x8 __attribute__((ext_vector_type(8)));
typedef short s16x4 __attribute__((ext_vector_type(4)));
typedef float f32x2 __attribute__((ext_vector_type(2)));
typedef float f32x4 __attribute__((ext_vector_type(4)));
typedef float f32x16 __attribute__((ext_vector_type(16)));
typedef unsigned u32x4 __attribute__((ext_vector_type(4)));
typedef unsigned u32x2 __attribute__((ext_vector_type(2)));
typedef __bf16 bf16x2_t __attribute__((ext_vector_type(2)));

constexpr int M = 16384, D = 1024, SEQ = 2048, HM = 8192;
constexpr int HP = 2304;
constexpr int NH1 = 5376;
constexpr int NWIN = 8448;
constexpr float LOG2E = 1.4426950408889634f;
constexpr float QS64 = 0.125f * LOG2E;
constexpr float QS96 = 0.10206207261596575f * LOG2E;
constexpr float ALPHA = 1.4142135623730951f;
constexpr int C_AZ = 0, C_BZ = 512, C_CZ = 1024, C_CKV = 1536, C_CQL = 1792;
constexpr size_t HM_AQ = (size_t)18 * 1048576, HM_AK = (size_t)22 * 1048576, HM_AV = (size_t)26 * 1048576, HM_CQ = (size_t)30 * 1048576, HM_CK = (size_t)34 * 1048576, HM_CV = (size_t)38 * 1048576;

constexpr size_t MiB = 1048576;
constexpr size_t WS_CTL = 0, WS_XB = 2 * MiB, WS_WT = 34 * MiB, WS_PB = 60 * MiB, WS_Y = 68 * MiB, WS_H = 116 * MiB, WS_MLA = 200 * MiB, WS_END = 232 * MiB;
constexpr size_t CTL_DEP = 8192, CTL_BAR = 16384, CTL_LAM = 4096, CTL_ROPE = 65536, CTL_KMP = 384 * 1024, CTL_STQ = 640 * 1024, CTL_STKV = 1152 * 1024;
constexpr size_t OFF_WIN = 0, OFF_WUQ = 8650752, OFF_WUKV = 8945664, OFF_WABC = 9207808, OFF_WO = 10780672, OFF_WPG = 11829248, OFF_WP = 12877824;
constexpr int LDS_BYTES = 132 * 1024, LDS_IDX = 131072;

DI int opaque_s(int v) { asm volatile("" : "+s"(v)); return v; }
DI int opaque_tid() { int t = threadIdx.x; asm volatile("" : "+v"(t)); return t; }
DI unsigned pk2(float lo, float hi) { f32x2 v = {lo, hi}; bf16x2_t b = __builtin_convertvector(v, bf16x2_t); return __builtin_bit_cast(unsigned, b); }
DI float bflo(unsigned w) { return __uint_as_float(w << 16); }
DI float bfhi(unsigned w) { return __uint_as_float(w & 0xffff0000u); }
DI float bf2f(bf16_t b) { return __uint_as_float((unsigned)b << 16); }
DI bf16_t f2bf(float f) { return (bf16_t)(pk2(f, 0.f) & 0xffffu); }
DI float sigm(float x) { return __builtin_amdgcn_rcpf(1.f + __builtin_amdgcn_exp2f(-x * LOG2E)); }
DI float silu(float x) { return x * sigm(x); }
DI u32x4 pack8(const f32x4 a, const f32x4 b) { u32x4 w; w.x = pk2(a[0], a[1]); w.y = pk2(a[2], a[3]); w.z = pk2(b[0], b[1]); w.w = pk2(b[2], b[3]); return w; }
DI void unpack8(const u32x4 w, f32x4& a, f32x4& b) { a = (f32x4){bflo(w.x), bfhi(w.x), bflo(w.y), bfhi(w.y)}; b = (f32x4){bflo(w.z), bfhi(w.z), bflo(w.w), bfhi(w.w)}; }

namespace pg8 {
constexpr int BM = 256, BK = 64, HALF = 128, HTB = HALF * BK * 2, NXCD = 8, WGM = 8;
__host__ __device__ __forceinline__ int lds_byte(int r, int c) { const int st = (r >> 4) * 2 + (c >> 5), rr = r & 15, cc = c & 31, ob = rr * 64 + cc * 2; return st * 1024 + (ob ^ (((ob >> 9) & 1) << 5)); }
__host__ __device__ __forceinline__ void stage_rc(int b, int& R, int& C) { const int st = b / 1024, sb = b % 1024, swz = sb ^ (((sb >> 9) & 1) << 5); R = (st >> 1) * 16 + swz / 64; C = (st & 1) * 32 + (swz % 64) / 2; }
__host__ __device__ __forceinline__ int perm32(int rho) { const int n = rho >> 4, i = rho & 15; return 8 * (i >> 2) + 4 * n + (i & 3); }

struct Unit { int pm, pn; };
struct Gemm { const bf16_t* A; const bf16_t* Bt; int lda, K; };

struct StaticOrder {
    int nM, nN, nwg, G, c;
    DI void init(int M_, int N_, int G_, int c_) { nM = M_ / BM; nN = N_ / BM; nwg = nM * nN; G = G_; c = c_; }
    DI bool next(int i, Unit& u) const {
        const long L = (long)i * G + c; if (L >= nwg) return false;
        int wgid = (int)L; { const int q = nwg / NXCD, r = nwg % NXCD, xcd = wgid % NXCD, off = wgid / NXCD; wgid = (xcd < r ? xcd * (q + 1) : r * (q + 1) + (xcd - r) * q) + off; }
        const int nig = WGM * nN, gid = wgid / nig, fm = gid * WGM, gsz = (nM - fm) < WGM ? (nM - fm) : WGM;
        u.pm = fm + ((wgid % nig) % gsz); u.pn = (wgid % nig) / gsz; return true;
    }
};
struct P1Order {
    int G, c;
    DI bool next(int i, Unit& u) const {
        const long L = (long)i * G + c; if (L >= 672) return false;
        if (L < 96) { u.pm = (int)L / 3; u.pn = 18 + (int)L % 3; return true; }
        const int nM = 32, nN = 18, nwg = 576;
        int wgid = (int)L - 96; { const int q = nwg / NXCD, r = nwg % NXCD, xcd = wgid % NXCD, off = wgid / NXCD; wgid = (xcd < r ? xcd * (q + 1) : r * (q + 1) + (xcd - r) * q) + off; }
        const int nig = WGM * nN, gid = wgid / nig, fm = gid * WGM, gsz = (nM - fm) < WGM ? (nM - fm) : WGM;
        u.pm = fm + ((wgid % nig) % gsz); u.pn = (wgid % nig) / gsz; return true;
    }
};
struct ListOrder {
    int lo, hi, nN, c, G;
    DI bool next(int i, Unit& u) const {
        int k0 = 0; if (c < lo) k0 = (lo - c + G - 1) / G;
        const int idx = c + (k0 + i) * G; if (idx >= hi) return false;
        const int loc = idx - lo; u.pm = loc / nN; u.pn = loc % nN; return true;
    }
};
struct MergeOrder {
    int c, G;
    DI bool next(int i, Unit& u) const {
        int tile = c + i * G; if (tile >= 256) return false;
        if (G == 256) tile = (c & 7) * 32 + (c >> 3);
        u.pm = tile >> 2; u.pn = tile & 3; return true;
    }
};

struct NoHook { static constexpr bool ACTIVE = false; template <class A> DI void operator()(A&, const Unit&, int, int, int, int, int) const {} };
template <class Epi, class Sched, class Hook = NoHook>
DI void gemm_phase(LAS unsigned char* lds, const Gemm g, const Sched& S, const Epi& E, const Hook& HK = Hook()) {
    const int tid = opaque_tid(), wid = __builtin_amdgcn_readfirstlane(tid >> 6), lane = tid & 63, wr = wid >> 2, wc = wid & 3, fr = lane & 15, fq = lane >> 4;
    const int K = g.K, nt = K / BK, lda = g.lda;
    unsigned voffA[2], voffB[2];
#pragma unroll
    for (int i = 0; i < 2; ++i) { int R, C; stage_rc(tid * 16 + i * 8192, R, C); const int Rb = (R & ~31) + perm32(R & 31);
        voffA[i] = (unsigned)(R * lda + C) * 2u; voffB[i] = (unsigned)(Rb * K + C) * 2u; }
    const size_t kstep = (size_t)(BK * 2);
    const size_t hstepA = (size_t)HALF * lda * 2, hstepB = (size_t)HALF * K * 2;
    const size_t tstepA = 2 * hstepA, tstepB = 2 * hstepB;
    const unsigned ldsw = (unsigned)wid * 1024u;
    const int aoff = lds_byte(wr * 64 + fr, fq * 8), boff = lds_byte(wc * 32 + fr, fq * 8);
#define PG8_SA(b, h) (((b) * 2 + (h)) * HTB)
#define PG8_SB(b, h) ((4 + (b) * 2 + (h)) * HTB)
#define PG8_STAGE(bufoff, gbase, voff) do { _Pragma("unroll") for (int _i = 0; _i < 2; ++_i) \
        __builtin_amdgcn_global_load_lds((const unsigned*)((const char*)(gbase) + (voff)[_i]), (LAS unsigned*)(lds + (bufoff) + ldsw + _i * 8192), 16, 0, 0); } while (0)
#define PG8_LDA(dst, b, h) do { _Pragma("unroll") for (int m = 0; m < 4; ++m) _Pragma("unroll") for (int k = 0; k < 2; ++k) dst[m][k] = *(const LAS bf16x8*)(lds + PG8_SA(b, h) + aoff + m * 2048 + k * 1024); } while (0)
#define PG8_LDB(dst, b, h) do { _Pragma("unroll") for (int n = 0; n < 2; ++n) _Pragma("unroll") for (int k = 0; k < 2; ++k) dst[n][k] = *(const LAS bf16x8*)(lds + PG8_SB(b, h) + boff + n * 2048 + k * 1024); } while (0)
#define PG8_MMA(ai, bj, At, Bt) do { __builtin_amdgcn_s_setprio(1); _Pragma("unroll") for (int m = 0; m < 4; ++m) _Pragma("unroll") for (int n = 0; n < 2; ++n) _Pragma("unroll") for (int k = 0; k < 2; ++k) \
        acc[ai][bj][m][n] = __builtin_amdgcn_mfma_f32_16x16x32_bf16(Bt[n][k], At[m][k], acc[ai][bj][m][n], 0, 0, 0); __builtin_amdgcn_s_setprio(0); } while (0)
#define PG8_WAIT_V(n) asm volatile("s_waitcnt vmcnt(" #n ")" ::: "memory")
#define PG8_WAIT_L(n) asm volatile("s_waitcnt lgkmcnt(" #n ")" ::: "memory")
#define PG8_BAR __builtin_amdgcn_s_barrier()
#define PG8_SCHED __builtin_amdgcn_sched_barrier(0)
    Unit cur, nxt; int ui = 0;
    if (!S.next(0, cur)) return;
    f32x4 acc[2][2][4][2];
#pragma unroll
    for (int a = 0; a < 2; ++a)
#pragma unroll
        for (int b = 0; b < 2; ++b)
#pragma unroll
            for (int m = 0; m < 4; ++m)
#pragma unroll
                for (int n = 0; n < 2; ++n) acc[a][b][m][n] = (f32x4){0.f, 0.f, 0.f, 0.f};
    bf16x8 At[4][2], B0[2][2], B1[2][2];
    const char* cA = (const char*)g.A + (size_t)cur.pm * tstepA; const char* cB = (const char*)g.Bt + (size_t)cur.pn * tstepB;
    PG8_STAGE(PG8_SB(0, 0), cB, voffB); PG8_STAGE(PG8_SB(0, 1), cB + hstepB, voffB); PG8_STAGE(PG8_SA(0, 0), cA, voffA); PG8_STAGE(PG8_SA(0, 1), cA + hstepA, voffA);
    if (wr == 1) PG8_BAR;
    PG8_WAIT_V(2); PG8_BAR;
    PG8_STAGE(PG8_SB(1, 0), cB + kstep, voffB); PG8_STAGE(PG8_SA(1, 0), cA + kstep, voffA); PG8_STAGE(PG8_SB(1, 1), cB + hstepB + kstep, voffB);
    PG8_WAIT_V(6); PG8_BAR;
    for (;;) {
        const bool has_next = S.next(ui + 1, nxt);
        const char* nA = has_next ? (const char*)g.A + (size_t)nxt.pm * tstepA : cA; const char* nB = has_next ? (const char*)g.Bt + (size_t)nxt.pn * tstepB : cB;
#pragma nounroll
        for (int t = 0; t < nt; t += 2) {
            if (Hook::ACTIVE) { if (t == 8 || t == 16) { HK(acc, cur, t, wr, wc, fr, fq); asm volatile("s_waitcnt vmcnt(0)" ::: "memory"); } }
            const bool last = (t == nt - 2);
            const char* a1 = cA + (size_t)(t + 1) * kstep;
            const char* a2 = last ? nA : cA + (size_t)(t + 2) * kstep; const char* b2 = last ? nB : cB + (size_t)(t + 2) * kstep;
            const char* a3 = a2 + kstep; const char* b3 = b2 + kstep;
            PG8_LDB(B0, 0, 0); PG8_LDB(B1, 0, 1); PG8_SCHED; PG8_LDA(At, 0, 0); PG8_STAGE(PG8_SA(1, 1), a1 + hstepA, voffA);
            PG8_WAIT_V(8); PG8_WAIT_L(0); PG8_BAR; PG8_MMA(0, 0, At, B0); PG8_MMA(0, 1, At, B1); PG8_BAR; PG8_SCHED;
            PG8_LDA(At, 0, 1); PG8_STAGE(PG8_SB(0, 0), b2, voffB); PG8_STAGE(PG8_SB(0, 1), b2 + hstepB, voffB); PG8_STAGE(PG8_SA(0, 0), a2, voffA);
            PG8_WAIT_V(8); PG8_WAIT_L(0); PG8_BAR; PG8_MMA(1, 0, At, B0); PG8_MMA(1, 1, At, B1); PG8_BAR; PG8_SCHED;
            PG8_LDB(B0, 1, 0); PG8_LDB(B1, 1, 1); PG8_SCHED; PG8_LDA(At, 1, 0); PG8_STAGE(PG8_SA(0, 1), a2 + hstepA, voffA);
            PG8_WAIT_V(8); PG8_WAIT_L(0); PG8_BAR; PG8_MMA(0, 0, At, B0); PG8_MMA(0, 1, At, B1); PG8_BAR; PG8_SCHED;
            PG8_LDA(At, 1, 1); PG8_STAGE(PG8_SB(1, 0), b3, voffB); PG8_STAGE(PG8_SB(1, 1), b3 + hstepB, voffB); PG8_STAGE(PG8_SA(1, 0), a3, voffA);
            PG8_WAIT_V(8); PG8_WAIT_L(0); PG8_BAR; PG8_MMA(1, 0, At, B0); PG8_MMA(1, 1, At, B1); PG8_BAR; PG8_SCHED;
        }
        if (wr == 0) PG8_BAR;
        E(acc, cur, wr, wc, fr, fq);
        if (!has_next) break;
#pragma unroll
        for (int a = 0; a < 2; ++a)
#pragma unroll
            for (int b = 0; b < 2; ++b)
#pragma unroll
                for (int m = 0; m < 4; ++m)
#pragma unroll
                    for (int n = 0; n < 2; ++n) acc[a][b][m][n] = (f32x4){0.f, 0.f, 0.f, 0.f};
        cur = nxt; cA = nA; cB = nB; ++ui;
        if (wr == 1) PG8_BAR;
    }
    PG8_WAIT_V(0);
    PG8_BAR;
#undef PG8_SA
#undef PG8_SB
#undef PG8_STAGE
#undef PG8_LDA
#undef PG8_LDB
#undef PG8_MMA
#undef PG8_WAIT_V
#undef PG8_WAIT_L
#undef PG8_BAR
#undef PG8_SCHED
}
typedef f32x4 Acc[2][2][4][2];

struct EpiH {
    bf16_t* H; bf16_t* KB; float* KMP; float* STQ; float* STKV; const float* rope; unsigned* dep;
    DI void operator()(const Acc& acc, const Unit& u, int wr, int wc, int fr, int fq) const {
        const int row0 = u.pm * BM + wr * 64 + fr;
        {
            const int pn = u.pn; bf16_t* base; int hw = 0, cseg;
            if (pn < 6) { base = H + (pn < 2 ? HM_AQ : pn < 4 ? HM_AK : HM_AV); hw = 64; cseg = (pn & 1) * 256; }
            else if (pn < 10) { base = H + (pn < 8 ? C_AZ : C_BZ); cseg = (pn & 1) * 256; }
            else if (pn < 16) { base = H + (pn < 12 ? HM_CQ : pn < 14 ? HM_CK : HM_CV); hw = 128; cseg = (pn & 1) * 256; }
            else if (pn < 18) { base = H + C_CZ; cseg = (pn & 1) * 256; }
            else { base = H + C_CKV; cseg = (pn - 18) * 256; }
            const int bl = u.pm >> 3, s0 = (u.pm & 7) * 256 + wr * 64 + fr;
#pragma unroll
            for (int bj = 0; bj < 2; ++bj) { const int cs = cseg + bj * HALF + wc * 32 + 8 * fq;
                bf16_t* colp; size_t pitch;
                if (hw == 64) { colp = base + ((size_t)(bl * 8 + (cs >> 6)) * SEQ) * 64 + (cs & 63); pitch = 64; }
                else if (hw == 128) { colp = base + ((size_t)(bl * 4 + (cs >> 7)) * SEQ) * 128 + (cs & 127); pitch = 128; }
                else { colp = base + (size_t)bl * SEQ * HP + cs; pitch = HP; }
#pragma unroll
                for (int ai = 0; ai < 2; ++ai)
#pragma unroll
                    for (int m = 0; m < 4; ++m) *(u32x4*)(colp + (size_t)(s0 + ai * HALF + m * 16) * pitch) = pack8(acc[ai][bj][m][0], acc[ai][bj][m][1]); }
        }
        if (u.pn == 2 || u.pn == 3) {
            float* dst = KMP + (size_t)(u.pm * 2 + wr) * 512 + (u.pn - 2) * 256 + wc * 32 + 8 * fq;
#pragma unroll
            for (int bj = 0; bj < 2; ++bj)
#pragma unroll
                for (int n = 0; n < 2; ++n) { f32x4 s = (f32x4){0.f, 0.f, 0.f, 0.f};
#pragma unroll
                    for (int ai = 0; ai < 2; ++ai)
#pragma unroll
                        for (int m = 0; m < 4; ++m) s += acc[ai][bj][m][n];
#pragma unroll
                    for (int e = 0; e < 4; ++e) { float v = s[e]; v += __shfl_xor(v, 1); v += __shfl_xor(v, 2); v += __shfl_xor(v, 4); v += __shfl_xor(v, 8); s[e] = v; }
                    if (fr == 0) *(f32x4*)(dst + bj * HALF + 4 * n) = s; }
        }
        if (u.pn >= 18) {
#pragma unroll
            for (int ai = 0; ai < 2; ++ai)
#pragma unroll
                for (int m = 0; m < 4; ++m) { const int row = row0 + ai * HALF + m * 16; float ss = 0.f;
#pragma unroll
                    for (int bj = 0; bj < 2; ++bj) { if (u.pn == 20 && bj == 1) continue;
#pragma unroll
                        for (int n = 0; n < 2; ++n) { const f32x4 x = acc[ai][bj][m][n]; ss += (x[0] * x[0] + x[1] * x[1]) + (x[2] * x[2] + x[3] * x[3]); } }
                    ss += __shfl_xor(ss, 16); ss += __shfl_xor(ss, 32);
                    if (fq == 0) { if (u.pn == 18) STKV[(size_t)row * 4 + wc] = ss; else STQ[(size_t)row * 8 + (u.pn - 19) * 4 + wc] = ss; }
                    if (u.pn == 20 && wc == 0) {
                        const int pos = row & (SEQ - 1); f32x4 o[2];
#pragma unroll
                        for (int n = 0; n < 2; ++n) { const f32x4 cs = *(const f32x4*)(rope + ((size_t)pos * 16 + 4 * fq + 2 * n) * 2); const f32x4 t = acc[ai][1][m][n];
                            o[n] = (f32x4){t[0] * cs[0] - t[1] * cs[1], t[0] * cs[1] + t[1] * cs[0], t[2] * cs[2] - t[3] * cs[3], t[2] * cs[3] + t[3] * cs[2]}; }
                        const u32x4 w = pack8(o[0], o[1]);
#pragma unroll
                        for (int h = 0; h < 8; ++h) *(u32x4*)(KB + ((size_t)((row >> 11) * 8 + h) * SEQ + pos) * 96 + 64 + 8 * fq) = w;
                    }
                }
        }
        if (u.pn >= 18) {
            asm volatile("s_waitcnt vmcnt(0)" ::: "memory");
            __syncthreads();
            if (threadIdx.x == 0) {
                __builtin_amdgcn_fence(__ATOMIC_RELEASE, "agent");
                asm volatile("s_waitcnt vmcnt(0)" ::: "memory");
                __hip_atomic_fetch_add(dep + u.pm, 8u, __ATOMIC_RELAXED, __HIP_MEMORY_SCOPE_AGENT);
            }
        }
    }
};
template <int MODE> struct EpiUp {
    bf16_t* QB; bf16_t* KB; bf16_t* VB; const float* ST; const float* rope;
    DI void operator()(const Acc& acc, const Unit& u, int wr, int wc, int fr, int fq) const {
        const int row0 = u.pm * BM + wr * 64 + fr;
#pragma unroll
        for (int ai = 0; ai < 2; ++ai)
#pragma unroll
            for (int m = 0; m < 4; ++m) { const int row = row0 + ai * HALF + m * 16; float sc;
                if (MODE == 0) { const f32x4 a = *(const f32x4*)(ST + (size_t)row * 8), b = *(const f32x4*)(ST + (size_t)row * 8 + 4);
                    sc = __builtin_amdgcn_rsqf(((a[0] + a[1]) + (a[2] + a[3]) + (b[0] + b[1]) + (b[2] + b[3])) * (1.f / 384.f) + 1e-6f) * QS96; }
                else { const f32x4 a = *(const f32x4*)(ST + (size_t)row * 4); sc = __builtin_amdgcn_rsqf(((a[0] + a[1]) + (a[2] + a[3])) * (1.f / 256.f) + 1e-6f); }
                const int pos = row & (SEQ - 1);
#pragma unroll
                for (int bj = 0; bj < 2; ++bj) { const int c0 = u.pn * BM + bj * HALF + wc * 32 + 8 * fq;
                    f32x4 v0 = acc[ai][bj][m][0] * sc, v1 = acc[ai][bj][m][1] * sc;
                    if (MODE == 0) { const int j = c0 % 96;
                        if (j >= 64) { const int i0 = (j - 64) >> 1; const f32x4 ca = *(const f32x4*)(rope + ((size_t)pos * 16 + i0) * 2), cb = *(const f32x4*)(rope + ((size_t)pos * 16 + i0 + 2) * 2);
                            v0 = (f32x4){v0[0] * ca[0] - v0[1] * ca[1], v0[0] * ca[1] + v0[1] * ca[0], v0[2] * ca[2] - v0[3] * ca[3], v0[2] * ca[3] + v0[3] * ca[2]};
                            v1 = (f32x4){v1[0] * cb[0] - v1[1] * cb[1], v1[0] * cb[1] + v1[1] * cb[0], v1[2] * cb[2] - v1[3] * cb[3], v1[2] * cb[3] + v1[3] * cb[2]}; }
                        *(u32x4*)(QB + ((size_t)((row >> 11) * 8 + c0 / 96) * SEQ + pos) * 96 + j) = pack8(v0, v1); }
                    else { if (c0 < 512) *(u32x4*)(KB + ((size_t)((row >> 11) * 8 + (c0 >> 6)) * SEQ + pos) * 96 + (c0 & 63)) = pack8(v0, v1);
                           else *(u32x4*)(VB + ((size_t)((row >> 11) * 8 + ((c0 - 512) >> 6)) * SEQ + pos) * 64 + (c0 & 63)) = pack8(v0, v1); }
                }
            }
    }
};
DI size_t gfrag(int pm, int pnn, int wr, int wc, int fr, int fq) { return ((size_t)(pm * 12 + pnn) * 65536) + (size_t)(((wr * 4 + wc) * 64 + fq * 16 + fr) * 8); }
struct EpiG {
    bf16_t* G; const float* bias;
    DI void operator()(const Acc& acc, const Unit& u, int wr, int wc, int fr, int fq) const {
        const int row0 = u.pm * BM + wr * 64 + fr, col0 = u.pn * BM + wc * 32 + 8 * fq;
        f32x4 bv[2][2];
#pragma unroll
        for (int bj = 0; bj < 2; ++bj)
#pragma unroll
            for (int n = 0; n < 2; ++n) bv[bj][n] = *(const f32x4*)(bias + col0 + bj * HALF + 4 * n);
#pragma unroll
        for (int ai = 0; ai < 2; ++ai)
#pragma unroll
            for (int m = 0; m < 4; ++m) { bf16_t* rowp = G + gfrag(u.pm, u.pn, wr, wc, fr, fq) + (size_t)((ai * 4 + m) * 2) * 4096;
#pragma unroll
                for (int bj = 0; bj < 2; ++bj) { f32x4 v0 = acc[ai][bj][m][0] + bv[bj][0], v1 = acc[ai][bj][m][1] + bv[bj][1];
#pragma unroll
                    for (int e = 0; e < 4; ++e) { v0[e] = fmaxf(sigm(v0[e]), 1e-12f); v1[e] = fmaxf(sigm(v1[e]), 1e-12f); }
                    *(u32x4*)(rowp + bj * 4096) = pack8(v0, v1); } }
    }
};
struct MergeHook {
    static constexpr bool ACTIVE = true;
    const bf16_t* G;
    DI void operator()(Acc& acc, const Unit& u, int t, int wr, int wc, int fr, int fq) const {
        const int seg = (t == 8) ? 0 : 1;
        const int row0 = u.pm * BM + wr * 64 + fr, col0 = u.pn * BM + wc * 32 + 8 * fq;
        const bf16_t* gp = G + gfrag(u.pm, seg * 4 + u.pn, wr, wc, fr, fq);
#pragma unroll
        for (int ai = 0; ai < 2; ++ai) {
            u32x4 ga[8], gb[8];
#pragma unroll
            for (int m = 0; m < 4; ++m)
#pragma unroll
                for (int bj = 0; bj < 2; ++bj) { const bf16_t* p = gp + (size_t)((ai * 4 + m) * 2 + bj) * 4096; ga[m * 2 + bj] = *(const u32x4*)p; gb[m * 2 + bj] = *(const u32x4*)(p + 4 * 65536); }
            __builtin_amdgcn_sched_barrier(0);
#pragma unroll
            for (int m = 0; m < 4; ++m)
#pragma unroll
                for (int bj = 0; bj < 2; ++bj) { f32x4 a0, a1, b0, b1; unpack8(ga[m * 2 + bj], a0, a1); unpack8(gb[m * 2 + bj], b0, b1);
#pragma unroll
                    for (int e = 0; e < 4; ++e) { acc[ai][bj][m][0][e] *= a0[e] * __builtin_amdgcn_rcpf(b0[e]); acc[ai][bj][m][1][e] *= a1[e] * __builtin_amdgcn_rcpf(b1[e]); } }
            __builtin_amdgcn_sched_barrier(0);
        }
    }
};
struct EpiMerge {
    const bf16_t* G; bf16_t* MG;
    DI void operator()(const Acc& acc, const Unit& u, int wr, int wc, int fr, int fq) const {
        const int row0 = u.pm * BM + wr * 64 + fr, col0 = u.pn * BM + wc * 32 + 8 * fq;
        const bf16_t* gp = G + gfrag(u.pm, 8 + u.pn, wr, wc, fr, fq); bf16_t* mp = MG + (size_t)row0 * 1024 + col0;
#pragma unroll
        for (int ai = 0; ai < 2; ++ai) {
            u32x4 gq[8];
#pragma unroll
            for (int m = 0; m < 4; ++m)
#pragma unroll
                for (int bj = 0; bj < 2; ++bj) gq[m * 2 + bj] = *(const u32x4*)(gp + (size_t)((ai * 4 + m) * 2 + bj) * 4096);
            __builtin_amdgcn_sched_barrier(0);
#pragma unroll
            for (int m = 0; m < 4; ++m)
#pragma unroll
                for (int bj = 0; bj < 2; ++bj) { f32x4 g0, g1; unpack8(gq[m * 2 + bj], g0, g1);
                    *(u32x4*)(mp + (size_t)(ai * HALF + m * 16) * 1024 + bj * HALF) = pack8(acc[ai][bj][m][0] * g0, acc[ai][bj][m][1] * g1); }
            __builtin_amdgcn_sched_barrier(0);
        }
    }
};
struct EpiR {
    const float* X; float* R; bf16_t* RB;
    DI void operator()(const Acc& acc, const Unit& u, int wr, int wc, int fr, int fq) const {
        const int row0 = u.pm * BM + wr * 64 + fr, col0 = u.pn * BM + wc * 32 + 8 * fq;
        const size_t base = (size_t)row0 * 1024 + col0;
#pragma unroll
        for (int hb = 0; hb < 4; ++hb) {
            const int ai = hb >> 1, m0 = (hb & 1) * 2;
            f32x4 xq[8];
#pragma unroll
            for (int mm = 0; mm < 2; ++mm)
#pragma unroll
                for (int bj = 0; bj < 2; ++bj) { const size_t off = base + (size_t)(ai * HALF + (m0 + mm) * 16) * 1024 + bj * HALF;
                    xq[(mm * 2 + bj) * 2] = __builtin_nontemporal_load((const f32x4*)(X + off)); xq[(mm * 2 + bj) * 2 + 1] = __builtin_nontemporal_load((const f32x4*)(X + off + 4)); }
            __builtin_amdgcn_sched_barrier(0);
#pragma unroll
            for (int mm = 0; mm < 2; ++mm)
#pragma unroll
                for (int bj = 0; bj < 2; ++bj) { const size_t off = base + (size_t)(ai * HALF + (m0 + mm) * 16) * 1024 + bj * HALF;
                    const f32x4 v0 = xq[(mm * 2 + bj) * 2] * ALPHA + acc[ai][bj][m0 + mm][0], v1 = xq[(mm * 2 + bj) * 2 + 1] * ALPHA + acc[ai][bj][m0 + mm][1];
                    *(f32x4*)(R + off) = v0; *(f32x4*)(R + off + 4) = v1;
                    *(u32x4*)(RB + off) = pack8(v0, v1); }
            __builtin_amdgcn_sched_barrier(0);
        }
    }
};
struct EpiBf {
    bf16_t* O;
    DI void operator()(const Acc& acc, const Unit& u, int wr, int wc, int fr, int fq) const {
        const int row0 = u.pm * BM + wr * 64 + fr, col0 = u.pn * BM + wc * 32 + 8 * fq;
#pragma unroll
        for (int ai = 0; ai < 2; ++ai)
#pragma unroll
            for (int m = 0; m < 4; ++m) { bf16_t* rowp = O + (size_t)(row0 + ai * HALF + m * 16) * 1024 + col0;
#pragma unroll
                for (int bj = 0; bj < 2; ++bj) *(u32x4*)(rowp + bj * HALF) = pack8(acc[ai][bj][m][0], acc[ai][bj][m][1]); }
    }
};
struct EpiR2 {
    float* R; const bf16_t* PP;
    DI void operator()(const Acc& acc, const Unit& u, int wr, int wc, int fr, int fq) const {
        const int row0 = u.pm * BM + wr * 64 + fr, col0 = u.pn * BM + wc * 32 + 8 * fq;
        const size_t base = (size_t)row0 * 1024 + col0;
#pragma unroll
        for (int hb = 0; hb < 4; ++hb) {
            const int ai = hb >> 1, m0 = (hb & 1) * 2;
            f32x4 rq[8]; u32x4 pq[4];
#pragma unroll
            for (int mm = 0; mm < 2; ++mm)
#pragma unroll
                for (int bj = 0; bj < 2; ++bj) { const size_t off = base + (size_t)(ai * HALF + (m0 + mm) * 16) * 1024 + bj * HALF;
                    pq[mm * 2 + bj] = __builtin_nontemporal_load((const u32x4*)(PP + off)); rq[(mm * 2 + bj) * 2] = *(const f32x4*)(R + off); rq[(mm * 2 + bj) * 2 + 1] = *(const f32x4*)(R + off + 4); }
            __builtin_amdgcn_sched_barrier(0);
#pragma unroll
            for (int mm = 0; mm < 2; ++mm)
#pragma unroll
                for (int bj = 0; bj < 2; ++bj) { const size_t off = base + (size_t)(ai * HALF + (m0 + mm) * 16) * 1024 + bj * HALF;
                    f32x4 p0, p1; unpack8(pq[mm * 2 + bj], p0, p1);
                    f32x4 r0 = rq[(mm * 2 + bj) * 2], r1 = rq[(mm * 2 + bj) * 2 + 1];
                    const f32x4 a0 = acc[ai][bj][m0 + mm][0], a1 = acc[ai][bj][m0 + mm][1];
#pragma unroll
                    for (int e = 0; e < 4; ++e) { r0[e] += sigm(a0[e]) * p0[e]; r1[e] += sigm(a1[e]) * p1[e]; }
                    *(f32x4*)(R + off) = r0; *(f32x4*)(R + off + 4) = r1; }
            __builtin_amdgcn_sched_barrier(0);
        }
    }
};
}

DI float row16_sum(float v) {
    v += __builtin_bit_cast(float, __builtin_amdgcn_update_dpp(0, __builtin_bit_cast(int, v), 0xB1, 0xF, 0xF, true));
    v += __builtin_bit_cast(float, __builtin_amdgcn_update_dpp(0, __builtin_bit_cast(int, v), 0x4E, 0xF, 0xF, true));
    v += __builtin_bit_cast(float, __builtin_amdgcn_update_dpp(0, __builtin_bit_cast(int, v), 0x124, 0xF, 0xF, true));
    v += __builtin_bit_cast(float, __builtin_amdgcn_update_dpp(0, __builtin_bit_cast(int, v), 0x128, 0xF, 0xF, true));
    return v;
}
DI int crow(int r, int hi) { return (r & 3) + 8 * (r >> 2) + 4 * hi; }
DI s16x4 vtr(LAS const char* p) { typedef short v4i16_t __attribute__((ext_vector_type(4))); return __builtin_bit_cast(s16x4, __builtin_amdgcn_ds_read_tr16_b64_v4i16((LAS v4i16_t*)p)); }
constexpr int AT_SCR = 112 * 1024, AT_KM = 113 * 1024;
constexpr float NEGBIG = -1e30f;
DI float max3f(float a, float b, float c) { return fmaxf(fmaxf(a, b), c); }

template <int DQK, int KW, int DV, int NROWS, bool ALIBI, bool MOBA, bool PIPE, int NSET>
DI void attn_unit(LAS char* lds, const bf16_t* Qp, int ldq, const bf16_t* Kp, int ldk, const bf16_t* Vp, int ldv,
                  const bf16_t* Zp, int ldz, bf16_t* Yp, int ldy, int q0, float sl2, const float* kmp, float lam, const float* subg, float post) {
    constexpr int NTD = NROWS / 64, NS = DQK / 16, ND = DV / 32, PVG = (DV == 64) ? 2 : 1;
    constexpr int KPITCH = KW * 2 + 16, VPITCH = DV * 2 + 64;
    constexpr int KOFF0 = 0, VOFF0 = 3 * 64 * KPITCH;
    constexpr int KCH = KW / 8, VCH = DV / 8, NKC = 64 * KCH, NVC = 64 * VCH, KPT = (NKC + 511) / 512, VPT = (NVC + 511) / 512;
    static_assert(VOFF0 + 3 * 64 * VPITCH <= AT_SCR, "attention LDS map");
    const int tid = opaque_tid(), lane = tid & 63, r32 = lane & 31, hi = lane >> 5;
    const int wid = __builtin_amdgcn_readfirstlane(tid >> 6);
    const int ro = (NROWS == 256) ? 32 * wid : 32 * (wid & 3);
    const int map = (NROWS == 256) ? 0 : (wid >> 2);
    const int qpos = q0 + ro + r32;
    LAS float* scr = (LAS float*)(lds + AT_SCR) + wid * 32;

    bf16x8 qf[NS];
    { const bf16_t* qrow = Qp + (size_t)qpos * ldq + 64 * map + 8 * hi;
#pragma unroll
      for (int s = 0; s < NS; ++s) qf[s] = *(const bf16x8*)(qrow + 16 * s); }

    unsigned sel = 0xFFu;
    if (MOBA) {
        const int u = q0 >> 8;
        if (u > 3) {
            LAS float* km = (LAS float*)(lds + AT_KM);
            { const int j = tid >> 6, d = tid & 63; if (j < u) km[j * 64 + d] = (kmp[(size_t)(j * 2) * 512 + d] + kmp[(size_t)(j * 2 + 1) * 512 + d]) * (1.f / 256.f); }
            __syncthreads();
            float g[7];
#pragma unroll
            for (int j = 0; j < 7; ++j) { float a = 0.f;
                if (j < u) {
#pragma unroll
                    for (int s = 0; s < 4; ++s) { const f32x4 k0 = *(const LAS f32x4*)(km + j * 64 + 16 * s + 8 * hi), k1 = *(const LAS f32x4*)(km + j * 64 + 16 * s + 8 * hi + 4);
#pragma unroll
                        for (int e = 0; e < 4; ++e) { a += bf2f((bf16_t)qf[s][e]) * k0[e]; a += bf2f((bf16_t)qf[s][4 + e]) * k1[e]; } }
                }
                a += __shfl_xor(a, 32); g[j] = a; }
            sel = 0u;
#pragma unroll
            for (int k = 0; k < 3; ++k) { float best = -INFINITY; int bi = 0;
#pragma unroll
                for (int j = 0; j < 7; ++j) { const bool ok = (j < u) && !((sel >> j) & 1u) && (g[j] > best); best = ok ? g[j] : best; bi = ok ? j : bi; }
                sel |= 1u << bi; }
        }
    }

    f32x16 o[ND];
#pragma unroll
    for (int d0 = 0; d0 < ND; ++d0)
#pragma unroll
        for (int r = 0; r < 16; ++r) o[d0][r] = 0.f;
    f32x16 bias;
#pragma unroll
    for (int r = 0; r < 16; ++r) bias[r] = ALIBI ? sl2 * (float)((r & 3) + 8 * (r >> 2) + 4 * hi) : 0.f;
    const float d32 = ALIBI ? 32.f * sl2 : 0.f;
    float mrun = NEGBIG, lrun = 0.f;
    const int nt = NTD + (q0 >> 6);
    u32x4 kregA[KPT], vregA[VPT], kregB[KPT], vregB[VPT], kregC[KPT], vregC[VPT], kregD[KPT], vregD[VPT];
#define AT_TB(it) ((it) < NTD ? q0 + 64 * (it) : 64 * ((it) - NTD))
#define AT_LOAD(it, kreg, vreg) do { const int _ti = ((it) < nt) ? (it) : nt - 1; const int _kb = AT_TB(_ti); \
        _Pragma("unroll") for (int _i = 0; _i < KPT; ++_i) { const int _c = tid + 512 * _i; if (NKC % 512 == 0 || _i + 1 < KPT || _c < NKC) { const int _r = _c / KCH, _cc = _c % KCH; kreg[_i] = *(const u32x4*)(Kp + (size_t)(_kb + _r) * ldk + 8 * _cc); } } \
        _Pragma("unroll") for (int _i = 0; _i < VPT; ++_i) { const int _c = tid + 512 * _i; if (NVC % 512 == 0 || _i + 1 < VPT || _c < NVC) { const int _r = _c / VCH, _cc = _c % VCH; vreg[_i] = *(const u32x4*)(Vp + (size_t)(_kb + _r) * ldv + 8 * _cc); } } } while (0)
#define AT_STORE(buf, kreg, vreg) do { \
        _Pragma("unroll") for (int _i = 0; _i < KPT; ++_i) { const int _c = tid + 512 * _i; if (NKC % 512 == 0 || _i + 1 < KPT || _c < NKC) { const int _r = _c / KCH, _cc = _c % KCH; *(LAS u32x4*)(lds + KOFF0 + (buf) * 64 * KPITCH + _r * KPITCH + 16 * _cc) = kreg[_i]; } } \
        _Pragma("unroll") for (int _i = 0; _i < VPT; ++_i) { const int _c = tid + 512 * _i; if (NVC % 512 == 0 || _i + 1 < VPT || _c < NVC) { const int _r = _c / VCH, _cc = _c % VCH; *(LAS u32x4*)(lds + VOFF0 + (buf) * 64 * VPITCH + _r * VPITCH + 16 * _cc) = vreg[_i]; } } } while (0)
#define AT_ACTIVE(it) ((it) >= NTD || 64 * (it) <= ro + 31)
#define AT_QK(it, bufi, P0, P1) do { if (AT_ACTIVE(it)) { \
        LAS const char* _Kb = lds + KOFF0 + (bufi) * 64 * KPITCH + r32 * KPITCH + (64 * map + 8 * hi) * 2; \
        _Pragma("unroll") for (int _h = 0; _h < NS; _h += 4) { \
            bf16x8 _kf[8]; \
            _Pragma("unroll") for (int _s = 0; _s < 4; ++_s) if (_h + _s < NS) { _kf[2 * _s] = *(const LAS bf16x8*)(_Kb + 32 * (_h + _s)); _kf[2 * _s + 1] = *(const LAS bf16x8*)(_Kb + 32 * KPITCH + 32 * (_h + _s)); } \
            __builtin_amdgcn_sched_barrier(0); \
            _Pragma("unroll") for (int _s = 0; _s < 4; ++_s) if (_h + _s < NS) { \
                if (_h + _s == 0) { P0 = __builtin_amdgcn_mfma_f32_32x32x16_bf16(_kf[0], qf[0], bias, 0, 0, 0); P1 = __builtin_amdgcn_mfma_f32_32x32x16_bf16(_kf[1], qf[0], bias, 0, 0, 0); } \
                else { P0 = __builtin_amdgcn_mfma_f32_32x32x16_bf16(_kf[2 * _s], qf[_h + _s], P0, 0, 0, 0); P1 = __builtin_amdgcn_mfma_f32_32x32x16_bf16(_kf[2 * _s + 1], qf[_h + _s], P1, 0, 0, 0); } } \
            __builtin_amdgcn_sched_barrier(0); } } } while (0)
    if (NSET == 4) { AT_LOAD(0, kregA, vregA); AT_LOAD(1, kregB, vregB); AT_LOAD(2, kregC, vregC); AT_LOAD(3, kregD, vregD); AT_STORE(0, kregA, vregA); AT_STORE(1, kregB, vregB);
                     AT_LOAD(4, kregA, vregA); AT_LOAD(5, kregB, vregB); }
    else if (NSET == 2) { AT_LOAD(0, kregA, vregA); AT_LOAD(1, kregB, vregB); AT_STORE(0, kregA, vregA); AT_STORE(1, kregB, vregB); AT_LOAD(2, kregA, vregA); AT_LOAD(3, kregB, vregB); }
    else { AT_LOAD(0, kregA, vregA); AT_STORE(0, kregA, vregA); AT_LOAD(1, kregA, vregA); AT_STORE(1, kregA, vregA); AT_LOAD(2, kregA, vregA); }
    __syncthreads();
    const int i16 = lane & 15;
    const int vlane = (4 * hi + (i16 >> 2)) * VPITCH + (16 * ((lane >> 4) & 1) + 4 * (i16 & 3)) * 2;
    f32x16 pa0, pa1, pb0, pb1;
#pragma unroll
    for (int r = 0; r < 16; ++r) { pa0[r] = 0.f; pa1[r] = 0.f; pb0[r] = 0.f; pb1[r] = 0.f; }
    if (PIPE) AT_QK(0, 0, pa0, pa1);
    int bcur = 0;
#define AT_ITER(it, C0, C1, N0, N1, kreg, vreg) do { \
        const int _b1 = (bcur == 2) ? 0 : bcur + 1, _b2 = (_b1 == 2) ? 0 : _b1 + 1; \
        AT_STORE(_b2, kreg, vreg); \
        AT_LOAD((it) + 2 + NSET, kreg, vreg); \
        if (PIPE) { if ((it) + 1 < nt) AT_QK((it) + 1, _b1, N0, N1); } else AT_QK(it, bcur, C0, C1); \
        if (AT_ACTIVE(it)) { \
            LAS const char* _Vb = lds + VOFF0 + bcur * 64 * VPITCH + vlane; \
            bf16x8 _vf[4 * PVG];                      \
            _Pragma("unroll") for (int _e = 0; _e < PVG; ++_e) _Pragma("unroll") for (int _ks = 0; _ks < 4; ++_ks) { \
                const s16x4 _lo = vtr(_Vb + (16 * _ks) * VPITCH + 64 * _e), _hh = vtr(_Vb + (16 * _ks + 8) * VPITCH + 64 * _e); \
                _vf[4 * _e + _ks] = __builtin_shufflevector(_lo, _hh, 0, 1, 2, 3, 4, 5, 6, 7); } \
            __builtin_amdgcn_sched_barrier(0); \
            const int _kb = AT_TB(it); const bool _diag = (it) < NTD; \
            if (_diag) { const int _kq = _kb + 4 * hi - qpos; \
                _Pragma("unroll") for (int _r = 0; _r < 16; ++_r) { const int _dd = _kq + (_r & 3) + 8 * (_r >> 2); if (_dd > 0) C0[_r] = NEGBIG; if (_dd + 32 > 0) C1[_r] = NEGBIG; } } \
            float _m0 = max3f(C0[0], C0[1], C0[2]), _m1 = max3f(C1[0], C1[1], C1[2]); \
            _Pragma("unroll") for (int _r = 3; _r < 15; _r += 2) { _m0 = max3f(_m0, C0[_r], C0[_r + 1]); _m1 = max3f(_m1, C1[_r], C1[_r + 1]); } \
            _m0 = fmaxf(_m0, C0[15]); _m1 = fmaxf(_m1, C1[15]); \
            const float _c0 = ALIBI ? sl2 * (float)(_kb - qpos) : 0.f; \
            float _mx = fmaxf(_m0, _m1 + d32) + _c0; \
            bool _selok = true; if (MOBA && !_diag) _selok = ((sel >> (_kb >> 8)) & 1u) != 0u; \
            if (!_selok) _mx = NEGBIG; \
            { const auto _rr = __builtin_amdgcn_permlane32_swap(__float_as_uint(_mx), __float_as_uint(_mx), false, false); _mx = fmaxf(__uint_as_float(_rr[0]), __uint_as_float(_rr[1])); }     \
            const float _mn = fmaxf(mrun, _mx); \
            if (__any(_mn - mrun > 8.f)) { \
                const float _alpha = __builtin_amdgcn_exp2f(mrun - _mn); lrun *= _alpha; mrun = _mn; \
                scr[r32] = _alpha; \
                asm volatile("s_waitcnt lgkmcnt(0)" ::: "memory"); \
                f32x4 _a4[4]; \
                _Pragma("unroll") for (int _g = 0; _g < 4; ++_g) _a4[_g] = *(const LAS f32x4*)(scr + 8 * _g + 4 * hi); \
                asm volatile("s_waitcnt lgkmcnt(0)" ::: "memory"); \
                _Pragma("unroll") for (int _d0 = 0; _d0 < ND; ++_d0) _Pragma("unroll") for (int _r = 0; _r < 16; ++_r) o[_d0][_r] *= _a4[_r >> 2][_r & 3]; \
            } \
            const float _ms0 = _selok ? (mrun - _c0) : INFINITY, _ms1 = _ms0 - d32; \
            float _ls = 0.f; \
            _Pragma("unroll") for (int _r = 0; _r < 16; ++_r) { C0[_r] = __builtin_amdgcn_exp2f(C0[_r] - _ms0); C1[_r] = __builtin_amdgcn_exp2f(C1[_r] - _ms1); _ls += C0[_r] + C1[_r]; } \
            lrun += _ls; \
            bf16x8 _pa[4]; \
            _Pragma("unroll") for (int _ks = 0; _ks < 2; ++_ks) { u32x4 _w; \
                _w.x = pk2(C0[8 * _ks], C0[8 * _ks + 1]); _w.y = pk2(C0[8 * _ks + 2], C0[8 * _ks + 3]); _w.z = pk2(C0[8 * _ks + 4], C0[8 * _ks + 5]); _w.w = pk2(C0[8 * _ks + 6], C0[8 * _ks + 7]); \
                _pa[_ks] = __builtin_bit_cast(bf16x8, _w); \
                _w.x = pk2(C1[8 * _ks], C1[8 * _ks + 1]); _w.y = pk2(C1[8 * _ks + 2], C1[8 * _ks + 3]); _w.z = pk2(C1[8 * _ks + 4], C1[8 * _ks + 5]); _w.w = pk2(C1[8 * _ks + 6], C1[8 * _ks + 7]); \
                _pa[2 + _ks] = __builtin_bit_cast(bf16x8, _w); } \
            _Pragma("unroll") for (int _d0 = 0; _d0 < ND; _d0 += PVG) { \
                if (_d0 > 0) { \
                    _Pragma("unroll") for (int _e = 0; _e < PVG; ++_e) _Pragma("unroll") for (int _ks = 0; _ks < 4; ++_ks) { \
                        const s16x4 _lo = vtr(_Vb + (16 * _ks) * VPITCH + 64 * (_d0 + _e)), _hh = vtr(_Vb + (16 * _ks + 8) * VPITCH + 64 * (_d0 + _e)); \
                        _vf[4 * _e + _ks] = __builtin_shufflevector(_lo, _hh, 0, 1, 2, 3, 4, 5, 6, 7); } \
                    __builtin_amdgcn_sched_barrier(0); } \
                _Pragma("unroll") for (int _ks = 0; _ks < 4; ++_ks) _Pragma("unroll") for (int _e = 0; _e < PVG; ++_e) \
                    o[_d0 + _e] = __builtin_amdgcn_mfma_f32_32x32x16_bf16(_pa[_ks], _vf[4 * _e + _ks], o[_d0 + _e], 0, 0, 0); \
                __builtin_amdgcn_sched_barrier(0); } \
        } \
        bcur = _b1; \
        asm volatile("s_waitcnt lgkmcnt(0)\n\ts_barrier" ::: "memory"); } while (0)
    if (NSET == 4) {
        for (int it = 0; it < nt; it += 4) {
            AT_ITER(it, pa0, pa1, pb0, pb1, kregC, vregC);
            AT_ITER(it + 1, pb0, pb1, pa0, pa1, kregD, vregD);
            AT_ITER(it + 2, pa0, pa1, pb0, pb1, kregA, vregA);
            AT_ITER(it + 3, pb0, pb1, pa0, pa1, kregB, vregB);
        }
    } else {
        for (int it = 0; it < nt; it += 2) {
            AT_ITER(it, pa0, pa1, pb0, pb1, kregA, vregA);
            if (NSET == 2) AT_ITER(it + 1, pb0, pb1, pa0, pa1, kregB, vregB); else AT_ITER(it + 1, pb0, pb1, pa0, pa1, kregA, vregA);
        }
    }
#undef AT_TB
#undef AT_LOAD
#undef AT_STORE
#undef AT_ACTIVE
#undef AT_QK
#undef AT_ITER
    {
        const float lt = lrun + __shfl_xor(lrun, 32);
        scr[r32] = 1.f / lt;
        asm volatile("s_waitcnt lgkmcnt(0)" ::: "memory");
        f32x4 a4[4];
#pragma unroll
        for (int g = 0; g < 4; ++g) a4[g] = *(const LAS f32x4*)(scr + 8 * g + 4 * hi);
        asm volatile("s_waitcnt lgkmcnt(0)" ::: "memory");
#pragma unroll
        for (int d0 = 0; d0 < ND; ++d0)
#pragma unroll
            for (int r = 0; r < 16; ++r) o[d0][r] *= a4[r >> 2][r & 3];
    }
    if (NROWS == 256) {
#pragma unroll
        for (int d0 = 0; d0 < ND; ++d0)
#pragma unroll
            for (int r = 0; r < 16; ++r) { const size_t row = (size_t)(q0 + ro + crow(r, hi)); const int col = 32 * d0 + r32;
                const float z = bf2f(Zp[row * ldz + col]); Yp[row * ldy + col] = f2bf(o[d0][r] * silu(z)); }
    } else {
        LAS float* xch = (LAS float*)lds;
        if (map == 1) {
#pragma unroll
            for (int d0 = 0; d0 < ND; ++d0)
#pragma unroll
                for (int r = 0; r < 16; ++r) xch[(((wid & 3) * ND + d0) * 16 + r) * 64 + lane] = o[d0][r];
        }
        __syncthreads();
        if (map == 0) {
#pragma unroll
            for (int d0 = 0; d0 < ND; ++d0)
#pragma unroll
                for (int r = 0; r < 16; ++r) o[d0][r] -= lam * xch[(((wid & 3) * ND + d0) * 16 + r) * 64 + lane];
#pragma unroll
            for (int r = 0; r < 16; ++r) { float ss = 0.f;
#pragma unroll
                for (int d0 = 0; d0 < ND; ++d0) ss += o[d0][r] * o[d0][r];
                ss = row16_sum(ss); ss += __shfl_xor(ss, 16);
                const float rs = __builtin_amdgcn_rsqf(ss * (1.f / (float)DV) + 1e-5f) * post;
                const size_t row = (size_t)(q0 + ro + crow(r, hi));
#pragma unroll
                for (int d0 = 0; d0 < ND; ++d0) { const int col = 32 * d0 + r32; const float z = bf2f(Zp[row * ldz + col]);
                    Yp[row * ldy + col] = f2bf(o[d0][r] * rs * subg[col] * silu(z)); } }
        }
        __syncthreads();
    }
}

#define XB_TMO      128
#define XB_XCNT(j)  (256  + 64 * (j))
#define XB_XSUB(j)  (1280 + 64 * (j))
#define XB_XGEN(j)  (2304 + 64 * (j))
#define XB_TOP      3328
#define XB_TOPGEN   3392
#define XCD_BAR_WORDS 3456
#define XB_SPIN_CAP (1u << 22)
DI unsigned xb_ld(unsigned* p)              { return __hip_atomic_load(p, __ATOMIC_RELAXED, __HIP_MEMORY_SCOPE_AGENT); }
DI unsigned xb_add(unsigned* p, unsigned v) { return __hip_atomic_fetch_add(p, v, __ATOMIC_RELAXED, __HIP_MEMORY_SCOPE_AGENT); }
DI unsigned xb_xcc_id() { return (unsigned)__builtin_amdgcn_s_getreg((3 << 11) | 20) & 0xFu; }
#define XB_SPIN(cond, bar) do { unsigned _sp = 0; while (cond) { __builtin_amdgcn_s_sleep(1); \
    if ((++_sp & 255u) == 0u) { if (xb_ld(&(bar)[XB_TMO])) break; if (_sp > XB_SPIN_CAP) { atomicAdd(&(bar)[XB_TMO], 1u); break; } } } } while (0)
DI void xcd_barrier_complete(unsigned* bar, unsigned x, unsigned& nloc, unsigned& nx) {
    const unsigned Gn = gridDim.x;
    unsigned sum, cnt, mine, sp = 0u;
    for (;;) {
        sum = 0u; cnt = 0u; mine = 0u;
#pragma unroll
        for (unsigned j = 0; j < 16; ++j) { const unsigned c = xb_ld(&bar[XB_XCNT(j)]); sum += c; cnt += (c > 0u) ? 1u : 0u; mine = (j == x) ? c : mine; }
        if (sum == Gn) break;
        __builtin_amdgcn_s_sleep(1);
        if ((++sp & 255u) == 0u) { if (xb_ld(&bar[XB_TMO])) break; if (sp > XB_SPIN_CAP) { atomicAdd(&bar[XB_TMO], 1u); break; } }
    }
    nloc = mine > 0u ? mine : 1u; nx = cnt > 0u ? cnt : 1u;
}
DI void xcd_barrier(unsigned* bar, volatile LAS unsigned* st) {
    asm volatile("s_waitcnt vmcnt(0)" ::: "memory");
    __syncthreads();
    if (threadIdx.x == 0) {
        __builtin_amdgcn_s_waitcnt(0);
        const unsigned x = xb_xcc_id();
        unsigned nloc = st[0], nx = st[1];
        if (nloc == 0u) { xcd_barrier_complete(bar, x, nloc, nx); st[0] = nloc; st[1] = nx; }
        const unsigned old = xb_add(&bar[XB_XSUB(x)], 1u);
        const unsigned gen = old / nloc;
        if (old + 1u == (gen + 1u) * nloc) {
            __builtin_amdgcn_fence(__ATOMIC_RELEASE, "agent");
            asm volatile("s_waitcnt vmcnt(0)" ::: "memory");
            const unsigned og = xb_add(&bar[XB_TOP], 1u);
            const unsigned tg = og / nx;
            if (og + 1u == (tg + 1u) * nx) xb_add(&bar[XB_TOPGEN], 1u);
            else XB_SPIN(xb_ld(&bar[XB_TOPGEN]) == tg, bar);
            __builtin_amdgcn_fence(__ATOMIC_ACQUIRE, "agent");
            xb_add(&bar[XB_XGEN(x)], 1u);
            asm volatile("s_waitcnt vmcnt(0)" ::: "memory");
        } else {
            XB_SPIN(xb_ld(&bar[XB_XGEN(x)]) == gen, bar);
            __builtin_amdgcn_fence(__ATOMIC_ACQUIRE, "agent");
            asm volatile("s_waitcnt vmcnt(0)" ::: "memory");
        }
    }
    __syncthreads();
}

struct Params { const float* in[19]; float* out; unsigned char* ws; };

DI void colmap(int kind, int n, int& col, float& cs) {
    cs = 1.f;
    if (kind == 0) {
        if (n < 2048) { col = n; if (n < 512) cs = QS64; }
        else if (n < 2560) col = 2720 + (n - 2048);
        else if (n < 3072) { col = 3232 + (n - 2560); cs = QS64; }
        else if (n < 3584) col = 3744 + (n - 3072);
        else if (n < 4096) col = 4256 + (n - 3584);
        else if (n < 4608) col = 4768 + (n - 4096);
        else if (n < 4864) col = 2432 + (n - 4608);
        else if (n < 5248) col = 2048 + (n - 4864);
        else if (n < 5280) { const int j = n - 5248; col = 2688 + (j >> 1) + 16 * (j & 1); }
        else col = -1;
    } else if (kind == 1) col = n;
    else if (kind == 2) { const int h = n / 96, j = n % 96; if (j < 64) col = h * 96 + j; else { const int jj = j - 64; col = h * 96 + 64 + (jj >> 1) + 16 * (jj & 1); } }
    else { if (n < 512) col = (n >> 6) * 128 + (n & 63); else { const int m = n - 512; col = (m >> 6) * 128 + 64 + (m & 63); } }
}
DI void tr_tile(const float* src, int srcN, int ldd, bf16_t* dst, int kind, int n0, int k0, const float* kscale, LAS float* scr, int tid) {
    { const int nl = tid & 127, kl0 = tid >> 7; int col; float cs; colmap(kind, n0 + nl, col, cs);
      float v[16];
#pragma unroll
      for (int i = 0; i < 16; ++i) { const int kl = kl0 + 4 * i; v[i] = (col >= 0) ? __builtin_nontemporal_load(src + (size_t)(k0 + kl) * srcN + col) : 0.f; }
#pragma unroll
      for (int i = 0; i < 16; ++i) { const int kl = kl0 + 4 * i; float w = v[i] * cs; if (kscale) w *= kscale[k0 + kl]; scr[kl * 129 + nl] = w; } }
    __syncthreads();
    { const int kp = tid & 31;
#pragma unroll
      for (int i = 0; i < 8; ++i) { const int nl = (tid >> 5) + 16 * i;
          *(unsigned*)(dst + (size_t)(n0 + nl) * ldd + k0 + 2 * kp) = pk2(scr[(2 * kp) * 129 + nl], scr[(2 * kp + 1) * 129 + nl]); } }
    __syncthreads();
}
typedef const __attribute__((address_space(4))) Params* KParams0;
DI void convert_weights(KParams0 Pk, int l, bf16_t* WT, LAS float* scr) {
    const int tid = opaque_tid();
    constexpr int T0 = 42 * 16, T1 = T0 + 24 * 16, T2 = T1 + 6 * 6, T3 = T2 + 8 * 4, T4 = T3 + 8 * 8, T5 = T4 + 8 * 8, T6 = T5 + 8 * 8, T7 = T6 + 8 * 16, T8 = T7 + 8 * 16, T9 = T8 + 8 * 4;
    for (int t = blockIdx.x; t < T9; t += gridDim.x) {
        const float* src; int srcN, K, kind, loc, ldd = 0; bf16_t* dst; const float* ks = nullptr;
        if (t < T0) { src = Pk->in[2] + (size_t)l * 1024 * 5280; srcN = 5280; K = 1024; kind = 0; loc = t; dst = WT + OFF_WIN; }
        else if (t < T1) { src = Pk->in[12] + (size_t)l * 1024 * 3072; srcN = 3072; K = 1024; kind = 1; loc = t - T0; dst = WT + OFF_WIN + (size_t)5376 * 1024; }
        else if (t < T2) { src = Pk->in[5] + (size_t)l * 384 * 768; srcN = 768; K = 384; kind = 2; loc = t - T1; dst = WT + OFF_WUQ; ks = Pk->in[3] + l * 384; }
        else if (t < T3) { src = Pk->in[6] + (size_t)l * 256 * 1024; srcN = 1024; K = 256; kind = 3; loc = t - T2; dst = WT + OFF_WUKV; ks = Pk->in[4] + l * 256; }
        else if (t < T4) { src = Pk->in[9] + (size_t)l * 512 * 1024; srcN = 1024; K = 512; kind = 1; loc = t - T3; dst = WT + OFF_WABC; ldd = 1536; }
        else if (t < T5) { src = Pk->in[10] + (size_t)l * 512 * 1024; srcN = 1024; K = 512; kind = 1; loc = t - T4; dst = WT + OFF_WABC + 512; ldd = 1536; }
        else if (t < T6) { src = Pk->in[11] + (size_t)l * 512 * 1024; srcN = 1024; K = 512; kind = 1; loc = t - T5; dst = WT + OFF_WABC + 1024; ldd = 1536; }
        else if (t < T7) { src = Pk->in[14] + (size_t)l * 1024 * 1024; srcN = 1024; K = 1024; kind = 1; loc = t - T6; dst = WT + OFF_WO; }
        else if (t < T8) { src = Pk->in[17] + (size_t)l * 1024 * 1024; srcN = 1024; K = 1024; kind = 1; loc = t - T7; dst = WT + OFF_WPG; }
        else { src = Pk->in[18] + (size_t)l * 256 * 1024; srcN = 1024; K = 256; kind = 1; loc = t - T8; dst = WT + OFF_WP; }
        const int kt = K / 64; const int n0 = (loc / kt) * 128, k0 = (loc % kt) * 64;
        tr_tile(src, srcN, ldd ? ldd : K, dst, kind, n0, k0, ks, scr, tid);
    }
}
DI void convert_rows(const float* src, bf16_t* dst, size_t n) {
    const size_t stride = (size_t)gridDim.x * blockDim.x, ng = n / 8;
    for (size_t i = (size_t)blockIdx.x * blockDim.x + opaque_tid(); i < ng; i += 4 * stride) {
        f32x4 a[4], b[4];
#pragma unroll
        for (int j = 0; j < 4; ++j) { const size_t q = i + j * stride; if (q < ng) { a[j] = __builtin_nontemporal_load((const f32x4*)(src + q * 8)); b[j] = __builtin_nontemporal_load((const f32x4*)(src + q * 8 + 4)); } }
#pragma unroll
        for (int j = 0; j < 4; ++j) { const size_t q = i + j * stride; if (q < ng) *(u32x4*)(dst + q * 8) = pack8(a[j], b[j]); }
    }
}
typedef const __attribute__((address_space(4))) Params* KParams;
DI KParams kparams() { KParams p = (KParams)__builtin_amdgcn_kernarg_segment_ptr(); asm volatile("" : "+s"(p)); return p; }
DI unsigned char* wsbase() { unsigned char* w = kparams()->ws; asm volatile("" : "+s"(w)); return w; }

__global__ void __launch_bounds__(512, 2) fwd_megakernel(Params Punused) {
    extern __shared__ __attribute__((aligned(16))) unsigned char lds_raw[];
    cg::grid_group grid = cg::this_grid();
    LAS unsigned char* lds = (LAS unsigned char*)lds_raw;
#define G opaque_s((int)gridDim.x)
#define cu opaque_s((int)blockIdx.x)
#define XB_  ((bf16_t*)(ws + WS_XB))
#define WT_  ((bf16_t*)(ws + WS_WT))
#define PB_  ((bf16_t*)(ws + WS_PB))
#define Y_   ((bf16_t*)(ws + WS_Y))
#define H_   ((bf16_t*)(ws + WS_H))
#define QB_  ((bf16_t*)(ws + WS_MLA))
#define KB_  (QB_ + (size_t)HM * 768)
#define VB_  (KB_ + (size_t)HM * 768)
#define R_   ((float*)(ws + WS_H))
#define ROPE_ ((float*)(ws + CTL_ROPE))
#define KMP_ ((float*)(ws + CTL_KMP))
#define STQ_ ((float*)(ws + CTL_STQ))
#define STKV_ ((float*)(ws + CTL_STKV))

    if (threadIdx.x < 2) ((volatile LAS unsigned*)(lds + LDS_IDX + 64))[threadIdx.x] = 0u;
    {
        const int tid = opaque_tid();
        KParams P = kparams(); unsigned char* ws = P->ws;
        for (int rep = 0; rep < REP_P0; ++rep) {
        convert_weights(P, 0, WT_, (LAS float*)lds);
        convert_rows(P->in[0], XB_, (size_t)M * D);
        convert_rows(P->in[1], PB_, (size_t)M * 256); }
        float* rope = ROPE_;
        for (int i = cu * 512 + tid; i < SEQ * 16; i += G * 512) {
            const int pos = i >> 4, k = i & 15;
            const float freq = __builtin_amdgcn_exp2f(-(float)k * (13.287712379549449f / 16.f));
            const float ang = (float)pos * freq;
            double rev = (double)ang * 0.15915494309189535; rev -= __builtin_rint(rev);
            const float fr = (float)rev;
            rope[2 * i] = __builtin_amdgcn_cosf(fr); rope[2 * i + 1] = __builtin_amdgcn_sinf(fr);
        }
        if (cu == 0) {
            unsigned* ctl = (unsigned*)(ws + WS_CTL); float* lamv = (float*)(ws + CTL_LAM);
            if (tid < 64) {
#pragma unroll
                for (int l = 0; l < 2; ++l) { const float* dl = P->in[7] + l * 256; float a = dl[tid] * dl[64 + tid], b = dl[128 + tid] * dl[192 + tid];
#pragma unroll
                    for (int s = 1; s < 64; s <<= 1) { a += __shfl_xor(a, s); b += __shfl_xor(b, s); }
                    const float li = (l == 0) ? 0.2f : 0.35550906759096924f;
                    if (tid == 0) lamv[l] = __builtin_amdgcn_exp2f(a * LOG2E) - __builtin_amdgcn_exp2f(b * LOG2E) + li; }
            }
            if (tid < 64) ctl[tid] = 0u;
            if (tid < 128) ((unsigned*)(ws + CTL_DEP))[tid] = 0u;
            { unsigned* bw = (unsigned*)(ws + CTL_BAR); for (int i = tid; i < XCD_BAR_WORDS; i += 512) bw[i] = 0u; }
        }
    }
    grid.sync();
    if (threadIdx.x == 0) { unsigned char* ws = wsbase(); (void)xb_add(&((unsigned*)(ws + CTL_BAR))[XB_XCNT(xb_xcc_id())], 1u); }
#define GSYNC() do { unsigned char* _w = wsbase(); xcd_barrier((unsigned*)(_w + CTL_BAR), (volatile LAS unsigned*)(lds + LDS_IDX + 64)); } while (0)

    for (int l = 0; l < 2; ++l) {
        for (int hf = 0; hf < 2; ++hf) {
            for (int rep = 0; rep < REP_P1; ++rep)
            { unsigned char* ws = wsbase();
              pg8::Gemm g{XB_ + (size_t)hf * HM * D, WT_ + OFF_WIN, D, D}; pg8::P1Order S{G, cu};
              pg8::EpiH E{H_, KB_, KMP_ + (size_t)hf * 32 * 2 * 512, STQ_ + (size_t)hf * HM * 8, STKV_ + (size_t)hf * HM * 4, ROPE_, (unsigned*)(ws + CTL_DEP) + (l * 2 + hf) * 32};
              pg8::gemm_phase(lds, g, S, E); }
            {
                const int Gn = G, rem = 672 % Gn, NE = Gn - rem, e = cu - rem;
                pg8::ListOrder Sq{0, (e >= 0) ? 96 : 0, 3, (e >= 0) ? e : 0, NE}, Skv{96, (e >= 0) ? 224 : 96, 4, (e >= 0) ? e : 0, NE};
                if (opaque_tid() == 0) {
                    unsigned char* ws = wsbase(); unsigned* dep = (unsigned*)(ws + CTL_DEP) + (l * 2 + hf) * 32; pg8::Unit u;
                    for (int pass = 0; pass < 2; ++pass)
                        for (int i = 0; pass == 0 ? Sq.next(i, u) : Skv.next(i, u); ++i) {
                            unsigned sp = 0;
                            while (__hip_atomic_load(dep + u.pm, __ATOMIC_RELAXED, __HIP_MEMORY_SCOPE_AGENT) < 24u) { __builtin_amdgcn_s_sleep(2); if (++sp > (1u << 24)) break; }
                        }
                    __builtin_amdgcn_fence(__ATOMIC_ACQUIRE, "agent");
                    asm volatile("s_waitcnt vmcnt(0)" ::: "memory");
                }
                __syncthreads();
                { unsigned char* ws = wsbase();
                  pg8::Gemm g{H_ + C_CQL, WT_ + OFF_WUQ, HP, 384};
                  pg8::EpiUp<0> E{QB_, KB_, VB_, STQ_ + (size_t)hf * HM * 8, ROPE_}; pg8::gemm_phase(lds, g, Sq, E); }
                { unsigned char* ws = wsbase();
                  pg8::Gemm g{H_ + C_CKV, WT_ + OFF_WUKV, HP, 256};
                  pg8::EpiUp<1> E{QB_, KB_, VB_, STKV_ + (size_t)hf * HM * 4, ROPE_}; pg8::gemm_phase(lds, g, Skv, E); }
            }
            GSYNC();
            {
                for (int vcu = cu; vcu < 256; vcu += G)
                for (int step = 0; ; ++step) {
                    KParams P = kparams(); unsigned char* ws = P->ws;
                    const int x = vcu & 7, sl_ = vcu >> 3;
                    int type, u, bh;
                    if (step < 2) {
                        if (sl_ < 16) { type = 2; bh = 2 * x + (sl_ >> 3); const int j = sl_ & 7; u = (step == 0) ? 15 - j : j; }
                        else { const int t = sl_ - 16; bh = 4 * x + (t >> 2); type = step; u = 7 - (t & 3); }
                    } else {
                        if (opaque_tid() == 0) *(LAS int*)(lds + LDS_IDX) = (int)atomicAdd((unsigned*)(ws + WS_CTL) + 16 + (l * 2 + hf) * 8 + x, 1u);
                        __syncthreads();
                        const int k = *(LAS int*)(lds + LDS_IDX);
                        __syncthreads();
                        if (k >= 32) break;
                        u = 3 - (k >> 3); type = (k & 4) ? 0 : 1; bh = 4 * x + (k & 3);
                    }
                    if (type == 0) {
                        const int bl = bh >> 3, h = bh & 7, bg = 4 * hf + bl; const size_t ho = (size_t)bh * SEQ * 64;
                        const float sl = __builtin_amdgcn_exp2f(-(2.f / 3.f) * (float)(h + (h >> 1) + 2)) * LOG2E;
                        attn_unit<64, 64, 64, 256, true, true, true, 2>((LAS char*)lds, H_ + HM_AQ + ho, 64, H_ + HM_AK + ho, 64, H_ + HM_AV + ho, 64,
                            H_ + (size_t)bl * SEQ * HP + C_AZ + h * 64, HP,
                            Y_ + (size_t)bg * SEQ * 1536 + h * 64, 1536, u * 256, sl, KMP_ + (size_t)bg * 8 * 2 * 512 + h * 64, 0.f, nullptr, 1.f);
                    } else if (type == 1) {
                        const int bl = bh >> 3, h = bh & 7, bg = 4 * hf + bl;
                        attn_unit<96, 96, 64, 256, false, false, true, 2>((LAS char*)lds, QB_ + (size_t)bh * SEQ * 96, 96, KB_ + (size_t)bh * SEQ * 96, 96,
                            VB_ + (size_t)bh * SEQ * 64, 64, H_ + (size_t)bl * SEQ * HP + C_BZ + h * 64, HP,
                            Y_ + 512 + (size_t)bg * SEQ * 1536 + h * 64, 1536, u * 256, 0.f, nullptr, 0.f, nullptr, 1.f);
                    } else {
                        const int bl = bh >> 2, h = bh & 3, bg = 4 * hf + bl; const size_t ho = (size_t)bh * SEQ * 128;
                        const float sl = __builtin_amdgcn_exp2f(-(2.f / 3.f) * (float)(3 * h + 1)) * LOG2E;
                        const float lam = ((const float*)(ws + CTL_LAM))[l];
                        const float post = (l == 0) ? 0.8f : (1.f - 0.35550906759096924f);
                        attn_unit<64, 128, 128, 128, true, false, false, 1>((LAS char*)lds, H_ + HM_CQ + ho, 128, H_ + HM_CK + ho, 128, H_ + HM_CV + ho, 128,
                            H_ + (size_t)bl * SEQ * HP + C_CZ + h * 128, HP,
                            Y_ + 1024 + (size_t)bg * SEQ * 1536 + h * 128, 1536, u * 128, sl, nullptr, lam, P->in[8] + l * 128, post);
                    }
                }
            }
            GSYNC();
        }
        { KParams P = kparams(); unsigned char* ws = P->ws;
          pg8::Gemm g{XB_, WT_ + OFF_WIN + (size_t)5376 * 1024, D, D}; pg8::StaticOrder S; S.init(M, 3072, G, cu);
          pg8::EpiG E{H_, P->in[13] + l * 3072}; pg8::gemm_phase(lds, g, S, E); }
        GSYNC();
        { unsigned char* ws = wsbase();
          pg8::Gemm g{Y_, WT_ + OFF_WABC, 1536, 1536}; pg8::MergeOrder S{cu, G};
          pg8::EpiMerge E{H_, XB_}; pg8::MergeHook HK{H_}; pg8::gemm_phase(lds, g, S, E, HK); }
        GSYNC();
        { KParams P = kparams(); unsigned char* ws = P->ws;
          pg8::Gemm g{XB_, WT_ + OFF_WO, D, D}; pg8::StaticOrder S; S.init(M, D, G, cu);
          pg8::EpiR E{(l == 0) ? P->in[0] : (const float*)P->out, R_, Y_}; pg8::gemm_phase(lds, g, S, E); }
        GSYNC();
        { unsigned char* ws = wsbase();
          pg8::Gemm g{PB_, WT_ + OFF_WP, 256, 256}; pg8::StaticOrder S; S.init(M, D, G, cu);
          pg8::EpiBf E{XB_}; pg8::gemm_phase(lds, g, S, E); }
        { unsigned char* ws = wsbase();
          pg8::Gemm g{Y_, WT_ + OFF_WPG, D, D}; pg8::StaticOrder S; S.init(M, D, G, cu);
          pg8::EpiR2 E{R_, XB_}; pg8::gemm_phase(lds, g, S, E); }
        GSYNC();
        {
            KParams P = kparams(); unsigned char* ws = P->ws;
            const int tid = opaque_tid(), lane = tid & 63, wid = tid >> 6;
            const float* lg = P->in[15] + l * 1024; const float* lb = P->in[16] + l * 1024;
            float* outp = P->out; const float* R = R_; bf16_t* XB = XB_;
            const int gstep = (int)gridDim.x * 8;
            for (int row = (int)blockIdx.x * 8 + wid; row < M; row += 2 * gstep) {
                const bool two = row + gstep < M;
                const float* rp0 = R + (size_t)row * 1024; const float* rp1 = R + (size_t)(two ? row + gstep : row) * 1024;
                f32x4 v[2][4]; float s0 = 0.f, s1 = 0.f;
#pragma unroll
                for (int j = 0; j < 4; ++j) { v[0][j] = __builtin_nontemporal_load((const f32x4*)(rp0 + 4 * lane + 256 * j)); v[1][j] = __builtin_nontemporal_load((const f32x4*)(rp1 + 4 * lane + 256 * j)); }
#pragma unroll
                for (int j = 0; j < 4; ++j) { s0 += (v[0][j][0] + v[0][j][1]) + (v[0][j][2] + v[0][j][3]); s1 += (v[1][j][0] + v[1][j][1]) + (v[1][j][2] + v[1][j][3]); }
#pragma unroll
                for (int k = 1; k < 64; k <<= 1) { s0 += __shfl_xor(s0, k); s1 += __shfl_xor(s1, k); }
                const float mu0 = s0 * (1.f / 1024.f), mu1 = s1 * (1.f / 1024.f); float q0 = 0.f, q1 = 0.f;
#pragma unroll
                for (int j = 0; j < 4; ++j) { v[0][j] -= mu0; v[1][j] -= mu1;
                    q0 += (v[0][j][0] * v[0][j][0] + v[0][j][1] * v[0][j][1]) + (v[0][j][2] * v[0][j][2] + v[0][j][3] * v[0][j][3]);
                    q1 += (v[1][j][0] * v[1][j][0] + v[1][j][1] * v[1][j][1]) + (v[1][j][2] * v[1][j][2] + v[1][j][3] * v[1][j][3]); }
#pragma unroll
                for (int k = 1; k < 64; k <<= 1) { q0 += __shfl_xor(q0, k); q1 += __shfl_xor(q1, k); }
                const float rs0 = __builtin_amdgcn_rsqf(q0 * (1.f / 1024.f) + 1e-5f), rs1 = __builtin_amdgcn_rsqf(q1 * (1.f / 1024.f) + 1e-5f);
#pragma unroll
                for (int j = 0; j < 4; ++j) { const f32x4 gv = *(const f32x4*)(lg + 4 * lane + 256 * j), bv = *(const f32x4*)(lb + 4 * lane + 256 * j);
#pragma unroll
                    for (int t = 0; t < 2; ++t) { if (t == 1 && !two) break;
                        const size_t rr = (size_t)(t == 0 ? row : row + gstep);
                        const f32x4 y = v[t][j] * (t == 0 ? rs0 : rs1) * gv + bv;
                        __builtin_nontemporal_store(y, (f32x4*)(outp + rr * 1024 + 4 * lane + 256 * j));
                        if (l == 0) { u32x2 w; w.x = pk2(y[0], y[1]); w.y = pk2(y[2], y[3]); *(u32x2*)(XB + rr * 1024 + 4 * lane + 256 * j) = w; } } }
            }
            if (l == 0) {
                __syncthreads();
                convert_weights(P, 1, WT_, (LAS float*)lds);
                convert_rows(P->in[1] + (size_t)M * 256, PB_, (size_t)M * 256);
            }
        }
        if (l == 0) GSYNC();
    }
}

#undef G
#undef cu
extern "C" void kernel_launch(void* const* d_in, const int* in_sizes, int n_in, void* d_out, int out_size, void* d_ws, size_t ws_size, hipStream_t stream) {
    static int grid_blocks = 0;
    if (grid_blocks == 0) {
        if (n_in != 19 || out_size != M * D || ws_size < WS_END) { fprintf(stderr, "kernel_launch: unexpected problem (n_in %d out %d ws %zu)\n", n_in, out_size, ws_size); grid_blocks = -1; return; }
        int dev = 0, cus = 0, per_cu = 0;
        hipGetDevice(&dev);
        hipDeviceGetAttribute(&cus, hipDeviceAttributeMultiprocessorCount, dev);
        if (hipFuncSetAttribute((const void*)fwd_megakernel, hipFuncAttributeMaxDynamicSharedMemorySize, LDS_BYTES) != hipSuccess) { fprintf(stderr, "kernel_launch: hipFuncSetAttribute failed\n"); grid_blocks = -1; return; }
        if (hipOccupancyMaxActiveBlocksPerMultiprocessor(&per_cu, (const void*)fwd_megakernel, 512, LDS_BYTES) != hipSuccess || per_cu < 1) { fprintf(stderr, "kernel_launch: occupancy query failed (%d)\n", per_cu); grid_blocks = -1; return; }
        grid_blocks = cus * per_cu;
        if (grid_blocks > 256) grid_blocks = 256;
    }
    if (grid_blocks < 0) return;
    Params p{};
    for (int i = 0; i < 19; ++i) p.in[i] = (const float*)d_in[i];
    p.out = (float*)d_out; p.ws = (unsigned char*)d_ws;
    void* args[] = {&p};
    hipError_t e = hipLaunchCooperativeKernel((const void*)fwd_megakernel, dim3(grid_blocks), dim3(512), args, LDS_BYTES, stream);
    if (e != hipSuccess) fprintf(stderr, "cooperative launch failed: %s (grid %d)\n", hipGetErrorString(e), grid_blocks);
}
```
